# Optimizing an MI355X kernel written in HIP

```python
import jax, jax.numpy as jnp
from jax import lax
import numpy as np

D_MODEL = 1024
BATCH = 2
SEQ = 16384
DEPTH = 4

GRID_W = 64
CTX_LEN = 256
N_HEADS = 8
QK_NOPE_DIM = 64
QK_ROPE_DIM = 32
QK_HEAD_DIM = QK_NOPE_DIM + QK_ROPE_DIM
V_HEAD_DIM = 64
Q_LORA_RANK = 256
KV_LORA_RANK = 128
MLA_WIDTH = N_HEADS * V_HEAD_DIM
ROPE_AXIS_DIM = QK_ROPE_DIM // 2
ROPE_BASE = 10000.0
Q_BLOCK = 128
FOURIER_GROUPS = 4
FOURIER_GROUP_DIM = 128
FOURIER_WIDTH = FOURIER_GROUPS * FOURIER_GROUP_DIM
MIX_WIDTH = MLA_WIDTH + FOURIER_WIDTH
IN_PROJ_WIDTH = Q_LORA_RANK + KV_LORA_RANK + QK_ROPE_DIM + FOURIER_WIDTH
N_EXPERTS = 16
N_EXPERT_GROUPS = 4
EXPERTS_PER_GROUP = N_EXPERTS // N_EXPERT_GROUPS
TOP_K = 2
D_EXPERT = 256
EXPERT_BLOCK = 128
EPS = 1e-6

kernel_name = "hymba_mla_fnet_grouped_moe_dit"


def rms_norm(x, g):
    xf = x.astype(jnp.float32)
    y = xf * lax.rsqrt(jnp.mean(xf * xf, axis=-1, keepdims=True) + EPS)
    return (y * g.astype(jnp.float32)).astype(x.dtype)


def modulate(h, shift, scale):
    return h * (1 + scale) + shift


def grid_angles(n_lat):
    rows = n_lat // GRID_W
    row = jnp.repeat(jnp.arange(rows, dtype=jnp.float32), GRID_W)
    col = jnp.tile(jnp.arange(GRID_W, dtype=jnp.float32), rows)
    half = ROPE_AXIS_DIM // 2
    freqs = ROPE_BASE ** (-jnp.arange(half, dtype=jnp.float32) / half)
    return row[:, None] * freqs, col[:, None] * freqs


def rope_1d(x, ang):
    f = x.shape[-1] // 2
    cos = jnp.cos(ang)[None, :, None, :].astype(x.dtype)
    sin = jnp.sin(ang)[None, :, None, :].astype(x.dtype)
    x1, x2 = x[..., :f], x[..., f:]
    return jnp.concatenate([x1 * cos - x2 * sin, x2 * cos + x1 * sin], axis=-1)


def rope_tail_2d(t, ang_row, ang_col):
    nope, rp = t[..., :QK_NOPE_DIM], t[..., QK_NOPE_DIM:]
    rp = jnp.concatenate([rope_1d(rp[..., :ROPE_AXIS_DIM], ang_row),
                          rope_1d(rp[..., ROPE_AXIS_DIM:], ang_col)], axis=-1)
    return jnp.concatenate([nope, rp], axis=-1)


def mla_queries(cq, q_a_norm, w_q_b, q_norm, ang_row, ang_col):
    B, N, _ = cq.shape
    q = (rms_norm(cq, q_a_norm) @ w_q_b).reshape(B, N, N_HEADS, QK_HEAD_DIM)
    q = rms_norm(q, q_norm)
    if ang_row is not None:
        q = rope_tail_2d(q, ang_row, ang_col)
    return q


def mla_keys_values(ckv, k_rope, kv_a_norm, w_kv_b, k_norm, ang_row, ang_col):
    B, N, _ = ckv.shape
    kv = (rms_norm(ckv, kv_a_norm) @ w_kv_b).reshape(B, N, N_HEADS, QK_NOPE_DIM + V_HEAD_DIM)
    k_nope, v = kv[..., :QK_NOPE_DIM], kv[..., QK_NOPE_DIM:]
    k_r = jnp.broadcast_to(k_rope[:, :, None, :], (B, N, N_HEADS, QK_ROPE_DIM))
    k = rms_norm(jnp.concatenate([k_nope, k_r], axis=-1), k_norm)
    if ang_row is not None:
        k = rope_tail_2d(k, ang_row, ang_col)
    return k, v


def blocked_attention(q, k, v):
    B, Nq, H, Dq = q.shape
    nb = Nq // Q_BLOCK
    qb = q.reshape(B, nb, Q_BLOCK, H, Dq).transpose(1, 0, 2, 3, 4)
    kt = k.transpose(0, 2, 1, 3)
    vt = v.transpose(0, 2, 1, 3)
    scale = QK_HEAD_DIM ** -0.5

    def one_block(qblk):
        s = jnp.einsum('bqhd,bhkd->bhqk', qblk, kt).astype(jnp.float32) * scale
        p = jax.nn.softmax(s, axis=-1).astype(vt.dtype)
        return jnp.einsum('bhqk,bhkd->bqhd', p, vt)

    o = lax.map(one_block, qb)
    return o.transpose(1, 0, 2, 3, 4).reshape(B, Nq, H * V_HEAD_DIM)


def fourier_mix(f, w_fourier):
    B, N, _ = f.shape
    z = f.reshape(B, N, FOURIER_GROUPS, FOURIER_GROUP_DIM).astype(jnp.float32)
    zr = jnp.fft.fft2(z, axes=(1, 3), norm="ortho").real.astype(f.dtype)
    return jnp.einsum('bngc,gcd->bngd', zr, w_fourier).reshape(B, N, FOURIER_WIDTH)


def hybrid_mixer(h_ctx, h_lat, ang_row, ang_col, w_in, q_a_norm, w_q_b, kv_a_norm, w_kv_b,
                 q_norm, k_norm, w_fourier, w_out, with_ctx_out):
    cuts = [Q_LORA_RANK, Q_LORA_RANK + KV_LORA_RANK, Q_LORA_RANK + KV_LORA_RANK + QK_ROPE_DIM]
    cq_c, ckv_c, kr_c, f_c = jnp.split(h_ctx @ w_in, cuts, axis=-1)
    cq_l, ckv_l, kr_l, f_l = jnp.split(h_lat @ w_in, cuts, axis=-1)
    k_c, v_c = mla_keys_values(ckv_c, kr_c, kv_a_norm, w_kv_b, k_norm, None, None)
    k_l, v_l = mla_keys_values(ckv_l, kr_l, kv_a_norm, w_kv_b, k_norm, ang_row, ang_col)
    k_all = jnp.concatenate([k_c, k_l], axis=1)
    v_all = jnp.concatenate([v_c, v_l], axis=1)
    q_l = mla_queries(cq_l, q_a_norm, w_q_b, q_norm, ang_row, ang_col)
    o_lat = blocked_attention(q_l, k_all, v_all)
    out_lat = jnp.concatenate([o_lat, fourier_mix(f_l, w_fourier)], axis=-1) @ w_out
    out_ctx = None
    if with_ctx_out:
        q_c = mla_queries(cq_c, q_a_norm, w_q_b, q_norm, None, None)
        o_ctx = blocked_attention(q_c, k_c, v_c)
        out_ctx = jnp.concatenate([o_ctx, fourier_mix(f_c, w_fourier)], axis=-1) @ w_out
    return out_ctx, out_lat


def grouped_moe(h, router_w, router_bias, w_gate, w_up, w_down):
    T, D = h.shape
    scores = jax.nn.sigmoid((h @ router_w).astype(jnp.float32))
    biased = (scores + router_bias.astype(jnp.float32)).reshape(T, N_EXPERT_GROUPS, EXPERTS_PER_GROUP)
    group_score = lax.top_k(biased, TOP_K)[0].sum(-1)
    grp = jnp.argmax(group_score, axis=-1).astype(jnp.int32)
    in_grp = jnp.take_along_axis(biased, grp[:, None, None], axis=1)[:, 0]
    _, local = lax.top_k(in_grp, TOP_K)
    expert = grp[:, None] * EXPERTS_PER_GROUP + local.astype(jnp.int32)
    wts = jnp.take_along_axis(scores, expert, axis=1)
    wts = wts / jnp.sum(wts, axis=-1, keepdims=True)
    A = T * TOP_K
    e = expert.reshape(A)
    tok = jnp.repeat(jnp.arange(T, dtype=jnp.int32), TOP_K)
    w = wts.reshape(A)
    order = jnp.argsort(e)
    e_s, tok_s, w_s = e[order], tok[order], w[order]
    counts = jnp.zeros((N_EXPERTS,), jnp.int32).at[e].add(1)
    padded = (counts + EXPERT_BLOCK - 1) // EXPERT_BLOCK * EXPERT_BLOCK
    pad_end = jnp.cumsum(padded)
    pad_start = pad_end - padded
    raw_start = jnp.cumsum(counts) - counts
    dest = pad_start[e_s] + jnp.arange(A, dtype=jnp.int32) - raw_start[e_s]
    n_blocks = -(-A // EXPERT_BLOCK) + N_EXPERTS
    P = n_blocks * EXPERT_BLOCK
    buf_tok = jnp.zeros((P,), jnp.int32).at[dest].set(tok_s)
    xb = h[buf_tok].reshape(n_blocks, EXPERT_BLOCK, D)
    blk_start = jnp.arange(n_blocks, dtype=jnp.int32) * EXPERT_BLOCK
    blk_e = jnp.minimum(jnp.searchsorted(pad_end, blk_start, side='right'), N_EXPERTS - 1)

    def expert_block(args):
        xblk, ei = args
        return (jax.nn.silu(xblk @ w_gate[ei]) * (xblk @ w_up[ei])) @ w_down[ei]

    yb = lax.map(expert_block, (xb, blk_e)).reshape(P, D)
    y = yb[dest] * w_s[:, None].astype(h.dtype)
    return jnp.zeros_like(h).at[tok_s].add(y)


def setup_inputs(seed: int = 0) -> dict:
    key = jax.random.key(seed)
    ks = jax.random.split(key, 24)
    D, L, E = D_MODEL, DEPTH, N_EXPERTS
    nrm = lambda k, shape, fan_in: jax.random.normal(k, shape, jnp.float32) * fan_in ** -0.5
    gain = lambda k, shape: 1.0 + 0.02 * jax.random.normal(k, shape, jnp.float32)
    return {
        "x": jax.random.normal(ks[0], (BATCH, SEQ, D), jnp.float32),
        "c": jax.random.normal(ks[1], (BATCH, D), jnp.float32),
        "ctx": jax.random.normal(ks[2], (BATCH, CTX_LEN, D), jnp.float32),
        "c_ctx": jax.random.normal(ks[3], (D,), jnp.float32),
        "w_ada": nrm(ks[4], (L, D, 6 * D), D) * 0.5,
        "b_ada": 0.01 * jax.random.normal(ks[5], (L, 6 * D), jnp.float32),
        "norm_mix": gain(ks[6], (L, D)),
        "norm_ffn": gain(ks[7], (L, D)),
        "w_in": nrm(ks[8], (L, D, IN_PROJ_WIDTH), D),
        "q_a_norm": gain(ks[9], (L, Q_LORA_RANK)),
        "w_q_b": nrm(ks[10], (L, Q_LORA_RANK, N_HEADS * QK_HEAD_DIM), Q_LORA_RANK),
        "kv_a_norm": gain(ks[11], (L, KV_LORA_RANK)),
        "w_kv_b": nrm(ks[12], (L, KV_LORA_RANK, N_HEADS * (QK_NOPE_DIM + V_HEAD_DIM)), KV_LORA_RANK),
        "q_norm": gain(ks[13], (L, QK_HEAD_DIM)),
        "k_norm": gain(ks[14], (L, QK_HEAD_DIM)),
        "w_fourier": nrm(ks[15], (L, FOURIER_GROUPS, FOURIER_GROUP_DIM, FOURIER_GROUP_DIM), FOURIER_GROUP_DIM),
        "w_out": nrm(ks[16], (L, MIX_WIDTH, D), MIX_WIDTH),
        "router_w": nrm(ks[17], (D, E), D),
        "router_bias": 0.01 * jax.random.normal(ks[18], (E,), jnp.float32),
        "w_gate": nrm(ks[19], (L, E, D, D_EXPERT), D),
        "w_up": nrm(ks[20], (L, E, D, D_EXPERT), D),
        "w_down": nrm(ks[21], (L, E, D_EXPERT, D), D_EXPERT),
    }


def reference(x, c, ctx, c_ctx, w_ada, b_ada, norm_mix, norm_ffn, w_in, q_a_norm, w_q_b,
              kv_a_norm, w_kv_b, q_norm, k_norm, w_fourier, w_out, router_w, router_bias,
              w_gate, w_up, w_down):
    B, S, D = x.shape
    n_ctx = ctx.shape[1]
    ang_row, ang_col = grid_angles(S)
    for l in range(DEPTH):
        last = l == DEPTH - 1
        mod_lat = (jax.nn.silu(c) @ w_ada[l] + b_ada[l])[:, None, :]
        mod_ctx = jax.nn.silu(c_ctx) @ w_ada[l] + b_ada[l]
        sh1, sc1, g1, sh2, sc2, g2 = jnp.split(mod_lat, 6, axis=-1)
        csh1, csc1, cg1, csh2, csc2, cg2 = jnp.split(mod_ctx, 6, axis=-1)
        h_lat = modulate(rms_norm(x, norm_mix[l]), sh1, sc1)
        h_ctx = modulate(rms_norm(ctx, norm_mix[l]), csh1, csc1)
        mix_ctx, mix_lat = hybrid_mixer(h_ctx, h_lat, ang_row, ang_col, w_in[l], q_a_norm[l], w_q_b[l],
                                        kv_a_norm[l], w_kv_b[l], q_norm[l], k_norm[l], w_fourier[l],
                                        w_out[l], not last)
        x = x + g1 * mix_lat
        f_lat = modulate(rms_norm(x, norm_ffn[l]), sh2, sc2).reshape(B * S, D)
        if last:
            y = grouped_moe(f_lat, router_w, router_bias, w_gate[l], w_up[l], w_down[l])
            x = x + g2 * y.reshape(B, S, D)
        else:
            ctx = ctx + cg1 * mix_ctx
            f_ctx = modulate(rms_norm(ctx, norm_ffn[l]), csh2, csc2).reshape(B * n_ctx, D)
            y = grouped_moe(jnp.concatenate([f_ctx, f_lat], axis=0), router_w, router_bias,
                            w_gate[l], w_up[l], w_down[l])
            ctx = ctx + cg2 * y[:B * n_ctx].reshape(B, n_ctx, D)
            x = x + g2 * y[B * n_ctx:].reshape(B, S, D)
    return x
```

```cpp
#include <hip/hip_runtime.h>
#include <hip/hip_bf16.h>
#include <cstdint>
#include <cstdio>

#define DEVI __device__ __forceinline__
#define PC_U0 0


#define EXP_WAIT() asm volatile("s_waitcnt vmcnt(0)" ::: "memory")

#define CHECKSEL 8
#ifndef REPMASK
#define REPMASK 0
#endif
#ifndef PHMASK
#define PHMASK 0xffff
#endif

constexpr int D = 1024, BATCH = 2, SEQ = 16384, DEPTH = 4, NCTX = 256;
constexpr int T_CTX = BATCH * NCTX, T_LAT = BATCH * SEQ, T = T_CTX + T_LAT;
constexpr int NH = 8, DQK = 96, DV = 64, QLR = 256, KVLR = 128;
constexpr int NKEY = NCTX + SEQ;
constexpr int INW = 928;
constexpr int ZLD = 1024;
constexpr int NE = 16, DE = 256, NCLS = 24;
constexpr float EPS = 1e-6f;
constexpr float ATT_QSCALE = 0.10206207261596577f * 1.4426950408889634f;
constexpr int NTHR = 512;

constexpr size_t al256(size_t x) { return (x + 255) / 256 * 256; }
constexpr size_t WS_CTL   = 0;
constexpr size_t CTL_BYTES = 65536;
constexpr size_t CTL_CNT_OFF = 32768;
constexpr size_t WS_COEF  = WS_CTL + CTL_BYTES;
constexpr size_t WS_F1    = WS_COEF + al256((size_t)4 * 3 * 6 * 1024 * 4);
constexpr size_t WS_F2    = WS_F1 + 256 * 256 * 2;
constexpr size_t WS_FC    = WS_F2 + 128 * 256 * 2;
constexpr size_t WS_TW    = WS_FC + 256 * 512 * 2;
constexpr size_t WS_ROPE  = WS_TW + 16384 * 8;
constexpr size_t WS_WIN   = WS_ROPE + 256 * 8 * 8;
constexpr size_t WS_WOUT  = WS_WIN + (size_t)4 * 1024 * 1024 * 2;
constexpr size_t WS_WGU   = WS_WOUT + (size_t)4 * 1024 * 1024 * 2;
constexpr size_t WS_WDN   = WS_WGU + (size_t)4 * 16 * 1024 * 512 * 2;
constexpr size_t WS_WQT   = WS_WDN + (size_t)4 * NCLS * 1024 * 512 * 2;
constexpr size_t WS_WKVT  = WS_WQT + (size_t)4 * 768 * 256 * 2;
constexpr size_t WS_WCS   = WS_WKVT + (size_t)4 * 1024 * 128 * 2;
constexpr size_t WS_CTXR  = WS_WCS + (size_t)4 * 4 * 128 * 256 * 2;
constexpr size_t WS_RCLS  = WS_CTXR + (size_t)T_CTX * 1024 * 4;
constexpr size_t WS_RW    = WS_RCLS + al256((size_t)T * 4);
constexpr size_t WS_CLIST = WS_RW + al256((size_t)T * 8);
constexpr size_t WS_HBUF  = WS_CLIST + al256((size_t)NCLS * T * 4);
constexpr size_t WS_MODP  = WS_HBUF;
constexpr size_t WS_ZBUF  = WS_HBUF + (size_t)T * 1024 * 2;
constexpr size_t WS_QBUF  = WS_ZBUF + (size_t)T * 1024 * 2;
constexpr size_t WS_QCTX  = WS_QBUF + (size_t)BATCH * NH * SEQ * DQK * 2;
constexpr size_t WS_KBUF  = WS_QCTX + (size_t)BATCH * NH * NCTX * DQK * 2;
constexpr size_t WS_VBUF  = WS_KBUF + (size_t)BATCH * NH * NKEY * DQK * 2;
constexpr size_t WS_UBUF  = WS_VBUF + (size_t)BATCH * NH * NKEY * DV * 2;
constexpr size_t WS_P1    = WS_UBUF;
constexpr size_t WS_UCTX  = WS_UBUF + (size_t)2 * 4 * 128 * 128 * 256 * 2;
static_assert(WS_UCTX + (size_t)T_CTX * 1024 * 2 <= WS_UBUF + (size_t)T * 1024 * 2, "P1 + ctx U fit the U region");
constexpr size_t WS_END   = WS_UBUF + (size_t)T * 1024 * 2;
static_assert((size_t)2 * 4 * 128 * 128 * 256 * 2 <= (size_t)T * 1024 * 2, "P1 fits zbuf region");
static_assert((size_t)(T + NCLS * 256) * 512 * 2 <= (size_t)BATCH * NH * NKEY * DQK * 2, "Hmoe (class-padded rows) fits kbuf region");
static_assert(WS_END <= (size_t)4 * T_LAT * D * 4, "workspace map must fit 4 x the largest tensor (the guaranteed d_ws size)");

constexpr int LDS_GEMM = 0;
constexpr int LDS_STAT = 128 * 1024;
constexpr int LDS_MISC = 132 * 1024;
constexpr int LDS_BYTES = 133 * 1024;

#define XB_TMO      128
#define XB_XCNT(j)  (256  + 64 * (j))
#define XB_XSUB(j)  (1280 + 64 * (j))
#define XB_XGEN(j)  (2304 + 64 * (j))
#define XB_TOP      3328
#define XB_TOPGEN   3392
#define XCD_BAR_WORDS 3456
#define XB_SPIN_CAP (1u << 24)
#define LAS __attribute__((address_space(3)))

DEVI unsigned xb_ld(unsigned* p)              { return __hip_atomic_load(p, __ATOMIC_RELAXED, __HIP_MEMORY_SCOPE_AGENT); }
DEVI unsigned xb_add(unsigned* p, unsigned v) { return __hip_atomic_fetch_add(p, v, __ATOMIC_RELAXED, __HIP_MEMORY_SCOPE_AGENT); }
DEVI unsigned xb_xcc_id() { return (unsigned)__builtin_amdgcn_s_getreg((3 << 11) | 20) & 0xFu; }
#define XB_SPIN(cond, bar) do { unsigned _sp = 0; while (cond) { __builtin_amdgcn_s_sleep(1); \
    if ((++_sp & 255u) == 0u) { if (xb_ld(&(bar)[XB_TMO])) break; if (_sp > XB_SPIN_CAP) { atomicAdd(&(bar)[XB_TMO], 1u); break; } } } } while (0)

struct XcdBarrier { unsigned* bar; unsigned x; volatile LAS unsigned* st; };

DEVI XcdBarrier xcd_barrier_post(unsigned* bar, volatile LAS unsigned* st) {
    XcdBarrier b; b.bar = bar; b.x = xb_xcc_id(); b.st = st;
    if (threadIdx.x == 0) (void)xb_add(&bar[XB_XCNT(b.x)], 1u);
    return b;
}
DEVI void xcd_barrier_complete(unsigned* bar, unsigned x, unsigned& nloc, unsigned& nx) {
    const unsigned G = gridDim.x * gridDim.y * gridDim.z;
    unsigned sum, cnt, mine, sp = 0u;
    for (;;) {
        sum = 0u; cnt = 0u; mine = 0u;
#pragma unroll
        for (unsigned j = 0; j < 16; ++j) { const unsigned c = xb_ld(&bar[XB_XCNT(j)]); sum += c; cnt += (c > 0u) ? 1u : 0u; mine = (j == x) ? c : mine; }
        if (sum == G) break;
        __builtin_amdgcn_s_sleep(1);
        if ((++sp & 255u) == 0u) { if (xb_ld(&bar[XB_TMO])) break; if (sp > XB_SPIN_CAP) { atomicAdd(&bar[XB_TMO], 1u); break; } }
    }
    nloc = mine > 0u ? mine : 1u; nx = cnt > 0u ? cnt : 1u;
}
DEVI void xcd_barrier(const XcdBarrier& b) {
    asm volatile("s_waitcnt vmcnt(0)" ::: "memory");
    __syncthreads();
    if (threadIdx.x == 0) {
        unsigned* bar = b.bar;
        __builtin_amdgcn_s_waitcnt(0);
        unsigned nloc = b.st[0], nx = b.st[1];
        if (nloc == 0u) { xcd_barrier_complete(bar, b.x, nloc, nx); b.st[0] = nloc; b.st[1] = nx; }
        const unsigned old = xb_add(&bar[XB_XSUB(b.x)], 1u);
        const unsigned gen = old / nloc;
        if (old + 1u == (gen + 1u) * nloc) {
            __builtin_amdgcn_fence(__ATOMIC_RELEASE, "agent");
            asm volatile("s_waitcnt vmcnt(0)" ::: "memory");
            const unsigned og = xb_add(&bar[XB_TOP], 1u);
            const unsigned tg = og / nx;
            if (og + 1u == (tg + 1u) * nx) xb_add(&bar[XB_TOPGEN], 1u);
            else XB_SPIN(xb_ld(&bar[XB_TOPGEN]) == tg, bar);
            __builtin_amdgcn_fence(__ATOMIC_ACQUIRE, "agent");
            xb_add(&bar[XB_XGEN(b.x)], 1u);
            asm volatile("s_waitcnt vmcnt(0)" ::: "memory");
        } else {
            XB_SPIN(xb_ld(&bar[XB_XGEN(b.x)]) == gen, bar);
            __builtin_amdgcn_fence(__ATOMIC_ACQUIRE, "agent");
            asm volatile("s_waitcnt vmcnt(0)" ::: "memory");
        }
    }
    __syncthreads();
}

using bf16x8 = __attribute__((ext_vector_type(8))) short;
using s16x4  = __attribute__((ext_vector_type(4))) short;
using f32x16 = __attribute__((ext_vector_type(16))) float;
using f32x4  = __attribute__((ext_vector_type(4))) float;
using u32x4  = __attribute__((ext_vector_type(4))) unsigned;
using u32x2  = __attribute__((ext_vector_type(2))) unsigned;
#define SBAR() __builtin_amdgcn_sched_barrier(0)

DEVI int crow(int r, int hi) { return (r & 3) + 8 * (r >> 2) + 4 * hi; }
DEVI unsigned cvtpk(float lo, float hi) { unsigned r; asm volatile("v_cvt_pk_bf16_f32 %0, %1, %2" : "=v"(r) : "v"(lo), "v"(hi)); return r; }
DEVI unsigned short f2bf(float x) { return (unsigned short)(cvtpk(x, 0.f) & 0xffffu); }
DEVI float bf2f(unsigned short u) { return __uint_as_float(((unsigned)u) << 16); }
DEVI float bflo(unsigned u) { return __uint_as_float(u << 16); }
DEVI float bfhi(unsigned u) { return __uint_as_float(u & 0xffff0000u); }
DEVI float wave_sum(float v) {
#pragma unroll
    for (int o = 32; o > 0; o >>= 1) v += __shfl_xor(v, o, 64);
    return v;
}
DEVI float silu(float x) { return x * __builtin_amdgcn_rcpf(1.f + __expf(-x)); }

DEVI int row_variant(int r) { return r < T_CTX ? 2 : ((r - T_CTX) >> 14); }

template <int BN> DEVI int nn_st(int k, int c) {
    const int kk = (k & ~0xC) | ((k & 4) << 1) | ((k & 8) >> 1);
    return ((kk >> 3) * (BN / 32) + (c >> 5)) * 512 + ((kk & 7) * 32 + (c & 31)) * 2;
}
DEVI int nn_rd_base(int lane) { return ((lane & 3) << 3) | (((lane >> 2) & 3) << 6) | (((lane >> 4) & 1) << 5) | (((lane >> 5) & 1) << 8); }
template <int OFF> DEVI s16x4 tr_read(int vb) {
    s16x4 r; asm volatile("ds_read_b64_tr_b16 %0, %1 offset:%2" : "=&v"(r) : "v"(vb), "i"(OFF) : "memory"); return r;
}
#define PK8(L, H) (bf16x8){L[0], L[1], L[2], L[3], H[0], H[1], H[2], H[3]}

typedef s16x4 LAS * lds_s16x4_ptr;
template <int MB, int NB, int WM, int WN, bool BNN, bool SWAPC, int STAGES = 2, bool BRES = false, class AF, class BF, class EF>
DEVI void gemm_tile(char* lds, int nk_in, AF arow, BF brow, EF epi) {
    int nk = nk_in; asm volatile("" : "+s"(nk));
    constexpr int BM = 32 * MB * WM, BN = 32 * NB * WN;
    constexpr int ABYTES = BM * 128, BBYTES = BN * 128;
    constexpr int ACH = BM / 64, BCH = BN / 64;
    static_assert(WM * WN == 8, "8 waves");
    static_assert(2 * ABYTES + 2 * BBYTES <= 128 * 1024, "LDS");
    int tid = threadIdx.x; asm volatile("" : "+v"(tid)); const int lane = tid & 63, wid = __builtin_amdgcn_readfirstlane(tid >> 6);
    const int wm = wid / WN, wn = wid % WN, r32 = lane & 31, hi = lane >> 5;
    LAS char* Abase = (LAS char*)lds; LAS char* Bbase = BRES ? Abase + 65536 : Abase + 2 * ABYTES;
    static_assert(!BRES || 2 * ABYTES <= 65536, "resident B image sits at +64 KB");
    const short* ap[ACH]; int aoff[ACH];
#pragma unroll
    for (int i = 0; i < ACH; ++i) { const int id = tid + NTHR * i, row = id >> 3, c = id & 7; ap[i] = (const short*)arow(row) + c * 8; aoff[i] = row * 128 + ((c ^ ((row >> 1) & 7)) << 4); }
    const short* bp[BCH]; int boff[BCH];
#pragma unroll
    for (int i = 0; i < BCH; ++i) {
        const int id = tid + NTHR * i;
        if constexpr (!BNN) { const int row = id >> 3, c = id & 7; bp[i] = (const short*)brow(row) + c * 8; boff[i] = row * 128 + ((c ^ ((row >> 1) & 7)) << 4); }
        else { const int krow = id / (BN / 8), c = id % (BN / 8); boff[i] = nn_st<BN>(krow, c * 8); bp[i] = nullptr; }
    }
    const int swz = (r32 >> 1) & 7;
    const int afr0 = (wm * 32 * MB + r32) * 128, bfr0 = (wn * 32 * NB + r32) * 128;
    const int bvb = nn_rd_base(lane) + wn * NB * 512;

    f32x16 acc[MB][NB];
#pragma unroll
    for (int i = 0; i < MB; ++i)
#pragma unroll
        for (int j = 0; j < NB; ++j) acc[i][j] = f32x16{};
    bf16x8 ra0[ACH], rb0[BCH], ra1[ACH], rb1[BCH];
#define G_LOAD(RA, RB, T) do {                                                                                                     \
        _Pragma("unroll") for (int i = 0; i < ACH; ++i) RA[i] = *(const bf16x8*)(ap[i] + (T) * 64);                                \
        if constexpr (!BRES) { _Pragma("unroll") for (int i = 0; i < BCH; ++i) { if constexpr (!BNN) RB[i] = *(const bf16x8*)(bp[i] + (T) * 64);          \
            else { const int id = tid + NTHR * i; RB[i] = *(const bf16x8*)((const short*)brow((T) * 64 + id / (BN / 8)) + (id % (BN / 8)) * 8); } } } } while (0)
#define G_WRITE(RA, RB, BUF) do {                                                                                                  \
        _Pragma("unroll") for (int i = 0; i < ACH; ++i) *(LAS bf16x8*)(Abase + (BUF) * ABYTES + aoff[i]) = RA[i];                  \
        if constexpr (!BRES) { _Pragma("unroll") for (int i = 0; i < BCH; ++i) *(LAS bf16x8*)(Bbase + (BUF) * BBYTES + boff[i]) = RB[i]; } } while (0)
#define G_COMPUTE(BUF, KT) do {                                                                                                    \
        LAS const char* As = Abase + (BUF) * ABYTES; LAS const char* Bs = Bbase + (BRES ? (KT) : (BUF)) * BBYTES;                  \
        _Pragma("unroll") for (int ks = 0; ks < 4; ++ks) {                                                                         \
            bf16x8 a[MB], b[NB];                                                                                                   \
            const int so = ((ks * 2 + hi) ^ swz) << 4;                                                                             \
            _Pragma("unroll") for (int mb = 0; mb < MB; ++mb) a[mb] = *(LAS const bf16x8*)(As + afr0 + so + mb * 4096);            \
            _Pragma("unroll") for (int nb = 0; nb < NB; ++nb) {                                                                    \
                if constexpr (BNN) {                                                                                               \
                    const s16x4 l = __builtin_amdgcn_ds_read_tr16_b64_v4i16((lds_s16x4_ptr)(Bs + bvb + nb * 512 + ks * (2 * (BN / 32) * 512)));                        \
                    const s16x4 h = __builtin_amdgcn_ds_read_tr16_b64_v4i16((lds_s16x4_ptr)(Bs + bvb + nb * 512 + ks * (2 * (BN / 32) * 512) + (BN / 32) * 512));      \
                    b[nb] = PK8(l, h);                                                                                             \
                } else b[nb] = *(LAS const bf16x8*)(Bs + bfr0 + so + nb * 4096);                                                   \
            }                                                                                                                      \
            _Pragma("unroll") for (int mb = 0; mb < MB; ++mb)                                                                      \
                _Pragma("unroll") for (int nb = 0; nb < NB; ++nb) acc[mb][nb] = SWAPC ? __builtin_amdgcn_mfma_f32_32x32x16_bf16(b[nb], a[mb], acc[mb][nb], 0, 0, 0) : __builtin_amdgcn_mfma_f32_32x32x16_bf16(a[mb], b[nb], acc[mb][nb], 0, 0, 0); \
        } } while (0)
    if constexpr (STAGES == 2) {
    G_LOAD(ra0, rb0, 0); G_LOAD(ra1, rb1, 1); SBAR();
    G_WRITE(ra0, rb0, 0);
    __syncthreads();
    int kt = 0;
    for (; kt + 2 < nk; kt += 2) {
        SBAR(); G_LOAD(ra0, rb0, kt + 2); SBAR();
        G_COMPUTE(0, kt); SBAR();
        G_WRITE(ra1, rb1, 1);
        __syncthreads();
        SBAR(); G_LOAD(ra1, rb1, kt + 3); SBAR();
        G_COMPUTE(1, kt + 1); SBAR();
        G_WRITE(ra0, rb0, 0);
        __syncthreads();
    }
    SBAR(); G_COMPUTE(0, kt); SBAR();
    G_WRITE(ra1, rb1, 1);
    __syncthreads();
    SBAR(); G_COMPUTE(1, kt + 1); SBAR();
    __syncthreads();
    } else {
    G_LOAD(ra0, rb0, 0); SBAR();
    G_WRITE(ra0, rb0, 0);
    __syncthreads();
    for (int kt = 0; kt < nk; ++kt) {
        const int cur = kt & 1;
        if (kt + 1 < nk) { SBAR(); G_LOAD(ra0, rb0, kt + 1); SBAR(); }
        G_COMPUTE(cur, kt); SBAR();
        if (kt + 1 < nk) G_WRITE(ra0, rb0, cur ^ 1);
        __syncthreads();
    }
    }
#undef G_LOAD
#undef G_WRITE
#undef G_COMPUTE
    epi(acc, wm, wn);
}


typedef __attribute__((address_space(1))) const unsigned* g8_gptr;
typedef __attribute__((address_space(3))) unsigned* g8_lptr;
constexpr int G8_HT = 128 * 64;
DEVI int g8_lds_byte(int r, int c) { const int st = (r >> 4) * 2 + (c >> 5), rr = r & 15, cc = c & 31, ob = rr * 64 + cc * 2; return st * 1024 + (ob ^ (((ob >> 9) & 1) << 5)); }
DEVI void g8_stage_rc(int b, int& R, int& C) { const int st = b / 1024, sb = b % 1024, swz = sb ^ (((sb >> 9) & 1) << 5); R = (st >> 1) * 16 + swz / 64; C = (st & 1) * 32 + (swz % 64) / 2; }
typedef f32x4 g8_acc[2][2][4][2];

template <bool GATHER, int NPASS, class EPI>
DEVI void gemm256(char* ldsb, int nt, const short* A, int lda, const int* ltok, const short* Bt, int ldb, int apass, const short* Bt2, EPI epi) {
    short* shm = (short*)ldsb;
#define SA(b, h) (shm + ((b) * 2 + (h)) * G8_HT)
#define SB(b, h) (shm + (4 + (b) * 2 + (h)) * G8_HT)
#define STAGE_A(P_, h_, kt_) do { _Pragma("unroll") for (int _i = 0; _i < 2; ++_i) { \
        const unsigned _o = (GATHER ? ao[(h_) * 2 + _i] : ao[0] + (unsigned)(((h_) * 128 + _i * 64) * lda * 2)) + (unsigned)((kt_) * 128); \
        __builtin_amdgcn_global_load_lds((g8_gptr)((const char*)A + (size_t)_o), (g8_lptr)((char*)(P_) + tz * 16 + _i * 8192), 16, 0, 0); } } while (0)
#define STAGE_B(P_, h_, kt_) do { _Pragma("unroll") for (int _i = 0; _i < 2; ++_i) { \
        const unsigned _o = bo + (unsigned)(((h_) * 128 + _i * 64) * ldb * 2) + (unsigned)((kt_) * 128); \
        __builtin_amdgcn_global_load_lds((g8_gptr)((const char*)Bt + (size_t)_o), (g8_lptr)((char*)(P_) + tz * 16 + _i * 8192), 16, 0, 0); } } while (0)
#define LDA(dst, b, h) _Pragma("unroll") for (int m = 0; m < 4; ++m) _Pragma("unroll") for (int k = 0; k < 2; ++k) \
        dst[m][k] = *reinterpret_cast<const bf16x8*>((char*)SA(b, h) + g8_lds_byte(wr * 64 + m * 16 + fr, k * 32 + fq * 8))
#define LDB(dst, b, h) _Pragma("unroll") for (int n = 0; n < 2; ++n) _Pragma("unroll") for (int k = 0; k < 2; ++k) \
        dst[n][k] = *reinterpret_cast<const bf16x8*>((char*)SB(b, h) + g8_lds_byte(wc * 32 + n * 16 + fr, k * 32 + fq * 8))
#define MMA(ai, bj, At_, Bt_) do { __builtin_amdgcn_s_setprio(1); \
        _Pragma("unroll") for (int m = 0; m < 4; ++m) _Pragma("unroll") for (int n = 0; n < 2; ++n) _Pragma("unroll") for (int k = 0; k < 2; ++k) \
            acc[ai][bj][m][n] = __builtin_amdgcn_mfma_f32_16x16x32_bf16(Bt_[n][k], At_[m][k], acc[ai][bj][m][n], 0, 0, 0); \
        __builtin_amdgcn_s_setprio(0); } while (0)
#define WAIT_V(n) asm volatile("s_waitcnt vmcnt(" #n ")" ::: "memory")
#define WAIT_L(n) asm volatile("s_waitcnt lgkmcnt(" #n ")" ::: "memory")
#define BAR __builtin_amdgcn_s_barrier()
#define SCHED __builtin_amdgcn_sched_barrier(0)
    int tz = threadIdx.x; asm volatile("" : "+v"(tz));
    int wid = __builtin_amdgcn_readfirstlane(tz >> 6), lane = tz & 63, wr = wid >> 2, wc = wid & 3, fr = lane & 15, fq = lane >> 4;
    unsigned ao[4], bo;
    { int r0, c0; g8_stage_rc(tz * 16, r0, c0);
      if constexpr (GATHER) {
#pragma unroll
          for (int q = 0; q < 4; ++q) ao[q] = (unsigned)(ltok[(q >> 1) * 128 + (q & 1) * 64 + r0] * lda + c0) * 2u;
      } else { ao[0] = (unsigned)(r0 * lda + c0) * 2u; ao[1] = ao[2] = ao[3] = 0; }
      bo = (unsigned)(r0 * ldb + c0) * 2u; }
    g8_acc acc;
#pragma unroll
    for (int a = 0; a < 2; ++a)
#pragma unroll
        for (int b = 0; b < 2; ++b)
#pragma unroll
            for (int m = 0; m < 4; ++m)
#pragma unroll
                for (int n = 0; n < 2; ++n) acc[a][b][m][n] = f32x4{0, 0, 0, 0};
    bf16x8 At[4][2], B0[2][2], B1[2][2];
#pragma unroll 1
    for (int pass = 0; pass < NPASS; ++pass) {
    if (pass == 1) { A += apass; Bt = Bt2;
        tz = threadIdx.x; asm volatile("" : "+v"(tz)); wid = __builtin_amdgcn_readfirstlane(tz >> 6); lane = tz & 63; wr = wid >> 2; wc = wid & 3; fr = lane & 15; fq = lane >> 4; }
    STAGE_B(SB(0, 0), 0, 0); STAGE_A(SA(0, 0), 0, 0);
    STAGE_B(SB(0, 1), 1, 0); STAGE_A(SA(0, 1), 1, 0);
    if (wr == 1) BAR;
    WAIT_V(4); BAR;
    STAGE_B(SB(1, 0), 0, 1); STAGE_A(SA(1, 0), 0, 1); STAGE_B(SB(1, 1), 1, 1);
    WAIT_V(6); BAR;
    for (int t = 0; t < nt - 2; t += 2) {
        LDB(B0, 0, 0); SCHED; LDA(At, 0, 0); STAGE_A(SA(1, 1), 1, t + 1);
        WAIT_L(8); BAR; WAIT_L(0); MMA(0, 0, At, B0); BAR; SCHED;
        LDB(B1, 0, 1); STAGE_B(SB(0, 0), 0, t + 2);
        BAR; WAIT_L(0); MMA(0, 1, At, B1); BAR;
        LDA(At, 0, 1); STAGE_A(SA(0, 0), 0, t + 2);
        BAR; WAIT_L(0); MMA(1, 0, At, B0); BAR; SCHED;
        STAGE_B(SB(0, 1), 1, t + 2);
        WAIT_V(6); BAR; MMA(1, 1, At, B1); BAR;
        LDB(B0, 1, 0); SCHED; LDA(At, 1, 0); STAGE_A(SA(0, 1), 1, t + 2);
        WAIT_L(8); BAR; WAIT_L(0); MMA(0, 0, At, B0); BAR; SCHED;
        LDB(B1, 1, 1); STAGE_B(SB(1, 0), 0, t + 3);
        BAR; WAIT_L(0); MMA(0, 1, At, B1); BAR;
        LDA(At, 1, 1); STAGE_A(SA(1, 0), 0, t + 3);
        BAR; WAIT_L(0); MMA(1, 0, At, B0); BAR; SCHED;
        STAGE_B(SB(1, 1), 1, t + 3);
        WAIT_V(6); BAR; MMA(1, 1, At, B1); BAR;
    }
    tz = threadIdx.x; asm volatile("" : "+v"(tz)); wid = __builtin_amdgcn_readfirstlane(tz >> 6); lane = tz & 63; wr = wid >> 2; wc = wid & 3; fr = lane & 15; fq = lane >> 4;
    { int r0, c0; g8_stage_rc(tz * 16, r0, c0);
      if constexpr (GATHER) {
#pragma unroll
          for (int q = 2; q < 4; ++q) ao[q] = (unsigned)(ltok[(q >> 1) * 128 + (q & 1) * 64 + r0] * lda + c0) * 2u;
      } else ao[0] = (unsigned)(r0 * lda + c0) * 2u; }
    { LDB(B0, 0, 0); WAIT_V(0); LDA(At, 0, 0); STAGE_A(SA(1, 1), 1, nt - 1);
      BAR; WAIT_L(0); MMA(0, 0, At, B0); BAR;
      LDB(B1, 0, 1); BAR; WAIT_L(0); MMA(0, 1, At, B1); BAR;
      LDA(At, 0, 1); WAIT_V(4); BAR; WAIT_L(0); MMA(1, 0, At, B0); MMA(1, 1, At, B1); BAR; }
    { LDB(B0, 1, 0); LDA(At, 1, 0); WAIT_V(2); BAR; WAIT_L(0); MMA(0, 0, At, B0); BAR;
      LDB(B1, 1, 1); WAIT_V(0); BAR; WAIT_L(0); MMA(0, 1, At, B1); BAR;
      LDA(At, 1, 1); BAR; WAIT_L(0); MMA(1, 0, At, B0); MMA(1, 1, At, B1); BAR; }
    if (wr == 0) BAR;
    }
    SBAR();
    epi(acc, wr, wc, fr, fq);
#undef SA
#undef SB
#undef STAGE_A
#undef STAGE_B
#undef LDA
#undef LDB
#undef MMA
#undef WAIT_V
#undef WAIT_L
#undef BAR
#undef SCHED
}
template <class F> DEVI void g8_for_acc(g8_acc& acc, int wr, int wc, int fr, int fq, F f) {
#pragma unroll
    for (int ai = 0; ai < 2; ++ai)
#pragma unroll
        for (int m = 0; m < 4; ++m)
        {
#pragma unroll
            for (int bj = 0; bj < 2; ++bj) { SBAR();
#pragma unroll
                for (int n = 0; n < 2; ++n) f(ai * 128 + wr * 64 + m * 16 + fr, bj * 128 + wc * 32 + n * 16 + fq * 4, acc[ai][bj][m][n]); } }
}

struct Params { const float* in[22]; float* out; char* ws; int nphases; int ph_lo; };

struct Ctx { float* out; char* ws; char* lds; int G, vcu; };
#define TID_SETUP() int tid = threadIdx.x; asm volatile("" : "+v"(tid)); const int lane = tid & 63; const int wid = __builtin_amdgcn_readfirstlane(tid >> 6); (void)lane; (void)wid

DEVI float* res_row(const Ctx& c, int r) { return r < T_CTX ? (float*)(c.ws + WS_CTXR) + (size_t)r * D : c.out + (size_t)(r - T_CTX) * D; }
DEVI const float* res_row_src(const Params& P, const Ctx& c, int r, int layer) {
    if (layer == 0) return r < T_CTX ? P.in[2] + (size_t)r * D : P.in[0] + (size_t)(r - T_CTX) * D;
    return res_row(c, r);
}

DEVI void cls_experts(int cls, int& ea, int& eb);
DEVI void phase_prologue(const Params& P, const Ctx& c) {
    TID_SETUP();
    const long gtid = (long)blockIdx.x * NTHR + tid; const long gsz = (long)c.G * NTHR;
    float* sv = (float*)(c.lds + LDS_GEMM);
    for (int i = tid; i < 3 * 1024; i += NTHR) { const int v = i >> 10, k = i & 1023; const float x = (v < 2) ? P.in[1][v * 1024 + k] : P.in[3][k]; sv[i] = silu(x); }
    float* tc = sv + 3 * 1024;
    for (int i = tid; i < 128; i += NTHR) { tc[i] = cospif(i / 64.f); tc[128 + i] = sinpif(i / 64.f); }
    __syncthreads();
    {
        float* modp = (float*)(c.ws + WS_MODP);
        const float* w_ada = P.in[4];
        for (long it = gtid; it < (long)8 * 4 * 6144; it += gsz) {
            const int j = (int)(it % 6144); const int l = (int)((it / 6144) & 3); const int ks = (int)(it / (6144 * 4));
            const float* w = w_ada + ((size_t)l * 1024 + ks * 128) * 6144 + j;
            float a0 = 0, a1 = 0, a2 = 0;
            for (int k = 0; k < 128; ++k) { const float wv = w[(size_t)k * 6144]; const int kk = ks * 128 + k; a0 += sv[kk] * wv; a1 += sv[1024 + kk] * wv; a2 += sv[2048 + kk] * wv; }
            float* o = modp + ((size_t)(ks * 4 + l) * 3) * 6144 + j;
            o[0] = a0; o[6144] = a1; o[2 * 6144] = a2;
        }
    }
    {
        float* tl = (float*)(c.lds + LDS_GEMM + 16384);
        const int NT_IN = 4 * 16 * 15, NT_OUT = 4 * 16 * 16, NT_GU = 4 * 16 * 16 * 4 * 2, NT_DN = 4 * NCLS * 2 * 4 * 16;
        struct TD { const float* s; short* d; int sld, dld, k0, n0, nvalid, mode; };
        auto desc = [&](int tix) { TD t; t.mode = 0;
            if (tix < NT_IN) { const int l = tix / 240, r = tix % 240, kt = r / 15, nt2 = r % 15; t.s = P.in[8] + (size_t)l * 1024 * INW; t.sld = INW; t.d = (short*)(c.ws + WS_WIN) + (size_t)l * 1024 * 1024; t.dld = 1024; t.k0 = kt * 64; t.n0 = nt2 * 64; t.nvalid = INW; }
            else if (tix < NT_IN + NT_OUT) { const int t2 = tix - NT_IN; const int l = t2 >> 8, r = t2 & 255; t.s = P.in[16] + (size_t)l * 1024 * 1024; t.sld = 1024; t.d = (short*)(c.ws + WS_WOUT) + (size_t)l * 1024 * 1024; t.dld = 1024; t.k0 = (r >> 4) * 64; t.n0 = (r & 15) * 64; t.nvalid = 1024; }
            else if (tix < NT_IN + NT_OUT + NT_GU) { const int t2 = tix - NT_IN - NT_OUT; const int gu = t2 & 1, r = t2 >> 1; const int le = r >> 6, kt = (r >> 2) & 15, nt2 = r & 3;
                t.s = (gu ? P.in[20] : P.in[19]) + (size_t)le * 1024 * 256; t.sld = 256; t.d = (short*)(c.ws + WS_WGU) + (size_t)le * 512 * 1024; t.dld = 1024; t.k0 = kt * 64; t.n0 = nt2 * 64; t.nvalid = 256; t.mode = 1 + gu; }
            else { const int t2 = tix - NT_IN - NT_OUT - NT_GU; const int lch = t2 >> 6, kt = (t2 >> 4) & 3, nt2 = t2 & 15; const int half = lch & 1, lc = lch >> 1, cl = lc % NCLS, l = lc / NCLS;
                int ea, eb; cls_experts(cl, ea, eb); const int e = half ? eb : ea;
                t.s = P.in[21] + (size_t)(l * 16 + e) * 256 * 1024; t.sld = 1024; t.d = (short*)(c.ws + WS_WDN) + (size_t)lc * 1024 * 512 + half * 256; t.dld = 512; t.k0 = kt * 64; t.n0 = nt2 * 64; t.nvalid = 1024; }
            return t; };
        const int NTILES = NT_IN + NT_OUT + NT_GU + NT_DN;
        const int lkk = tid >> 3, lcg = (tid & 7) * 8;
        f32x4 x0 = {0, 0, 0, 0}, x1 = {0, 0, 0, 0};
        auto tload = [&](const TD& t) { x0 = f32x4{0, 0, 0, 0}; x1 = f32x4{0, 0, 0, 0};
            if (t.n0 + lcg < t.nvalid) { const float* sp = t.s + (size_t)(t.k0 + lkk) * t.sld + t.n0 + lcg; x0 = *(const f32x4*)sp; x1 = *(const f32x4*)(sp + 4); } };
        int tix = blockIdx.x, pb = 0;
        TD cur = desc(tix < NTILES ? tix : 0);
        __syncthreads();
        if (tix < NTILES) tload(cur);
        for (; tix < NTILES; tix += c.G, pb ^= 1) {
            float* tlb = tl + pb * (64 * 65);
#pragma unroll
            for (int j = 0; j < 4; ++j) { tlb[lkk * 65 + lcg + j] = x0[j]; tlb[lkk * 65 + lcg + 4 + j] = x1[j]; }
            const TD nxt = desc(tix + c.G < NTILES ? tix + c.G : 0);
            if (tix + c.G < NTILES) tload(nxt);
            __syncthreads();
            { const int n = tid >> 3, kg = (tid & 7) * 8; const int nn = cur.n0 + n;
              if (nn < cur.nvalid) { float v[8];
#pragma unroll
                for (int j = 0; j < 8; ++j) v[j] = tlb[(kg + j) * 65 + n];
                const int drow = cur.mode == 0 ? nn : ((nn >> 4) * 32 + (cur.mode - 1) * 16 + (nn & 15));
                *(u32x4*)(cur.d + (size_t)drow * cur.dld + cur.k0 + kg) = u32x4{cvtpk(v[0], v[1]), cvtpk(v[2], v[3]), cvtpk(v[4], v[5]), cvtpk(v[6], v[7])}; } }
            cur = nxt;
        }
        __syncthreads();
        { short* d = (short*)(c.ws + WS_WIN);
          for (long it = gtid; it < (long)4 * 96 * 128; it += gsz) { const int k8 = (int)(it & 127); const long lr = it >> 7; const int l = (int)(lr / 96), rr = (int)(lr % 96);
              *(u32x4*)(d + ((size_t)l * 1024 + INW + rr) * 1024 + k8 * 8) = u32x4{0, 0, 0, 0}; } }
    }
    {
        short* dst = (short*)(c.ws + WS_WQT);
        for (long it = gtid; it < (long)4 * 768 * 256; it += gsz) { const int k = (int)(it & 255); const long lf = it >> 8; const int f = (int)(lf % 768), l = (int)(lf / 768);
            dst[it] = (short)f2bf(P.in[9][l * 256 + k] * P.in[10][((size_t)l * 256 + k) * 768 + f]); }
        dst = (short*)(c.ws + WS_WKVT);
        for (long it = gtid; it < (long)4 * 1024 * 128; it += gsz) { const int k = (int)(it & 127); const long lf = it >> 7; const int f = (int)(lf & 1023), l = (int)(lf >> 10);
            dst[it] = (short)f2bf(P.in[11][l * 128 + k] * P.in[12][((size_t)l * 128 + k) * 1024 + f]); }
    }
    {
        short* dst = (short*)(c.ws + WS_WCS); const float* wf = P.in[15];
        for (long it = gtid; it < (long)4 * 4 * 128 * 256; it += gsz) {
            const int d = (int)(it & 127), ab = (int)((it >> 7) & 1), cc = (int)((it >> 8) & 127); const long lg = it >> 15;
            const float* w = wf + lg * 128 * 128 + d; const float* tt = tc + ab * 128;
            float a = 0;
            for (int j = 0; j < 128; ++j) a += tt[(cc * j) & 127] * w[j * 128];
            dst[it] = (short)f2bf(a * 0.08838834764831845f);
        }
    }
    {
        short* f1 = (short*)(c.ws + WS_F1);
        for (long it = gtid; it < 256 * 256; it += gsz) { const int kk = (int)(it & 255), m = (int)(it >> 8); const int k1 = (m >> 6) * 32 + (m & 31), ri = (m >> 5) & 1, n1 = kk >> 1, ab = kk & 1;
            const int a = (n1 * k1) & 127; const float cs = tc[a], sn = tc[128 + a];
            const float v = (ri == 0) ? (ab == 0 ? cs : -sn) : (ab == 0 ? -sn : -cs);
            f1[it] = (short)f2bf(v * 0.08838834764831845f); }
        short* f2 = (short*)(c.ws + WS_F2);
        for (long it = gtid; it < 128 * 256; it += gsz) { const int kk = (int)(it & 255), k2 = (int)(it >> 8); const int n2 = kk >> 1, ri = kk & 1;
            const int a = (n2 * k2) & 127; f2[it] = (short)f2bf((ri == 0 ? tc[a] : tc[128 + a]) * 0.08838834764831845f); }
        short* fc = (short*)(c.ws + WS_FC);
        for (long it = gtid; it < 256 * 512; it += gsz) { const int kk = (int)(it & 511), k = (int)(it >> 9); const int n = kk >> 1, ab = kk & 1;
            const int a = (n * k) & 255; const float v = ab == 0 ? cospif(a / 128.f) : -sinpif(a / 128.f); fc[it] = (short)f2bf(v * 0.0625f); }
        float2* tw = (float2*)(c.ws + WS_TW);
        for (long it = gtid; it < 16384; it += gsz) tw[it] = make_float2(cospif((float)it / 8192.f), sinpif((float)it / 8192.f));
        float2* rp = (float2*)(c.ws + WS_ROPE);
        for (long it = gtid; it < 256 * 8; it += gsz) { const int i = (int)(it & 7), pos = (int)(it >> 3); const float fr = powf(10000.f, -(float)i / 8.f); const float ang = (float)pos * fr;
            rp[it] = make_float2(cosf(ang), sinf(ang)); }
    }
}

DEVI void phase_coef(const Params& P, const Ctx& c) {
    TID_SETUP();
    const long gtid = (long)blockIdx.x * NTHR + tid; const long gsz = (long)c.G * NTHR;
    const float* modp = (const float*)(c.ws + WS_MODP); float* coef = (float*)(c.ws + WS_COEF);
    for (long it = gtid; it < (long)4 * 3 * 6144; it += gsz) {
        const int j = (int)(it % 6144); const int v = (int)((it / 6144) % 3); const int l = (int)(it / (6144 * 3));
        float m = P.in[5][l * 6144 + j];
        for (int ks = 0; ks < 8; ++ks) m += modp[((size_t)(ks * 4 + l) * 3 + v) * 6144 + j];
        const int chunk = j >> 10, col = j & 1023;
        float val; int slot;
        if (chunk == 0) { slot = 1; val = m; } else if (chunk == 1) { slot = 0; val = P.in[6][l * 1024 + col] * (1.f + m); } else if (chunk == 2) { slot = 2; val = m; }
        else if (chunk == 3) { slot = 4; val = m; } else if (chunk == 4) { slot = 3; val = P.in[7][l * 1024 + col] * (1.f + m); } else { slot = 5; val = m; }
        coef[((size_t)(l * 3 + v) * 6 + slot) * 1024 + col] = val;
    }
}

DEVI void phase_norm_mix(const Params& P, const Ctx& c, int l) {
    TID_SETUP();
    const float* coef = (const float*)(c.ws + WS_COEF) + (size_t)l * 3 * 6 * 1024;
    short* hbuf = (short*)(c.ws + WS_HBUF);
    for (int r = c.vcu * 8 + wid; r < T; r += c.G * 8) {
        const float* x = res_row_src(P, c, r, l); const int v = row_variant(r);
        const float* a1 = coef + (size_t)(v * 6 + 0) * 1024; const float* b1 = coef + (size_t)(v * 6 + 1) * 1024;
        f32x4 xv[4]; float ss = 0;
#pragma unroll
        for (int i = 0; i < 4; ++i) { xv[i] = *(const f32x4*)(x + i * 256 + lane * 4); ss += xv[i][0] * xv[i][0] + xv[i][1] * xv[i][1] + xv[i][2] * xv[i][2] + xv[i][3] * xv[i][3]; }
        ss = wave_sum(ss); const float rstd = rsqrtf(ss * (1.f / 1024.f) + EPS);
#pragma unroll
        for (int i = 0; i < 4; ++i) { const int col = i * 256 + lane * 4; const f32x4 a = *(const f32x4*)(a1 + col), b = *(const f32x4*)(b1 + col);
            u32x2 o = {cvtpk(xv[i][0] * rstd * a[0] + b[0], xv[i][1] * rstd * a[1] + b[1]), cvtpk(xv[i][2] * rstd * a[2] + b[2], xv[i][3] * rstd * a[3] + b[3])};
            *(u32x2*)(hbuf + (size_t)r * 1024 + col) = o; }
    }
}

DEVI u32x4 pack8(const float* p) {
    const unsigned a0 = cvtpk(p[0], p[1]), a1 = cvtpk(p[2], p[3]), b0 = cvtpk(p[4], p[5]), b1 = cvtpk(p[6], p[7]);
    auto r0 = __builtin_amdgcn_permlane32_swap(a0, b0, false, false); auto r1 = __builtin_amdgcn_permlane32_swap(a1, b1, false, false);
    return u32x4{r0[0], r1[0], r0[1], r1[1]};
}
template <int MB, int NB, class F> DEVI void for_acc_bf8(f32x16 (&acc)[MB][NB], int wm, int wn, int lane, F f) {
    const int r32 = lane & 31, hi = lane >> 5;
#pragma unroll
    for (int mb = 0; mb < MB; ++mb)
#pragma unroll
        for (int nb = 0; nb < NB; ++nb)
#pragma unroll
            for (int s = 0; s < 2; ++s) { float t[8];
#pragma unroll
                for (int j = 0; j < 8; ++j) t[j] = acc[mb][nb][8 * s + j];
                f((wm * MB + mb) * 32 + r32, (wn * NB + nb) * 32 + 16 * s + 8 * hi, pack8(t)); }
}
template <int MB, int NB, class F> DEVI void for_acc_f4(f32x16 (&acc)[MB][NB], int wm, int wn, int lane, F f) {
    const int r32 = lane & 31, hi = lane >> 5;
#pragma unroll
    for (int mb = 0; mb < MB; ++mb)
#pragma unroll
        for (int nb = 0; nb < NB; ++nb)
#pragma unroll
            for (int g = 0; g < 4; ++g) f((wm * MB + mb) * 32 + r32, (wn * NB + nb) * 32 + 8 * g + 4 * hi, f32x4{acc[mb][nb][4 * g], acc[mb][nb][4 * g + 1], acc[mb][nb][4 * g + 2], acc[mb][nb][4 * g + 3]});
}

DEVI void phase_inproj(const Params& P, const Ctx& c, int l) {
    TID_SETUP();
    const short* hbuf = (const short*)(c.ws + WS_HBUF); const short* WT = (const short*)(c.ws + WS_WIN) + (size_t)l * 1024 * 1024; short* zbuf = (short*)(c.ws + WS_ZBUF);
    for (int u = c.vcu; u < 64; u += c.G) {
        const int rt = u >> 3, ct = u & 7; const int row0 = rt * 64, col0 = ct * 128;
        gemm_tile<1, 1, 2, 4, false, true>(c.lds + LDS_GEMM, 16,
            [&](int r) { return hbuf + (size_t)(row0 + r) * 1024; },
            [&](int n) { return WT + (size_t)(col0 + n) * 1024; },
            [&](f32x16 (&acc)[1][1], int wm, int wn) {
                for_acc_bf8<1, 1>(acc, wm, wn, lane, [&](int r, int cc, u32x4 v) { const int col = col0 + cc; if (col < INW) *(u32x4*)(zbuf + (size_t)(row0 + r) * ZLD + col) = v; });
            });
    }
    for (int u = c.vcu; u < 512; u += c.G) {
        const int rt = 2 + (u >> 2), ct = u & 3; const int row0 = rt * 256, col0 = ct * 256;
        __syncthreads();
        gemm256<false, 1>(c.lds + LDS_GEMM, 16, hbuf + (size_t)row0 * 1024, 1024, nullptr, WT + (size_t)col0 * 1024, 1024, 0, nullptr,
            [&](g8_acc& acc, int wr, int wc, int fr, int fq) {
                g8_for_acc(acc, wr, wc, fr, fq, [&](int r, int cc, f32x4 v) { const int col = col0 + cc;
                    if (col < INW) *(u32x2*)(zbuf + (size_t)(row0 + r) * ZLD + col) = u32x2{cvtpk(v[0], v[1]), cvtpk(v[2], v[3])}; });
            });
    }
}

template <int NCOL, int NTOK = 128> DEVI void tile_rowstat(const Ctx& c, int tid, int tok0, int col0, float* stat) {
    const short* zbuf = (const short*)(c.ws + WS_ZBUF);
    constexpr int TPT = NTHR / NTOK, per = NCOL / TPT;
    const int t = tid / TPT, q = tid % TPT;
    const short* p = zbuf + (size_t)(tok0 + t) * ZLD + col0 + q * per;
    u32x4 w[per / 8];
#pragma unroll
    for (int i = 0; i < per / 8; ++i) w[i] = *(const u32x4*)(p + i * 8);
    float ss = 0;
#pragma unroll
    for (int i = 0; i < per / 8; ++i)
#pragma unroll
        for (int j = 0; j < 4; ++j) { const float a = bflo(w[i][j]), b = bfhi(w[i][j]); ss += a * a + b * b; }
    ss += __shfl_xor(ss, 1, 64); if constexpr (TPT == 4) ss += __shfl_xor(ss, 2, 64);
    if (q == 0) stat[t] = ss / (float)NCOL;
}
DEVI float half_sum(float v) { auto rr = __builtin_amdgcn_permlane32_swap(__float_as_uint(v), __float_as_uint(v), false, false); return __uint_as_float(rr[0]) + __uint_as_float(rr[1]); }

DEVI void rope16(float (&x)[16], int n, bool lat, int hi, const float2* ropetab) {
    if (!lat) return;
    const int prow = n >> 6, pcol = n & 63;
#pragma unroll
    for (int j = 0; j < 4; ++j) {
        const int i = j + 4 * hi;
        const float2 cr = ropetab[prow * 8 + i], cc = ropetab[pcol * 8 + i];
        const float a1 = x[j], a2 = x[j + 4]; x[j] = a1 * cr.x - a2 * cr.y; x[j + 4] = a2 * cr.x + a1 * cr.y;
        const float b1 = x[8 + j], b2 = x[12 + j]; x[8 + j] = b1 * cc.x - b2 * cc.y; x[12 + j] = b2 * cc.x + b1 * cc.y;
    }
}

template <int NB> DEVI void pc_q_unit(const Params& P, const Ctx& c, int l, int tok0, int hp, int tid, int lane) {
    const short* zbuf = (const short*)(c.ws + WS_ZBUF);
    float* stat = (float*)(c.lds + LDS_STAT);
    const float2* ropetab = (const float2*)(c.ws + WS_ROPE);
    tile_rowstat<QLR, 128 * NB>(c, tid, tok0, 0, stat);
    const short* WQT = (const short*)(c.ws + WS_WQT) + ((size_t)l * 768 + hp * 192) * 256;
    const float* qn = P.in[13] + l * DQK;
    gemm_tile<3, NB, 2, 4, false, false>(c.lds + LDS_GEMM, 4,
        [&](int r) { return WQT + (size_t)r * 256; },
        [&](int n) { return zbuf + (size_t)(tok0 + n) * ZLD; },
        [&](f32x16 (&acc)[3][NB], int wm, int wn) {
#pragma unroll
            for (int nb = 0; nb < NB; ++nb) {
                const int hi = lane >> 5, r32 = lane & 31; const int tl = (wn * NB + nb) * 32 + r32, row = tok0 + tl, h = hp * 2 + wm;
                const bool lat = row >= T_CTX; const int rr = lat ? row - T_CTX : row; const int b = lat ? (rr >> 14) : (rr >> 8); const int n = lat ? (rr & 16383) : (rr & 255);
                const float s1 = rsqrtf(stat[tl] + EPS);
                float ss = 0;
#pragma unroll
                for (int mb = 0; mb < 3; ++mb)
#pragma unroll
                    for (int r = 0; r < 16; ++r) ss += acc[mb][nb][r] * acc[mb][nb][r];
                ss = half_sum(ss);
                const float s2 = rsqrtf(s1 * s1 * ss * (1.f / 96.f) + EPS); const float sc = s1 * s2 * ATT_QSCALE;
                float x[3][16];
#pragma unroll
                for (int mb = 0; mb < 3; ++mb)
#pragma unroll
                    for (int g4 = 0; g4 < 4; ++g4) { const f32x4 g = *(const f32x4*)(qn + mb * 32 + 8 * g4 + 4 * hi);
#pragma unroll
                        for (int j = 0; j < 4; ++j) x[mb][g4 * 4 + j] = acc[mb][nb][g4 * 4 + j] * sc * g[j]; }
                rope16(x[2], n, lat, hi, ropetab);
                short* dst = lat ? (short*)(c.ws + WS_QBUF) + ((size_t)(b * NH + h) * SEQ + n) * DQK : (short*)(c.ws + WS_QCTX) + ((size_t)(b * NH + h) * NCTX + n) * DQK;
#pragma unroll
                for (int mb = 0; mb < 3; ++mb)
#pragma unroll
                    for (int s = 0; s < 2; ++s) *(u32x4*)(dst + mb * 32 + s * 16 + hi * 8) = pack8(&x[mb][s * 8]);
            }
        });
}

template <int NB> DEVI void pc_kv_unit(const Params& P, const Ctx& c, int l, int tok0, int hp, int tid, int lane) {
    const short* zbuf = (const short*)(c.ws + WS_ZBUF);
    float* stat = (float*)(c.lds + LDS_STAT);
    const float2* ropetab = (const float2*)(c.ws + WS_ROPE);
    tile_rowstat<KVLR, 128 * NB>(c, tid, tok0, QLR, stat);
    const short* WKVT = (const short*)(c.ws + WS_WKVT) + ((size_t)l * 1024 + hp * 256) * 128;
    const float* kn = P.in[14] + l * DQK;
    gemm_tile<4, NB, 2, 4, false, false, (NB == 1 ? 2 : 1)>(c.lds + LDS_GEMM, 2,
        [&](int r) { return WKVT + (size_t)r * 128; },
        [&](int n) { return zbuf + (size_t)(tok0 + n) * ZLD + QLR; },
        [&](f32x16 (&acc)[4][NB], int wm, int wn) {
#pragma unroll
            for (int nb = 0; nb < NB; ++nb) {
                const int hi = lane >> 5, r32 = lane & 31; const int tl = (wn * NB + nb) * 32 + r32, row = tok0 + tl, h = hp * 2 + wm;
                const bool lat = row >= T_CTX; const int rr = lat ? row - T_CTX : row; const int b = lat ? (rr >> 14) : (rr >> 8); const int n = lat ? (rr & 16383) : (rr & 255);
                const int pos = lat ? NCTX + n : n;
                const float s1 = rsqrtf(stat[tl] + EPS);
                float kr[16];
#pragma unroll
                for (int g4 = 0; g4 < 4; ++g4) { const u32x2 w = *(const u32x2*)(zbuf + (size_t)row * ZLD + QLR + KVLR + 8 * g4 + 4 * hi);
                    kr[g4 * 4 + 0] = bflo(w[0]); kr[g4 * 4 + 1] = bfhi(w[0]); kr[g4 * 4 + 2] = bflo(w[1]); kr[g4 * 4 + 3] = bfhi(w[1]); }
                float ss = 0;
#pragma unroll
                for (int mb = 0; mb < 2; ++mb)
#pragma unroll
                    for (int r = 0; r < 16; ++r) { const float t = acc[mb][nb][r] * s1; ss += t * t; }
#pragma unroll
                for (int r = 0; r < 16; ++r) ss += kr[r] * kr[r];
                ss = half_sum(ss);
                const float s2 = rsqrtf(ss * (1.f / 96.f) + EPS);
                float x[3][16];
#pragma unroll
                for (int mb = 0; mb < 3; ++mb)
#pragma unroll
                    for (int g4 = 0; g4 < 4; ++g4) { const f32x4 g = *(const f32x4*)(kn + mb * 32 + 8 * g4 + 4 * hi);
#pragma unroll
                        for (int j = 0; j < 4; ++j) x[mb][g4 * 4 + j] = (mb < 2 ? acc[mb][nb][g4 * 4 + j] * s1 : kr[g4 * 4 + j]) * s2 * g[j]; }
                rope16(x[2], n, lat, hi, ropetab);
                short* kd = (short*)(c.ws + WS_KBUF) + ((size_t)(b * NH + h) * NKEY + pos) * DQK;
#pragma unroll
                for (int mb = 0; mb < 3; ++mb)
#pragma unroll
                    for (int s = 0; s < 2; ++s) *(u32x4*)(kd + mb * 32 + s * 16 + hi * 8) = pack8(&x[mb][s * 8]);
                short* vd = (short*)(c.ws + WS_VBUF) + ((size_t)(b * NH + h) * NKEY + pos) * DV;
                float vv[2][16];
#pragma unroll
                for (int mb = 0; mb < 2; ++mb)
#pragma unroll
                    for (int r = 0; r < 16; ++r) vv[mb][r] = acc[2 + mb][nb][r] * s1;
#pragma unroll
                for (int mb = 0; mb < 2; ++mb)
#pragma unroll
                    for (int s = 0; s < 2; ++s) *(u32x4*)(vd + mb * 32 + s * 16 + hi * 8) = pack8(&vv[mb][s * 8]);
            }
        });
}

DEVI void phase_proj2(const Params& P, const Ctx& c, int l) {
    TID_SETUP();
    const short* zbuf = (const short*)(c.ws + WS_ZBUF);
    for (int u = c.vcu + PC_U0; u < (l < DEPTH - 1 ? 1072 : 1056); u += c.G) {
        __syncthreads();
        if (u < 512) pc_q_unit<2>(P, c, l, T_CTX + (u >> 2) * 256, u & 3, tid, lane);
        else if (u < 1024) pc_kv_unit<2>(P, c, l, T_CTX + ((u - 512) >> 2) * 256, u & 3, tid, lane);
        else if (u < 1040) pc_q_unit<1>(P, c, l, ((u - 1024) >> 2) * 128, u & 3, tid, lane);
        else if (u < 1056) pc_kv_unit<1>(P, c, l, ((u - 1040) >> 2) * 128, u & 3, tid, lane);
        else {
            const int uu = u - 1056; const int rt = uu >> 3, g = (uu >> 1) & 3, ct = uu & 1; const int row0 = rt * 256;
            const short* W = (const short*)(c.ws + WS_WCS) + ((size_t)(l * 4 + g) * 128) * 256 + ct * 128; short* U = (short*)(c.ws + WS_UCTX);
            gemm_tile<2, 2, 4, 2, true, true>(c.lds + LDS_GEMM, 2,
                [&](int r) { return zbuf + (size_t)(row0 + r) * ZLD + 416 + g * 128; },
                [&](int k) { return W + (size_t)k * 256; },
                [&](f32x16 (&acc)[2][2], int wm, int wn) {
                    for_acc_bf8<2, 2>(acc, wm, wn, lane, [&](int r, int cc, u32x4 v) { *(u32x4*)(U + (size_t)(row0 + r) * 1024 + g * 256 + ct * 128 + cc) = v; });
                });
        }
    }
}

constexpr int AT_VB = 64 * 64 * 2, AT_KB = 64 * 256, AT_V = 0, AT_K = 3 * AT_VB, AT_WS = AT_K + 3 * AT_KB;
#define KSWZ(row, colB) ((row) * 256 + ((colB) ^ (((row) & 15) << 4)))

DEVI void att_exp16(f32x16& p, float& l) {
#pragma unroll
    for (int r = 0; r < 16; ++r) { p[r] = __builtin_amdgcn_exp2f(p[r]); l += p[r]; }
}
DEVI void att_pack(const f32x16& p0, const f32x16& p1, bf16x8& pa0, bf16x8& pa1, bf16x8& pa2, bf16x8& pa3) {
#define PK4(P, BASE, OUT) do { u32x4 w = {cvtpk(P[BASE + 0], P[BASE + 1]), cvtpk(P[BASE + 2], P[BASE + 3]), cvtpk(P[BASE + 4], P[BASE + 5]), cvtpk(P[BASE + 6], P[BASE + 7])}; \
    OUT = *reinterpret_cast<bf16x8*>(&w); } while (0)
    PK4(p0, 0, pa0); PK4(p0, 8, pa1); PK4(p1, 0, pa2); PK4(p1, 8, pa3);
#undef PK4
}
template <bool SHIFT> DEVI void att_qkt(f32x16& p0, f32x16& p1, const char* Ks, const bf16x8* qr, int r32, int hi, float init) {
    if constexpr (SHIFT) {
#pragma unroll
        for (int r = 0; r < 16; ++r) { p0[r] = init; p1[r] = init; }
    } else { p0 = f32x16{}; p1 = f32x16{}; }
    bf16x8 b0 = *reinterpret_cast<const bf16x8*>(Ks + KSWZ(r32, hi * 16));
    bf16x8 b1 = *reinterpret_cast<const bf16x8*>(Ks + KSWZ(32 + r32, hi * 16));
#pragma unroll
    for (int d0 = 0; d0 < 6; ++d0) {
        bf16x8 n0 = b0, n1 = b1;
        if (d0 < 5) { const int cb = ((d0 + 1) * 16 + hi * 8) * 2;
            n0 = *reinterpret_cast<const bf16x8*>(Ks + KSWZ(r32, cb)); n1 = *reinterpret_cast<const bf16x8*>(Ks + KSWZ(32 + r32, cb)); }
        p0 = __builtin_amdgcn_mfma_f32_32x32x16_bf16(b0, qr[d0], p0, 0, 0, 0);
        p1 = __builtin_amdgcn_mfma_f32_32x32x16_bf16(b1, qr[d0], p1, 0, 0, 0);
        b0 = n0; b1 = n1; }
}
constexpr int att_v_off(int d0, int ks, int half) { return d0 * 512 + ks * 2048 + half * 1024; }
struct VFrag { s16x4 l0, h0, l1, h1, l2, h2, l3, h3; };
template <int D0> DEVI void att_vread(VFrag& f, int vb) {
    f.l0 = tr_read<att_v_off(D0, 0, 0)>(vb); f.h0 = tr_read<att_v_off(D0, 0, 1)>(vb); f.l1 = tr_read<att_v_off(D0, 1, 0)>(vb); f.h1 = tr_read<att_v_off(D0, 1, 1)>(vb);
    f.l2 = tr_read<att_v_off(D0, 2, 0)>(vb); f.h2 = tr_read<att_v_off(D0, 2, 1)>(vb); f.l3 = tr_read<att_v_off(D0, 3, 0)>(vb); f.h3 = tr_read<att_v_off(D0, 3, 1)>(vb);
}
DEVI void att_pv_mm(f32x16& od, const VFrag& f, bf16x8 pa0, bf16x8 pa1, bf16x8 pa2, bf16x8 pa3) {
    od = __builtin_amdgcn_mfma_f32_32x32x16_bf16(pa0, PK8(f.l0, f.h0), od, 0, 0, 0);
    od = __builtin_amdgcn_mfma_f32_32x32x16_bf16(pa1, PK8(f.l1, f.h1), od, 0, 0, 0);
    od = __builtin_amdgcn_mfma_f32_32x32x16_bf16(pa2, PK8(f.l2, f.h2), od, 0, 0, 0);
    od = __builtin_amdgcn_mfma_f32_32x32x16_bf16(pa3, PK8(f.l3, f.h3), od, 0, 0, 0);
}
DEVI void att_lsum(f32x16& l, bf16x8 pa, bf16x8 pb) {
    const bf16x8 ones = {(short)0x3F80, (short)0x3F80, (short)0x3F80, (short)0x3F80, (short)0x3F80, (short)0x3F80, (short)0x3F80, (short)0x3F80};
    l = __builtin_amdgcn_mfma_f32_32x32x16_bf16(pa, ones, l, 0, 0, 0);
    l = __builtin_amdgcn_mfma_f32_32x32x16_bf16(pb, ones, l, 0, 0, 0);
}

template <bool SHIFT> DEVI void attn_body(const short* __restrict__ Qb, const short* __restrict__ Kh, const short* __restrict__ Vh, short* __restrict__ Ob, int seq, float shift, char* lds) {
    int tid = threadIdx.x; asm volatile("" : "+v"(tid)); const int wid = __builtin_amdgcn_readfirstlane(tid >> 6), lane = tid & 63, r32 = lane & 31, hi = lane >> 5;
    char* V_lds = lds + AT_V; char* K_lds = lds + AT_K;
    if (wid >= 4) __builtin_amdgcn_s_setprio(1);
    f32x16 o[2] = {f32x16{}, f32x16{}}; float l_reg = 0.f; bf16x8 qr[6];
    const short* Qw = Qb + (size_t)(wid * 32 + r32) * DQK + hi * 8;
#pragma unroll
    for (int d0 = 0; d0 < 6; ++d0) qr[d0] = *(const bf16x8*)(Qw + d0 * 16);
    const int kc0 = tid, kc1 = (tid + 512 < 768) ? tid + 512 : 767;
    const int kst0 = KSWZ(kc0 / 12, (kc0 % 12) * 16), kst1 = KSWZ(kc1 / 12, (kc1 % 12) * 16);
    const int vkey = tid >> 3, vcol = (tid & 7) * 8;
    const int vkk = vkey;
    const int vst = ((vkk >> 3) * 2 + (vcol >> 5)) * 512 + ((vkk & 7) * 32 + (vcol & 31)) * 2;
    const int vb0 = (int)(uintptr_t)V_lds + nn_rd_base(lane);
    struct { bf16x8 vs, k0, k1; } sr_;
    const int NT = seq / 64; const float init = -shift;
#define SLOAD(t) do { const int tt_ = (t) < NT ? (t) : NT - 1; sr_.vs = *(const bf16x8*)(Vh + (size_t)tt_ * 64 * DV + tid * 8); \
    sr_.k0 = *(const bf16x8*)(Kh + (size_t)tt_ * 64 * DQK + kc0 * 8); sr_.k1 = *(const bf16x8*)(Kh + (size_t)tt_ * 64 * DQK + kc1 * 8); } while (0)
#define SWRITE(b) do { *(bf16x8*)(V_lds + (b) * AT_VB + vst) = sr_.vs; *(bf16x8*)(K_lds + (b) * AT_KB + kst0) = sr_.k0; *(bf16x8*)(K_lds + (b) * AT_KB + kst1) = sr_.k1; } while (0)
    f32x16 pA0, pA1, pB0, pB1; bf16x8 pa0, pa1, pa2, pa3; VFrag vf, vf1;
#define STEP(PC0, PC1, PP0, PP1, TNEXT2, DOWRITE) do {                                                            \
        int bn = bc + 1; if (bn == 3) bn = 0;                                                                      \
        if (DOWRITE) SWRITE(bn);                                                                                   \
        SBAR(); SLOAD(TNEXT2);                                                                                     \
        SBAR(); att_vread<0>(vf, vb0 + bp * AT_VB); att_vread<1>(vf1, vb0 + bp * AT_VB);                           \
        att_qkt<SHIFT>(PC0, PC1, K_lds + bc * AT_KB, qr, r32, hi, init);                                           \
        att_exp16(PP1, l_reg); att_pack(PP0, PP1, pa0, pa1, pa2, pa3); SBAR();                                     \
        asm volatile("s_waitcnt lgkmcnt(0)" ::: "memory"); SBAR();                                                 \
        att_pv_mm(o[0], vf, pa0, pa1, pa2, pa3); att_pv_mm(o[1], vf1, pa0, pa1, pa2, pa3);                         \
        att_exp16(PC0, l_reg);                                                                                     \
        __syncthreads();                                                                                           \
        bp = bc; bc = bn; } while (0)
    SLOAD(0); asm volatile("s_waitcnt vmcnt(0)" ::: "memory"); SWRITE(0); SBAR(); SLOAD(1); __syncthreads();
    SWRITE(1); SBAR(); SLOAD(2); SBAR();
    att_qkt<SHIFT>(pA0, pA1, K_lds, qr, r32, hi, init); att_exp16(pA0, l_reg);
    __syncthreads();
    int bc = 1, bp = 0;
    for (int j = 1; j + 1 < NT; j += 2) {
        STEP(pB0, pB1, pA0, pA1, j + 2, true);
        STEP(pA0, pA1, pB0, pB1, j + 3, (j + 2 < NT));
    }
    STEP(pB0, pB1, pA0, pA1, NT - 1, false);
    att_vread<0>(vf, vb0 + bp * AT_VB);
    att_exp16(pB1, l_reg); att_pack(pB0, pB1, pa0, pa1, pa2, pa3); SBAR();
    asm volatile("s_waitcnt lgkmcnt(0)" ::: "memory"); SBAR();
    att_pv_mm(o[0], vf, pa0, pa1, pa2, pa3); att_vread<1>(vf, vb0 + bp * AT_VB); SBAR();
    asm volatile("s_waitcnt lgkmcnt(0)" ::: "memory"); SBAR();
    att_pv_mm(o[1], vf, pa0, pa1, pa2, pa3);
    __builtin_amdgcn_s_setprio(0);
    short* Ow = Ob + (size_t)(wid * 32) * 1024;
    { auto rr = __builtin_amdgcn_permlane32_swap(__float_as_uint(l_reg), __float_as_uint(l_reg), false, false); l_reg = __uint_as_float(rr[0]) + __uint_as_float(rr[1]); }
    float* li_l = (float*)(lds + AT_WS) + wid * 32;
    __syncthreads();
    if (hi == 0) li_l[r32] = l_reg; asm volatile("s_waitcnt lgkmcnt(0)" ::: "memory");
#pragma unroll
    for (int r = 0; r < 16; ++r) { const int orow = crow(r, hi); const float rl = __builtin_amdgcn_rcpf(li_l[orow]);
#pragma unroll
        for (int d0 = 0; d0 < 2; ++d0) Ow[(size_t)orow * 1024 + d0 * 32 + r32] = (short)f2bf(o[d0][r] * rl); }
    __syncthreads();
#undef SLOAD
#undef SWRITE
#undef STEP
}

DEVI void phase_attn_fft1(const Params& P, const Ctx& c, int l) {
    TID_SETUP();
    short* mix = (short*)(c.ws + WS_HBUF);
    const short* qb = (const short*)(c.ws + WS_QBUF); const short* qc = (const short*)(c.ws + WS_QCTX);
    const short* kb = (const short*)(c.ws + WS_KBUF); const short* vb = (const short*)(c.ws + WS_VBUF);
    const int n_att = (l < DEPTH - 1) ? 1040 : 1024;
    float shift;
    { float mq = 0.f, mk = 0.f;
      for (int i = lane; i < DQK; i += 64) { mq = fmaxf(mq, fabsf(P.in[13][l * DQK + i])); mk = fmaxf(mk, fabsf(P.in[14][l * DQK + i])); }
#pragma unroll
      for (int o = 32; o > 0; o >>= 1) { mq = fmaxf(mq, __shfl_xor(mq, o, 64)); mk = fmaxf(mk, __shfl_xor(mk, o, 64)); }
      shift = 9.797958971132712f * 1.4426950408889634f * mq * mk * 1.0001f; }
    for (int u = c.vcu; u < n_att; u += c.G) {
        const short* Qp; short* Op; int bh, seq;
        if (u < 1024) {
            const int rnd = u >> 8, v = u & 255, xcd = v >> 5, j = v & 31; bh = xcd * 2 + (rnd >> 1); const int qblk = j + 32 * (rnd & 1);
            Qp = qb + ((size_t)bh * SEQ + qblk * 256) * DQK; Op = mix + (size_t)(T_CTX + (bh >> 3) * SEQ + qblk * 256) * 1024 + (bh & 7) * DV; seq = NKEY;
        } else {
            bh = u - 1024; Qp = qc + (size_t)bh * NCTX * DQK; Op = mix + (size_t)((bh >> 3) * NCTX) * 1024 + (bh & 7) * DV; seq = NCTX;
        }
        if (shift < 64.f) attn_body<false>(Qp, kb + (size_t)bh * NKEY * DQK, vb + (size_t)bh * NKEY * DV, Op, seq, shift, c.lds + LDS_GEMM);
        else attn_body<true>(Qp, kb + (size_t)bh * NKEY * DQK, vb + (size_t)bh * NKEY * DV, Op, seq, shift, c.lds + LDS_GEMM);
    }
#ifndef ATT_ONLY
    const short* zbuf = (const short*)(c.ws + WS_ZBUF); const short* F1 = (const short*)(c.ws + WS_F1); short* P1 = (short*)(c.ws + WS_P1);
    const float2* tw = (const float2*)(c.ws + WS_TW);
    for (int u = c.vcu; u < 1024; u += c.G) {
        const int n2 = u & 127, g = (u >> 7) & 3, b = u >> 9;
        const short* Zb = zbuf + (size_t)(T_CTX + b * SEQ + n2) * ZLD + 416 + g * 128;
        const short* W = (const short*)(c.ws + WS_WCS) + ((size_t)(l * 4 + g) * 128) * 256;
        short* Pb = P1 + ((size_t)(b * 4 + g) * 128 * 128 + n2) * 256;
        LAS char* Sres = (LAS char*)(c.lds + LDS_GEMM) + 65536;
        gemm_tile<1, 4, 4, 2, true, true, 1>(c.lds + LDS_GEMM, 2,
            [&](int r) { return Zb + (size_t)r * (128 * ZLD); },
            [&](int k) { return W + (size_t)k * 256; },
            [&](f32x16 (&acc)[1][4], int wm, int wn) {
                for_acc_bf8<1, 4>(acc, wm, wn, lane, [&](int n1, int cc, u32x4 v) { const int kk = 2 * n1 + (cc >> 7), cp = cc & 127;
                    *(LAS u32x4*)(Sres + (kk >> 6) * 16384 + nn_st<128>(kk & 63, cp)) = v; });
            });
        gemm_tile<2, 2, 4, 2, true, true, 2, true>(c.lds + LDS_GEMM, 4,
            [&](int r) { return F1 + (size_t)r * 256; },
            [&](int kk) { return (const short*)nullptr; },
            [&](f32x16 (&acc)[2][2], int wm, int wn) {
                const int hi = lane >> 5, r32 = lane & 31; const int k1 = wm * 32 + r32;
                const float2 t = tw[(n2 * k1) & 16383];
                short* p = Pb + (size_t)k1 * (128 * 256);
#pragma unroll
                for (int nb = 0; nb < 2; ++nb)
#pragma unroll
                    for (int s = 0; s < 2; ++s) { float yr[8], yi[8];
#pragma unroll
                        for (int j = 0; j < 8; ++j) { const float a = acc[0][nb][8 * s + j], bb = acc[1][nb][8 * s + j]; yr[j] = a * t.x + bb * t.y; yi[j] = bb * t.x - a * t.y; }
                        const int cc = (wn * 2 + nb) * 32 + 16 * s + 8 * hi;
                        *(u32x4*)(p + cc) = pack8(yr); *(u32x4*)(p + 128 + cc) = pack8(yi); }
            });
    }
    if (l < DEPTH - 1) {
        const short* FC = (const short*)(c.ws + WS_FC);
        for (int u = c.vcu; u < 8; u += c.G) {
            const int g = u & 3, b = u >> 2;
            const short* Ub = (const short*)(c.ws + WS_UCTX) + (size_t)(b * NCTX) * 1024 + g * 256;
            gemm_tile<2, 2, 4, 2, true, true>(c.lds + LDS_GEMM, 8,
                [&](int r) { return FC + (size_t)r * 512; },
                [&](int kk) { return Ub + (size_t)(kk >> 1) * 1024 + (kk & 1) * 128; },
                [&](f32x16 (&acc)[2][2], int wm, int wn) {
                    for_acc_bf8<2, 2>(acc, wm, wn, lane, [&](int r, int cc, u32x4 v) { *(u32x4*)(mix + (size_t)(b * NCTX + r) * 1024 + 512 + g * 128 + cc) = v; });
                });
        }
    }
#endif
}

DEVI void phase_fft2(const Params& P, const Ctx& c, int l) {
    TID_SETUP();
    short* mix = (short*)(c.ws + WS_HBUF); const short* P1 = (const short*)(c.ws + WS_P1); const short* F2 = (const short*)(c.ws + WS_F2);
    for (int u = c.vcu; u < 1024; u += c.G) {
        const int k1 = u & 127, g = (u >> 7) & 3, b = u >> 9;
        const short* Pb = P1 + ((size_t)(b * 4 + g) * 128 + k1) * (128 * 256);
        gemm_tile<1, 2, 4, 2, true, true>(c.lds + LDS_GEMM, 4,
            [&](int r) { return F2 + (size_t)r * 256; },
            [&](int kk) { return Pb + (size_t)kk * 128; },
            [&](f32x16 (&acc)[1][2], int wm, int wn) {
                for_acc_bf8<1, 2>(acc, wm, wn, lane, [&](int k2, int cc, u32x4 v) { *(u32x4*)(mix + (size_t)(T_CTX + b * SEQ + k1 + 128 * k2) * 1024 + 512 + g * 128 + cc) = v; });
            });
    }
}

DEVI void phase_outproj(const Params& P, const Ctx& c, int l) {
    TID_SETUP();
    const short* mix = (const short*)(c.ws + WS_HBUF); const short* WT = (const short*)(c.ws + WS_WOUT) + (size_t)l * 1024 * 1024;
    const float* coef = (const float*)(c.ws + WS_COEF) + (size_t)l * 3 * 6 * 1024;
    if (l < DEPTH - 1) for (int u = c.vcu; u < 64; u += c.G) {
        const int rt = u >> 3, ct = u & 7; const int row0 = rt * 64, col0 = ct * 128;
        const float* g1 = coef + (size_t)(2 * 6 + 2) * 1024;
        gemm_tile<1, 1, 2, 4, false, true>(c.lds + LDS_GEMM, 16,
            [&](int r) { return mix + (size_t)(row0 + r) * 1024; },
            [&](int n) { return WT + (size_t)(col0 + n) * 1024; },
            [&](f32x16 (&acc)[1][1], int wm, int wn) {
                for_acc_f4<1, 1>(acc, wm, wn, lane, [&](int r, int cc, f32x4 v) { const int row = row0 + r, col = col0 + cc;
                    const f32x4 x = *(const f32x4*)(res_row_src(P, c, row, l) + col), g = *(const f32x4*)(g1 + col);
                    *(f32x4*)(res_row(c, row) + col) = f32x4{x[0] + g[0] * v[0], x[1] + g[1] * v[1], x[2] + g[2] * v[2], x[3] + g[3] * v[3]}; });
            });
    }
    for (int u = c.vcu; u < 512; u += c.G) {
        const int rt = 2 + (u >> 2), ct = u & 3; const int row0 = rt * 256, col0 = ct * 256;
        const float* g1 = coef + (size_t)(row_variant(row0) * 6 + 2) * 1024;
        __syncthreads();
        gemm256<false, 1>(c.lds + LDS_GEMM, 16, mix + (size_t)row0 * 1024, 1024, nullptr, WT + (size_t)col0 * 1024, 1024, 0, nullptr,
            [&](g8_acc& acc, int wr, int wc, int fr, int fq) {
                g8_for_acc(acc, wr, wc, fr, fq, [&](int r, int cc, f32x4 v) { const int row = row0 + r, col = col0 + cc;
                    const f32x4 x = *(const f32x4*)(res_row_src(P, c, row, l) + col), g = *(const f32x4*)(g1 + col);
                    *(f32x4*)(res_row(c, row) + col) = f32x4{x[0] + g[0] * v[0], x[1] + g[1] * v[1], x[2] + g[2] * v[2], x[3] + g[3] * v[3]}; });
            });
    }
}

DEVI void phase_norm_route(const Params& P, const Ctx& c, int l) {
    TID_SETUP();
    const float* coef = (const float*)(c.ws + WS_COEF) + (size_t)l * 3 * 6 * 1024;
    short* hbuf = (short*)(c.ws + WS_HBUF);
    constexpr int XP = 2064;
    char* xs_hi = c.lds + LDS_GEMM; char* xs_lo = xs_hi + 16 * XP;
    int* lcnt = (int*)(c.lds + LDS_GEMM + 66560);
    int* lrow = lcnt + 64;
    float* lgt = (float*)(c.lds + LDS_GEMM + 73728);
    float* part = (float*)(c.lds + LDS_GEMM + 90112);
    const int rows_per = (T + c.G - 1) / c.G; const int r_begin = c.vcu * rows_per; const int r_lim = (l == DEPTH - 1) ? T_CTX : 0;
    int r_end = r_begin + rows_per; if (r_end > T) r_end = T;
    __syncthreads();
    if (tid < 64) lcnt[tid] = 0;
    int* rcls = (int*)(c.ws + WS_RCLS); float2* rw = (float2*)(c.ws + WS_RW);
    const int e16 = lane & 15, kq = lane >> 4;
    bf16x8 wh[4], wl[4];
#pragma unroll
    for (int s = 0; s < 4; ++s) { float v[8];
#pragma unroll
        for (int j = 0; j < 8; ++j) v[j] = P.in[17][(size_t)(128 * wid + 32 * s + 8 * kq + j) * 16 + e16];
        u32x4 h = {cvtpk(v[0], v[1]), cvtpk(v[2], v[3]), cvtpk(v[4], v[5]), cvtpk(v[6], v[7])};
        u32x4 lo = {cvtpk(v[0] - bflo(h[0]), v[1] - bfhi(h[0])), cvtpk(v[2] - bflo(h[1]), v[3] - bfhi(h[1])), cvtpk(v[4] - bflo(h[2]), v[5] - bfhi(h[2])), cvtpk(v[6] - bflo(h[3]), v[7] - bfhi(h[3]))};
        wh[s] = *reinterpret_cast<bf16x8*>(&h); wl[s] = *reinterpret_cast<bf16x8*>(&lo); }
    const int nrows = r_end - r_begin; const int nch = (nrows + 15) >> 4;
    f32x4 xn[2][4];
#pragma unroll
    for (int h = 0; h < 2; ++h) { int i = 8 * h + wid; if (i > nrows - 1) i = nrows - 1; const float* x = res_row(c, r_begin + i);
#pragma unroll
        for (int q = 0; q < 4; ++q) xn[h][q] = *(const f32x4*)(x + q * 256 + lane * 4); }
    for (int ch = 0; ch < nch; ++ch) {
#pragma unroll
        for (int h = 0; h < 2; ++h) {
            const int i = 16 * ch + 8 * h + wid; const bool valid = i < nrows; const int r = r_begin + (valid ? i : nrows - 1); const int v = row_variant(r);
            const float* a2 = coef + (size_t)(v * 6 + 3) * 1024; const float* b2 = coef + (size_t)(v * 6 + 4) * 1024;
            f32x4 xv[4]; float ss = 0;
#pragma unroll
            for (int q = 0; q < 4; ++q) { xv[q] = xn[h][q]; ss += xv[q][0] * xv[q][0] + xv[q][1] * xv[q][1] + xv[q][2] * xv[q][2] + xv[q][3] * xv[q][3]; }
            if (ch + 1 < nch) { int i2 = i + 16; if (i2 > nrows - 1) i2 = nrows - 1; const float* x = res_row(c, r_begin + i2);
#pragma unroll
                for (int q = 0; q < 4; ++q) xn[h][q] = *(const f32x4*)(x + q * 256 + lane * 4); }
            ss = wave_sum(ss); const float rstd = rsqrtf(ss * (1.f / 1024.f) + EPS);
#pragma unroll
            for (int q = 0; q < 4; ++q) { const int col = q * 256 + lane * 4; const f32x4 a = *(const f32x4*)(a2 + col), b = *(const f32x4*)(b2 + col);
#pragma unroll
                for (int j = 0; j < 4; ++j) xv[q][j] = xv[q][j] * rstd * a[j] + b[j];
                const u32x2 o = {cvtpk(xv[q][0], xv[q][1]), cvtpk(xv[q][2], xv[q][3])};
                if (valid) *(u32x2*)(hbuf + (size_t)r * 1024 + col) = o;
                const u32x2 ol = {cvtpk(xv[q][0] - bflo(o[0]), xv[q][1] - bfhi(o[0])), cvtpk(xv[q][2] - bflo(o[1]), xv[q][3] - bfhi(o[1]))};
                *(LAS u32x2*)((LAS char*)xs_hi + (8 * h + wid) * XP + col * 2) = o; *(LAS u32x2*)((LAS char*)xs_lo + (8 * h + wid) * XP + col * 2) = ol; }
        }
        __syncthreads();
        if (ch > 0 && tid < 256) { const float* pp = part + ((ch - 1) & 1) * 2048 + tid; float sum = pp[0];
#pragma unroll
            for (int w = 1; w < 8; ++w) sum += pp[w * 256];
            lgt[(16 * (ch - 1)) * 16 + tid] = sum; }
        f32x4 acc = {0, 0, 0, 0};
#pragma unroll
        for (int s = 0; s < 4; ++s) { const int off = e16 * XP + (128 * wid + 32 * s + 8 * kq) * 2;
            const bf16x8 ah = *(LAS const bf16x8*)((LAS char*)xs_hi + off), al = *(LAS const bf16x8*)((LAS char*)xs_lo + off);
            acc = __builtin_amdgcn_mfma_f32_16x16x32_bf16(ah, wh[s], acc, 0, 0, 0);
            acc = __builtin_amdgcn_mfma_f32_16x16x32_bf16(ah, wl[s], acc, 0, 0, 0);
            acc = __builtin_amdgcn_mfma_f32_16x16x32_bf16(al, wh[s], acc, 0, 0, 0); }
        { float* pw = part + (ch & 1) * 2048 + wid * 256;
#pragma unroll
          for (int j = 0; j < 4; ++j) pw[(4 * kq + j) * 16 + e16] = acc[j]; }
        __syncthreads();
    }
    if (tid < 256) { const float* pp = part + ((nch - 1) & 1) * 2048 + tid; float sum = pp[0];
#pragma unroll
        for (int w = 1; w < 8; ++w) sum += pp[w * 256];
        lgt[(16 * (nch - 1)) * 16 + tid] = sum; }
    __syncthreads();
    for (int i = tid; i < r_end - r_begin; i += NTHR) {
        const int r = r_begin + i; if (r < r_lim) continue;
        float lg[16];
        { const f32x4 t0 = *(const f32x4*)(lgt + i * 16), t1 = *(const f32x4*)(lgt + i * 16 + 4), t2 = *(const f32x4*)(lgt + i * 16 + 8), t3 = *(const f32x4*)(lgt + i * 16 + 12);
#pragma unroll
          for (int j = 0; j < 4; ++j) { lg[j] = t0[j]; lg[4 + j] = t1[j]; lg[8 + j] = t2[j]; lg[12 + j] = t3[j]; } }
        float sc[16], bi[16];
#pragma unroll
        for (int e = 0; e < 16; ++e) { sc[e] = __builtin_amdgcn_rcpf(1.f + __expf(-lg[e])); bi[e] = sc[e] + P.in[18][e]; }
        int bg = 0; float bgs = -1e30f;
#pragma unroll
        for (int g = 0; g < 4; ++g) { float m1 = -1e30f, m2 = -1e30f;
#pragma unroll
            for (int j = 0; j < 4; ++j) { const float t = bi[g * 4 + j]; if (t > m1) { m2 = m1; m1 = t; } else if (t > m2) m2 = t; }
            const float gs = m1 + m2; if (gs > bgs) { bgs = gs; bg = g; } }
        float b4[4], s4[4];
#pragma unroll
        for (int j = 0; j < 4; ++j) { b4[j] = bg == 0 ? bi[j] : bg == 1 ? bi[4 + j] : bg == 2 ? bi[8 + j] : bi[12 + j]; s4[j] = bg == 0 ? sc[j] : bg == 1 ? sc[4 + j] : bg == 2 ? sc[8 + j] : sc[12 + j]; }
        int i1 = 0;
#pragma unroll
        for (int j = 1; j < 4; ++j) if (b4[j] > b4[i1]) i1 = j;
        int i2 = (i1 == 0) ? 1 : 0;
#pragma unroll
        for (int j = 0; j < 4; ++j) if (j != i1 && b4[j] > b4[i2]) i2 = j;
        const int ea = i1 < i2 ? i1 : i2, eb = i1 < i2 ? i2 : i1;
        float wa = 0, wb = 0;
#pragma unroll
        for (int j = 0; j < 4; ++j) { if (j == ea) wa = s4[j]; if (j == eb) wb = s4[j]; }
        const float inv = 1.f / (wa + wb);
        const int pidx = ea == 0 ? eb - 1 : ea == 1 ? eb + 1 : 5;
        const int cls = bg * 6 + pidx;
        const int lp = atomicAdd(&lcnt[cls], 1); lrow[i] = cls | (lp << 8); rcls[r] = cls; rw[r] = make_float2(wa * inv, wb * inv);
    }
    __syncthreads();
    int* gcnt = (int*)(c.ws + WS_CTL + CTL_CNT_OFF) + l * 32;
    if (tid < NCLS) lcnt[32 + tid] = lcnt[tid] > 0 ? (int)__hip_atomic_fetch_add(&gcnt[tid], lcnt[tid], __ATOMIC_RELAXED, __HIP_MEMORY_SCOPE_AGENT) : 0;
    __syncthreads();
    int* clist = (int*)(c.ws + WS_CLIST);
    for (int i = tid; i < r_end - r_begin; i += NTHR) { const int r = r_begin + i; if (r < r_lim) continue; const int w = lrow[i]; const int cls = w & 255, lp = w >> 8; clist[(size_t)cls * T + lcnt[32 + cls] + lp] = r; }
}

DEVI bool moe_decode(const int* gcnt, int u, int per_rt, int& cls, int& rt, int& sub, int& hpad, int& ccnt) {
    int acc_t = 0, acc_h = 0;
    for (int cc = 0; cc < NCLS; ++cc) { const int n = __builtin_amdgcn_readfirstlane(gcnt[cc]);
        const int nrt = (n + 255) >> 8; const int nt = nrt * per_rt;
        if (u < acc_t + nt) { cls = cc; const int loc = u - acc_t; rt = loc / per_rt; sub = loc % per_rt; hpad = acc_h; ccnt = n; return true; }
        acc_t += nt; acc_h += nrt * 256; }
    return false;
}
DEVI void cls_experts(int cls, int& ea, int& eb) { const int g = cls / 6, p = cls % 6; const int a = p < 3 ? 0 : p < 5 ? 1 : 2; const int b = p < 3 ? p + 1 : p < 5 ? p - 1 : 3; ea = g * 4 + a; eb = g * 4 + b; }

DEVI int moe_total(const int* gcnt, int per_rt) { int t = 0; for (int cc = 0; cc < NCLS; ++cc) { const int n = __builtin_amdgcn_readfirstlane(gcnt[cc]); t += ((n + 255) >> 8) * per_rt; } return t; }
DEVI int moe_nfull(int utot, int G) { const int nf = (utot / G) * G; return ((utot - nf) * 4 > 2 * G) ? utot : nf; }

DEVI void phase_moe_up(const Params& P, const Ctx& c, int l) {
    TID_SETUP();
    const int* gcnt = (const int*)(c.ws + WS_CTL + CTL_CNT_OFF) + l * 32;
    const short* hbuf = (const short*)(c.ws + WS_HBUF); short* Hm = (short*)(c.ws + WS_KBUF);
    const int* clist = (const int*)(c.ws + WS_CLIST); const float2* rw = (const float2*)(c.ws + WS_RW);
    int* ltok = (int*)(c.lds + LDS_STAT); float* lw = (float*)(c.lds + LDS_STAT + 1024);
    const int utot = moe_total(gcnt, 4), nfull = moe_nfull(utot, c.G);
    for (int it = c.vcu; it < nfull + (utot - nfull) * 4; it += c.G) {
        const bool fast = it < nfull; const int u = fast ? it : nfull + ((it - nfull) >> 2); const int q = (it - nfull) & 3;
        int cls, rt, ct, hpad, ccnt; if (!moe_decode(gcnt, u, 4, cls, rt, ct, hpad, ccnt)) break;
        int ea, eb; cls_experts(cls, ea, eb); const int e = ct < 2 ? ea : eb;
        __syncthreads();
        { int t2 = threadIdx.x; asm volatile("" : "+v"(t2));
          if (t2 < 256) { int i = rt * 256 + t2; if (i > ccnt - 1) i = ccnt - 1; const int tok = clist[(size_t)cls * T + i]; ltok[t2] = tok; const float2 w = rw[tok]; lw[t2] = ct < 2 ? w.x : w.y; } }
        asm volatile("s_waitcnt vmcnt(0)" ::: "memory");
        __syncthreads();
        const short* WT = (const short*)(c.ws + WS_WGU) + ((size_t)(l * 16 + e) * 512 + (ct & 1) * 256) * 1024;
        short* Hrow = Hm + (size_t)(hpad + rt * 256) * 512 + (ct >> 1) * 256;
        if (fast) {
            gemm256<true, 1>(c.lds + LDS_GEMM, 16, hbuf, 1024, ltok, WT, 1024, 0, nullptr,
                [&](g8_acc& acc, int wr, int wc, int fr, int fq) {
#pragma unroll
                    for (int ai = 0; ai < 2; ++ai)
#pragma unroll
                        for (int m = 0; m < 4; ++m) { const int row = ai * 128 + wr * 64 + m * 16 + fr; const float w = lw[row];
#pragma unroll
                            for (int bj = 0; bj < 2; ++bj) { const f32x4 g = acc[ai][bj][m][0], uu = acc[ai][bj][m][1]; float hv[4];
#pragma unroll
                                for (int j = 0; j < 4; ++j) hv[j] = silu(g[j]) * uu[j] * w;
                                *(u32x2*)(Hrow + (size_t)row * 512 + ((ct & 1) * 8 + bj * 4 + wc) * 16 + fq * 4) = u32x2{cvtpk(hv[0], hv[1]), cvtpk(hv[2], hv[3])}; } }
                });
        } else {
            gemm_tile<1, 2, 8, 1, false, true>(c.lds + LDS_GEMM, 16,
                [&](int r) { return hbuf + (size_t)ltok[r] * 1024; },
                [&](int n) { return WT + (size_t)(q * 64 + n) * 1024; },
                [&](f32x16 (&acc)[1][2], int wm, int wn) {
                    const int hi = lane >> 5, r32 = lane & 31; const int row = wm * 32 + r32; const float w = lw[row];
#pragma unroll
                    for (int nb = 0; nb < 2; ++nb)
#pragma unroll
                        for (int s = 0; s < 2; ++s) { float hv[4];
#pragma unroll
                            for (int j = 0; j < 4; ++j) hv[j] = silu(acc[0][nb][4 * s + j]) * acc[0][nb][8 + 4 * s + j] * w;
                            *(u32x2*)(Hrow + (size_t)row * 512 + ((ct & 1) * 8 + q * 2 + nb) * 16 + 8 * s + 4 * hi) = u32x2{cvtpk(hv[0], hv[1]), cvtpk(hv[2], hv[3])}; }
                });
        }
    }
}
DEVI void phase_moe_down(const Params& P, const Ctx& c, int l) {
    TID_SETUP();
    const int* gcnt = (const int*)(c.ws + WS_CTL + CTL_CNT_OFF) + l * 32;
    const short* Hm = (const short*)(c.ws + WS_KBUF);
    const int* clist = (const int*)(c.ws + WS_CLIST);
    const float* coef = (const float*)(c.ws + WS_COEF) + (size_t)l * 3 * 6 * 1024;
    unsigned long long* lrp = (unsigned long long*)(c.lds + LDS_STAT);
    const int utot = moe_total(gcnt, 4), nfull = moe_nfull(utot, c.G);
    for (int it = c.vcu; it < nfull + (utot - nfull) * 4; it += c.G) {
        const bool fast = it < nfull; const int u = fast ? it : nfull + ((it - nfull) >> 2); const int q = (it - nfull) & 3;
        int cls, rt, ct, hpad, ccnt; if (!moe_decode(gcnt, u, 4, cls, rt, ct, hpad, ccnt)) break;
        __syncthreads();
        { int t2 = threadIdx.x; asm volatile("" : "+v"(t2));
          if (t2 < 256) { int i = rt * 256 + t2; if (i > ccnt - 1) i = ccnt - 1; const int tok = clist[(size_t)cls * T + i]; lrp[t2] = (unsigned long long)(uintptr_t)res_row(c, tok) | (unsigned long long)row_variant(tok); } }
        asm volatile("s_waitcnt vmcnt(0)" ::: "memory");
        __syncthreads();
        const short* WT = (const short*)(c.ws + WS_WDN) + ((size_t)(l * NCLS + cls) * 1024 + ct * 256) * 512;
        const short* Ab = Hm + (size_t)(hpad + rt * 256) * 512;
        auto rmw = [&](int rl, int col, f32x4 v) { const int i = rt * 256 + rl;
            if (i < ccnt) { const unsigned long long pv = lrp[rl]; float* xr = (float*)(uintptr_t)(pv & ~3ull) + col; const f32x4 g = *(const f32x4*)(coef + (size_t)((int)(pv & 3ull) * 6 + 5) * 1024 + col);
                const f32x4 x = *(const f32x4*)xr; *(f32x4*)xr = f32x4{x[0] + g[0] * v[0], x[1] + g[1] * v[1], x[2] + g[2] * v[2], x[3] + g[3] * v[3]}; } };
        if (fast) {
            gemm256<false, 1>(c.lds + LDS_GEMM, 8, Ab, 512, nullptr, WT, 512, 0, nullptr,
                [&](g8_acc& acc, int wr, int wc, int fr, int fq) { g8_for_acc(acc, wr, wc, fr, fq, [&](int rl, int cc, f32x4 v) { rmw(rl, ct * 256 + cc, v); }); });
        } else {
            gemm_tile<1, 2, 8, 1, false, true>(c.lds + LDS_GEMM, 8,
                [&](int r) { return Ab + (size_t)r * 512; },
                [&](int n) { return WT + (size_t)(q * 64 + n) * 512; },
                [&](f32x16 (&acc)[1][2], int wm, int wn) { for_acc_f4<1, 2>(acc, wm, wn, lane, [&](int rl, int cc, f32x4 v) { rmw(rl, ct * 256 + q * 64 + cc, v); }); });
        }
    }
}

__global__ void __launch_bounds__(NTHR, 2) mega_fwd(Params P) {
    extern __shared__ __attribute__((aligned(16))) char lds[];
    Ctx c;
    c.out = P.out; c.ws = P.ws; c.lds = lds; c.G = gridDim.x;
    { const int bx = blockIdx.x; c.vcu = (c.G % 8 == 0) ? (bx % 8) * (c.G / 8) + bx / 8 : bx; }
    volatile LAS unsigned* st = (volatile LAS unsigned*)(lds + LDS_MISC);
    if (threadIdx.x < 4) st[threadIdx.x] = 0u;
    __syncthreads();
    XcdBarrier bar = xcd_barrier_post((unsigned*)(P.ws + WS_CTL), st);
    int ph = 0;
#define PHASE_END() do { if (++ph >= P.nphases) return; if (ph > P.ph_lo) xcd_barrier(bar); } while (0)
    if ((PHMASK & 1) && ph >= P.ph_lo) phase_prologue(P, c); PHASE_END();
    if ((PHMASK & 2) && ph >= P.ph_lo) phase_coef(P, c); PHASE_END();
    for (int l = 0; l < DEPTH; ++l) {
        if ((PHMASK & 4) && ph >= P.ph_lo) { phase_norm_mix(P, c, l); if (REPMASK & 4) { xcd_barrier(bar); phase_norm_mix(P, c, l); } } PHASE_END();
        if ((PHMASK & 8) && ph >= P.ph_lo) { phase_inproj(P, c, l); if (REPMASK & 8) { xcd_barrier(bar); phase_inproj(P, c, l); } } PHASE_END();
        if ((PHMASK & 16) && ph >= P.ph_lo) { phase_proj2(P, c, l); if (REPMASK & 16) { xcd_barrier(bar); phase_proj2(P, c, l); } } PHASE_END();
        if ((PHMASK & 32) && ph >= P.ph_lo) { phase_attn_fft1(P, c, l); if (REPMASK & 32) { xcd_barrier(bar); phase_attn_fft1(P, c, l); } } PHASE_END();
        if ((PHMASK & 64) && ph >= P.ph_lo) { phase_fft2(P, c, l); if (REPMASK & 64) { xcd_barrier(bar); phase_fft2(P, c, l); } } PHASE_END();
        if ((PHMASK & 128) && ph >= P.ph_lo) { phase_outproj(P, c, l); if (REPMASK & 128) { xcd_barrier(bar); phase_outproj(P, c, l); } } PHASE_END();
        if ((PHMASK & 256) && ph >= P.ph_lo) { phase_norm_route(P, c, l); if (REPMASK & 256) { xcd_barrier(bar); phase_norm_route(P, c, l); } } PHASE_END();
        if ((PHMASK & 512) && ph >= P.ph_lo) { phase_moe_up(P, c, l); if (REPMASK & 512) { xcd_barrier(bar); phase_moe_up(P, c, l); } } PHASE_END();
        if ((PHMASK & 1024) && ph >= P.ph_lo) { phase_moe_down(P, c, l); if (REPMASK & 1024) { xcd_barrier(bar); phase_moe_down(P, c, l); } } PHASE_END();
    }
}


#ifdef DUMPDBG
__global__ void dump_kernel(float* out, const char* ws, int keep_out) {
    const size_t n = (size_t)T_LAT * D;
    for (size_t i = (size_t)blockIdx.x * blockDim.x + threadIdx.x; i < n; i += (size_t)gridDim.x * blockDim.x) {
        float v = keep_out ? out[i] : 0.f;
        const size_t offs[8] = {WS_HBUF, WS_ZBUF, WS_QBUF, WS_KBUF, WS_VBUF, WS_UBUF, WS_WCS, WS_WIN};
        const size_t lens[8] = {(size_t)T * 1024, (size_t)T * 1024, (size_t)BATCH * NH * SEQ * DQK, (size_t)BATCH * NH * NKEY * DQK, (size_t)BATCH * NH * NKEY * DV, (size_t)T * 1024, (size_t)4 * 4 * 128 * 256, (size_t)4 * 1024 * 1024};
#pragma unroll
        for (int b = 0; b < 8; ++b) {
            if (!((DUMPMASK >> b) & 1)) continue;
            const unsigned short u = ((const unsigned short*)(ws + offs[b]))[i % lens[b]];
            float f = __uint_as_float(((unsigned)u) << 16);
            if (!(fabsf(f) < 1e30f)) f = 777.f;
            v += f;
        }
        if (!(fabsf(v) < 1e30f)) v = 999.f;
        out[i] = v;
    }
}
#endif

#ifdef CHECKDBG
constexpr size_t WS_CHK = WS_END;
__device__ inline float blk_sum(float v, float* red) {
    for (int o = 32; o > 0; o >>= 1) v += __shfl_xor(v, o, 64);
    __syncthreads(); if ((threadIdx.x & 63) == 0) red[threadIdx.x >> 6] = v; __syncthreads();
    float t = 0; for (int i = 0; i < (int)blockDim.x / 64; ++i) t += red[i]; return t;
}
__device__ inline float blk_max(float v, float* red) {
    for (int o = 32; o > 0; o >>= 1) v = fmaxf(v, __shfl_xor(v, o, 64));
    __syncthreads(); if ((threadIdx.x & 63) == 0) red[threadIdx.x >> 6] = v; __syncthreads();
    float t = -1e30f; for (int i = 0; i < (int)blockDim.x / 64; ++i) t = fmaxf(t, red[i]); return t;
}
__global__ void chk_qkv(Params P) {
    __shared__ float red[8]; __shared__ float xin[256]; __shared__ float outv[128]; __shared__ float kr[32];
    const int s = blockIdx.x, tid = threadIdx.x;
    const int row = (s * 7919 + 13) % T; const int h = s & 7;
    const short* z = (const short*)(P.ws + WS_ZBUF) + (size_t)row * ZLD;
    const bool lat = row >= T_CTX; const int rr = lat ? row - T_CTX : row; const int b = lat ? (rr >> 14) : (rr >> 8); const int n = lat ? (rr & 16383) : (rr & 255);
    float* err = (float*)(P.ws + WS_CHK);
    const float2* ropetab = (const float2*)(P.ws + WS_ROPE);
    { const float cq = bf2f((unsigned short)z[tid]); const float ms = blk_sum(cq * cq, red) / 256.f; xin[tid] = cq * rsqrtf(ms + EPS) * P.in[9][tid]; __syncthreads();
      float u = 0; if (tid < 96) for (int k = 0; k < 256; ++k) u += xin[k] * P.in[10][(size_t)k * 768 + h * 96 + tid];
      const float ms2 = blk_sum(tid < 96 ? u * u : 0.f, red) / 96.f; if (tid < 96) outv[tid] = u * rsqrtf(ms2 + EPS) * P.in[13][tid]; __syncthreads();
      float val = 0; if (tid < 96) { val = outv[tid];
        if (lat && tid >= 64) { const int m = tid - 64; const int ax = m >> 4, i = m & 7, second = (m >> 3) & 1; const int pos = ax == 0 ? (n >> 6) : (n & 63); const float2 cs = ropetab[pos * 8 + i];
            const float x1 = outv[64 + ax * 16 + i], x2 = outv[64 + ax * 16 + 8 + i]; val = second ? (x2 * cs.x + x1 * cs.y) : (x1 * cs.x - x2 * cs.y); }
        val *= ATT_QSCALE; }
      const short* qd = lat ? (const short*)(P.ws + WS_QBUF) + ((size_t)(b * NH + h) * SEQ + n) * DQK : (const short*)(P.ws + WS_QCTX) + ((size_t)(b * NH + h) * NCTX + n) * DQK;
      const float got = tid < 96 ? bf2f((unsigned short)qd[tid]) : 0.f;
      const float d2 = blk_sum(tid < 96 ? (got - val) * (got - val) : 0.f, red), r2 = blk_sum(tid < 96 ? val * val : 0.f, red);
      if (tid == 0) { atomicAdd(&err[0], d2); atomicAdd(&err[1], r2); } }
    { __syncthreads(); const float ck = tid < 128 ? bf2f((unsigned short)z[256 + tid]) : 0.f; const float ms = blk_sum(ck * ck, red) / 128.f; if (tid < 128) xin[tid] = ck * rsqrtf(ms + EPS) * P.in[11][tid];
      if (tid < 32) kr[tid] = bf2f((unsigned short)z[384 + tid]); __syncthreads();
      float u = 0; if (tid < 128) for (int k = 0; k < 128; ++k) u += xin[k] * P.in[12][(size_t)k * 1024 + h * 128 + tid];
      float sq = 0; if (tid < 64) sq = u * u; else if (tid >= 128 && tid < 160) sq = kr[tid - 128] * kr[tid - 128];
      const float ms2 = blk_sum(sq, red) / 96.f; const float rs = rsqrtf(ms2 + EPS);
      if (tid < 64) outv[tid] = u * rs * P.in[14][tid]; if (tid >= 128 && tid < 160) outv[64 + tid - 128] = kr[tid - 128] * rs * P.in[14][64 + tid - 128]; __syncthreads();
      const int pos = lat ? NCTX + n : n;
      float val = 0; if (tid < 96) { val = outv[tid];
        if (lat && tid >= 64) { const int m = tid - 64; const int ax = m >> 4, i = m & 7, second = (m >> 3) & 1; const int pp = ax == 0 ? (n >> 6) : (n & 63); const float2 cs = ropetab[pp * 8 + i];
            const float x1 = outv[64 + ax * 16 + i], x2 = outv[64 + ax * 16 + 8 + i]; val = second ? (x2 * cs.x + x1 * cs.y) : (x1 * cs.x - x2 * cs.y); } }
      const short* kd = (const short*)(P.ws + WS_KBUF) + ((size_t)(b * NH + h) * NKEY + pos) * DQK;
      const float gotk = tid < 96 ? bf2f((unsigned short)kd[tid]) : 0.f;
      float d2 = blk_sum(tid < 96 ? (gotk - val) * (gotk - val) : 0.f, red), r2 = blk_sum(tid < 96 ? val * val : 0.f, red);
      if (tid == 0) { atomicAdd(&err[2], d2); atomicAdd(&err[3], r2); }
      const short* vd = (const short*)(P.ws + WS_VBUF) + ((size_t)(b * NH + h) * NKEY + pos) * DV;
      const bool isv = tid >= 64 && tid < 128; const float gotv = isv ? bf2f((unsigned short)vd[tid - 64]) : 0.f; const float vv = isv ? u : 0.f;
      d2 = blk_sum((gotv - vv) * (gotv - vv), red); r2 = blk_sum(vv * vv, red);
      if (tid == 0) { atomicAdd(&err[4], d2); atomicAdd(&err[5], r2); } }
}
__global__ void chk_attn(Params P) {
    extern __shared__ float pbuf[];
    __shared__ float red[8]; __shared__ float qv[96];
    const int s = blockIdx.x, tid = threadIdx.x; const int b = s & 1, h = (s >> 1) & 7; const bool ctxq = (s % 5) == 4; const int n = ctxq ? (s * 37) % NCTX : (s * 4099 + 77) % SEQ;
    const int bh = b * NH + h; const int nk = ctxq ? NCTX : NKEY;
    const short* q = ctxq ? (const short*)(P.ws + WS_QCTX) + ((size_t)bh * NCTX + n) * DQK : (const short*)(P.ws + WS_QBUF) + ((size_t)bh * SEQ + n) * DQK;
    const short* K = (const short*)(P.ws + WS_KBUF) + (size_t)bh * NKEY * DQK; const short* V = (const short*)(P.ws + WS_VBUF) + (size_t)bh * NKEY * DV;
    if (tid < 96) qv[tid] = bf2f((unsigned short)q[tid]); __syncthreads();
    float mx = -1e30f;
    for (int k = tid; k < nk; k += blockDim.x) { float a = 0; for (int d = 0; d < 96; ++d) a += qv[d] * bf2f((unsigned short)K[(size_t)k * DQK + d]); pbuf[k] = a; mx = fmaxf(mx, a); }
    mx = blk_max(mx, red);
    float sm = 0; for (int k = tid; k < nk; k += blockDim.x) { const float p = exp2f(pbuf[k] - mx); pbuf[k] = p; sm += p; }
    sm = blk_sum(sm, red);
    float o = 0; if (tid < 64) for (int k = 0; k < nk; ++k) o += pbuf[k] * bf2f((unsigned short)V[(size_t)k * DV + tid]);
    o /= sm;
    const short* mix = (const short*)(P.ws + WS_HBUF) + (size_t)(ctxq ? b * NCTX + n : T_CTX + b * SEQ + n) * 1024 + h * DV;
    const float got = tid < 64 ? bf2f((unsigned short)mix[tid]) : 0.f; const float ov = tid < 64 ? o : 0.f;
    const float d2 = blk_sum((got - ov) * (got - ov), red), r2 = blk_sum(ov * ov, red);
    float* err = (float*)(P.ws + WS_CHK);
    if (tid == 0) { atomicAdd(&err[6], d2); atomicAdd(&err[7], r2); }
}
__global__ void chk_fixup(float* out, const char* ws) {
    const float* err = (const float*)(ws + WS_CHK);
    float e = 0.f; bool zero = false;
    for (int k = 0; k < 4; ++k) if ((CHECKSEL >> k) & 1) { e = fmaxf(e, sqrtf(err[2 * k] / fmaxf(err[2 * k + 1], 1e-30f))); zero |= (err[2 * k + 1] == 0.f); }
    float f = 1.f; if (!(e < 0.006f)) f = 1.1f; if (!(e < 0.02f)) f = 1.3f; if (!(e < 0.1f)) f = 2.f; if (zero) f = 3.f;
    if (f == 1.f) return;
    const size_t n = (size_t)T_LAT * D;
    for (size_t i = (size_t)blockIdx.x * blockDim.x + threadIdx.x; i < n; i += (size_t)gridDim.x * blockDim.x) out[i] *= f;
}
#endif
#ifndef PHMASK
#define PHMASK 0xffff
#endif
#ifndef NPHASES
#define NPHASES 1000
#endif
extern "C" void kernel_launch(void* const* d_in, const int* in_sizes, int n_in, void* d_out, int out_size, void* d_ws, size_t ws_size, hipStream_t stream) {
    static int grid = 0;
    if (grid == 0) {
        if (n_in != 22 || out_size != T_LAT * D || ws_size < WS_END) { fprintf(stderr, "kernel_launch: shape/workspace mismatch (n_in %d out %d ws %zu need %zu)\n", n_in, out_size, ws_size, (size_t)WS_END); grid = -1; return; }
        int dev = 0, cus = 0, per_cu = 0;
        if (hipGetDevice(&dev) != hipSuccess || hipDeviceGetAttribute(&cus, hipDeviceAttributeMultiprocessorCount, dev) != hipSuccess) { grid = -1; return; }
        if (hipFuncSetAttribute((const void*)mega_fwd, hipFuncAttributeMaxDynamicSharedMemorySize, LDS_BYTES) != hipSuccess) { fprintf(stderr, "kernel_launch: hipFuncSetAttribute failed\n"); grid = -1; return; }
        if (hipOccupancyMaxActiveBlocksPerMultiprocessor(&per_cu, (const void*)mega_fwd, NTHR, LDS_BYTES) != hipSuccess || per_cu < 1) { fprintf(stderr, "kernel_launch: occupancy query says %d\n", per_cu); grid = -1; return; }
        (void)hipGetLastError();
#ifdef CHECKDBG
        (void)hipFuncSetAttribute((const void*)chk_attn, hipFuncAttributeMaxDynamicSharedMemorySize, NKEY * 4);
#endif
        grid = cus;
    }
    if (grid < 0) return;
    hipMemsetAsync((char*)d_ws + WS_CTL, 0, CTL_BYTES, stream);
    Params p{};
    for (int i = 0; i < 22; ++i) p.in[i] = (const float*)d_in[i];
    p.out = (float*)d_out; p.ws = (char*)d_ws; p.nphases = NPHASES; p.ph_lo = 0;
#ifdef CHECKDBG
    hipMemsetAsync((char*)d_ws + WS_CHK, 0, 64, stream);
    p.nphases = 5; hipLaunchKernelGGL(mega_fwd, dim3(grid), dim3(NTHR), LDS_BYTES, stream, p);
    hipLaunchKernelGGL(chk_qkv, dim3(512), dim3(256), 0, stream, p);
    hipMemsetAsync((char*)d_ws + WS_CTL, 0, CTL_BYTES, stream);
    p.nphases = 6; hipLaunchKernelGGL(mega_fwd, dim3(grid), dim3(NTHR), LDS_BYTES, stream, p);
    hipLaunchKernelGGL(chk_attn, dim3(160), dim3(256), NKEY * 4, stream, p);
    hipMemsetAsync((char*)d_ws + WS_CTL, 0, CTL_BYTES, stream);
    p.nphases = NPHASES;
#endif
#ifdef SPLIT_AT
    p.nphases = SPLIT_AT;
    hipLaunchKernelGGL(mega_fwd, dim3(grid), dim3(NTHR), LDS_BYTES, stream, p);
    hipMemsetAsync((char*)d_ws + WS_CTL, 0, XCD_BAR_WORDS * 4, stream);
    p.nphases = NPHASES; p.ph_lo = SPLIT_AT;
#endif
    hipLaunchKernelGGL(mega_fwd, dim3(grid), dim3(NTHR), LDS_BYTES, stream, p);
    const hipError_t le = hipPeekAtLastError();
    if (le != hipSuccess) fprintf(stderr, "kernel_launch: launch failed: %s\n", hipGetErrorName(le));
#ifdef CHECKDBG
    hipLaunchKernelGGL(chk_fixup, dim3(2048), dim3(256), 0, stream, (float*)d_out, (const char*)d_ws);
#endif
#ifdef DUMPDBG
    hipLaunchKernelGGL(dump_kernel, dim3(2048), dim3(256), 0, stream, (float*)d_out, (const char*)d_ws, (NPHASES >= 8) ? 1 : 0);
#endif
}
```

```cpp
#include <hip/hip_runtime.h>
#include <hip/hip_bf16.h>
#include <cstdint>
#include <cstdio>

#define DEVI __device__ __forceinline__
#define PC_U0 0


#define EXP_WAIT() asm volatile("s_waitcnt vmcnt(0)" ::: "memory")

#define CHECKSEL 8
#ifndef REPMASK
#define REPMASK 0
#endif
#ifndef PHMASK
#define PHMASK 0xffff
#endif

constexpr int D = 1024, BATCH = 2, SEQ = 16384, DEPTH = 4, NCTX = 256;
constexpr int T_CTX = BATCH * NCTX, T_LAT = BATCH * SEQ, T = T_CTX + T_LAT;
constexpr int NH = 8, DQK = 96, DV = 64, QLR = 256, KVLR = 128;
constexpr int NKEY = NCTX + SEQ;
constexpr int INW = 928;
constexpr int ZLD = 1024;
constexpr int NE = 16, DE = 256, NCLS = 24;
constexpr float EPS = 1e-6f;
constexpr float ATT_QSCALE = 0.10206207261596577f * 1.4426950408889634f;
constexpr int NTHR = 512;

constexpr size_t al256(size_t x) { return (x + 255) / 256 * 256; }
constexpr size_t WS_CTL   = 0;
constexpr size_t CTL_BYTES = 65536;
constexpr size_t CTL_CNT_OFF = 32768;
constexpr size_t WS_COEF  = WS_CTL + CTL_BYTES;
constexpr size_t WS_F1    = WS_COEF + al256((size_t)4 * 3 * 6 * 1024 * 4);
constexpr size_t WS_F2    = WS_F1 + 256 * 256 * 2;
constexpr size_t WS_FC    = WS_F2 + 128 * 256 * 2;
constexpr size_t WS_TW    = WS_FC + 256 * 512 * 2;
constexpr size_t WS_ROPE  = WS_TW + 16384 * 8;
constexpr size_t WS_WIN   = WS_ROPE + 256 * 8 * 8;
constexpr size_t WS_WOUT  = WS_WIN + (size_t)4 * 1024 * 1024 * 2;
constexpr size_t WS_WGU   = WS_WOUT + (size_t)4 * 1024 * 1024 * 2;
constexpr size_t WS_WDN   = WS_WGU + (size_t)4 * 16 * 1024 * 512 * 2;
constexpr size_t WS_WQT   = WS_WDN + (size_t)4 * NCLS * 1024 * 512 * 2;
constexpr size_t WS_WKVT  = WS_WQT + (size_t)4 * 768 * 256 * 2;
constexpr size_t WS_WCS   = WS_WKVT + (size_t)4 * 1024 * 128 * 2;
constexpr size_t WS_CTXR  = WS_WCS + (size_t)4 * 4 * 128 * 256 * 2;
constexpr size_t WS_RCLS  = WS_CTXR + (size_t)T_CTX * 1024 * 4;
constexpr size_t WS_RW    = WS_RCLS + al256((size_t)T * 4);
constexpr size_t WS_CLIST = WS_RW + al256((size_t)T * 8);
constexpr size_t WS_HBUF  = WS_CLIST + al256((size_t)NCLS * T * 4);
constexpr size_t WS_MODP  = WS_HBUF;
constexpr size_t WS_RES   = WS_HBUF + (size_t)T * 1024 * 2;
constexpr size_t WS_ZBUF  = WS_RES;
constexpr size_t WS_QBUF  = WS_ZBUF + (size_t)T * 1024 * 2;
constexpr size_t WS_QCTX  = WS_QBUF + (size_t)BATCH * NH * SEQ * DQK * 2;
constexpr size_t WS_KBUF  = WS_QCTX + (size_t)BATCH * NH * NCTX * DQK * 2;
constexpr size_t WS_VBUF  = WS_KBUF + (size_t)BATCH * NH * NKEY * DQK * 2;
constexpr size_t WS_UBUF  = WS_VBUF + (size_t)BATCH * NH * NKEY * DV * 2;
constexpr size_t WS_P1    = WS_UBUF;
constexpr size_t WS_UCTX  = WS_UBUF + (size_t)2 * 4 * 128 * 128 * 256 * 2;
static_assert(WS_UCTX + (size_t)T_CTX * 1024 * 2 <= WS_UBUF + (size_t)T * 1024 * 2, "P1 + ctx U fit the U region");
constexpr size_t WS_END   = WS_UBUF + (size_t)T * 1024 * 2;
static_assert((size_t)2 * 4 * 128 * 128 * 256 * 2 <= (size_t)T * 1024 * 2, "P1 fits zbuf region");
static_assert((size_t)(T + NCLS * 256) * 512 * 2 <= (size_t)BATCH * NH * NKEY * DQK * 2, "Hmoe (class-padded rows) fits kbuf region");
static_assert(WS_END <= (size_t)4 * T_LAT * D * 4, "workspace map must fit 4 x the largest tensor (the guaranteed d_ws size)");

constexpr int LDS_GEMM = 0;
constexpr int LDS_STAT = 128 * 1024;
constexpr int LDS_MISC = 132 * 1024;
constexpr int LDS_BYTES = 133 * 1024;

#define XB_TMO      128
#define XB_XCNT(j)  (256  + 64 * (j))
#define XB_XSUB(j)  (1280 + 64 * (j))
#define XB_XGEN(j)  (2304 + 64 * (j))
#define XB_TOP      3328
#define XB_TOPGEN   3392
#define XCD_BAR_WORDS 3456
#define XB_SPIN_CAP (1u << 24)
#define LAS __attribute__((address_space(3)))

DEVI unsigned xb_ld(unsigned* p)              { return __hip_atomic_load(p, __ATOMIC_RELAXED, __HIP_MEMORY_SCOPE_AGENT); }
DEVI unsigned xb_add(unsigned* p, unsigned v) { return __hip_atomic_fetch_add(p, v, __ATOMIC_RELAXED, __HIP_MEMORY_SCOPE_AGENT); }
DEVI unsigned xb_xcc_id() { return (unsigned)__builtin_amdgcn_s_getreg((3 << 11) | 20) & 0xFu; }
#define XB_SPIN(cond, bar) do { unsigned _sp = 0; while (cond) { __builtin_amdgcn_s_sleep(1); \
    if ((++_sp & 255u) == 0u) { if (xb_ld(&(bar)[XB_TMO])) break; if (_sp > XB_SPIN_CAP) { atomicAdd(&(bar)[XB_TMO], 1u); break; } } } } while (0)

struct XcdBarrier { unsigned* bar; unsigned x; volatile LAS unsigned* st; };

DEVI XcdBarrier xcd_barrier_post(unsigned* bar, volatile LAS unsigned* st) {
    XcdBarrier b; b.bar = bar; b.x = xb_xcc_id(); b.st = st;
    if (threadIdx.x == 0) (void)xb_add(&bar[XB_XCNT(b.x)], 1u);
    return b;
}
DEVI void xcd_barrier_complete(unsigned* bar, unsigned x, unsigned& nloc, unsigned& nx) {
    const unsigned G = gridDim.x * gridDim.y * gridDim.z;
    unsigned sum, cnt, mine, sp = 0u;
    for (;;) {
        sum = 0u; cnt = 0u; mine = 0u;
#pragma unroll
        for (unsigned j = 0; j < 16; ++j) { const unsigned c = xb_ld(&bar[XB_XCNT(j)]); sum += c; cnt += (c > 0u) ? 1u : 0u; mine = (j == x) ? c : mine; }
        if (sum == G) break;
        __builtin_amdgcn_s_sleep(1);
        if ((++sp & 255u) == 0u) { if (xb_ld(&bar[XB_TMO])) break; if (sp > XB_SPIN_CAP) { atomicAdd(&bar[XB_TMO], 1u); break; } }
    }
    nloc = mine > 0u ? mine : 1u; nx = cnt > 0u ? cnt : 1u;
}
DEVI void xcd_barrier(const XcdBarrier& b) {
    asm volatile("s_waitcnt vmcnt(0)" ::: "memory");
    __syncthreads();
    if (threadIdx.x == 0) {
        unsigned* bar = b.bar;
        __builtin_amdgcn_s_waitcnt(0);
        unsigned nloc = b.st[0], nx = b.st[1];
        if (nloc == 0u) { xcd_barrier_complete(bar, b.x, nloc, nx); b.st[0] = nloc; b.st[1] = nx; }
        const unsigned old = xb_add(&bar[XB_XSUB(b.x)], 1u);
        const unsigned gen = old / nloc;
        if (old + 1u == (gen + 1u) * nloc) {
            __builtin_amdgcn_fence(__ATOMIC_RELEASE, "agent");
            asm volatile("s_waitcnt vmcnt(0)" ::: "memory");
            const unsigned og = xb_add(&bar[XB_TOP], 1u);
            const unsigned tg = og / nx;
            if (og + 1u == (tg + 1u) * nx) xb_add(&bar[XB_TOPGEN], 1u);
            else XB_SPIN(xb_ld(&bar[XB_TOPGEN]) == tg, bar);
            __builtin_amdgcn_fence(__ATOMIC_ACQUIRE, "agent");
            xb_add(&bar[XB_XGEN(b.x)], 1u);
            asm volatile("s_waitcnt vmcnt(0)" ::: "memory");
        } else {
            XB_SPIN(xb_ld(&bar[XB_XGEN(b.x)]) == gen, bar);
            __builtin_amdgcn_fence(__ATOMIC_ACQUIRE, "agent");
            asm volatile("s_waitcnt vmcnt(0)" ::: "memory");
        }
    }
    __syncthreads();
}

using bf16x8 = __attribute__((ext_vector_type(8))) short;
using s16x4  = __attribute__((ext_vector_type(4))) short;
using f32x16 = __attribute__((ext_vector_type(16))) float;
using f32x4  = __attribute__((ext_vector_type(4))) float;
using u32x4  = __attribute__((ext_vector_type(4))) unsigned;
using u32x2  = __attribute__((ext_vector_type(2))) unsigned;
#define SBAR() __builtin_amdgcn_sched_barrier(0)

DEVI int crow(int r, int hi) { return (r & 3) + 8 * (r >> 2) + 4 * hi; }
DEVI unsigned cvtpk(float lo, float hi) { unsigned r; asm volatile("v_cvt_pk_bf16_f32 %0, %1, %2" : "=v"(r) : "v"(lo), "v"(hi)); return r; }
DEVI unsigned short f2bf(float x) { return (unsigned short)(cvtpk(x, 0.f) & 0xffffu); }
DEVI float bf2f(unsigned short u) { return __uint_as_float(((unsigned)u) << 16); }
DEVI float bflo(unsigned u) { return __uint_as_float(u << 16); }
DEVI float bfhi(unsigned u) { return __uint_as_float(u & 0xffff0000u); }
DEVI float wave_sum(float v) {
#pragma unroll
    for (int o = 32; o > 0; o >>= 1) v += __shfl_xor(v, o, 64);
    return v;
}
DEVI float silu(float x) { return x * __builtin_amdgcn_rcpf(1.f + __expf(-x)); }

DEVI int row_variant(int r) { return r < T_CTX ? 2 : ((r - T_CTX) >> 14); }

template <int BN> DEVI int nn_st(int k, int c) {
    const int kk = (k & ~0xC) | ((k & 4) << 1) | ((k & 8) >> 1);
    return ((kk >> 3) * (BN / 32) + (c >> 5)) * 512 + ((kk & 7) * 32 + (c & 31)) * 2;
}
DEVI int nn_rd_base(int lane) { return ((lane & 3) << 3) | (((lane >> 2) & 3) << 6) | (((lane >> 4) & 1) << 5) | (((lane >> 5) & 1) << 8); }
template <int OFF> DEVI s16x4 tr_read(int vb) {
    s16x4 r; asm volatile("ds_read_b64_tr_b16 %0, %1 offset:%2" : "=&v"(r) : "v"(vb), "i"(OFF) : "memory"); return r;
}
#define PK8(L, H) (bf16x8){L[0], L[1], L[2], L[3], H[0], H[1], H[2], H[3]}

typedef s16x4 LAS * lds_s16x4_ptr;
template <int MB, int NB, int WM, int WN, bool BNN, bool SWAPC, int STAGES = 2, bool BRES = false, class AF, class BF, class EF>
DEVI void gemm_tile(char* lds, int nk_in, AF arow, BF brow, EF epi) {
    int nk = nk_in; asm volatile("" : "+s"(nk));
    constexpr int BM = 32 * MB * WM, BN = 32 * NB * WN;
    constexpr int ABYTES = BM * 128, BBYTES = BN * 128;
    constexpr int ACH = BM / 64, BCH = BN / 64;
    static_assert(WM * WN == 8, "8 waves");
    static_assert(2 * ABYTES + 2 * BBYTES <= 128 * 1024, "LDS");
    int tid = threadIdx.x; asm volatile("" : "+v"(tid)); const int lane = tid & 63, wid = __builtin_amdgcn_readfirstlane(tid >> 6);
    const int wm = wid / WN, wn = wid % WN, r32 = lane & 31, hi = lane >> 5;
    LAS char* Abase = (LAS char*)lds; LAS char* Bbase = BRES ? Abase + 65536 : Abase + 2 * ABYTES;
    static_assert(!BRES || 2 * ABYTES <= 65536, "resident B image sits at +64 KB");
    const short* ap[ACH]; int aoff[ACH];
#pragma unroll
    for (int i = 0; i < ACH; ++i) { const int id = tid + NTHR * i, row = id >> 3, c = id & 7; ap[i] = (const short*)arow(row) + c * 8; aoff[i] = row * 128 + ((c ^ ((row >> 1) & 7)) << 4); }
    const short* bp[BCH]; int boff[BCH];
#pragma unroll
    for (int i = 0; i < BCH; ++i) {
        const int id = tid + NTHR * i;
        if constexpr (!BNN) { const int row = id >> 3, c = id & 7; bp[i] = (const short*)brow(row) + c * 8; boff[i] = row * 128 + ((c ^ ((row >> 1) & 7)) << 4); }
        else { const int krow = id / (BN / 8), c = id % (BN / 8); boff[i] = nn_st<BN>(krow, c * 8); bp[i] = nullptr; }
    }
    const int swz = (r32 >> 1) & 7;
    const int afr0 = (wm * 32 * MB + r32) * 128, bfr0 = (wn * 32 * NB + r32) * 128;
    const int bvb = nn_rd_base(lane) + wn * NB * 512;

    f32x16 acc[MB][NB];
#pragma unroll
    for (int i = 0; i < MB; ++i)
#pragma unroll
        for (int j = 0; j < NB; ++j) acc[i][j] = f32x16{};
    bf16x8 ra0[ACH], rb0[BCH], ra1[ACH], rb1[BCH];
#define G_LOAD(RA, RB, T) do {                                                                                                     \
        _Pragma("unroll") for (int i = 0; i < ACH; ++i) RA[i] = *(const bf16x8*)(ap[i] + (T) * 64);                                \
        if constexpr (!BRES) { _Pragma("unroll") for (int i = 0; i < BCH; ++i) { if constexpr (!BNN) RB[i] = *(const bf16x8*)(bp[i] + (T) * 64);          \
            else { const int id = tid + NTHR * i; RB[i] = *(const bf16x8*)((const short*)brow((T) * 64 + id / (BN / 8)) + (id % (BN / 8)) * 8); } } } } while (0)
#define G_WRITE(RA, RB, BUF) do {                                                                                                  \
        _Pragma("unroll") for (int i = 0; i < ACH; ++i) *(LAS bf16x8*)(Abase + (BUF) * ABYTES + aoff[i]) = RA[i];                  \
        if constexpr (!BRES) { _Pragma("unroll") for (int i = 0; i < BCH; ++i) *(LAS bf16x8*)(Bbase + (BUF) * BBYTES + boff[i]) = RB[i]; } } while (0)
#define G_COMPUTE(BUF, KT) do {                                                                                                    \
        LAS const char* As = Abase + (BUF) * ABYTES; LAS const char* Bs = Bbase + (BRES ? (KT) : (BUF)) * BBYTES;                  \
        _Pragma("unroll") for (int ks = 0; ks < 4; ++ks) {                                                                         \
            bf16x8 a[MB], b[NB];                                                                                                   \
            const int so = ((ks * 2 + hi) ^ swz) << 4;                                                                             \
            _Pragma("unroll") for (int mb = 0; mb < MB; ++mb) a[mb] = *(LAS const bf16x8*)(As + afr0 + so + mb * 4096);            \
            _Pragma("unroll") for (int nb = 0; nb < NB; ++nb) {                                                                    \
                if constexpr (BNN) {                                                                                               \
                    const s16x4 l = __builtin_amdgcn_ds_read_tr16_b64_v4i16((lds_s16x4_ptr)(Bs + bvb + nb * 512 + ks * (2 * (BN / 32) * 512)));                        \
                    const s16x4 h = __builtin_amdgcn_ds_read_tr16_b64_v4i16((lds_s16x4_ptr)(Bs + bvb + nb * 512 + ks * (2 * (BN / 32) * 512) + (BN / 32) * 512));      \
                    b[nb] = PK8(l, h);                                                                                             \
                } else b[nb] = *(LAS const bf16x8*)(Bs + bfr0 + so + nb * 4096);                                                   \
            }                                                                                                                      \
            _Pragma("unroll") for (int mb = 0; mb < MB; ++mb)                                                                      \
                _Pragma("unroll") for (int nb = 0; nb < NB; ++nb) acc[mb][nb] = SWAPC ? __builtin_amdgcn_mfma_f32_32x32x16_bf16(b[nb], a[mb], acc[mb][nb], 0, 0, 0) : __builtin_amdgcn_mfma_f32_32x32x16_bf16(a[mb], b[nb], acc[mb][nb], 0, 0, 0); \
        } } while (0)
    if constexpr (STAGES == 2) {
    G_LOAD(ra0, rb0, 0); G_LOAD(ra1, rb1, 1); SBAR();
    G_WRITE(ra0, rb0, 0);
    __syncthreads();
    int kt = 0;
    for (; kt + 2 < nk; kt += 2) {
        SBAR(); G_LOAD(ra0, rb0, kt + 2); SBAR();
        G_COMPUTE(0, kt); SBAR();
        G_WRITE(ra1, rb1, 1);
        __syncthreads();
        SBAR(); G_LOAD(ra1, rb1, kt + 3); SBAR();
        G_COMPUTE(1, kt + 1); SBAR();
        G_WRITE(ra0, rb0, 0);
        __syncthreads();
    }
    SBAR(); G_COMPUTE(0, kt); SBAR();
    G_WRITE(ra1, rb1, 1);
    __syncthreads();
    SBAR(); G_COMPUTE(1, kt + 1); SBAR();
    __syncthreads();
    } else {
    G_LOAD(ra0, rb0, 0); SBAR();
    G_WRITE(ra0, rb0, 0);
    __syncthreads();
    for (int kt = 0; kt < nk; ++kt) {
        const int cur = kt & 1;
        if (kt + 1 < nk) { SBAR(); G_LOAD(ra0, rb0, kt + 1); SBAR(); }
        G_COMPUTE(cur, kt); SBAR();
        if (kt + 1 < nk) G_WRITE(ra0, rb0, cur ^ 1);
        __syncthreads();
    }
    }
#undef G_LOAD
#undef G_WRITE
#undef G_COMPUTE
    epi(acc, wm, wn);
}


typedef __attribute__((address_space(1))) const unsigned* g8_gptr;
typedef __attribute__((address_space(3))) unsigned* g8_lptr;
constexpr int G8_HT = 128 * 64;
DEVI int g8_lds_byte(int r, int c) { const int st = (r >> 4) * 2 + (c >> 5), rr = r & 15, cc = c & 31, ob = rr * 64 + cc * 2; return st * 1024 + (ob ^ (((ob >> 9) & 1) << 5)); }
DEVI void g8_stage_rc(int b, int& R, int& C) { const int st = b / 1024, sb = b % 1024, swz = sb ^ (((sb >> 9) & 1) << 5); R = (st >> 1) * 16 + swz / 64; C = (st & 1) * 32 + (swz % 64) / 2; }
typedef f32x4 g8_acc[2][2][4][2];

template <bool GATHER, int NPASS, class EPI>
DEVI void gemm256(char* ldsb, int nt, const short* A, int lda, const int* ltok, const short* Bt, int ldb, int apass, const short* Bt2, EPI epi) {
    short* shm = (short*)ldsb;
#define SA(b, h) (shm + ((b) * 2 + (h)) * G8_HT)
#define SB(b, h) (shm + (4 + (b) * 2 + (h)) * G8_HT)
#define STAGE_A(P_, h_, kt_) do { _Pragma("unroll") for (int _i = 0; _i < 2; ++_i) { \
        const unsigned _o = (GATHER ? ao[(h_) * 2 + _i] : ao[0] + (unsigned)(((h_) * 128 + _i * 64) * lda * 2)) + (unsigned)((kt_) * 128); \
        __builtin_amdgcn_global_load_lds((g8_gptr)((const char*)A + (size_t)_o), (g8_lptr)((char*)(P_) + tz * 16 + _i * 8192), 16, 0, 0); } } while (0)
#define STAGE_B(P_, h_, kt_) do { _Pragma("unroll") for (int _i = 0; _i < 2; ++_i) { \
        const unsigned _o = bo + (unsigned)(((h_) * 128 + _i * 64) * ldb * 2) + (unsigned)((kt_) * 128); \
        __builtin_amdgcn_global_load_lds((g8_gptr)((const char*)Bt + (size_t)_o), (g8_lptr)((char*)(P_) + tz * 16 + _i * 8192), 16, 0, 0); } } while (0)
#define LDA(dst, b, h) _Pragma("unroll") for (int m = 0; m < 4; ++m) _Pragma("unroll") for (int k = 0; k < 2; ++k) \
        dst[m][k] = *reinterpret_cast<const bf16x8*>((char*)SA(b, h) + g8_lds_byte(wr * 64 + m * 16 + fr, k * 32 + fq * 8))
#define LDB(dst, b, h) _Pragma("unroll") for (int n = 0; n < 2; ++n) _Pragma("unroll") for (int k = 0; k < 2; ++k) \
        dst[n][k] = *reinterpret_cast<const bf16x8*>((char*)SB(b, h) + g8_lds_byte(wc * 32 + n * 16 + fr, k * 32 + fq * 8))
#define MMA(ai, bj, At_, Bt_) do { __builtin_amdgcn_s_setprio(1); \
        _Pragma("unroll") for (int m = 0; m < 4; ++m) _Pragma("unroll") for (int n = 0; n < 2; ++n) _Pragma("unroll") for (int k = 0; k < 2; ++k) \
            acc[ai][bj][m][n] = __builtin_amdgcn_mfma_f32_16x16x32_bf16(Bt_[n][k], At_[m][k], acc[ai][bj][m][n], 0, 0, 0); \
        __builtin_amdgcn_s_setprio(0); } while (0)
#define WAIT_V(n) asm volatile("s_waitcnt vmcnt(" #n ")" ::: "memory")
#define WAIT_L(n) asm volatile("s_waitcnt lgkmcnt(" #n ")" ::: "memory")
#define BAR __builtin_amdgcn_s_barrier()
#define SCHED __builtin_amdgcn_sched_barrier(0)
    int tz = threadIdx.x; asm volatile("" : "+v"(tz));
    int wid = __builtin_amdgcn_readfirstlane(tz >> 6), lane = tz & 63, wr = wid >> 2, wc = wid & 3, fr = lane & 15, fq = lane >> 4;
    unsigned ao[4], bo;
    { int r0, c0; g8_stage_rc(tz * 16, r0, c0);
      if constexpr (GATHER) {
#pragma unroll
          for (int q = 0; q < 4; ++q) ao[q] = (unsigned)(ltok[(q >> 1) * 128 + (q & 1) * 64 + r0] * lda + c0) * 2u;
      } else { ao[0] = (unsigned)(r0 * lda + c0) * 2u; ao[1] = ao[2] = ao[3] = 0; }
      bo = (unsigned)(r0 * ldb + c0) * 2u; }
    g8_acc acc;
#pragma unroll
    for (int a = 0; a < 2; ++a)
#pragma unroll
        for (int b = 0; b < 2; ++b)
#pragma unroll
            for (int m = 0; m < 4; ++m)
#pragma unroll
                for (int n = 0; n < 2; ++n) acc[a][b][m][n] = f32x4{0, 0, 0, 0};
    bf16x8 At[4][2], B0[2][2], B1[2][2];
#pragma unroll 1
    for (int pass = 0; pass < NPASS; ++pass) {
    if (pass == 1) { A += apass; Bt = Bt2;
        tz = threadIdx.x; asm volatile("" : "+v"(tz)); wid = __builtin_amdgcn_readfirstlane(tz >> 6); lane = tz & 63; wr = wid >> 2; wc = wid & 3; fr = lane & 15; fq = lane >> 4; }
    STAGE_B(SB(0, 0), 0, 0); STAGE_A(SA(0, 0), 0, 0);
    STAGE_B(SB(0, 1), 1, 0); STAGE_A(SA(0, 1), 1, 0);
    if (wr == 1) BAR;
    WAIT_V(4); BAR;
    STAGE_B(SB(1, 0), 0, 1); STAGE_A(SA(1, 0), 0, 1); STAGE_B(SB(1, 1), 1, 1);
    WAIT_V(6); BAR;
    for (int t = 0; t < nt - 2; t += 2) {
        LDB(B0, 0, 0); SCHED; LDA(At, 0, 0); STAGE_A(SA(1, 1), 1, t + 1);
        WAIT_L(8); BAR; WAIT_L(0); MMA(0, 0, At, B0); BAR; SCHED;
        LDB(B1, 0, 1); STAGE_B(SB(0, 0), 0, t + 2);
        BAR; WAIT_L(0); MMA(0, 1, At, B1); BAR;
        LDA(At, 0, 1); STAGE_A(SA(0, 0), 0, t + 2);
        BAR; WAIT_L(0); MMA(1, 0, At, B0); BAR; SCHED;
        STAGE_B(SB(0, 1), 1, t + 2);
        WAIT_V(6); BAR; MMA(1, 1, At, B1); BAR;
        LDB(B0, 1, 0); SCHED; LDA(At, 1, 0); STAGE_A(SA(0, 1), 1, t + 2);
        WAIT_L(8); BAR; WAIT_L(0); MMA(0, 0, At, B0); BAR; SCHED;
        LDB(B1, 1, 1); STAGE_B(SB(1, 0), 0, t + 3);
        BAR; WAIT_L(0); MMA(0, 1, At, B1); BAR;
        LDA(At, 1, 1); STAGE_A(SA(1, 0), 0, t + 3);
        BAR; WAIT_L(0); MMA(1, 0, At, B0); BAR; SCHED;
        STAGE_B(SB(1, 1), 1, t + 3);
        WAIT_V(6); BAR; MMA(1, 1, At, B1); BAR;
    }
    tz = threadIdx.x; asm volatile("" : "+v"(tz)); wid = __builtin_amdgcn_readfirstlane(tz >> 6); lane = tz & 63; wr = wid >> 2; wc = wid & 3; fr = lane & 15; fq = lane >> 4;
    { int r0, c0; g8_stage_rc(tz * 16, r0, c0);
      if constexpr (GATHER) {
#pragma unroll
          for (int q = 2; q < 4; ++q) ao[q] = (unsigned)(ltok[(q >> 1) * 128 + (q & 1) * 64 + r0] * lda + c0) * 2u;
      } else ao[0] = (unsigned)(r0 * lda + c0) * 2u; }
    { LDB(B0, 0, 0); WAIT_V(0); LDA(At, 0, 0); STAGE_A(SA(1, 1), 1, nt - 1);
      BAR; WAIT_L(0); MMA(0, 0, At, B0); BAR;
      LDB(B1, 0, 1); BAR; WAIT_L(0); MMA(0, 1, At, B1); BAR;
      LDA(At, 0, 1); WAIT_V(4); BAR; WAIT_L(0); MMA(1, 0, At, B0); MMA(1, 1, At, B1); BAR; }
    { LDB(B0, 1, 0); LDA(At, 1, 0); WAIT_V(2); BAR; WAIT_L(0); MMA(0, 0, At, B0); BAR;
      LDB(B1, 1, 1); WAIT_V(0); BAR; WAIT_L(0); MMA(0, 1, At, B1); BAR;
      LDA(At, 1, 1); BAR; WAIT_L(0); MMA(1, 0, At, B0); MMA(1, 1, At, B1); BAR; }
    if (wr == 0) BAR;
    }
    SBAR();
    epi(acc, wr, wc, fr, fq);
#undef SA
#undef SB
#undef STAGE_A
#undef STAGE_B
#undef LDA
#undef LDB
#undef MMA
#undef WAIT_V
#undef WAIT_L
#undef BAR
#undef SCHED
}
template <class F> DEVI void g8_for_acc(g8_acc& acc, int wr, int wc, int fr, int fq, F f) {
#pragma unroll
    for (int ai = 0; ai < 2; ++ai)
#pragma unroll
        for (int m = 0; m < 4; ++m)
        {
#pragma unroll
            for (int bj = 0; bj < 2; ++bj) { SBAR();
#pragma unroll
                for (int n = 0; n < 2; ++n) f(ai * 128 + wr * 64 + m * 16 + fr, bj * 128 + wc * 32 + n * 16 + fq * 4, acc[ai][bj][m][n]); } }
}

struct Params { const float* in[22]; float* out; char* ws; int nphases; int ph_lo; };

struct Ctx { float* out; char* ws; char* lds; int G, vcu; };
#define TID_SETUP() int tid = threadIdx.x; asm volatile("" : "+v"(tid)); const int lane = tid & 63; const int wid = __builtin_amdgcn_readfirstlane(tid >> 6); (void)lane; (void)wid

DEVI short* res_row(const Ctx& c, int r) { return (short*)(c.ws + WS_RES) + (size_t)r * D; }
DEVI const float* in_row(const Params& P, int r) { return r < T_CTX ? P.in[2] + (size_t)r * D : P.in[0] + (size_t)(r - T_CTX) * D; }
DEVI f32x4 ld_bf4(const short* p) { const u32x2 w = *(const u32x2*)p; return f32x4{bflo(w[0]), bfhi(w[0]), bflo(w[1]), bfhi(w[1])}; }
DEVI void st_bf4(short* p, f32x4 v) { *(u32x2*)p = u32x2{cvtpk(v[0], v[1]), cvtpk(v[2], v[3])}; }
DEVI f32x4 res_load4(const Params& P, const Ctx& c, int r, int col, int layer) { return layer == 0 ? *(const f32x4*)(in_row(P, r) + col) : ld_bf4(res_row(c, r) + col); }

DEVI void cls_experts(int cls, int& ea, int& eb);
DEVI void phase_prologue(const Params& P, const Ctx& c) {
    TID_SETUP();
    const long gtid = (long)blockIdx.x * NTHR + tid; const long gsz = (long)c.G * NTHR;
    float* sv = (float*)(c.lds + LDS_GEMM);
    for (int i = tid; i < 3 * 1024; i += NTHR) { const int v = i >> 10, k = i & 1023; const float x = (v < 2) ? P.in[1][v * 1024 + k] : P.in[3][k]; sv[i] = silu(x); }
    float* tc = sv + 3 * 1024;
    for (int i = tid; i < 128; i += NTHR) { tc[i] = cospif(i / 64.f); tc[128 + i] = sinpif(i / 64.f); }
    __syncthreads();
    {
        float* modp = (float*)(c.ws + WS_MODP);
        const float* w_ada = P.in[4];
        for (long it = gtid; it < (long)8 * 4 * 6144; it += gsz) {
            const int j = (int)(it % 6144); const int l = (int)((it / 6144) & 3); const int ks = (int)(it / (6144 * 4));
            const float* w = w_ada + ((size_t)l * 1024 + ks * 128) * 6144 + j;
            float a0 = 0, a1 = 0, a2 = 0;
            for (int k = 0; k < 128; ++k) { const float wv = w[(size_t)k * 6144]; const int kk = ks * 128 + k; a0 += sv[kk] * wv; a1 += sv[1024 + kk] * wv; a2 += sv[2048 + kk] * wv; }
            float* o = modp + ((size_t)(ks * 4 + l) * 3) * 6144 + j;
            o[0] = a0; o[6144] = a1; o[2 * 6144] = a2;
        }
    }
    {
        float* tl = (float*)(c.lds + LDS_GEMM + 16384);
        const int NT_IN = 4 * 16 * 15, NT_OUT = 4 * 16 * 16, NT_GU = 4 * 16 * 16 * 4 * 2, NT_DN = 4 * NCLS * 2 * 4 * 16;
        struct TD { const float* s; short* d; int sld, dld, k0, n0, nvalid, mode; };
        auto desc = [&](int tix) { TD t; t.mode = 0;
            if (tix < NT_IN) { const int l = tix / 240, r = tix % 240, kt = r / 15, nt2 = r % 15; t.s = P.in[8] + (size_t)l * 1024 * INW; t.sld = INW; t.d = (short*)(c.ws + WS_WIN) + (size_t)l * 1024 * 1024; t.dld = 1024; t.k0 = kt * 64; t.n0 = nt2 * 64; t.nvalid = INW; }
            else if (tix < NT_IN + NT_OUT) { const int t2 = tix - NT_IN; const int l = t2 >> 8, r = t2 & 255; t.s = P.in[16] + (size_t)l * 1024 * 1024; t.sld = 1024; t.d = (short*)(c.ws + WS_WOUT) + (size_t)l * 1024 * 1024; t.dld = 1024; t.k0 = (r >> 4) * 64; t.n0 = (r & 15) * 64; t.nvalid = 1024; }
            else if (tix < NT_IN + NT_OUT + NT_GU) { const int t2 = tix - NT_IN - NT_OUT; const int gu = t2 & 1, r = t2 >> 1; const int le = r >> 6, kt = (r >> 2) & 15, nt2 = r & 3;
                t.s = (gu ? P.in[20] : P.in[19]) + (size_t)le * 1024 * 256; t.sld = 256; t.d = (short*)(c.ws + WS_WGU) + (size_t)le * 512 * 1024; t.dld = 1024; t.k0 = kt * 64; t.n0 = nt2 * 64; t.nvalid = 256; t.mode = 1 + gu; }
            else { const int t2 = tix - NT_IN - NT_OUT - NT_GU; const int lch = t2 >> 6, kt = (t2 >> 4) & 3, nt2 = t2 & 15; const int half = lch & 1, lc = lch >> 1, cl = lc % NCLS, l = lc / NCLS;
                int ea, eb; cls_experts(cl, ea, eb); const int e = half ? eb : ea;
                t.s = P.in[21] + (size_t)(l * 16 + e) * 256 * 1024; t.sld = 1024; t.d = (short*)(c.ws + WS_WDN) + (size_t)lc * 1024 * 512 + half * 256; t.dld = 512; t.k0 = kt * 64; t.n0 = nt2 * 64; t.nvalid = 1024; }
            return t; };
        const int NTILES = NT_IN + NT_OUT + NT_GU + NT_DN;
        const int lkk = tid >> 3, lcg = (tid & 7) * 8;
        f32x4 x0 = {0, 0, 0, 0}, x1 = {0, 0, 0, 0};
        auto tload = [&](const TD& t) { x0 = f32x4{0, 0, 0, 0}; x1 = f32x4{0, 0, 0, 0};
            if (t.n0 + lcg < t.nvalid) { const float* sp = t.s + (size_t)(t.k0 + lkk) * t.sld + t.n0 + lcg; x0 = *(const f32x4*)sp; x1 = *(const f32x4*)(sp + 4); } };
        int tix = blockIdx.x, pb = 0;
        TD cur = desc(tix < NTILES ? tix : 0);
        __syncthreads();
        if (tix < NTILES) tload(cur);
        for (; tix < NTILES; tix += c.G, pb ^= 1) {
            float* tlb = tl + pb * (64 * 65);
#pragma unroll
            for (int j = 0; j < 4; ++j) { tlb[lkk * 65 + lcg + j] = x0[j]; tlb[lkk * 65 + lcg + 4 + j] = x1[j]; }
            const TD nxt = desc(tix + c.G < NTILES ? tix + c.G : 0);
            if (tix + c.G < NTILES) tload(nxt);
            __syncthreads();
            { const int n = tid >> 3, kg = (tid & 7) * 8; const int nn = cur.n0 + n;
              if (nn < cur.nvalid) { float v[8];
#pragma unroll
                for (int j = 0; j < 8; ++j) v[j] = tlb[(kg + j) * 65 + n];
                const int drow = cur.mode == 0 ? nn : ((nn >> 4) * 32 + (cur.mode - 1) * 16 + (nn & 15));
                *(u32x4*)(cur.d + (size_t)drow * cur.dld + cur.k0 + kg) = u32x4{cvtpk(v[0], v[1]), cvtpk(v[2], v[3]), cvtpk(v[4], v[5]), cvtpk(v[6], v[7])}; } }
            cur = nxt;
        }
        __syncthreads();
        { short* d = (short*)(c.ws + WS_WIN);
          for (long it = gtid; it < (long)4 * 96 * 128; it += gsz) { const int k8 = (int)(it & 127); const long lr = it >> 7; const int l = (int)(lr / 96), rr = (int)(lr % 96);
              *(u32x4*)(d + ((size_t)l * 1024 + INW + rr) * 1024 + k8 * 8) = u32x4{0, 0, 0, 0}; } }
    }
    {
        short* dst = (short*)(c.ws + WS_WQT);
        for (long it = gtid; it < (long)4 * 768 * 256; it += gsz) { const int k = (int)(it & 255); const long lf = it >> 8; const int f = (int)(lf % 768), l = (int)(lf / 768);
            dst[it] = (short)f2bf(P.in[9][l * 256 + k] * P.in[10][((size_t)l * 256 + k) * 768 + f]); }
        dst = (short*)(c.ws + WS_WKVT);
        for (long it = gtid; it < (long)4 * 1024 * 128; it += gsz) { const int k = (int)(it & 127); const long lf = it >> 7; const int f = (int)(lf & 1023), l = (int)(lf >> 10);
            dst[it] = (short)f2bf(P.in[11][l * 128 + k] * P.in[12][((size_t)l * 128 + k) * 1024 + f]); }
    }
    {
        short* dst = (short*)(c.ws + WS_WCS); const float* wf = P.in[15];
        for (long it = gtid; it < (long)4 * 4 * 128 * 256; it += gsz) {
            const int d = (int)(it & 127), ab = (int)((it >> 7) & 1), cc = (int)((it >> 8) & 127); const long lg = it >> 15;
            const float* w = wf + lg * 128 * 128 + d; const float* tt = tc + ab * 128;
            float a = 0;
            for (int j = 0; j < 128; ++j) a += tt[(cc * j) & 127] * w[j * 128];
            dst[it] = (short)f2bf(a * 0.08838834764831845f);
        }
    }
    {
        short* f1 = (short*)(c.ws + WS_F1);
        for (long it = gtid; it < 256 * 256; it += gsz) { const int kk = (int)(it & 255), m = (int)(it >> 8); const int k1 = (m >> 6) * 32 + (m & 31), ri = (m >> 5) & 1, n1 = kk >> 1, ab = kk & 1;
            const int a = (n1 * k1) & 127; const float cs = tc[a], sn = tc[128 + a];
            const float v = (ri == 0) ? (ab == 0 ? cs : -sn) : (ab == 0 ? -sn : -cs);
            f1[it] = (short)f2bf(v * 0.08838834764831845f); }
        short* f2 = (short*)(c.ws + WS_F2);
        for (long it = gtid; it < 128 * 256; it += gsz) { const int kk = (int)(it & 255), k2 = (int)(it >> 8); const int n2 = kk >> 1, ri = kk & 1;
            const int a = (n2 * k2) & 127; f2[it] = (short)f2bf((ri == 0 ? tc[a] : tc[128 + a]) * 0.08838834764831845f); }
        short* fc = (short*)(c.ws + WS_FC);
        for (long it = gtid; it < 256 * 512; it += gsz) { const int kk = (int)(it & 511), k = (int)(it >> 9); const int n = kk >> 1, ab = kk & 1;
            const int a = (n * k) & 255; const float v = ab == 0 ? cospif(a / 128.f) : -sinpif(a / 128.f); fc[it] = (short)f2bf(v * 0.0625f); }
        float2* tw = (float2*)(c.ws + WS_TW);
        for (long it = gtid; it < 16384; it += gsz) tw[it] = make_float2(cospif((float)it / 8192.f), sinpif((float)it / 8192.f));
        float2* rp = (float2*)(c.ws + WS_ROPE);
        for (long it = gtid; it < 256 * 8; it += gsz) { const int i = (int)(it & 7), pos = (int)(it >> 3); const float fr = powf(10000.f, -(float)i / 8.f); const float ang = (float)pos * fr;
            rp[it] = make_float2(cosf(ang), sinf(ang)); }
    }
}

DEVI void phase_coef(const Params& P, const Ctx& c) {
    TID_SETUP();
    const long gtid = (long)blockIdx.x * NTHR + tid; const long gsz = (long)c.G * NTHR;
    const float* modp = (const float*)(c.ws + WS_MODP); float* coef = (float*)(c.ws + WS_COEF);
    for (long it = gtid; it < (long)4 * 3 * 6144; it += gsz) {
        const int j = (int)(it % 6144); const int v = (int)((it / 6144) % 3); const int l = (int)(it / (6144 * 3));
        float m = P.in[5][l * 6144 + j];
        for (int ks = 0; ks < 8; ++ks) m += modp[((size_t)(ks * 4 + l) * 3 + v) * 6144 + j];
        const int chunk = j >> 10, col = j & 1023;
        float val; int slot;
        if (chunk == 0) { slot = 1; val = m; } else if (chunk == 1) { slot = 0; val = P.in[6][l * 1024 + col] * (1.f + m); } else if (chunk == 2) { slot = 2; val = m; }
        else if (chunk == 3) { slot = 4; val = m; } else if (chunk == 4) { slot = 3; val = P.in[7][l * 1024 + col] * (1.f + m); } else { slot = 5; val = m; }
        coef[((size_t)(l * 3 + v) * 6 + slot) * 1024 + col] = val;
    }
}

DEVI void phase_norm_mix(const Params& P, const Ctx& c, int l) {
    TID_SETUP();
    const float* coef = (const float*)(c.ws + WS_COEF) + (size_t)l * 3 * 6 * 1024;
    short* hbuf = (short*)(c.ws + WS_HBUF);
    for (int r = c.vcu * 8 + wid; r < T; r += c.G * 8) {
        const int v = row_variant(r);
        const float* a1 = coef + (size_t)(v * 6 + 0) * 1024; const float* b1 = coef + (size_t)(v * 6 + 1) * 1024;
        float xv[2][8]; float ss = 0;
        if (l == 0) { const float* x = in_row(P, r);
#pragma unroll
            for (int q = 0; q < 2; ++q) { const f32x4 t0 = *(const f32x4*)(x + q * 512 + lane * 8), t1 = *(const f32x4*)(x + q * 512 + lane * 8 + 4);
#pragma unroll
                for (int j = 0; j < 4; ++j) { xv[q][j] = t0[j]; xv[q][4 + j] = t1[j]; } } }
        else { const short* x = res_row(c, r);
#pragma unroll
            for (int q = 0; q < 2; ++q) { const u32x4 t = *(const u32x4*)(x + q * 512 + lane * 8);
#pragma unroll
                for (int j = 0; j < 4; ++j) { xv[q][2 * j] = bflo(t[j]); xv[q][2 * j + 1] = bfhi(t[j]); } } }
#pragma unroll
        for (int q = 0; q < 2; ++q)
#pragma unroll
            for (int j = 0; j < 8; ++j) ss += xv[q][j] * xv[q][j];
        ss = wave_sum(ss); const float rstd = rsqrtf(ss * (1.f / 1024.f) + EPS);
#pragma unroll
        for (int q = 0; q < 2; ++q) { const int col = q * 512 + lane * 8; const f32x4 a0 = *(const f32x4*)(a1 + col), a4 = *(const f32x4*)(a1 + col + 4), b0 = *(const f32x4*)(b1 + col), b4 = *(const f32x4*)(b1 + col + 4);
            float y[8];
#pragma unroll
            for (int j = 0; j < 4; ++j) { y[j] = xv[q][j] * rstd * a0[j] + b0[j]; y[4 + j] = xv[q][4 + j] * rstd * a4[j] + b4[j]; }
            *(u32x4*)(hbuf + (size_t)r * 1024 + col) = u32x4{cvtpk(y[0], y[1]), cvtpk(y[2], y[3]), cvtpk(y[4], y[5]), cvtpk(y[6], y[7])}; }
    }
}

DEVI u32x4 pack8(const float* p) {
    const unsigned a0 = cvtpk(p[0], p[1]), a1 = cvtpk(p[2], p[3]), b0 = cvtpk(p[4], p[5]), b1 = cvtpk(p[6], p[7]);
    auto r0 = __builtin_amdgcn_permlane32_swap(a0, b0, false, false); auto r1 = __builtin_amdgcn_permlane32_swap(a1, b1, false, false);
    return u32x4{r0[0], r1[0], r0[1], r1[1]};
}
template <int MB, int NB, class F> DEVI void for_acc_bf8(f32x16 (&acc)[MB][NB], int wm, int wn, int lane, F f) {
    const int r32 = lane & 31, hi = lane >> 5;
#pragma unroll
    for (int mb = 0; mb < MB; ++mb)
#pragma unroll
        for (int nb = 0; nb < NB; ++nb)
#pragma unroll
            for (int s = 0; s < 2; ++s) { float t[8];
#pragma unroll
                for (int j = 0; j < 8; ++j) t[j] = acc[mb][nb][8 * s + j];
                f((wm * MB + mb) * 32 + r32, (wn * NB + nb) * 32 + 16 * s + 8 * hi, pack8(t)); }
}
template <int MB, int NB, class F> DEVI void for_acc_f4(f32x16 (&acc)[MB][NB], int wm, int wn, int lane, F f) {
    const int r32 = lane & 31, hi = lane >> 5;
#pragma unroll
    for (int mb = 0; mb < MB; ++mb)
#pragma unroll
        for (int nb = 0; nb < NB; ++nb)
#pragma unroll
            for (int g = 0; g < 4; ++g) f((wm * MB + mb) * 32 + r32, (wn * NB + nb) * 32 + 8 * g + 4 * hi, f32x4{acc[mb][nb][4 * g], acc[mb][nb][4 * g + 1], acc[mb][nb][4 * g + 2], acc[mb][nb][4 * g + 3]});
}

DEVI void phase_inproj(const Params& P, const Ctx& c, int l) {
    TID_SETUP();
    const short* hbuf = (const short*)(c.ws + WS_HBUF); const short* WT = (const short*)(c.ws + WS_WIN) + (size_t)l * 1024 * 1024; short* zbuf = (short*)((char*)c.out);
    for (int u = c.vcu; u < 64; u += c.G) {
        const int rt = u >> 3, ct = u & 7; const int row0 = rt * 64, col0 = ct * 128;
        gemm_tile<1, 1, 2, 4, false, true>(c.lds + LDS_GEMM, 16,
            [&](int r) { return hbuf + (size_t)(row0 + r) * 1024; },
            [&](int n) { return WT + (size_t)(col0 + n) * 1024; },
            [&](f32x16 (&acc)[1][1], int wm, int wn) {
                for_acc_bf8<1, 1>(acc, wm, wn, lane, [&](int r, int cc, u32x4 v) { const int col = col0 + cc; if (col < INW) *(u32x4*)(zbuf + (size_t)(row0 + r) * ZLD + col) = v; });
            });
    }
    for (int u = c.vcu; u < 512; u += c.G) {
        const int rt = 2 + (u >> 2), ct = u & 3; const int row0 = rt * 256, col0 = ct * 256;
        __syncthreads();
        gemm256<false, 1>(c.lds + LDS_GEMM, 16, hbuf + (size_t)row0 * 1024, 1024, nullptr, WT + (size_t)col0 * 1024, 1024, 0, nullptr,
            [&](g8_acc& acc, int wr, int wc, int fr, int fq) {
                g8_for_acc(acc, wr, wc, fr, fq, [&](int r, int cc, f32x4 v) { const int col = col0 + cc;
                    if (col < INW) *(u32x2*)(zbuf + (size_t)(row0 + r) * ZLD + col) = u32x2{cvtpk(v[0], v[1]), cvtpk(v[2], v[3])}; });
            });
    }
}

template <int NCOL, int NTOK = 128> DEVI void tile_rowstat(const Ctx& c, int tid, int tok0, int col0, float* stat) {
    const short* zbuf = (const short*)((char*)c.out);
    constexpr int TPT = NTHR / NTOK, per = NCOL / TPT;
    const int t = tid / TPT, q = tid % TPT;
    const short* p = zbuf + (size_t)(tok0 + t) * ZLD + col0 + q * per;
    u32x4 w[per / 8];
#pragma unroll
    for (int i = 0; i < per / 8; ++i) w[i] = *(const u32x4*)(p + i * 8);
    float ss = 0;
#pragma unroll
    for (int i = 0; i < per / 8; ++i)
#pragma unroll
        for (int j = 0; j < 4; ++j) { const float a = bflo(w[i][j]), b = bfhi(w[i][j]); ss += a * a + b * b; }
    ss += __shfl_xor(ss, 1, 64); if constexpr (TPT == 4) ss += __shfl_xor(ss, 2, 64);
    if (q == 0) stat[t] = ss / (float)NCOL;
}
DEVI float half_sum(float v) { auto rr = __builtin_amdgcn_permlane32_swap(__float_as_uint(v), __float_as_uint(v), false, false); return __uint_as_float(rr[0]) + __uint_as_float(rr[1]); }

DEVI void rope16(float (&x)[16], int n, bool lat, int hi, const float2* ropetab) {
    if (!lat) return;
    const int prow = n >> 6, pcol = n & 63;
#pragma unroll
    for (int j = 0; j < 4; ++j) {
        const int i = j + 4 * hi;
        const float2 cr = ropetab[prow * 8 + i], cc = ropetab[pcol * 8 + i];
        const float a1 = x[j], a2 = x[j + 4]; x[j] = a1 * cr.x - a2 * cr.y; x[j + 4] = a2 * cr.x + a1 * cr.y;
        const float b1 = x[8 + j], b2 = x[12 + j]; x[8 + j] = b1 * cc.x - b2 * cc.y; x[12 + j] = b2 * cc.x + b1 * cc.y;
    }
}

template <int NB> DEVI void pc_q_unit(const Params& P, const Ctx& c, int l, int tok0, int hp, int tid, int lane) {
    const short* zbuf = (const short*)((char*)c.out);
    float* stat = (float*)(c.lds + LDS_STAT);
    const float2* ropetab = (const float2*)(c.ws + WS_ROPE);
    tile_rowstat<QLR, 128 * NB>(c, tid, tok0, 0, stat);
    const short* WQT = (const short*)(c.ws + WS_WQT) + ((size_t)l * 768 + hp * 192) * 256;
    const float* qn = P.in[13] + l * DQK;
    gemm_tile<3, NB, 2, 4, false, false>(c.lds + LDS_GEMM, 4,
        [&](int r) { return WQT + (size_t)r * 256; },
        [&](int n) { return zbuf + (size_t)(tok0 + n) * ZLD; },
        [&](f32x16 (&acc)[3][NB], int wm, int wn) {
#pragma unroll
            for (int nb = 0; nb < NB; ++nb) {
                const int hi = lane >> 5, r32 = lane & 31; const int tl = (wn * NB + nb) * 32 + r32, row = tok0 + tl, h = hp * 2 + wm;
                const bool lat = row >= T_CTX; const int rr = lat ? row - T_CTX : row; const int b = lat ? (rr >> 14) : (rr >> 8); const int n = lat ? (rr & 16383) : (rr & 255);
                const float s1 = rsqrtf(stat[tl] + EPS);
                float ss = 0;
#pragma unroll
                for (int mb = 0; mb < 3; ++mb)
#pragma unroll
                    for (int r = 0; r < 16; ++r) ss += acc[mb][nb][r] * acc[mb][nb][r];
                ss = half_sum(ss);
                const float s2 = rsqrtf(s1 * s1 * ss * (1.f / 96.f) + EPS); const float sc = s1 * s2 * ATT_QSCALE;
                float x[3][16];
#pragma unroll
                for (int mb = 0; mb < 3; ++mb)
#pragma unroll
                    for (int g4 = 0; g4 < 4; ++g4) { const f32x4 g = *(const f32x4*)(qn + mb * 32 + 8 * g4 + 4 * hi);
#pragma unroll
                        for (int j = 0; j < 4; ++j) x[mb][g4 * 4 + j] = acc[mb][nb][g4 * 4 + j] * sc * g[j]; }
                rope16(x[2], n, lat, hi, ropetab);
                short* dst = lat ? (short*)(c.ws + WS_QBUF) + ((size_t)(b * NH + h) * SEQ + n) * DQK : (short*)(c.ws + WS_QCTX) + ((size_t)(b * NH + h) * NCTX + n) * DQK;
#pragma unroll
                for (int mb = 0; mb < 3; ++mb)
#pragma unroll
                    for (int s = 0; s < 2; ++s) *(u32x4*)(dst + mb * 32 + s * 16 + hi * 8) = pack8(&x[mb][s * 8]);
            }
        });
}

template <int NB> DEVI void pc_kv_unit(const Params& P, const Ctx& c, int l, int tok0, int hp, int tid, int lane) {
    const short* zbuf = (const short*)((char*)c.out);
    float* stat = (float*)(c.lds + LDS_STAT);
    const float2* ropetab = (const float2*)(c.ws + WS_ROPE);
    tile_rowstat<KVLR, 128 * NB>(c, tid, tok0, QLR, stat);
    const short* WKVT = (const short*)(c.ws + WS_WKVT) + ((size_t)l * 1024 + hp * 256) * 128;
    const float* kn = P.in[14] + l * DQK;
    gemm_tile<4, NB, 2, 4, false, false, (NB == 1 ? 2 : 1)>(c.lds + LDS_GEMM, 2,
        [&](int r) { return WKVT + (size_t)r * 128; },
        [&](int n) { return zbuf + (size_t)(tok0 + n) * ZLD + QLR; },
        [&](f32x16 (&acc)[4][NB], int wm, int wn) {
#pragma unroll
            for (int nb = 0; nb < NB; ++nb) {
                const int hi = lane >> 5, r32 = lane & 31; const int tl = (wn * NB + nb) * 32 + r32, row = tok0 + tl, h = hp * 2 + wm;
                const bool lat = row >= T_CTX; const int rr = lat ? row - T_CTX : row; const int b = lat ? (rr >> 14) : (rr >> 8); const int n = lat ? (rr & 16383) : (rr & 255);
                const int pos = lat ? NCTX + n : n;
                const float s1 = rsqrtf(stat[tl] + EPS);
                float kr[16];
#pragma unroll
                for (int g4 = 0; g4 < 4; ++g4) { const u32x2 w = *(const u32x2*)(zbuf + (size_t)row * ZLD + QLR + KVLR + 8 * g4 + 4 * hi);
                    kr[g4 * 4 + 0] = bflo(w[0]); kr[g4 * 4 + 1] = bfhi(w[0]); kr[g4 * 4 + 2] = bflo(w[1]); kr[g4 * 4 + 3] = bfhi(w[1]); }
                float ss = 0;
#pragma unroll
                for (int mb = 0; mb < 2; ++mb)
#pragma unroll
                    for (int r = 0; r < 16; ++r) { const float t = acc[mb][nb][r] * s1; ss += t * t; }
#pragma unroll
                for (int r = 0; r < 16; ++r) ss += kr[r] * kr[r];
                ss = half_sum(ss);
                const float s2 = rsqrtf(ss * (1.f / 96.f) + EPS);
                float x[3][16];
#pragma unroll
                for (int mb = 0; mb < 3; ++mb)
#pragma unroll
                    for (int g4 = 0; g4 < 4; ++g4) { const f32x4 g = *(const f32x4*)(kn + mb * 32 + 8 * g4 + 4 * hi);
#pragma unroll
                        for (int j = 0; j < 4; ++j) x[mb][g4 * 4 + j] = (mb < 2 ? acc[mb][nb][g4 * 4 + j] * s1 : kr[g4 * 4 + j]) * s2 * g[j]; }
                rope16(x[2], n, lat, hi, ropetab);
                short* kd = (short*)(c.ws + WS_KBUF) + ((size_t)(b * NH + h) * NKEY + pos) * DQK;
#pragma unroll
                for (int mb = 0; mb < 3; ++mb)
#pragma unroll
                    for (int s = 0; s < 2; ++s) *(u32x4*)(kd + mb * 32 + s * 16 + hi * 8) = pack8(&x[mb][s * 8]);
                short* vd = (short*)(c.ws + WS_VBUF) + ((size_t)(b * NH + h) * NKEY + pos) * DV;
                float vv[2][16];
#pragma unroll
                for (int mb = 0; mb < 2; ++mb)
#pragma unroll
                    for (int r = 0; r < 16; ++r) vv[mb][r] = acc[2 + mb][nb][r] * s1;
#pragma unroll
                for (int mb = 0; mb < 2; ++mb)
#pragma unroll
                    for (int s = 0; s < 2; ++s) *(u32x4*)(vd + mb * 32 + s * 16 + hi * 8) = pack8(&vv[mb][s * 8]);
            }
        });
}

DEVI void phase_proj2(const Params& P, const Ctx& c, int l) {
    TID_SETUP();
    const short* zbuf = (const short*)((char*)c.out);
    for (int u = c.vcu + PC_U0; u < (l < DEPTH - 1 ? 1072 : 1056); u += c.G) {
        __syncthreads();
        if (u < 512) pc_q_unit<2>(P, c, l, T_CTX + (u >> 2) * 256, u & 3, tid, lane);
        else if (u < 1024) pc_kv_unit<2>(P, c, l, T_CTX + ((u - 512) >> 2) * 256, u & 3, tid, lane);
        else if (u < 1040) pc_q_unit<1>(P, c, l, ((u - 1024) >> 2) * 128, u & 3, tid, lane);
        else if (u < 1056) pc_kv_unit<1>(P, c, l, ((u - 1040) >> 2) * 128, u & 3, tid, lane);
        else {
            const int uu = u - 1056; const int rt = uu >> 3, g = (uu >> 1) & 3, ct = uu & 1; const int row0 = rt * 256;
            const short* W = (const short*)(c.ws + WS_WCS) + ((size_t)(l * 4 + g) * 128) * 256 + ct * 128; short* U = (short*)(c.ws + WS_UCTX);
            gemm_tile<2, 2, 4, 2, true, true>(c.lds + LDS_GEMM, 2,
                [&](int r) { return zbuf + (size_t)(row0 + r) * ZLD + 416 + g * 128; },
                [&](int k) { return W + (size_t)k * 256; },
                [&](f32x16 (&acc)[2][2], int wm, int wn) {
                    for_acc_bf8<2, 2>(acc, wm, wn, lane, [&](int r, int cc, u32x4 v) { *(u32x4*)(U + (size_t)(row0 + r) * 1024 + g * 256 + ct * 128 + cc) = v; });
                });
        }
    }
}

constexpr int AT_VB = 64 * 64 * 2, AT_KB = 64 * 256, AT_V = 0, AT_K = 3 * AT_VB, AT_WS = AT_K + 3 * AT_KB;
#define KSWZ(row, colB) ((row) * 256 + ((colB) ^ (((row) & 15) << 4)))

DEVI void att_exp16(f32x16& p, float& l) {
#pragma unroll
    for (int r = 0; r < 16; ++r) { p[r] = __builtin_amdgcn_exp2f(p[r]); l += p[r]; }
}
DEVI void att_pack(const f32x16& p0, const f32x16& p1, bf16x8& pa0, bf16x8& pa1, bf16x8& pa2, bf16x8& pa3) {
#define PK4(P, BASE, OUT) do { u32x4 w = {cvtpk(P[BASE + 0], P[BASE + 1]), cvtpk(P[BASE + 2], P[BASE + 3]), cvtpk(P[BASE + 4], P[BASE + 5]), cvtpk(P[BASE + 6], P[BASE + 7])}; \
    OUT = *reinterpret_cast<bf16x8*>(&w); } while (0)
    PK4(p0, 0, pa0); PK4(p0, 8, pa1); PK4(p1, 0, pa2); PK4(p1, 8, pa3);
#undef PK4
}
template <bool SHIFT> DEVI void att_qkt(f32x16& p0, f32x16& p1, const char* Ks, const bf16x8* qr, int r32, int hi, float init) {
    if constexpr (SHIFT) {
#pragma unroll
        for (int r = 0; r < 16; ++r) { p0[r] = init; p1[r] = init; }
    } else { p0 = f32x16{}; p1 = f32x16{}; }
    bf16x8 b0 = *reinterpret_cast<const bf16x8*>(Ks + KSWZ(r32, hi * 16));
    bf16x8 b1 = *reinterpret_cast<const bf16x8*>(Ks + KSWZ(32 + r32, hi * 16));
#pragma unroll
    for (int d0 = 0; d0 < 6; ++d0) {
        bf16x8 n0 = b0, n1 = b1;
        if (d0 < 5) { const int cb = ((d0 + 1) * 16 + hi * 8) * 2;
            n0 = *reinterpret_cast<const bf16x8*>(Ks + KSWZ(r32, cb)); n1 = *reinterpret_cast<const bf16x8*>(Ks + KSWZ(32 + r32, cb)); }
        p0 = __builtin_amdgcn_mfma_f32_32x32x16_bf16(b0, qr[d0], p0, 0, 0, 0);
        p1 = __builtin_amdgcn_mfma_f32_32x32x16_bf16(b1, qr[d0], p1, 0, 0, 0);
        b0 = n0; b1 = n1; }
}
constexpr int att_v_off(int d0, int ks, int half) { return d0 * 512 + ks * 2048 + half * 1024; }
struct VFrag { s16x4 l0, h0, l1, h1, l2, h2, l3, h3; };
template <int D0> DEVI void att_vread(VFrag& f, int vb) {
    f.l0 = tr_read<att_v_off(D0, 0, 0)>(vb); f.h0 = tr_read<att_v_off(D0, 0, 1)>(vb); f.l1 = tr_read<att_v_off(D0, 1, 0)>(vb); f.h1 = tr_read<att_v_off(D0, 1, 1)>(vb);
    f.l2 = tr_read<att_v_off(D0, 2, 0)>(vb); f.h2 = tr_read<att_v_off(D0, 2, 1)>(vb); f.l3 = tr_read<att_v_off(D0, 3, 0)>(vb); f.h3 = tr_read<att_v_off(D0, 3, 1)>(vb);
}
DEVI void att_pv_mm(f32x16& od, const VFrag& f, bf16x8 pa0, bf16x8 pa1, bf16x8 pa2, bf16x8 pa3) {
    od = __builtin_amdgcn_mfma_f32_32x32x16_bf16(pa0, PK8(f.l0, f.h0), od, 0, 0, 0);
    od = __builtin_amdgcn_mfma_f32_32x32x16_bf16(pa1, PK8(f.l1, f.h1), od, 0, 0, 0);
    od = __builtin_amdgcn_mfma_f32_32x32x16_bf16(pa2, PK8(f.l2, f.h2), od, 0, 0, 0);
    od = __builtin_amdgcn_mfma_f32_32x32x16_bf16(pa3, PK8(f.l3, f.h3), od, 0, 0, 0);
}
DEVI void att_lsum(f32x16& l, bf16x8 pa, bf16x8 pb) {
    const bf16x8 ones = {(short)0x3F80, (short)0x3F80, (short)0x3F80, (short)0x3F80, (short)0x3F80, (short)0x3F80, (short)0x3F80, (short)0x3F80};
    l = __builtin_amdgcn_mfma_f32_32x32x16_bf16(pa, ones, l, 0, 0, 0);
    l = __builtin_amdgcn_mfma_f32_32x32x16_bf16(pb, ones, l, 0, 0, 0);
}

template <bool SHIFT> DEVI void attn_body(const short* __restrict__ Qb, const short* __restrict__ Kh, const short* __restrict__ Vh, short* __restrict__ Ob, int seq, float shift, char* lds) {
    int tid = threadIdx.x; asm volatile("" : "+v"(tid)); const int wid = __builtin_amdgcn_readfirstlane(tid >> 6), lane = tid & 63, r32 = lane & 31, hi = lane >> 5;
    char* V_lds = lds + AT_V; char* K_lds = lds + AT_K;
    if (wid >= 4) __builtin_amdgcn_s_setprio(1);
    f32x16 o[2] = {f32x16{}, f32x16{}}; float l_reg = 0.f; bf16x8 qr[6];
    const short* Qw = Qb + (size_t)(wid * 32 + r32) * DQK + hi * 8;
#pragma unroll
    for (int d0 = 0; d0 < 6; ++d0) qr[d0] = *(const bf16x8*)(Qw + d0 * 16);
    const int kc0 = tid, kc1 = (tid + 512 < 768) ? tid + 512 : 767;
    const int kst0 = KSWZ(kc0 / 12, (kc0 % 12) * 16), kst1 = KSWZ(kc1 / 12, (kc1 % 12) * 16);
    const int vkey = tid >> 3, vcol = (tid & 7) * 8;
    const int vkk = vkey;
    const int vst = ((vkk >> 3) * 2 + (vcol >> 5)) * 512 + ((vkk & 7) * 32 + (vcol & 31)) * 2;
    const int vb0 = (int)(uintptr_t)V_lds + nn_rd_base(lane);
    struct { bf16x8 vs, k0, k1; } sr_;
    const int NT = seq / 64; const float init = -shift;
#define SLOAD(t) do { const int tt_ = (t) < NT ? (t) : NT - 1; sr_.vs = *(const bf16x8*)(Vh + (size_t)tt_ * 64 * DV + tid * 8); \
    sr_.k0 = *(const bf16x8*)(Kh + (size_t)tt_ * 64 * DQK + kc0 * 8); sr_.k1 = *(const bf16x8*)(Kh + (size_t)tt_ * 64 * DQK + kc1 * 8); } while (0)
#define SWRITE(b) do { *(bf16x8*)(V_lds + (b) * AT_VB + vst) = sr_.vs; *(bf16x8*)(K_lds + (b) * AT_KB + kst0) = sr_.k0; *(bf16x8*)(K_lds + (b) * AT_KB + kst1) = sr_.k1; } while (0)
    f32x16 pA0, pA1, pB0, pB1; bf16x8 pa0, pa1, pa2, pa3; VFrag vf, vf1;
#define STEP(PC0, PC1, PP0, PP1, TNEXT2, DOWRITE) do {                                                            \
        int bn = bc + 1; if (bn == 3) bn = 0;                                                                      \
        if (DOWRITE) SWRITE(bn);                                                                                   \
        SBAR(); SLOAD(TNEXT2);                                                                                     \
        SBAR(); att_vread<0>(vf, vb0 + bp * AT_VB); att_vread<1>(vf1, vb0 + bp * AT_VB);                           \
        att_qkt<SHIFT>(PC0, PC1, K_lds + bc * AT_KB, qr, r32, hi, init);                                           \
        att_exp16(PP1, l_reg); att_pack(PP0, PP1, pa0, pa1, pa2, pa3); SBAR();                                     \
        asm volatile("s_waitcnt lgkmcnt(0)" ::: "memory"); SBAR();                                                 \
        att_pv_mm(o[0], vf, pa0, pa1, pa2, pa3); att_pv_mm(o[1], vf1, pa0, pa1, pa2, pa3);                         \
        att_exp16(PC0, l_reg);                                                                                     \
        __syncthreads();                                                                                           \
        bp = bc; bc = bn; } while (0)
    SLOAD(0); asm volatile("s_waitcnt vmcnt(0)" ::: "memory"); SWRITE(0); SBAR(); SLOAD(1); __syncthreads();
    SWRITE(1); SBAR(); SLOAD(2); SBAR();
    att_qkt<SHIFT>(pA0, pA1, K_lds, qr, r32, hi, init); att_exp16(pA0, l_reg);
    __syncthreads();
    int bc = 1, bp = 0;
    for (int j = 1; j + 1 < NT; j += 2) {
        STEP(pB0, pB1, pA0, pA1, j + 2, true);
        STEP(pA0, pA1, pB0, pB1, j + 3, (j + 2 < NT));
    }
    STEP(pB0, pB1, pA0, pA1, NT - 1, false);
    att_vread<0>(vf, vb0 + bp * AT_VB);
    att_exp16(pB1, l_reg); att_pack(pB0, pB1, pa0, pa1, pa2, pa3); SBAR();
    asm volatile("s_waitcnt lgkmcnt(0)" ::: "memory"); SBAR();
    att_pv_mm(o[0], vf, pa0, pa1, pa2, pa3); att_vread<1>(vf, vb0 + bp * AT_VB); SBAR();
    asm volatile("s_waitcnt lgkmcnt(0)" ::: "memory"); SBAR();
    att_pv_mm(o[1], vf, pa0, pa1, pa2, pa3);
    __builtin_amdgcn_s_setprio(0);
    short* Ow = Ob + (size_t)(wid * 32) * 1024;
    { auto rr = __builtin_amdgcn_permlane32_swap(__float_as_uint(l_reg), __float_as_uint(l_reg), false, false); l_reg = __uint_as_float(rr[0]) + __uint_as_float(rr[1]); }
    float* li_l = (float*)(lds + AT_WS) + wid * 32;
    __syncthreads();
    if (hi == 0) li_l[r32] = l_reg; asm volatile("s_waitcnt lgkmcnt(0)" ::: "memory");
#pragma unroll
    for (int r = 0; r < 16; ++r) { const int orow = crow(r, hi); const float rl = __builtin_amdgcn_rcpf(li_l[orow]);
#pragma unroll
        for (int d0 = 0; d0 < 2; ++d0) Ow[(size_t)orow * 1024 + d0 * 32 + r32] = (short)f2bf(o[d0][r] * rl); }
    __syncthreads();
#undef SLOAD
#undef SWRITE
#undef STEP
}

DEVI void phase_attn_fft1(const Params& P, const Ctx& c, int l) {
    TID_SETUP();
    short* mix = (short*)(c.ws + WS_HBUF);
    const short* qb = (const short*)(c.ws + WS_QBUF); const short* qc = (const short*)(c.ws + WS_QCTX);
    const short* kb = (const short*)(c.ws + WS_KBUF); const short* vb = (const short*)(c.ws + WS_VBUF);
    const int n_att = (l < DEPTH - 1) ? 1040 : 1024;
    float shift;
    { float mq = 0.f, mk = 0.f;
      for (int i = lane; i < DQK; i += 64) { mq = fmaxf(mq, fabsf(P.in[13][l * DQK + i])); mk = fmaxf(mk, fabsf(P.in[14][l * DQK + i])); }
#pragma unroll
      for (int o = 32; o > 0; o >>= 1) { mq = fmaxf(mq, __shfl_xor(mq, o, 64)); mk = fmaxf(mk, __shfl_xor(mk, o, 64)); }
      shift = 9.797958971132712f * 1.4426950408889634f * mq * mk * 1.0001f; }
    for (int u = c.vcu; u < n_att; u += c.G) {
        const short* Qp; short* Op; int bh, seq;
        if (u < 1024) {
            const int rnd = u >> 8, v = u & 255, xcd = v >> 5, j = v & 31; bh = xcd * 2 + (rnd >> 1); const int qblk = j + 32 * (rnd & 1);
            Qp = qb + ((size_t)bh * SEQ + qblk * 256) * DQK; Op = mix + (size_t)(T_CTX + (bh >> 3) * SEQ + qblk * 256) * 1024 + (bh & 7) * DV; seq = NKEY;
        } else {
            bh = u - 1024; Qp = qc + (size_t)bh * NCTX * DQK; Op = mix + (size_t)((bh >> 3) * NCTX) * 1024 + (bh & 7) * DV; seq = NCTX;
        }
        if (shift < 64.f) attn_body<false>(Qp, kb + (size_t)bh * NKEY * DQK, vb + (size_t)bh * NKEY * DV, Op, seq, shift, c.lds + LDS_GEMM);
        else attn_body<true>(Qp, kb + (size_t)bh * NKEY * DQK, vb + (size_t)bh * NKEY * DV, Op, seq, shift, c.lds + LDS_GEMM);
    }
#ifndef ATT_ONLY
    const short* zbuf = (const short*)((char*)c.out); const short* F1 = (const short*)(c.ws + WS_F1); short* P1 = (short*)(c.ws + WS_P1);
    const float2* tw = (const float2*)(c.ws + WS_TW);
    for (int u = c.vcu; u < 1024; u += c.G) {
        const int n2 = u & 127, g = (u >> 7) & 3, b = u >> 9;
        const short* Zb = zbuf + (size_t)(T_CTX + b * SEQ + n2) * ZLD + 416 + g * 128;
        const short* W = (const short*)(c.ws + WS_WCS) + ((size_t)(l * 4 + g) * 128) * 256;
        short* Pb = P1 + ((size_t)(b * 4 + g) * 128 * 128 + n2) * 256;
        LAS char* Sres = (LAS char*)(c.lds + LDS_GEMM) + 65536;
        gemm_tile<1, 4, 4, 2, true, true, 1>(c.lds + LDS_GEMM, 2,
            [&](int r) { return Zb + (size_t)r * (128 * ZLD); },
            [&](int k) { return W + (size_t)k * 256; },
            [&](f32x16 (&acc)[1][4], int wm, int wn) {
                for_acc_bf8<1, 4>(acc, wm, wn, lane, [&](int n1, int cc, u32x4 v) { const int kk = 2 * n1 + (cc >> 7), cp = cc & 127;
                    *(LAS u32x4*)(Sres + (kk >> 6) * 16384 + nn_st<128>(kk & 63, cp)) = v; });
            });
        gemm_tile<2, 2, 4, 2, true, true, 2, true>(c.lds + LDS_GEMM, 4,
            [&](int r) { return F1 + (size_t)r * 256; },
            [&](int kk) { return (const short*)nullptr; },
            [&](f32x16 (&acc)[2][2], int wm, int wn) {
                const int hi = lane >> 5, r32 = lane & 31; const int k1 = wm * 32 + r32;
                const float2 t = tw[(n2 * k1) & 16383];
                short* p = Pb + (size_t)k1 * (128 * 256);
#pragma unroll
                for (int nb = 0; nb < 2; ++nb)
#pragma unroll
                    for (int s = 0; s < 2; ++s) { float yr[8], yi[8];
#pragma unroll
                        for (int j = 0; j < 8; ++j) { const float a = acc[0][nb][8 * s + j], bb = acc[1][nb][8 * s + j]; yr[j] = a * t.x + bb * t.y; yi[j] = bb * t.x - a * t.y; }
                        const int cc = (wn * 2 + nb) * 32 + 16 * s + 8 * hi;
                        *(u32x4*)(p + cc) = pack8(yr); *(u32x4*)(p + 128 + cc) = pack8(yi); }
            });
    }
    if (l < DEPTH - 1) {
        const short* FC = (const short*)(c.ws + WS_FC);
        for (int u = c.vcu; u < 8; u += c.G) {
            const int g = u & 3, b = u >> 2;
            const short* Ub = (const short*)(c.ws + WS_UCTX) + (size_t)(b * NCTX) * 1024 + g * 256;
            gemm_tile<2, 2, 4, 2, true, true>(c.lds + LDS_GEMM, 8,
                [&](int r) { return FC + (size_t)r * 512; },
                [&](int kk) { return Ub + (size_t)(kk >> 1) * 1024 + (kk & 1) * 128; },
                [&](f32x16 (&acc)[2][2], int wm, int wn) {
                    for_acc_bf8<2, 2>(acc, wm, wn, lane, [&](int r, int cc, u32x4 v) { *(u32x4*)(mix + (size_t)(b * NCTX + r) * 1024 + 512 + g * 128 + cc) = v; });
                });
        }
    }
#endif
}

DEVI void phase_fft2(const Params& P, const Ctx& c, int l) {
    TID_SETUP();
    short* mix = (short*)(c.ws + WS_HBUF); const short* P1 = (const short*)(c.ws + WS_P1); const short* F2 = (const short*)(c.ws + WS_F2);
    for (int u = c.vcu; u < 1024; u += c.G) {
        const int k1 = u & 127, g = (u >> 7) & 3, b = u >> 9;
        const short* Pb = P1 + ((size_t)(b * 4 + g) * 128 + k1) * (128 * 256);
        gemm_tile<1, 2, 4, 2, true, true>(c.lds + LDS_GEMM, 4,
            [&](int r) { return F2 + (size_t)r * 256; },
            [&](int kk) { return Pb + (size_t)kk * 128; },
            [&](f32x16 (&acc)[1][2], int wm, int wn) {
                for_acc_bf8<1, 2>(acc, wm, wn, lane, [&](int k2, int cc, u32x4 v) { *(u32x4*)(mix + (size_t)(T_CTX + b * SEQ + k1 + 128 * k2) * 1024 + 512 + g * 128 + cc) = v; });
            });
    }
}

DEVI void phase_outproj(const Params& P, const Ctx& c, int l) {
    TID_SETUP();
    const short* mix = (const short*)(c.ws + WS_HBUF); const short* WT = (const short*)(c.ws + WS_WOUT) + (size_t)l * 1024 * 1024;
    const float* coef = (const float*)(c.ws + WS_COEF) + (size_t)l * 3 * 6 * 1024;
    if (l < DEPTH - 1) for (int u = c.vcu; u < 64; u += c.G) {
        const int rt = u >> 3, ct = u & 7; const int row0 = rt * 64, col0 = ct * 128;
        const float* g1 = coef + (size_t)(2 * 6 + 2) * 1024;
        gemm_tile<1, 1, 2, 4, false, true>(c.lds + LDS_GEMM, 16,
            [&](int r) { return mix + (size_t)(row0 + r) * 1024; },
            [&](int n) { return WT + (size_t)(col0 + n) * 1024; },
            [&](f32x16 (&acc)[1][1], int wm, int wn) {
                for_acc_f4<1, 1>(acc, wm, wn, lane, [&](int r, int cc, f32x4 v) { const int row = row0 + r, col = col0 + cc;
                    const f32x4 x = res_load4(P, c, row, col, l), g = *(const f32x4*)(g1 + col);
                    st_bf4(res_row(c, row) + col, f32x4{x[0] + g[0] * v[0], x[1] + g[1] * v[1], x[2] + g[2] * v[2], x[3] + g[3] * v[3]}); });
            });
    }
    for (int u = c.vcu; u < 512; u += c.G) {
        const int rt = 2 + (u >> 2), ct = u & 3; const int row0 = rt * 256, col0 = ct * 256;
        const float* g1 = coef + (size_t)(row_variant(row0) * 6 + 2) * 1024;
        __syncthreads();
        gemm256<false, 1>(c.lds + LDS_GEMM, 16, mix + (size_t)row0 * 1024, 1024, nullptr, WT + (size_t)col0 * 1024, 1024, 0, nullptr,
            [&](g8_acc& acc, int wr, int wc, int fr, int fq) {
                g8_for_acc(acc, wr, wc, fr, fq, [&](int r, int cc, f32x4 v) { const int row = row0 + r, col = col0 + cc;
                    const f32x4 x = res_load4(P, c, row, col, l), g = *(const f32x4*)(g1 + col);
                    st_bf4(res_row(c, row) + col, f32x4{x[0] + g[0] * v[0], x[1] + g[1] * v[1], x[2] + g[2] * v[2], x[3] + g[3] * v[3]}); });
            });
    }
}

DEVI void phase_norm_route(const Params& P, const Ctx& c, int l) {
    TID_SETUP();
    const float* coef = (const float*)(c.ws + WS_COEF) + (size_t)l * 3 * 6 * 1024;
    short* hbuf = (short*)(c.ws + WS_HBUF);
    constexpr int XP = 2064;
    char* xs_hi = c.lds + LDS_GEMM; char* xs_lo = xs_hi + 16 * XP;
    int* lcnt = (int*)(c.lds + LDS_GEMM + 66560);
    int* lrow = lcnt + 64;
    float* lgt = (float*)(c.lds + LDS_GEMM + 73728);
    float* part = (float*)(c.lds + LDS_GEMM + 90112);
    const int rows_per = (T + c.G - 1) / c.G; const int r_begin = c.vcu * rows_per; const int r_lim = (l == DEPTH - 1) ? T_CTX : 0;
    int r_end = r_begin + rows_per; if (r_end > T) r_end = T;
    __syncthreads();
    if (tid < 64) lcnt[tid] = 0;
    int* rcls = (int*)(c.ws + WS_RCLS); float2* rw = (float2*)(c.ws + WS_RW);
    const int e16 = lane & 15, kq = lane >> 4;
    bf16x8 wh[4], wl[4];
#pragma unroll
    for (int s = 0; s < 4; ++s) { float v[8];
#pragma unroll
        for (int j = 0; j < 8; ++j) v[j] = P.in[17][(size_t)(128 * wid + 32 * s + 8 * kq + j) * 16 + e16];
        u32x4 h = {cvtpk(v[0], v[1]), cvtpk(v[2], v[3]), cvtpk(v[4], v[5]), cvtpk(v[6], v[7])};
        u32x4 lo = {cvtpk(v[0] - bflo(h[0]), v[1] - bfhi(h[0])), cvtpk(v[2] - bflo(h[1]), v[3] - bfhi(h[1])), cvtpk(v[4] - bflo(h[2]), v[5] - bfhi(h[2])), cvtpk(v[6] - bflo(h[3]), v[7] - bfhi(h[3]))};
        wh[s] = *reinterpret_cast<bf16x8*>(&h); wl[s] = *reinterpret_cast<bf16x8*>(&lo); }
    const int nrows = r_end - r_begin; const int nch = (nrows + 15) >> 4;
    u32x4 xn[2][2];
#pragma unroll
    for (int h = 0; h < 2; ++h) { int i = 8 * h + wid; if (i > nrows - 1) i = nrows - 1; const short* x = res_row(c, r_begin + i);
#pragma unroll
        for (int q = 0; q < 2; ++q) xn[h][q] = *(const u32x4*)(x + q * 512 + lane * 8); }
    for (int ch = 0; ch < nch; ++ch) {
#pragma unroll
        for (int h = 0; h < 2; ++h) {
            const int i = 16 * ch + 8 * h + wid; const bool valid = i < nrows; const int r = r_begin + (valid ? i : nrows - 1); const int v = row_variant(r);
            const float* a2 = coef + (size_t)(v * 6 + 3) * 1024; const float* b2 = coef + (size_t)(v * 6 + 4) * 1024;
            float xv[2][8]; float ss = 0;
#pragma unroll
            for (int q = 0; q < 2; ++q)
#pragma unroll
                for (int j = 0; j < 4; ++j) { xv[q][2 * j] = bflo(xn[h][q][j]); xv[q][2 * j + 1] = bfhi(xn[h][q][j]); ss += xv[q][2 * j] * xv[q][2 * j] + xv[q][2 * j + 1] * xv[q][2 * j + 1]; }
            if (ch + 1 < nch) { int i2 = i + 16; if (i2 > nrows - 1) i2 = nrows - 1; const short* x = res_row(c, r_begin + i2);
#pragma unroll
                for (int q = 0; q < 2; ++q) xn[h][q] = *(const u32x4*)(x + q * 512 + lane * 8); }
            ss = wave_sum(ss); const float rstd = rsqrtf(ss * (1.f / 1024.f) + EPS);
#pragma unroll
            for (int q = 0; q < 2; ++q) { const int col = q * 512 + lane * 8; const f32x4 a0 = *(const f32x4*)(a2 + col), a4 = *(const f32x4*)(a2 + col + 4), b0 = *(const f32x4*)(b2 + col), b4 = *(const f32x4*)(b2 + col + 4);
                float y[8];
#pragma unroll
                for (int j = 0; j < 4; ++j) { y[j] = xv[q][j] * rstd * a0[j] + b0[j]; y[4 + j] = xv[q][4 + j] * rstd * a4[j] + b4[j]; }
                const u32x4 o = {cvtpk(y[0], y[1]), cvtpk(y[2], y[3]), cvtpk(y[4], y[5]), cvtpk(y[6], y[7])};
                if (valid) *(u32x4*)(hbuf + (size_t)r * 1024 + col) = o;
                const u32x4 ol = {cvtpk(y[0] - bflo(o[0]), y[1] - bfhi(o[0])), cvtpk(y[2] - bflo(o[1]), y[3] - bfhi(o[1])), cvtpk(y[4] - bflo(o[2]), y[5] - bfhi(o[2])), cvtpk(y[6] - bflo(o[3]), y[7] - bfhi(o[3]))};
                *(LAS u32x4*)((LAS char*)xs_hi + (8 * h + wid) * XP + col * 2) = o; *(LAS u32x4*)((LAS char*)xs_lo + (8 * h + wid) * XP + col * 2) = ol; }
        }
        __syncthreads();
        if (ch > 0 && tid < 256) { const float* pp = part + ((ch - 1) & 1) * 2048 + tid; float sum = pp[0];
#pragma unroll
            for (int w = 1; w < 8; ++w) sum += pp[w * 256];
            lgt[(16 * (ch - 1)) * 16 + tid] = sum; }
        f32x4 acc = {0, 0, 0, 0};
#pragma unroll
        for (int s = 0; s < 4; ++s) { const int off = e16 * XP + (128 * wid + 32 * s + 8 * kq) * 2;
            const bf16x8 ah = *(LAS const bf16x8*)((LAS char*)xs_hi + off), al = *(LAS const bf16x8*)((LAS char*)xs_lo + off);
            acc = __builtin_amdgcn_mfma_f32_16x16x32_bf16(ah, wh[s], acc, 0, 0, 0);
            acc = __builtin_amdgcn_mfma_f32_16x16x32_bf16(ah, wl[s], acc, 0, 0, 0);
            acc = __builtin_amdgcn_mfma_f32_16x16x32_bf16(al, wh[s], acc, 0, 0, 0); }
        { float* pw = part + (ch & 1) * 2048 + wid * 256;
#pragma unroll
          for (int j = 0; j < 4; ++j) pw[(4 * kq + j) * 16 + e16] = acc[j]; }
        __syncthreads();
    }
    if (tid < 256) { const float* pp = part + ((nch - 1) & 1) * 2048 + tid; float sum = pp[0];
#pragma unroll
        for (int w = 1; w < 8; ++w) sum += pp[w * 256];
        lgt[(16 * (nch - 1)) * 16 + tid] = sum; }
    __syncthreads();
    for (int i = tid; i < r_end - r_begin; i += NTHR) {
        const int r = r_begin + i; if (r < r_lim) continue;
        float lg[16];
        { const f32x4 t0 = *(const f32x4*)(lgt + i * 16), t1 = *(const f32x4*)(lgt + i * 16 + 4), t2 = *(const f32x4*)(lgt + i * 16 + 8), t3 = *(const f32x4*)(lgt + i * 16 + 12);
#pragma unroll
          for (int j = 0; j < 4; ++j) { lg[j] = t0[j]; lg[4 + j] = t1[j]; lg[8 + j] = t2[j]; lg[12 + j] = t3[j]; } }
        float sc[16], bi[16];
#pragma unroll
        for (int e = 0; e < 16; ++e) { sc[e] = __builtin_amdgcn_rcpf(1.f + __expf(-lg[e])); bi[e] = sc[e] + P.in[18][e]; }
        int bg = 0; float bgs = -1e30f;
#pragma unroll
        for (int g = 0; g < 4; ++g) { float m1 = -1e30f, m2 = -1e30f;
#pragma unroll
            for (int j = 0; j < 4; ++j) { const float t = bi[g * 4 + j]; if (t > m1) { m2 = m1; m1 = t; } else if (t > m2) m2 = t; }
            const float gs = m1 + m2; if (gs > bgs) { bgs = gs; bg = g; } }
        float b4[4], s4[4];
#pragma unroll
        for (int j = 0; j < 4; ++j) { b4[j] = bg == 0 ? bi[j] : bg == 1 ? bi[4 + j] : bg == 2 ? bi[8 + j] : bi[12 + j]; s4[j] = bg == 0 ? sc[j] : bg == 1 ? sc[4 + j] : bg == 2 ? sc[8 + j] : sc[12 + j]; }
        int i1 = 0;
#pragma unroll
        for (int j = 1; j < 4; ++j) if (b4[j] > b4[i1]) i1 = j;
        int i2 = (i1 == 0) ? 1 : 0;
#pragma unroll
        for (int j = 0; j < 4; ++j) if (j != i1 && b4[j] > b4[i2]) i2 = j;
        const int ea = i1 < i2 ? i1 : i2, eb = i1 < i2 ? i2 : i1;
        float wa = 0, wb = 0;
#pragma unroll
        for (int j = 0; j < 4; ++j) { if (j == ea) wa = s4[j]; if (j == eb) wb = s4[j]; }
        const float inv = 1.f / (wa + wb);
        const int pidx = ea == 0 ? eb - 1 : ea == 1 ? eb + 1 : 5;
        const int cls = bg * 6 + pidx;
        const int lp = atomicAdd(&lcnt[cls], 1); lrow[i] = cls | (lp << 8); rcls[r] = cls; rw[r] = make_float2(wa * inv, wb * inv);
    }
    __syncthreads();
    int* gcnt = (int*)(c.ws + WS_CTL + CTL_CNT_OFF) + l * 32;
    if (tid < NCLS) lcnt[32 + tid] = lcnt[tid] > 0 ? (int)__hip_atomic_fetch_add(&gcnt[tid], lcnt[tid], __ATOMIC_RELAXED, __HIP_MEMORY_SCOPE_AGENT) : 0;
    __syncthreads();
    int* clist = (int*)(c.ws + WS_CLIST);
    for (int i = tid; i < r_end - r_begin; i += NTHR) { const int r = r_begin + i; if (r < r_lim) continue; const int w = lrow[i]; const int cls = w & 255, lp = w >> 8; clist[(size_t)cls * T + lcnt[32 + cls] + lp] = r; }
}

DEVI bool moe_decode(const int* gcnt, int u, int per_rt, int& cls, int& rt, int& sub, int& hpad, int& ccnt) {
    int acc_t = 0, acc_h = 0;
    for (int cc = 0; cc < NCLS; ++cc) { const int n = __builtin_amdgcn_readfirstlane(gcnt[cc]);
        const int nrt = (n + 255) >> 8; const int nt = nrt * per_rt;
        if (u < acc_t + nt) { cls = cc; const int loc = u - acc_t; rt = loc / per_rt; sub = loc % per_rt; hpad = acc_h; ccnt = n; return true; }
        acc_t += nt; acc_h += nrt * 256; }
    return false;
}
DEVI void cls_experts(int cls, int& ea, int& eb) { const int g = cls / 6, p = cls % 6; const int a = p < 3 ? 0 : p < 5 ? 1 : 2; const int b = p < 3 ? p + 1 : p < 5 ? p - 1 : 3; ea = g * 4 + a; eb = g * 4 + b; }

DEVI int moe_total(const int* gcnt, int per_rt) { int t = 0; for (int cc = 0; cc < NCLS; ++cc) { const int n = __builtin_amdgcn_readfirstlane(gcnt[cc]); t += ((n + 255) >> 8) * per_rt; } return t; }
DEVI int moe_nfull(int utot, int G) { const int nf = (utot / G) * G; return ((utot - nf) * 4 > 2 * G) ? utot : nf; }

DEVI void phase_moe_up(const Params& P, const Ctx& c, int l) {
    TID_SETUP();
    const int* gcnt = (const int*)(c.ws + WS_CTL + CTL_CNT_OFF) + l * 32;
    const short* hbuf = (const short*)(c.ws + WS_HBUF); short* Hm = (short*)(c.ws + WS_KBUF);
    const int* clist = (const int*)(c.ws + WS_CLIST); const float2* rw = (const float2*)(c.ws + WS_RW);
    int* ltok = (int*)(c.lds + LDS_STAT); float* lw = (float*)(c.lds + LDS_STAT + 1024);
    const int utot = moe_total(gcnt, 4), nfull = moe_nfull(utot, c.G);
    for (int it = c.vcu; it < nfull + (utot - nfull) * 4; it += c.G) {
        const bool fast = it < nfull; const int u = fast ? it : nfull + ((it - nfull) >> 2); const int q = (it - nfull) & 3;
        int cls, rt, ct, hpad, ccnt; if (!moe_decode(gcnt, u, 4, cls, rt, ct, hpad, ccnt)) break;
        int ea, eb; cls_experts(cls, ea, eb); const int e = ct < 2 ? ea : eb;
        __syncthreads();
        { int t2 = threadIdx.x; asm volatile("" : "+v"(t2));
          if (t2 < 256) { int i = rt * 256 + t2; if (i > ccnt - 1) i = ccnt - 1; const int tok = clist[(size_t)cls * T + i]; ltok[t2] = tok; const float2 w = rw[tok]; lw[t2] = ct < 2 ? w.x : w.y; } }
        asm volatile("s_waitcnt vmcnt(0)" ::: "memory");
        __syncthreads();
        const short* WT = (const short*)(c.ws + WS_WGU) + ((size_t)(l * 16 + e) * 512 + (ct & 1) * 256) * 1024;
        short* Hrow = Hm + (size_t)(hpad + rt * 256) * 512 + (ct >> 1) * 256;
        if (fast) {
            gemm256<true, 1>(c.lds + LDS_GEMM, 16, hbuf, 1024, ltok, WT, 1024, 0, nullptr,
                [&](g8_acc& acc, int wr, int wc, int fr, int fq) {
#pragma unroll
                    for (int ai = 0; ai < 2; ++ai)
#pragma unroll
                        for (int m = 0; m < 4; ++m) { const int row = ai * 128 + wr * 64 + m * 16 + fr; const float w = lw[row];
#pragma unroll
                            for (int bj = 0; bj < 2; ++bj) { const f32x4 g = acc[ai][bj][m][0], uu = acc[ai][bj][m][1]; float hv[4];
#pragma unroll
                                for (int j = 0; j < 4; ++j) hv[j] = silu(g[j]) * uu[j] * w;
                                *(u32x2*)(Hrow + (size_t)row * 512 + ((ct & 1) * 8 + bj * 4 + wc) * 16 + fq * 4) = u32x2{cvtpk(hv[0], hv[1]), cvtpk(hv[2], hv[3])}; } }
                });
        } else {
            gemm_tile<1, 2, 8, 1, false, true>(c.lds + LDS_GEMM, 16,
                [&](int r) { return hbuf + (size_t)ltok[r] * 1024; },
                [&](int n) { return WT + (size_t)(q * 64 + n) * 1024; },
                [&](f32x16 (&acc)[1][2], int wm, int wn) {
                    const int hi = lane >> 5, r32 = lane & 31; const int row = wm * 32 + r32; const float w = lw[row];
#pragma unroll
                    for (int nb = 0; nb < 2; ++nb)
#pragma unroll
                        for (int s = 0; s < 2; ++s) { float hv[4];
#pragma unroll
                            for (int j = 0; j < 4; ++j) hv[j] = silu(acc[0][nb][4 * s + j]) * acc[0][nb][8 + 4 * s + j] * w;
                            *(u32x2*)(Hrow + (size_t)row * 512 + ((ct & 1) * 8 + q * 2 + nb) * 16 + 8 * s + 4 * hi) = u32x2{cvtpk(hv[0], hv[1]), cvtpk(hv[2], hv[3])}; }
                });
        }
    }
}
DEVI void phase_moe_down(const Params& P, const Ctx& c, int l) {
    TID_SETUP();
    const int* gcnt = (const int*)(c.ws + WS_CTL + CTL_CNT_OFF) + l * 32;
    const short* Hm = (const short*)(c.ws + WS_KBUF);
    const int* clist = (const int*)(c.ws + WS_CLIST);
    const float* coef = (const float*)(c.ws + WS_COEF) + (size_t)l * 3 * 6 * 1024;
    unsigned long long* lrp = (unsigned long long*)(c.lds + LDS_STAT);
    const int utot = moe_total(gcnt, 4), nfull = moe_nfull(utot, c.G);
    for (int it = c.vcu; it < nfull + (utot - nfull) * 4; it += c.G) {
        const bool fast = it < nfull; const int u = fast ? it : nfull + ((it - nfull) >> 2); const int q = (it - nfull) & 3;
        int cls, rt, ct, hpad, ccnt; if (!moe_decode(gcnt, u, 4, cls, rt, ct, hpad, ccnt)) break;
        __syncthreads();
        { int t2 = threadIdx.x; asm volatile("" : "+v"(t2));
          if (t2 < 256) { int i = rt * 256 + t2; if (i > ccnt - 1) i = ccnt - 1; const int tok = clist[(size_t)cls * T + i]; lrp[t2] = (unsigned long long)(uintptr_t)res_row(c, tok) | (unsigned long long)row_variant(tok); } }
        asm volatile("s_waitcnt vmcnt(0)" ::: "memory");
        __syncthreads();
        const short* WT = (const short*)(c.ws + WS_WDN) + ((size_t)(l * NCLS + cls) * 1024 + ct * 256) * 512;
        const short* Ab = Hm + (size_t)(hpad + rt * 256) * 512;
        auto rmw = [&](int rl, int col, f32x4 v) { const int i = rt * 256 + rl;
            if (i < ccnt) { const unsigned long long pv = lrp[rl]; short* xr = (short*)(uintptr_t)(pv & ~3ull) + col; const f32x4 g = *(const f32x4*)(coef + (size_t)((int)(pv & 3ull) * 6 + 5) * 1024 + col);
                const f32x4 x = ld_bf4(xr); const f32x4 y = f32x4{x[0] + g[0] * v[0], x[1] + g[1] * v[1], x[2] + g[2] * v[2], x[3] + g[3] * v[3]};
                if (l < DEPTH - 1) st_bf4(xr, y);
                else *(f32x4*)((char*)c.out + (((size_t)(uintptr_t)xr - (size_t)(uintptr_t)(c.ws + WS_RES)) - (size_t)T_CTX * D * 2) * 2) = y; } };
        if (fast) {
            gemm256<false, 1>(c.lds + LDS_GEMM, 8, Ab, 512, nullptr, WT, 512, 0, nullptr,
                [&](g8_acc& acc, int wr, int wc, int fr, int fq) { g8_for_acc(acc, wr, wc, fr, fq, [&](int rl, int cc, f32x4 v) { rmw(rl, ct * 256 + cc, v); }); });
        } else {
            gemm_tile<1, 2, 8, 1, false, true>(c.lds + LDS_GEMM, 8,
                [&](int r) { return Ab + (size_t)r * 512; },
                [&](int n) { return WT + (size_t)(q * 64 + n) * 512; },
                [&](f32x16 (&acc)[1][2], int wm, int wn) { for_acc_f4<1, 2>(acc, wm, wn, lane, [&](int rl, int cc, f32x4 v) { rmw(rl, ct * 256 + q * 64 + cc, v); }); });
        }
    }
}

__global__ void __launch_bounds__(NTHR, 2) mega_fwd(Params P) {
    extern __shared__ __attribute__((aligned(16))) char lds[];
    Ctx c;
    c.out = P.out; c.ws = P.ws; c.lds = lds; c.G = gridDim.x;
    { const int bx = blockIdx.x; c.vcu = (c.G % 8 == 0) ? (bx % 8) * (c.G / 8) + bx / 8 : bx; }
    volatile LAS unsigned* st = (volatile LAS unsigned*)(lds + LDS_MISC);
    if (threadIdx.x < 4) st[threadIdx.x] = 0u;
    __syncthreads();
    XcdBarrier bar = xcd_barrier_post((unsigned*)(P.ws + WS_CTL), st);
    int ph = 0;
#define PHASE_END() do { if (++ph >= P.nphases) return; if (ph > P.ph_lo) xcd_barrier(bar); } while (0)
    if ((PHMASK & 1) && ph >= P.ph_lo) phase_prologue(P, c); PHASE_END();
    if ((PHMASK & 2) && ph >= P.ph_lo) phase_coef(P, c); PHASE_END();
    for (int l = 0; l < DEPTH; ++l) {
        if ((PHMASK & 4) && ph >= P.ph_lo) { phase_norm_mix(P, c, l); if (REPMASK & 4) { xcd_barrier(bar); phase_norm_mix(P, c, l); } } PHASE_END();
        if ((PHMASK & 8) && ph >= P.ph_lo) { phase_inproj(P, c, l); if (REPMASK & 8) { xcd_barrier(bar); phase_inproj(P, c, l); } } PHASE_END();
        if ((PHMASK & 16) && ph >= P.ph_lo) { phase_proj2(P, c, l); if (REPMASK & 16) { xcd_barrier(bar); phase_proj2(P, c, l); } } PHASE_END();
        if ((PHMASK & 32) && ph >= P.ph_lo) { phase_attn_fft1(P, c, l); if (REPMASK & 32) { xcd_barrier(bar); phase_attn_fft1(P, c, l); } } PHASE_END();
        if ((PHMASK & 64) && ph >= P.ph_lo) { phase_fft2(P, c, l); if (REPMASK & 64) { xcd_barrier(bar); phase_fft2(P, c, l); } } PHASE_END();
        if ((PHMASK & 128) && ph >= P.ph_lo) { phase_outproj(P, c, l); if (REPMASK & 128) { xcd_barrier(bar); phase_outproj(P, c, l); } } PHASE_END();
        if ((PHMASK & 256) && ph >= P.ph_lo) { phase_norm_route(P, c, l); if (REPMASK & 256) { xcd_barrier(bar); phase_norm_route(P, c, l); } } PHASE_END();
        if ((PHMASK & 512) && ph >= P.ph_lo) { phase_moe_up(P, c, l); if (REPMASK & 512) { xcd_barrier(bar); phase_moe_up(P, c, l); } } PHASE_END();
        if ((PHMASK & 1024) && ph >= P.ph_lo) { phase_moe_down(P, c, l); if (REPMASK & 1024) { xcd_barrier(bar); phase_moe_down(P, c, l); } } PHASE_END();
    }
}


#ifdef DUMPDBG
__global__ void dump_kernel(float* out, const char* ws, int keep_out) {
    const size_t n = (size_t)T_LAT * D;
    for (size_t i = (size_t)blockIdx.x * blockDim.x + threadIdx.x; i < n; i += (size_t)gridDim.x * blockDim.x) {
        float v = keep_out ? out[i] : 0.f;
        const size_t offs[8] = {WS_HBUF, WS_ZBUF, WS_QBUF, WS_KBUF, WS_VBUF, WS_UBUF, WS_WCS, WS_WIN};
        const size_t lens[8] = {(size_t)T * 1024, (size_t)T * 1024, (size_t)BATCH * NH * SEQ * DQK, (size_t)BATCH * NH * NKEY * DQK, (size_t)BATCH * NH * NKEY * DV, (size_t)T * 1024, (size_t)4 * 4 * 128 * 256, (size_t)4 * 1024 * 1024};
#pragma unroll
        for (int b = 0; b < 8; ++b) {
            if (!((DUMPMASK >> b) & 1)) continue;
            const unsigned short u = ((const unsigned short*)(ws + offs[b]))[i % lens[b]];
            float f = __uint_as_float(((unsigned)u) << 16);
            if (!(fabsf(f) < 1e30f)) f = 777.f;
            v += f;
        }
        if (!(fabsf(v) < 1e30f)) v = 999.f;
        out[i] = v;
    }
}
#endif

#ifdef CHECKDBG
constexpr size_t WS_CHK = WS_END;
__device__ inline float blk_sum(float v, float* red) {
    for (int o = 32; o > 0; o >>= 1) v += __shfl_xor(v, o, 64);
    __syncthreads(); if ((threadIdx.x & 63) == 0) red[threadIdx.x >> 6] = v; __syncthreads();
    float t = 0; for (int i = 0; i < (int)blockDim.x / 64; ++i) t += red[i]; return t;
}
__device__ inline float blk_max(float v, float* red) {
    for (int o = 32; o > 0; o >>= 1) v = fmaxf(v, __shfl_xor(v, o, 64));
    __syncthreads(); if ((threadIdx.x & 63) == 0) red[threadIdx.x >> 6] = v; __syncthreads();
    float t = -1e30f; for (int i = 0; i < (int)blockDim.x / 64; ++i) t = fmaxf(t, red[i]); return t;
}
__global__ void chk_qkv(Params P) {
    __shared__ float red[8]; __shared__ float xin[256]; __shared__ float outv[128]; __shared__ float kr[32];
    const int s = blockIdx.x, tid = threadIdx.x;
    const int row = (s * 7919 + 13) % T; const int h = s & 7;
    const short* z = (const short*)P.out + (size_t)row * ZLD;
    const bool lat = row >= T_CTX; const int rr = lat ? row - T_CTX : row; const int b = lat ? (rr >> 14) : (rr >> 8); const int n = lat ? (rr & 16383) : (rr & 255);
    float* err = (float*)(P.ws + WS_CHK);
    const float2* ropetab = (const float2*)(P.ws + WS_ROPE);
    { const float cq = bf2f((unsigned short)z[tid]); const float ms = blk_sum(cq * cq, red) / 256.f; xin[tid] = cq * rsqrtf(ms + EPS) * P.in[9][tid]; __syncthreads();
      float u = 0; if (tid < 96) for (int k = 0; k < 256; ++k) u += xin[k] * P.in[10][(size_t)k * 768 + h * 96 + tid];
      const float ms2 = blk_sum(tid < 96 ? u * u : 0.f, red) / 96.f; if (tid < 96) outv[tid] = u * rsqrtf(ms2 + EPS) * P.in[13][tid]; __syncthreads();
      float val = 0; if (tid < 96) { val = outv[tid];
        if (lat && tid >= 64) { const int m = tid - 64; const int ax = m >> 4, i = m & 7, second = (m >> 3) & 1; const int pos = ax == 0 ? (n >> 6) : (n & 63); const float2 cs = ropetab[pos * 8 + i];
            const float x1 = outv[64 + ax * 16 + i], x2 = outv[64 + ax * 16 + 8 + i]; val = second ? (x2 * cs.x + x1 * cs.y) : (x1 * cs.x - x2 * cs.y); }
        val *= ATT_QSCALE; }
      const short* qd = lat ? (const short*)(P.ws + WS_QBUF) + ((size_t)(b * NH + h) * SEQ + n) * DQK : (const short*)(P.ws + WS_QCTX) + ((size_t)(b * NH + h) * NCTX + n) * DQK;
      const float got = tid < 96 ? bf2f((unsigned short)qd[tid]) : 0.f;
      const float d2 = blk_sum(tid < 96 ? (got - val) * (got - val) : 0.f, red), r2 = blk_sum(tid < 96 ? val * val : 0.f, red);
      if (tid == 0) { atomicAdd(&err[0], d2); atomicAdd(&err[1], r2); } }
    { __syncthreads(); const float ck = tid < 128 ? bf2f((unsigned short)z[256 + tid]) : 0.f; const float ms = blk_sum(ck * ck, red) / 128.f; if (tid < 128) xin[tid] = ck * rsqrtf(ms + EPS) * P.in[11][tid];
      if (tid < 32) kr[tid] = bf2f((unsigned short)z[384 + tid]); __syncthreads();
      float u = 0; if (tid < 128) for (int k = 0; k < 128; ++k) u += xin[k] * P.in[12][(size_t)k * 1024 + h * 128 + tid];
      float sq = 0; if (tid < 64) sq = u * u; else if (tid >= 128 && tid < 160) sq = kr[tid - 128] * kr[tid - 128];
      const float ms2 = blk_sum(sq, red) / 96.f; const float rs = rsqrtf(ms2 + EPS);
      if (tid < 64) outv[tid] = u * rs * P.in[14][tid]; if (tid >= 128 && tid < 160) outv[64 + tid - 128] = kr[tid - 128] * rs * P.in[14][64 + tid - 128]; __syncthreads();
      const int pos = lat ? NCTX + n : n;
      float val = 0; if (tid < 96) { val = outv[tid];
        if (lat && tid >= 64) { const int m = tid - 64; const int ax = m >> 4, i = m & 7, second = (m >> 3) & 1; const int pp = ax == 0 ? (n >> 6) : (n & 63); const float2 cs = ropetab[pp * 8 + i];
            const float x1 = outv[64 + ax * 16 + i], x2 = outv[64 + ax * 16 + 8 + i]; val = second ? (x2 * cs.x + x1 * cs.y) : (x1 * cs.x - x2 * cs.y); } }
      const short* kd = (const short*)(P.ws + WS_KBUF) + ((size_t)(b * NH + h) * NKEY + pos) * DQK;
      const float gotk = tid < 96 ? bf2f((unsigned short)kd[tid]) : 0.f;
      float d2 = blk_sum(tid < 96 ? (gotk - val) * (gotk - val) : 0.f, red), r2 = blk_sum(tid < 96 ? val * val : 0.f, red);
      if (tid == 0) { atomicAdd(&err[2], d2); atomicAdd(&err[3], r2); }
      const short* vd = (const short*)(P.ws + WS_VBUF) + ((size_t)(b * NH + h) * NKEY + pos) * DV;
      const bool isv = tid >= 64 && tid < 128; const float gotv = isv ? bf2f((unsigned short)vd[tid - 64]) : 0.f; const float vv = isv ? u : 0.f;
      d2 = blk_sum((gotv - vv) * (gotv - vv), red); r2 = blk_sum(vv * vv, red);
      if (tid == 0) { atomicAdd(&err[4], d2); atomicAdd(&err[5], r2); } }
}
__global__ void chk_attn(Params P) {
    extern __shared__ float pbuf[];
    __shared__ float red[8]; __shared__ float qv[96];
    const int s = blockIdx.x, tid = threadIdx.x; const int b = s & 1, h = (s >> 1) & 7; const bool ctxq = (s % 5) == 4; const int n = ctxq ? (s * 37) % NCTX : (s * 4099 + 77) % SEQ;
    const int bh = b * NH + h; const int nk = ctxq ? NCTX : NKEY;
    const short* q = ctxq ? (const short*)(P.ws + WS_QCTX) + ((size_t)bh * NCTX + n) * DQK : (const short*)(P.ws + WS_QBUF) + ((size_t)bh * SEQ + n) * DQK;
    const short* K = (const short*)(P.ws + WS_KBUF) + (size_t)bh * NKEY * DQK; const short* V = (const short*)(P.ws + WS_VBUF) + (size_t)bh * NKEY * DV;
    if (tid < 96) qv[tid] = bf2f((unsigned short)q[tid]); __syncthreads();
    float mx = -1e30f;
    for (int k = tid; k < nk; k += blockDim.x) { float a = 0; for (int d = 0; d < 96; ++d) a += qv[d] * bf2f((unsigned short)K[(size_t)k * DQK + d]); pbuf[k] = a; mx = fmaxf(mx, a); }
    mx = blk_max(mx, red);
    float sm = 0; for (int k = tid; k < nk; k += blockDim.x) { const float p = exp2f(pbuf[k] - mx); pbuf[k] = p; sm += p; }
    sm = blk_sum(sm, red);
    float o = 0; if (tid < 64) for (int k = 0; k < nk; ++k) o += pbuf[k] * bf2f((unsigned short)V[(size_t)k * DV + tid]);
    o /= sm;
    const short* mix = (const short*)(P.ws + WS_HBUF) + (size_t)(ctxq ? b * NCTX + n : T_CTX + b * SEQ + n) * 1024 + h * DV;
    const float got = tid < 64 ? bf2f((unsigned short)mix[tid]) : 0.f; const float ov = tid < 64 ? o : 0.f;
    const float d2 = blk_sum((got - ov) * (got - ov), red), r2 = blk_sum(ov * ov, red);
    float* err = (float*)(P.ws + WS_CHK);
    if (tid == 0) { atomicAdd(&err[6], d2); atomicAdd(&err[7], r2); }
}
__global__ void chk_fixup(float* out, const char* ws) {
    const float* err = (const float*)(ws + WS_CHK);
    float e = 0.f; bool zero = false;
    for (int k = 0; k < 4; ++k) if ((CHECKSEL >> k) & 1) { e = fmaxf(e, sqrtf(err[2 * k] / fmaxf(err[2 * k + 1], 1e-30f))); zero |= (err[2 * k + 1] == 0.f); }
    float f = 1.f; if (!(e < 0.006f)) f = 1.1f; if (!(e < 0.02f)) f = 1.3f; if (!(e < 0.1f)) f = 2.f; if (zero) f = 3.f;
    if (f == 1.f) return;
    const size_t n = (size_t)T_LAT * D;
    for (size_t i = (size_t)blockIdx.x * blockDim.x + threadIdx.x; i < n; i += (size_t)gridDim.x * blockDim.x) out[i] *= f;
}
#endif
#ifndef PHMASK
#define PHMASK 0xffff
#endif
#ifndef NPHASES
#define NPHASES 1000
#endif
extern "C" void kernel_launch(void* const* d_in, const int* in_sizes, int n_in, void* d_out, int out_size, void* d_ws, size_t ws_size, hipStream_t stream) {
    static int grid = 0;
    if (grid == 0) {
        if (n_in != 22 || out_size != T_LAT * D || ws_size < WS_END) { fprintf(stderr, "kernel_launch: shape/workspace mismatch (n_in %d out %d ws %zu need %zu)\n", n_in, out_size, ws_size, (size_t)WS_END); grid = -1; return; }
        int dev = 0, cus = 0, per_cu = 0;
        if (hipGetDevice(&dev) != hipSuccess || hipDeviceGetAttribute(&cus, hipDeviceAttributeMultiprocessorCount, dev) != hipSuccess) { grid = -1; return; }
        if (hipFuncSetAttribute((const void*)mega_fwd, hipFuncAttributeMaxDynamicSharedMemorySize, LDS_BYTES) != hipSuccess) { fprintf(stderr, "kernel_launch: hipFuncSetAttribute failed\n"); grid = -1; return; }
        if (hipOccupancyMaxActiveBlocksPerMultiprocessor(&per_cu, (const void*)mega_fwd, NTHR, LDS_BYTES) != hipSuccess || per_cu < 1) { fprintf(stderr, "kernel_launch: occupancy query says %d\n", per_cu); grid = -1; return; }
        (void)hipGetLastError();
#ifdef CHECKDBG
        (void)hipFuncSetAttribute((const void*)chk_attn, hipFuncAttributeMaxDynamicSharedMemorySize, NKEY * 4);
#endif
        grid = cus;
    }
    if (grid < 0) return;
    hipMemsetAsync((char*)d_ws + WS_CTL, 0, CTL_BYTES, stream);
    Params p{};
    for (int i = 0; i < 22; ++i) p.in[i] = (const float*)d_in[i];
    p.out = (float*)d_out; p.ws = (char*)d_ws; p.nphases = NPHASES; p.ph_lo = 0;
#ifdef CHECKDBG
    hipMemsetAsync((char*)d_ws + WS_CHK, 0, 64, stream);
    p.nphases = 5; hipLaunchKernelGGL(mega_fwd, dim3(grid), dim3(NTHR), LDS_BYTES, stream, p);
    hipLaunchKernelGGL(chk_qkv, dim3(512), dim3(256), 0, stream, p);
    hipMemsetAsync((char*)d_ws + WS_CTL, 0, CTL_BYTES, stream);
    p.nphases = 6; hipLaunchKernelGGL(mega_fwd, dim3(grid), dim3(NTHR), LDS_BYTES, stream, p);
    hipLaunchKernelGGL(chk_attn, dim3(160), dim3(256), NKEY * 4, stream, p);
    hipMemsetAsync((char*)d_ws + WS_CTL, 0, CTL_BYTES, stream);
    p.nphases = NPHASES;
#endif
#ifdef SPLIT_AT
    p.nphases = SPLIT_AT;
    hipLaunchKernelGGL(mega_fwd, dim3(grid), dim3(NTHR), LDS_BYTES, stream, p);
    hipMemsetAsync((char*)d_ws + WS_CTL, 0, XCD_BAR_WORDS * 4, stream);
    p.nphases = NPHASES; p.ph_lo = SPLIT_AT;
#endif
    hipLaunchKernelGGL(mega_fwd, dim3(grid), dim3(NTHR), LDS_BYTES, stream, p);
    const hipError_t le = hipPeekAtLastError();
    if (le != hipSuccess) fprintf(stderr, "kernel_launch: launch failed: %s\n", hipGetErrorName(le));
#ifdef CHECKDBG
    hipLaunchKernelGGL(chk_fixup, dim3(2048), dim3(256), 0, stream, (float*)d_out, (const char*)d_ws);
#endif
#ifdef DUMPDBG
    hipLaunchKernelGGL(dump_kernel, dim3(2048), dim3(256), 0, stream, (float*)d_out, (const char*)d_ws, (NPHASES >= 8) ? 1 : 0);
#endif
}
```

```cpp
#include <hip/hip_runtime.h>
#include <hip/hip_bf16.h>
#include <cstdint>
#include <cstdio>

#define DEVI __device__ __forceinline__
#define PC_U0 0


#define EXP_WAIT() asm volatile("s_waitcnt vmcnt(0)" ::: "memory")

#define CHECKSEL 8
#ifndef REPMASK
#define REPMASK 0
#endif
#ifndef PHMASK
#define PHMASK 0xffff
#endif

constexpr int D = 1024, BATCH = 2, SEQ = 16384, DEPTH = 4, NCTX = 256;
constexpr int T_CTX = BATCH * NCTX, T_LAT = BATCH * SEQ, T = T_CTX + T_LAT;
constexpr int NH = 8, DQK = 96, DV = 64, QLR = 256, KVLR = 128;
constexpr int NKEY = NCTX + SEQ;
constexpr int INW = 928;
constexpr int ZLD = 1024;
constexpr int NE = 16, DE = 256, NCLS = 24;
constexpr float EPS = 1e-6f;
constexpr float ATT_QSCALE = 0.10206207261596577f * 1.4426950408889634f;
constexpr int NTHR = 512;

constexpr size_t al256(size_t x) { return (x + 255) / 256 * 256; }
constexpr size_t WS_CTL   = 0;
constexpr size_t CTL_BYTES = 65536;
constexpr size_t CTL_CNT_OFF = 32768;
constexpr size_t WS_COEF  = WS_CTL + CTL_BYTES;
constexpr size_t WS_F1    = WS_COEF + al256((size_t)4 * 3 * 6 * 1024 * 4);
constexpr size_t WS_F2    = WS_F1 + 256 * 256 * 2;
constexpr size_t WS_FC    = WS_F2 + 128 * 256 * 2;
constexpr size_t WS_TW    = WS_FC + 256 * 512 * 2;
constexpr size_t WS_ROPE  = WS_TW + 16384 * 8;
constexpr size_t WS_WIN   = WS_ROPE + 256 * 8 * 8;
constexpr size_t WS_WOUT  = WS_WIN + (size_t)4 * 1024 * 1024 * 2;
constexpr size_t WS_WGU   = WS_WOUT + (size_t)4 * 1024 * 1024 * 2;
constexpr size_t WS_WDN   = WS_WGU + (size_t)4 * 16 * 1024 * 512 * 2;
constexpr size_t WS_WQT   = WS_WDN + (size_t)4 * NCLS * 1024 * 512 * 2;
constexpr size_t WS_WKVT  = WS_WQT + (size_t)4 * 768 * 256 * 2;
constexpr size_t WS_WCS   = WS_WKVT + (size_t)4 * 1024 * 128 * 2;
constexpr size_t WS_CTXR  = WS_WCS + (size_t)4 * 4 * 128 * 256 * 2;
constexpr size_t WS_RCLS  = WS_CTXR + (size_t)T_CTX * 1024 * 4;
constexpr size_t WS_RW    = WS_RCLS + al256((size_t)T * 4);
constexpr size_t WS_CLIST = WS_RW + al256((size_t)T * 8);
constexpr size_t WS_HBUF  = WS_CLIST + al256((size_t)NCLS * T * 4);
constexpr size_t WS_MODP  = WS_HBUF;
constexpr size_t WS_RES   = WS_HBUF + (size_t)T * 1024 * 2;
constexpr size_t WS_ZBUF  = WS_RES;
constexpr size_t WS_QBUF  = WS_ZBUF + (size_t)T * 1024 * 2;
constexpr size_t WS_QCTX  = WS_QBUF + (size_t)BATCH * NH * SEQ * DQK * 2;
constexpr size_t WS_KBUF  = WS_QCTX + (size_t)BATCH * NH * NCTX * DQK * 2;
constexpr size_t WS_VBUF  = WS_KBUF + (size_t)BATCH * NH * NKEY * DQK * 2;
constexpr size_t WS_UBUF  = WS_VBUF + (size_t)BATCH * NH * NKEY * DV * 2;
constexpr size_t WS_P1    = WS_UBUF;
constexpr size_t WS_UCTX  = WS_UBUF + (size_t)2 * 4 * 128 * 128 * 256 * 2;
static_assert(WS_UCTX + (size_t)T_CTX * 1024 * 2 <= WS_UBUF + (size_t)T * 1024 * 2, "P1 + ctx U fit the U region");
constexpr size_t WS_END   = WS_UBUF + (size_t)T * 1024 * 2;
static_assert((size_t)2 * 4 * 128 * 128 * 256 * 2 <= (size_t)T * 1024 * 2, "P1 fits zbuf region");
static_assert((size_t)(T + NCLS * 256) * 512 * 2 <= (size_t)BATCH * NH * NKEY * DQK * 2, "Hmoe (class-padded rows) fits kbuf region");
static_assert(WS_END <= (size_t)4 * T_LAT * D * 4, "workspace map must fit 4 x the largest tensor (the guaranteed d_ws size)");

constexpr int LDS_GEMM = 0;
constexpr int LDS_STAT = 128 * 1024;
constexpr int LDS_MISC = 132 * 1024;
constexpr int LDS_BYTES = 133 * 1024;

#define XB_TMO      128
#define XB_XCNT(j)  (256  + 64 * (j))
#define XB_XSUB(j)  (1280 + 64 * (j))
#define XB_XGEN(j)  (2304 + 64 * (j))
#define XB_TOP      3328
#define XB_TOPGEN   3392
#define XCD_BAR_WORDS 3456
#define XB_SPIN_CAP (1u << 24)
#define LAS __attribute__((address_space(3)))

DEVI unsigned xb_ld(unsigned* p)              { return __hip_atomic_load(p, __ATOMIC_RELAXED, __HIP_MEMORY_SCOPE_AGENT); }
DEVI unsigned xb_add(unsigned* p, unsigned v) { return __hip_atomic_fetch_add(p, v, __ATOMIC_RELAXED, __HIP_MEMORY_SCOPE_AGENT); }
DEVI unsigned xb_xcc_id() { return (unsigned)__builtin_amdgcn_s_getreg((3 << 11) | 20) & 0xFu; }
#define XB_SPIN(cond, bar) do { unsigned _sp = 0; while (cond) { __builtin_amdgcn_s_sleep(1); \
    if ((++_sp & 255u) == 0u) { if (xb_ld(&(bar)[XB_TMO])) break; if (_sp > XB_SPIN_CAP) { atomicAdd(&(bar)[XB_TMO], 1u); break; } } } } while (0)

struct XcdBarrier { unsigned* bar; unsigned x; volatile LAS unsigned* st; };

DEVI XcdBarrier xcd_barrier_post(unsigned* bar, volatile LAS unsigned* st) {
    XcdBarrier b; b.bar = bar; b.x = xb_xcc_id(); b.st = st;
    if (threadIdx.x == 0) (void)xb_add(&bar[XB_XCNT(b.x)], 1u);
    return b;
}
DEVI void xcd_barrier_complete(unsigned* bar, unsigned x, unsigned& nloc, unsigned& nx) {
    const unsigned G = gridDim.x * gridDim.y * gridDim.z;
    unsigned sum, cnt, mine, sp = 0u;
    for (;;) {
        sum = 0u; cnt = 0u; mine = 0u;
#pragma unroll
        for (unsigned j = 0; j < 16; ++j) { const unsigned c = xb_ld(&bar[XB_XCNT(j)]); sum += c; cnt += (c > 0u) ? 1u : 0u; mine = (j == x) ? c : mine; }
        if (sum == G) break;
        __builtin_amdgcn_s_sleep(1);
        if ((++sp & 255u) == 0u) { if (xb_ld(&bar[XB_TMO])) break; if (sp > XB_SPIN_CAP) { atomicAdd(&bar[XB_TMO], 1u); break; } }
    }
    nloc = mine > 0u ? mine : 1u; nx = cnt > 0u ? cnt : 1u;
}
DEVI void xcd_barrier(const XcdBarrier& b) {
    asm volatile("s_waitcnt vmcnt(0)" ::: "memory");
    __syncthreads();
    if (threadIdx.x == 0) {
        unsigned* bar = b.bar;
        __builtin_amdgcn_s_waitcnt(0);
        unsigned nloc = b.st[0], nx = b.st[1];
        if (nloc == 0u) { xcd_barrier_complete(bar, b.x, nloc, nx); b.st[0] = nloc; b.st[1] = nx; }
        const unsigned old = xb_add(&bar[XB_XSUB(b.x)], 1u);
        const unsigned gen = old / nloc;
        if (old + 1u == (gen + 1u) * nloc) {
            __builtin_amdgcn_fence(__ATOMIC_RELEASE, "agent");
            asm volatile("s_waitcnt vmcnt(0)" ::: "memory");
            const unsigned og = xb_add(&bar[XB_TOP], 1u);
            const unsigned tg = og / nx;
            if (og + 1u == (tg + 1u) * nx) xb_add(&bar[XB_TOPGEN], 1u);
            else XB_SPIN(xb_ld(&bar[XB_TOPGEN]) == tg, bar);
            __builtin_amdgcn_fence(__ATOMIC_ACQUIRE, "agent");
            xb_add(&bar[XB_XGEN(b.x)], 1u);
            asm volatile("s_waitcnt vmcnt(0)" ::: "memory");
        } else {
            XB_SPIN(xb_ld(&bar[XB_XGEN(b.x)]) == gen, bar);
            __builtin_amdgcn_fence(__ATOMIC_ACQUIRE, "agent");
            asm volatile("s_waitcnt vmcnt(0)" ::: "memory");
        }
    }
    __syncthreads();
}

using bf16x8 = __attribute__((ext_vector_type(8))) short;
using s16x4  = __attribute__((ext_vector_type(4))) short;
using f32x16 = __attribute__((ext_vector_type(16))) float;
using f32x4  = __attribute__((ext_vector_type(4))) float;
using u32x4  = __attribute__((ext_vector_type(4))) unsigned;
using u32x2  = __attribute__((ext_vector_type(2))) unsigned;
#define SBAR() __builtin_amdgcn_sched_barrier(0)

DEVI int crow(int r, int hi) { return (r & 3) + 8 * (r >> 2) + 4 * hi; }
DEVI unsigned cvtpk(float lo, float hi) { unsigned r; asm volatile("v_cvt_pk_bf16_f32 %0, %1, %2" : "=v"(r) : "v"(lo), "v"(hi)); return r; }
DEVI unsigned short f2bf(float x) { return (unsigned short)(cvtpk(x, 0.f) & 0xffffu); }
DEVI float bf2f(unsigned short u) { return __uint_as_float(((unsigned)u) << 16); }
DEVI float bflo(unsigned u) { return __uint_as_float(u << 16); }
DEVI float bfhi(unsigned u) { return __uint_as_float(u & 0xffff0000u); }
DEVI float wave_sum(float v) {
#pragma unroll
    for (int o = 32; o > 0; o >>= 1) v += __shfl_xor(v, o, 64);
    return v;
}
DEVI float silu(float x) { return x * __builtin_amdgcn_rcpf(1.f + __expf(-x)); }

DEVI int row_variant(int r) { return r < T_CTX ? 2 : ((r - T_CTX) >> 14); }

template <int BN> DEVI int nn_st(int k, int c) {
    const int kk = (k & ~0xC) | ((k & 4) << 1) | ((k & 8) >> 1);
    return ((kk >> 3) * (BN / 32) + (c >> 5)) * 512 + ((kk & 7) * 32 + (c & 31)) * 2;
}
DEVI int nn_rd_base(int lane) { return ((lane & 3) << 3) | (((lane >> 2) & 3) << 6) | (((lane >> 4) & 1) << 5) | (((lane >> 5) & 1) << 8); }
template <int OFF> DEVI s16x4 tr_read(int vb) {
    s16x4 r; asm volatile("ds_read_b64_tr_b16 %0, %1 offset:%2" : "=&v"(r) : "v"(vb), "i"(OFF) : "memory"); return r;
}
#define PK8(L, H) (bf16x8){L[0], L[1], L[2], L[3], H[0], H[1], H[2], H[3]}

typedef s16x4 LAS * lds_s16x4_ptr;
template <int MB, int NB, int WM, int WN, bool BNN, bool SWAPC, int STAGES = 2, bool BRES = false, class AF, class BF, class EF>
DEVI void gemm_tile(char* lds, int nk_in, AF arow, BF brow, EF epi) {
    int nk = nk_in; asm volatile("" : "+s"(nk));
    constexpr int BM = 32 * MB * WM, BN = 32 * NB * WN;
    constexpr int ABYTES = BM * 128, BBYTES = BN * 128;
    constexpr int ACH = BM / 64, BCH = BN / 64;
    static_assert(WM * WN == 8, "8 waves");
    static_assert(2 * ABYTES + 2 * BBYTES <= 128 * 1024, "LDS");
    int tid = threadIdx.x; asm volatile("" : "+v"(tid)); const int lane = tid & 63, wid = __builtin_amdgcn_readfirstlane(tid >> 6);
    const int wm = wid / WN, wn = wid % WN, r32 = lane & 31, hi = lane >> 5;
    LAS char* Abase = (LAS char*)lds; LAS char* Bbase = BRES ? Abase + 65536 : Abase + 2 * ABYTES;
    static_assert(!BRES || 2 * ABYTES <= 65536, "resident B image sits at +64 KB");
    const short* ap[ACH]; int aoff[ACH];
#pragma unroll
    for (int i = 0; i < ACH; ++i) { const int id = tid + NTHR * i, row = id >> 3, c = id & 7; ap[i] = (const short*)arow(row) + c * 8; aoff[i] = row * 128 + ((c ^ ((row >> 1) & 7)) << 4); }
    const short* bp[BCH]; int boff[BCH];
#pragma unroll
    for (int i = 0; i < BCH; ++i) {
        const int id = tid + NTHR * i;
        if constexpr (!BNN) { const int row = id >> 3, c = id & 7; bp[i] = (const short*)brow(row) + c * 8; boff[i] = row * 128 + ((c ^ ((row >> 1) & 7)) << 4); }
        else { const int krow = id / (BN / 8), c = id % (BN / 8); boff[i] = nn_st<BN>(krow, c * 8); bp[i] = nullptr; }
    }
    const int swz = (r32 >> 1) & 7;
    const int afr0 = (wm * 32 * MB + r32) * 128, bfr0 = (wn * 32 * NB + r32) * 128;
    const int bvb = nn_rd_base(lane) + wn * NB * 512;

    f32x16 acc[MB][NB];
#pragma unroll
    for (int i = 0; i < MB; ++i)
#pragma unroll
        for (int j = 0; j < NB; ++j) acc[i][j] = f32x16{};
    bf16x8 ra0[ACH], rb0[BCH], ra1[ACH], rb1[BCH];
#define G_LOAD(RA, RB, T) do {                                                                                                     \
        _Pragma("unroll") for (int i = 0; i < ACH; ++i) RA[i] = *(const bf16x8*)(ap[i] + (T) * 64);                                \
        if constexpr (!BRES) { _Pragma("unroll") for (int i = 0; i < BCH; ++i) { if constexpr (!BNN) RB[i] = *(const bf16x8*)(bp[i] + (T) * 64);          \
            else { const int id = tid + NTHR * i; RB[i] = *(const bf16x8*)((const short*)brow((T) * 64 + id / (BN / 8)) + (id % (BN / 8)) * 8); } } } } while (0)
#define G_WRITE(RA, RB, BUF) do {                                                                                                  \
        _Pragma("unroll") for (int i = 0; i < ACH; ++i) *(LAS bf16x8*)(Abase + (BUF) * ABYTES + aoff[i]) = RA[i];                  \
        if constexpr (!BRES) { _Pragma("unroll") for (int i = 0; i < BCH; ++i) *(LAS bf16x8*)(Bbase + (BUF) * BBYTES + boff[i]) = RB[i]; } } while (0)
#define G_COMPUTE(BUF, KT) do {                                                                                                    \
        LAS const char* As = Abase + (BUF) * ABYTES; LAS const char* Bs = Bbase + (BRES ? (KT) : (BUF)) * BBYTES;                  \
        _Pragma("unroll") for (int ks = 0; ks < 4; ++ks) {                                                                         \
            bf16x8 a[MB], b[NB];                                                                                                   \
            const int so = ((ks * 2 + hi) ^ swz) << 4;                                                                             \
            _Pragma("unroll") for (int mb = 0; mb < MB; ++mb) a[mb] = *(LAS const bf16x8*)(As + afr0 + so + mb * 4096);            \
            _Pragma("unroll") for (int nb = 0; nb < NB; ++nb) {                                                                    \
                if constexpr (BNN) {                                                                                               \
                    const s16x4 l = __builtin_amdgcn_ds_read_tr16_b64_v4i16((lds_s16x4_ptr)(Bs + bvb + nb * 512 + ks * (2 * (BN / 32) * 512)));                        \
                    const s16x4 h = __builtin_amdgcn_ds_read_tr16_b64_v4i16((lds_s16x4_ptr)(Bs + bvb + nb * 512 + ks * (2 * (BN / 32) * 512) + (BN / 32) * 512));      \
                    b[nb] = PK8(l, h);                                                                                             \
                } else b[nb] = *(LAS const bf16x8*)(Bs + bfr0 + so + nb * 4096);                                                   \
            }                                                                                                                      \
            _Pragma("unroll") for (int mb = 0; mb < MB; ++mb)                                                                      \
                _Pragma("unroll") for (int nb = 0; nb < NB; ++nb) acc[mb][nb] = SWAPC ? __builtin_amdgcn_mfma_f32_32x32x16_bf16(b[nb], a[mb], acc[mb][nb], 0, 0, 0) : __builtin_amdgcn_mfma_f32_32x32x16_bf16(a[mb], b[nb], acc[mb][nb], 0, 0, 0); \
        } } while (0)
    if constexpr (STAGES == 2) {
    G_LOAD(ra0, rb0, 0); G_LOAD(ra1, rb1, 1); SBAR();
    G_WRITE(ra0, rb0, 0);
    __syncthreads();
    int kt = 0;
    for (; kt + 2 < nk; kt += 2) {
        SBAR(); G_LOAD(ra0, rb0, kt + 2); SBAR();
        G_COMPUTE(0, kt); SBAR();
        G_WRITE(ra1, rb1, 1);
        __syncthreads();
        SBAR(); G_LOAD(ra1, rb1, kt + 3); SBAR();
        G_COMPUTE(1, kt + 1); SBAR();
        G_WRITE(ra0, rb0, 0);
        __syncthreads();
    }
    SBAR(); G_COMPUTE(0, kt); SBAR();
    G_WRITE(ra1, rb1, 1);
    __syncthreads();
    SBAR(); G_COMPUTE(1, kt + 1); SBAR();
    __syncthreads();
    } else {
    G_LOAD(ra0, rb0, 0); SBAR();
    G_WRITE(ra0, rb0, 0);
    __syncthreads();
    for (int kt = 0; kt < nk; ++kt) {
        const int cur = kt & 1;
        if (kt + 1 < nk) { SBAR(); G_LOAD(ra0, rb0, kt + 1); SBAR(); }
        G_COMPUTE(cur, kt); SBAR();
        if (kt + 1 < nk) G_WRITE(ra0, rb0, cur ^ 1);
        __syncthreads();
    }
    }
#undef G_LOAD
#undef G_WRITE
#undef G_COMPUTE
    epi(acc, wm, wn);
}


typedef __attribute__((address_space(1))) const unsigned* g8_gptr;
typedef __attribute__((address_space(3))) unsigned* g8_lptr;
constexpr int G8_HT = 128 * 64;
DEVI int g8_lds_byte(int r, int c) { const int st = (r >> 4) * 2 + (c >> 5), rr = r & 15, cc = c & 31, ob = rr * 64 + cc * 2; return st * 1024 + (ob ^ (((ob >> 9) & 1) << 5)); }
DEVI void g8_stage_rc(int b, int& R, int& C) { const int st = b / 1024, sb = b % 1024, swz = sb ^ (((sb >> 9) & 1) << 5); R = (st >> 1) * 16 + swz / 64; C = (st & 1) * 32 + (swz % 64) / 2; }
typedef f32x4 g8_acc[2][2][4][2];

template <bool GATHER, int NPASS, class EPI>
DEVI void gemm256(char* ldsb, int nt, const short* A, int lda, const int* ltok, const short* Bt, int ldb, int apass, const short* Bt2, EPI epi) {
    short* shm = (short*)ldsb;
#define SA(b, h) (shm + ((b) * 2 + (h)) * G8_HT)
#define SB(b, h) (shm + (4 + (b) * 2 + (h)) * G8_HT)
#define STAGE_A(P_, h_, kt_) do { _Pragma("unroll") for (int _i = 0; _i < 2; ++_i) { \
        const unsigned _o = (GATHER ? ao[(h_) * 2 + _i] : ao[0] + (unsigned)(((h_) * 128 + _i * 64) * lda * 2)) + (unsigned)((kt_) * 128); \
        __builtin_amdgcn_global_load_lds((g8_gptr)((const char*)A + (size_t)_o), (g8_lptr)((char*)(P_) + tz * 16 + _i * 8192), 16, 0, 0); } } while (0)
#define STAGE_B(P_, h_, kt_) do { _Pragma("unroll") for (int _i = 0; _i < 2; ++_i) { \
        const unsigned _o = bo + (unsigned)(((h_) * 128 + _i * 64) * ldb * 2) + (unsigned)((kt_) * 128); \
        __builtin_amdgcn_global_load_lds((g8_gptr)((const char*)Bt + (size_t)_o), (g8_lptr)((char*)(P_) + tz * 16 + _i * 8192), 16, 0, 0); } } while (0)
#define LDA(dst, b, h) _Pragma("unroll") for (int m = 0; m < 4; ++m) _Pragma("unroll") for (int k = 0; k < 2; ++k) \
        dst[m][k] = *reinterpret_cast<const bf16x8*>((char*)SA(b, h) + g8_lds_byte(wr * 64 + m * 16 + fr, k * 32 + fq * 8))
#define LDB(dst, b, h) _Pragma("unroll") for (int n = 0; n < 2; ++n) _Pragma("unroll") for (int k = 0; k < 2; ++k) \
        dst[n][k] = *reinterpret_cast<const bf16x8*>((char*)SB(b, h) + g8_lds_byte(wc * 32 + n * 16 + fr, k * 32 + fq * 8))
#define MMA(ai, bj, At_, Bt_) do { __builtin_amdgcn_s_setprio(1); \
        _Pragma("unroll") for (int m = 0; m < 4; ++m) _Pragma("unroll") for (int n = 0; n < 2; ++n) _Pragma("unroll") for (int k = 0; k < 2; ++k) \
            acc[ai][bj][m][n] = __builtin_amdgcn_mfma_f32_16x16x32_bf16(Bt_[n][k], At_[m][k], acc[ai][bj][m][n], 0, 0, 0); \
        __builtin_amdgcn_s_setprio(0); } while (0)
#define WAIT_V(n) asm volatile("s_waitcnt vmcnt(" #n ")" ::: "memory")
#define WAIT_L(n) asm volatile("s_waitcnt lgkmcnt(" #n ")" ::: "memory")
#define BAR __builtin_amdgcn_s_barrier()
#define SCHED __builtin_amdgcn_sched_barrier(0)
    int tz = threadIdx.x; asm volatile("" : "+v"(tz));
    int wid = __builtin_amdgcn_readfirstlane(tz >> 6), lane = tz & 63, wr = wid >> 2, wc = wid & 3, fr = lane & 15, fq = lane >> 4;
    unsigned ao[4], bo;
    { int r0, c0; g8_stage_rc(tz * 16, r0, c0);
      if constexpr (GATHER) {
#pragma unroll
          for (int q = 0; q < 4; ++q) ao[q] = (unsigned)(ltok[(q >> 1) * 128 + (q & 1) * 64 + r0] * lda + c0) * 2u;
      } else { ao[0] = (unsigned)(r0 * lda + c0) * 2u; ao[1] = ao[2] = ao[3] = 0; }
      bo = (unsigned)(r0 * ldb + c0) * 2u; }
    g8_acc acc;
#pragma unroll
    for (int a = 0; a < 2; ++a)
#pragma unroll
        for (int b = 0; b < 2; ++b)
#pragma unroll
            for (int m = 0; m < 4; ++m)
#pragma unroll
                for (int n = 0; n < 2; ++n) acc[a][b][m][n] = f32x4{0, 0, 0, 0};
    bf16x8 At[4][2], B0[2][2], B1[2][2];
#pragma unroll 1
    for (int pass = 0; pass < NPASS; ++pass) {
    if (pass == 1) { A += apass; Bt = Bt2;
        tz = threadIdx.x; asm volatile("" : "+v"(tz)); wid = __builtin_amdgcn_readfirstlane(tz >> 6); lane = tz & 63; wr = wid >> 2; wc = wid & 3; fr = lane & 15; fq = lane >> 4; }
    STAGE_B(SB(0, 0), 0, 0); STAGE_A(SA(0, 0), 0, 0);
    STAGE_B(SB(0, 1), 1, 0); STAGE_A(SA(0, 1), 1, 0);
    if (wr == 1) BAR;
    WAIT_V(4); BAR;
    STAGE_B(SB(1, 0), 0, 1); STAGE_A(SA(1, 0), 0, 1); STAGE_B(SB(1, 1), 1, 1);
    WAIT_V(6); BAR;
    for (int t = 0; t < nt - 2; t += 2) {
        LDB(B0, 0, 0); SCHED; LDA(At, 0, 0); STAGE_A(SA(1, 1), 1, t + 1);
        WAIT_L(8); BAR; WAIT_L(0); MMA(0, 0, At, B0); BAR; SCHED;
        LDB(B1, 0, 1); STAGE_B(SB(0, 0), 0, t + 2);
        BAR; WAIT_L(0); MMA(0, 1, At, B1); BAR;
        LDA(At, 0, 1); STAGE_A(SA(0, 0), 0, t + 2);
        BAR; WAIT_L(0); MMA(1, 0, At, B0); BAR; SCHED;
        STAGE_B(SB(0, 1), 1, t + 2);
        WAIT_V(6); BAR; MMA(1, 1, At, B1); BAR;
        LDB(B0, 1, 0); SCHED; LDA(At, 1, 0); STAGE_A(SA(0, 1), 1, t + 2);
        WAIT_L(8); BAR; WAIT_L(0); MMA(0, 0, At, B0); BAR; SCHED;
        LDB(B1, 1, 1); STAGE_B(SB(1, 0), 0, t + 3);
        BAR; WAIT_L(0); MMA(0, 1, At, B1); BAR;
        LDA(At, 1, 1); STAGE_A(SA(1, 0), 0, t + 3);
        BAR; WAIT_L(0); MMA(1, 0, At, B0); BAR; SCHED;
        STAGE_B(SB(1, 1), 1, t + 3);
        WAIT_V(6); BAR; MMA(1, 1, At, B1); BAR;
    }
    tz = threadIdx.x; asm volatile("" : "+v"(tz)); wid = __builtin_amdgcn_readfirstlane(tz >> 6); lane = tz & 63; wr = wid >> 2; wc = wid & 3; fr = lane & 15; fq = lane >> 4;
    { int r0, c0; g8_stage_rc(tz * 16, r0, c0);
      if constexpr (GATHER) {
#pragma unroll
          for (int q = 2; q < 4; ++q) ao[q] = (unsigned)(ltok[(q >> 1) * 128 + (q & 1) * 64 + r0] * lda + c0) * 2u;
      } else ao[0] = (unsigned)(r0 * lda + c0) * 2u; }
    { LDB(B0, 0, 0); WAIT_V(0); LDA(At, 0, 0); STAGE_A(SA(1, 1), 1, nt - 1);
      BAR; WAIT_L(0); MMA(0, 0, At, B0); BAR;
      LDB(B1, 0, 1); BAR; WAIT_L(0); MMA(0, 1, At, B1); BAR;
      LDA(At, 0, 1); WAIT_V(4); BAR; WAIT_L(0); MMA(1, 0, At, B0); MMA(1, 1, At, B1); BAR; }
    { LDB(B0, 1, 0); LDA(At, 1, 0); WAIT_V(2); BAR; WAIT_L(0); MMA(0, 0, At, B0); BAR;
      LDB(B1, 1, 1); WAIT_V(0); BAR; WAIT_L(0); MMA(0, 1, At, B1); BAR;
      LDA(At, 1, 1); BAR; WAIT_L(0); MMA(1, 0, At, B0); MMA(1, 1, At, B1); BAR; }
    if (wr == 0) BAR;
    }
    SBAR();
    epi(acc, wr, wc, fr, fq);
#undef SA
#undef SB
#undef STAGE_A
#undef STAGE_B
#undef LDA
#undef LDB
#undef MMA
#undef WAIT_V
#undef WAIT_L
#undef BAR
#undef SCHED
}
template <class F> DEVI void g8_for_acc(g8_acc& acc, int wr, int wc, int fr, int fq, F f) {
#pragma unroll
    for (int ai = 0; ai < 2; ++ai)
#pragma unroll
        for (int m = 0; m < 4; ++m)
        {
#pragma unroll
            for (int bj = 0; bj < 2; ++bj) { SBAR();
#pragma unroll
                for (int n = 0; n < 2; ++n) f(ai * 128 + wr * 64 + m * 16 + fr, bj * 128 + wc * 32 + n * 16 + fq * 4, acc[ai][bj][m][n]); } }
}
template <class F> DEVI void g8_for_acc8(g8_acc& acc, int wr, int wc, int fr, int fq, F f) {
#pragma unroll
    for (int ai = 0; ai < 2; ++ai)
#pragma unroll
        for (int m = 0; m < 4; ++m)
        {
#pragma unroll
            for (int bj = 0; bj < 2; ++bj) { SBAR(); float v[8];
#pragma unroll
                for (int j = 0; j < 4; ++j) { auto rr = __builtin_amdgcn_permlane16_swap(__float_as_uint(acc[ai][bj][m][0][j]), __float_as_uint(acc[ai][bj][m][1][j]), false, false);
                    v[j] = __uint_as_float(rr[0]); v[4 + j] = __uint_as_float(rr[1]); }
                f(ai * 128 + wr * 64 + m * 16 + fr, bj * 128 + wc * 32 + (fq & 1) * 16 + (fq & ~1) * 4, v); } }
}

struct Params { const float* in[22]; float* out; char* ws; int nphases; int ph_lo; };

struct Ctx { float* out; char* ws; char* lds; int G, vcu; };
#define TID_SETUP() int tid = threadIdx.x; asm volatile("" : "+v"(tid)); const int lane = tid & 63; const int wid = __builtin_amdgcn_readfirstlane(tid >> 6); (void)lane; (void)wid

DEVI short* res_row(const Ctx& c, int r) { return (short*)(c.ws + WS_RES) + (size_t)r * D; }
DEVI const float* in_row(const Params& P, int r) { return r < T_CTX ? P.in[2] + (size_t)r * D : P.in[0] + (size_t)(r - T_CTX) * D; }
DEVI f32x4 ld_bf4(const short* p) { const u32x2 w = *(const u32x2*)p; return f32x4{bflo(w[0]), bfhi(w[0]), bflo(w[1]), bfhi(w[1])}; }
DEVI void st_bf4(short* p, f32x4 v) { *(u32x2*)p = u32x2{cvtpk(v[0], v[1]), cvtpk(v[2], v[3])}; }
DEVI void res_load8(const Params& P, const Ctx& c, int r, int col, int layer, float (&x)[8]) {
    if (layer == 0) { const float* p = in_row(P, r) + col; const f32x4 a = *(const f32x4*)p, b = *(const f32x4*)(p + 4);
#pragma unroll
        for (int j = 0; j < 4; ++j) { x[j] = a[j]; x[4 + j] = b[j]; } }
    else { const u32x4 w = *(const u32x4*)(res_row(c, r) + col);
#pragma unroll
        for (int j = 0; j < 4; ++j) { x[2 * j] = bflo(w[j]); x[2 * j + 1] = bfhi(w[j]); } }
}
DEVI f32x4 res_load4(const Params& P, const Ctx& c, int r, int col, int layer) { return layer == 0 ? *(const f32x4*)(in_row(P, r) + col) : ld_bf4(res_row(c, r) + col); }

DEVI void cls_experts(int cls, int& ea, int& eb);
DEVI void phase_prologue(const Params& P, const Ctx& c) {
    TID_SETUP();
    const long gtid = (long)blockIdx.x * NTHR + tid; const long gsz = (long)c.G * NTHR;
    float* sv = (float*)(c.lds + LDS_GEMM);
    for (int i = tid; i < 3 * 1024; i += NTHR) { const int v = i >> 10, k = i & 1023; const float x = (v < 2) ? P.in[1][v * 1024 + k] : P.in[3][k]; sv[i] = silu(x); }
    float* tc = sv + 3 * 1024;
    for (int i = tid; i < 128; i += NTHR) { tc[i] = cospif(i / 64.f); tc[128 + i] = sinpif(i / 64.f); }
    __syncthreads();
    {
        float* modp = (float*)(c.ws + WS_MODP);
        const float* w_ada = P.in[4];
        for (long it = gtid; it < (long)8 * 4 * 6144; it += gsz) {
            const int j = (int)(it % 6144); const int l = (int)((it / 6144) & 3); const int ks = (int)(it / (6144 * 4));
            const float* w = w_ada + ((size_t)l * 1024 + ks * 128) * 6144 + j;
            float a0 = 0, a1 = 0, a2 = 0;
            for (int k = 0; k < 128; ++k) { const float wv = w[(size_t)k * 6144]; const int kk = ks * 128 + k; a0 += sv[kk] * wv; a1 += sv[1024 + kk] * wv; a2 += sv[2048 + kk] * wv; }
            float* o = modp + ((size_t)(ks * 4 + l) * 3) * 6144 + j;
            o[0] = a0; o[6144] = a1; o[2 * 6144] = a2;
        }
    }
    {
        float* tl = (float*)(c.lds + LDS_GEMM + 16384);
        const int NT_IN = 4 * 16 * 15, NT_OUT = 4 * 16 * 16, NT_GU = 4 * 16 * 16 * 4 * 2, NT_DN = 4 * NCLS * 2 * 4 * 16;
        struct TD { const float* s; short* d; int sld, dld, k0, n0, nvalid, mode; };
        auto desc = [&](int tix) { TD t; t.mode = 0;
            if (tix < NT_IN) { const int l = tix / 240, r = tix % 240, kt = r / 15, nt2 = r % 15; t.s = P.in[8] + (size_t)l * 1024 * INW; t.sld = INW; t.d = (short*)(c.ws + WS_WIN) + (size_t)l * 1024 * 1024; t.dld = 1024; t.k0 = kt * 64; t.n0 = nt2 * 64; t.nvalid = INW; }
            else if (tix < NT_IN + NT_OUT) { const int t2 = tix - NT_IN; const int l = t2 >> 8, r = t2 & 255; t.s = P.in[16] + (size_t)l * 1024 * 1024; t.sld = 1024; t.d = (short*)(c.ws + WS_WOUT) + (size_t)l * 1024 * 1024; t.dld = 1024; t.k0 = (r >> 4) * 64; t.n0 = (r & 15) * 64; t.nvalid = 1024; }
            else if (tix < NT_IN + NT_OUT + NT_GU) { const int t2 = tix - NT_IN - NT_OUT; const int gu = t2 & 1, r = t2 >> 1; const int le = r >> 6, kt = (r >> 2) & 15, nt2 = r & 3;
                t.s = (gu ? P.in[20] : P.in[19]) + (size_t)le * 1024 * 256; t.sld = 256; t.d = (short*)(c.ws + WS_WGU) + (size_t)le * 512 * 1024; t.dld = 1024; t.k0 = kt * 64; t.n0 = nt2 * 64; t.nvalid = 256; t.mode = 1 + gu; }
            else { const int t2 = tix - NT_IN - NT_OUT - NT_GU; const int lch = t2 >> 6, kt = (t2 >> 4) & 3, nt2 = t2 & 15; const int half = lch & 1, lc = lch >> 1, cl = lc % NCLS, l = lc / NCLS;
                int ea, eb; cls_experts(cl, ea, eb); const int e = half ? eb : ea;
                t.s = P.in[21] + (size_t)(l * 16 + e) * 256 * 1024; t.sld = 1024; t.d = (short*)(c.ws + WS_WDN) + (size_t)lc * 1024 * 512 + half * 256; t.dld = 512; t.k0 = kt * 64; t.n0 = nt2 * 64; t.nvalid = 1024; }
            return t; };
        const int NTILES = NT_IN + NT_OUT + NT_GU + NT_DN;
        const int lkk = tid >> 3, lcg = (tid & 7) * 8;
        f32x4 x0 = {0, 0, 0, 0}, x1 = {0, 0, 0, 0};
        auto tload = [&](const TD& t) { x0 = f32x4{0, 0, 0, 0}; x1 = f32x4{0, 0, 0, 0};
            if (t.n0 + lcg < t.nvalid) { const float* sp = t.s + (size_t)(t.k0 + lkk) * t.sld + t.n0 + lcg; x0 = *(const f32x4*)sp; x1 = *(const f32x4*)(sp + 4); } };
        int tix = blockIdx.x, pb = 0;
        TD cur = desc(tix < NTILES ? tix : 0);
        __syncthreads();
        if (tix < NTILES) tload(cur);
        for (; tix < NTILES; tix += c.G, pb ^= 1) {
            float* tlb = tl + pb * (64 * 65);
#pragma unroll
            for (int j = 0; j < 4; ++j) { tlb[lkk * 65 + lcg + j] = x0[j]; tlb[lkk * 65 + lcg + 4 + j] = x1[j]; }
            const TD nxt = desc(tix + c.G < NTILES ? tix + c.G : 0);
            if (tix + c.G < NTILES) tload(nxt);
            __syncthreads();
            { const int n = tid >> 3, kg = (tid & 7) * 8; const int nn = cur.n0 + n;
              if (nn < cur.nvalid) { float v[8];
#pragma unroll
                for (int j = 0; j < 8; ++j) v[j] = tlb[(kg + j) * 65 + n];
                const int drow = cur.mode == 0 ? nn : ((nn >> 4) * 32 + (cur.mode - 1) * 16 + (nn & 15));
                *(u32x4*)(cur.d + (size_t)drow * cur.dld + cur.k0 + kg) = u32x4{cvtpk(v[0], v[1]), cvtpk(v[2], v[3]), cvtpk(v[4], v[5]), cvtpk(v[6], v[7])}; } }
            cur = nxt;
        }
        __syncthreads();
        { short* d = (short*)(c.ws + WS_WIN);
          for (long it = gtid; it < (long)4 * 96 * 128; it += gsz) { const int k8 = (int)(it & 127); const long lr = it >> 7; const int l = (int)(lr / 96), rr = (int)(lr % 96);
              *(u32x4*)(d + ((size_t)l * 1024 + INW + rr) * 1024 + k8 * 8) = u32x4{0, 0, 0, 0}; } }
    }
    {
        short* dst = (short*)(c.ws + WS_WQT);
        for (long it = gtid; it < (long)4 * 768 * 256; it += gsz) { const int k = (int)(it & 255); const long lf = it >> 8; const int f = (int)(lf % 768), l = (int)(lf / 768);
            dst[it] = (short)f2bf(P.in[9][l * 256 + k] * P.in[10][((size_t)l * 256 + k) * 768 + f]); }
        dst = (short*)(c.ws + WS_WKVT);
        for (long it = gtid; it < (long)4 * 1024 * 128; it += gsz) { const int k = (int)(it & 127); const long lf = it >> 7; const int f = (int)(lf & 1023), l = (int)(lf >> 10);
            dst[it] = (short)f2bf(P.in[11][l * 128 + k] * P.in[12][((size_t)l * 128 + k) * 1024 + f]); }
    }
    {
        short* dst = (short*)(c.ws + WS_WCS); const float* wf = P.in[15];
        for (long it = gtid; it < (long)4 * 4 * 128 * 256; it += gsz) {
            const int d = (int)(it & 127), ab = (int)((it >> 7) & 1), cc = (int)((it >> 8) & 127); const long lg = it >> 15;
            const float* w = wf + lg * 128 * 128 + d; const float* tt = tc + ab * 128;
            float a = 0;
            for (int j = 0; j < 128; ++j) a += tt[(cc * j) & 127] * w[j * 128];
            dst[it] = (short)f2bf(a * 0.08838834764831845f);
        }
    }
    {
        short* f1 = (short*)(c.ws + WS_F1);
        for (long it = gtid; it < 256 * 256; it += gsz) { const int kk = (int)(it & 255), m = (int)(it >> 8); const int k1 = (m >> 6) * 32 + (m & 31), ri = (m >> 5) & 1, n1 = kk >> 1, ab = kk & 1;
            const int a = (n1 * k1) & 127; const float cs = tc[a], sn = tc[128 + a];
            const float v = (ri == 0) ? (ab == 0 ? cs : -sn) : (ab == 0 ? -sn : -cs);
            f1[it] = (short)f2bf(v * 0.08838834764831845f); }
        short* f2 = (short*)(c.ws + WS_F2);
        for (long it = gtid; it < 128 * 256; it += gsz) { const int kk = (int)(it & 255), k2 = (int)(it >> 8); const int n2 = kk >> 1, ri = kk & 1;
            const int a = (n2 * k2) & 127; f2[it] = (short)f2bf((ri == 0 ? tc[a] : tc[128 + a]) * 0.08838834764831845f); }
        short* fc = (short*)(c.ws + WS_FC);
        for (long it = gtid; it < 256 * 512; it += gsz) { const int kk = (int)(it & 511), k = (int)(it >> 9); const int n = kk >> 1, ab = kk & 1;
            const int a = (n * k) & 255; const float v = ab == 0 ? cospif(a / 128.f) : -sinpif(a / 128.f); fc[it] = (short)f2bf(v * 0.0625f); }
        float2* tw = (float2*)(c.ws + WS_TW);
        for (long it = gtid; it < 16384; it += gsz) tw[it] = make_float2(cospif((float)it / 8192.f), sinpif((float)it / 8192.f));
        float2* rp = (float2*)(c.ws + WS_ROPE);
        for (long it = gtid; it < 256 * 8; it += gsz) { const int i = (int)(it & 7), pos = (int)(it >> 3); const float fr = powf(10000.f, -(float)i / 8.f); const float ang = (float)pos * fr;
            rp[it] = make_float2(cosf(ang), sinf(ang)); }
    }
}

DEVI void phase_coef(const Params& P, const Ctx& c) {
    TID_SETUP();
    const long gtid = (long)blockIdx.x * NTHR + tid; const long gsz = (long)c.G * NTHR;
    const float* modp = (const float*)(c.ws + WS_MODP); float* coef = (float*)(c.ws + WS_COEF);
    for (long it = gtid; it < (long)4 * 3 * 6144; it += gsz) {
        const int j = (int)(it % 6144); const int v = (int)((it / 6144) % 3); const int l = (int)(it / (6144 * 3));
        float m = P.in[5][l * 6144 + j];
        for (int ks = 0; ks < 8; ++ks) m += modp[((size_t)(ks * 4 + l) * 3 + v) * 6144 + j];
        const int chunk = j >> 10, col = j & 1023;
        float val; int slot;
        if (chunk == 0) { slot = 1; val = m; } else if (chunk == 1) { slot = 0; val = P.in[6][l * 1024 + col] * (1.f + m); } else if (chunk == 2) { slot = 2; val = m; }
        else if (chunk == 3) { slot = 4; val = m; } else if (chunk == 4) { slot = 3; val = P.in[7][l * 1024 + col] * (1.f + m); } else { slot = 5; val = m; }
        coef[((size_t)(l * 3 + v) * 6 + slot) * 1024 + col] = val;
    }
}

DEVI void phase_norm_mix(const Params& P, const Ctx& c, int l) {
    TID_SETUP();
    const float* coef = (const float*)(c.ws + WS_COEF) + (size_t)l * 3 * 6 * 1024;
    short* hbuf = (short*)(c.ws + WS_HBUF);
    for (int r = c.vcu * 8 + wid; r < T; r += c.G * 8) {
        const int v = row_variant(r);
        const float* a1 = coef + (size_t)(v * 6 + 0) * 1024; const float* b1 = coef + (size_t)(v * 6 + 1) * 1024;
        float xv[2][8]; float ss = 0;
        if (l == 0) { const float* x = in_row(P, r);
#pragma unroll
            for (int q = 0; q < 2; ++q) { const f32x4 t0 = *(const f32x4*)(x + q * 512 + lane * 8), t1 = *(const f32x4*)(x + q * 512 + lane * 8 + 4);
#pragma unroll
                for (int j = 0; j < 4; ++j) { xv[q][j] = t0[j]; xv[q][4 + j] = t1[j]; } } }
        else { const short* x = res_row(c, r);
#pragma unroll
            for (int q = 0; q < 2; ++q) { const u32x4 t = *(const u32x4*)(x + q * 512 + lane * 8);
#pragma unroll
                for (int j = 0; j < 4; ++j) { xv[q][2 * j] = bflo(t[j]); xv[q][2 * j + 1] = bfhi(t[j]); } } }
#pragma unroll
        for (int q = 0; q < 2; ++q)
#pragma unroll
            for (int j = 0; j < 8; ++j) ss += xv[q][j] * xv[q][j];
        ss = wave_sum(ss); const float rstd = rsqrtf(ss * (1.f / 1024.f) + EPS);
#pragma unroll
        for (int q = 0; q < 2; ++q) { const int col = q * 512 + lane * 8; const f32x4 a0 = *(const f32x4*)(a1 + col), a4 = *(const f32x4*)(a1 + col + 4), b0 = *(const f32x4*)(b1 + col), b4 = *(const f32x4*)(b1 + col + 4);
            float y[8];
#pragma unroll
            for (int j = 0; j < 4; ++j) { y[j] = xv[q][j] * rstd * a0[j] + b0[j]; y[4 + j] = xv[q][4 + j] * rstd * a4[j] + b4[j]; }
            *(u32x4*)(hbuf + (size_t)r * 1024 + col) = u32x4{cvtpk(y[0], y[1]), cvtpk(y[2], y[3]), cvtpk(y[4], y[5]), cvtpk(y[6], y[7])}; }
    }
}

DEVI u32x4 pack8(const float* p) {
    const unsigned a0 = cvtpk(p[0], p[1]), a1 = cvtpk(p[2], p[3]), b0 = cvtpk(p[4], p[5]), b1 = cvtpk(p[6], p[7]);
    auto r0 = __builtin_amdgcn_permlane32_swap(a0, b0, false, false); auto r1 = __builtin_amdgcn_permlane32_swap(a1, b1, false, false);
    return u32x4{r0[0], r1[0], r0[1], r1[1]};
}
template <int MB, int NB, class F> DEVI void for_acc_bf8(f32x16 (&acc)[MB][NB], int wm, int wn, int lane, F f) {
    const int r32 = lane & 31, hi = lane >> 5;
#pragma unroll
    for (int mb = 0; mb < MB; ++mb)
#pragma unroll
        for (int nb = 0; nb < NB; ++nb)
#pragma unroll
            for (int s = 0; s < 2; ++s) { float t[8];
#pragma unroll
                for (int j = 0; j < 8; ++j) t[j] = acc[mb][nb][8 * s + j];
                f((wm * MB + mb) * 32 + r32, (wn * NB + nb) * 32 + 16 * s + 8 * hi, pack8(t)); }
}
template <int MB, int NB, class F> DEVI void for_acc_f4(f32x16 (&acc)[MB][NB], int wm, int wn, int lane, F f) {
    const int r32 = lane & 31, hi = lane >> 5;
#pragma unroll
    for (int mb = 0; mb < MB; ++mb)
#pragma unroll
        for (int nb = 0; nb < NB; ++nb)
#pragma unroll
            for (int g = 0; g < 4; ++g) f((wm * MB + mb) * 32 + r32, (wn * NB + nb) * 32 + 8 * g + 4 * hi, f32x4{acc[mb][nb][4 * g], acc[mb][nb][4 * g + 1], acc[mb][nb][4 * g + 2], acc[mb][nb][4 * g + 3]});
}

DEVI void phase_inproj(const Params& P, const Ctx& c, int l) {
    TID_SETUP();
    const short* hbuf = (const short*)(c.ws + WS_HBUF); const short* WT = (const short*)(c.ws + WS_WIN) + (size_t)l * 1024 * 1024; short* zbuf = (short*)((char*)c.out);
    for (int u = c.vcu; u < 64; u += c.G) {
        const int rt = u >> 3, ct = u & 7; const int row0 = rt * 64, col0 = ct * 128;
        gemm_tile<1, 1, 2, 4, false, true>(c.lds + LDS_GEMM, 16,
            [&](int r) { return hbuf + (size_t)(row0 + r) * 1024; },
            [&](int n) { return WT + (size_t)(col0 + n) * 1024; },
            [&](f32x16 (&acc)[1][1], int wm, int wn) {
                for_acc_bf8<1, 1>(acc, wm, wn, lane, [&](int r, int cc, u32x4 v) { const int col = col0 + cc; if (col < INW) *(u32x4*)(zbuf + (size_t)(row0 + r) * ZLD + col) = v; });
            });
    }
    for (int u = c.vcu; u < 512; u += c.G) {
        const int rt = 2 + (u >> 2), ct = u & 3; const int row0 = rt * 256, col0 = ct * 256;
        __syncthreads();
        gemm256<false, 1>(c.lds + LDS_GEMM, 16, hbuf + (size_t)row0 * 1024, 1024, nullptr, WT + (size_t)col0 * 1024, 1024, 0, nullptr,
            [&](g8_acc& acc, int wr, int wc, int fr, int fq) {
                g8_for_acc8(acc, wr, wc, fr, fq, [&](int r, int cc, const float (&v)[8]) { const int col = col0 + cc;
                    if (col < INW) *(u32x4*)(zbuf + (size_t)(row0 + r) * ZLD + col) = u32x4{cvtpk(v[0], v[1]), cvtpk(v[2], v[3]), cvtpk(v[4], v[5]), cvtpk(v[6], v[7])}; });
            });
    }
}

template <int NCOL, int NTOK = 128> DEVI void tile_rowstat(const Ctx& c, int tid, int tok0, int col0, float* stat) {
    const short* zbuf = (const short*)((char*)c.out);
    constexpr int TPT = NTHR / NTOK, per = NCOL / TPT;
    const int t = tid / TPT, q = tid % TPT;
    const short* p = zbuf + (size_t)(tok0 + t) * ZLD + col0 + q * per;
    u32x4 w[per / 8];
#pragma unroll
    for (int i = 0; i < per / 8; ++i) w[i] = *(const u32x4*)(p + i * 8);
    float ss = 0;
#pragma unroll
    for (int i = 0; i < per / 8; ++i)
#pragma unroll
        for (int j = 0; j < 4; ++j) { const float a = bflo(w[i][j]), b = bfhi(w[i][j]); ss += a * a + b * b; }
    ss += __shfl_xor(ss, 1, 64); if constexpr (TPT == 4) ss += __shfl_xor(ss, 2, 64);
    if (q == 0) stat[t] = ss / (float)NCOL;
}
DEVI float half_sum(float v) { auto rr = __builtin_amdgcn_permlane32_swap(__float_as_uint(v), __float_as_uint(v), false, false); return __uint_as_float(rr[0]) + __uint_as_float(rr[1]); }

DEVI void rope16(float (&x)[16], int n, bool lat, int hi, const float2* ropetab) {
    if (!lat) return;
    const int prow = n >> 6, pcol = n & 63;
#pragma unroll
    for (int j = 0; j < 4; ++j) {
        const int i = j + 4 * hi;
        const float2 cr = ropetab[prow * 8 + i], cc = ropetab[pcol * 8 + i];
        const float a1 = x[j], a2 = x[j + 4]; x[j] = a1 * cr.x - a2 * cr.y; x[j + 4] = a2 * cr.x + a1 * cr.y;
        const float b1 = x[8 + j], b2 = x[12 + j]; x[8 + j] = b1 * cc.x - b2 * cc.y; x[12 + j] = b2 * cc.x + b1 * cc.y;
    }
}

template <int NB> DEVI void pc_q_unit(const Params& P, const Ctx& c, int l, int tok0, int hp, int tid, int lane) {
    const short* zbuf = (const short*)((char*)c.out);
    float* stat = (float*)(c.lds + LDS_STAT);
    const float2* ropetab = (const float2*)(c.ws + WS_ROPE);
    tile_rowstat<QLR, 128 * NB>(c, tid, tok0, 0, stat);
    const short* WQT = (const short*)(c.ws + WS_WQT) + ((size_t)l * 768 + hp * 192) * 256;
    const float* qn = P.in[13] + l * DQK;
    gemm_tile<3, NB, 2, 4, false, false>(c.lds + LDS_GEMM, 4,
        [&](int r) { return WQT + (size_t)r * 256; },
        [&](int n) { return zbuf + (size_t)(tok0 + n) * ZLD; },
        [&](f32x16 (&acc)[3][NB], int wm, int wn) {
#pragma unroll
            for (int nb = 0; nb < NB; ++nb) {
                const int hi = lane >> 5, r32 = lane & 31; const int tl = (wn * NB + nb) * 32 + r32, row = tok0 + tl, h = hp * 2 + wm;
                const bool lat = row >= T_CTX; const int rr = lat ? row - T_CTX : row; const int b = lat ? (rr >> 14) : (rr >> 8); const int n = lat ? (rr & 16383) : (rr & 255);
                const float s1 = rsqrtf(stat[tl] + EPS);
                float ss = 0;
#pragma unroll
                for (int mb = 0; mb < 3; ++mb)
#pragma unroll
                    for (int r = 0; r < 16; ++r) ss += acc[mb][nb][r] * acc[mb][nb][r];
                ss = half_sum(ss);
                const float s2 = rsqrtf(s1 * s1 * ss * (1.f / 96.f) + EPS); const float sc = s1 * s2 * ATT_QSCALE;
                float x[3][16];
#pragma unroll
                for (int mb = 0; mb < 3; ++mb)
#pragma unroll
                    for (int g4 = 0; g4 < 4; ++g4) { const f32x4 g = *(const f32x4*)(qn + mb * 32 + 8 * g4 + 4 * hi);
#pragma unroll
                        for (int j = 0; j < 4; ++j) x[mb][g4 * 4 + j] = acc[mb][nb][g4 * 4 + j] * sc * g[j]; }
                rope16(x[2], n, lat, hi, ropetab);
                short* dst = lat ? (short*)(c.ws + WS_QBUF) + ((size_t)(b * NH + h) * SEQ + n) * DQK : (short*)(c.ws + WS_QCTX) + ((size_t)(b * NH + h) * NCTX + n) * DQK;
#pragma unroll
                for (int mb = 0; mb < 3; ++mb)
#pragma unroll
                    for (int s = 0; s < 2; ++s) *(u32x4*)(dst + mb * 32 + s * 16 + hi * 8) = pack8(&x[mb][s * 8]);
            }
        });
}

template <int NB> DEVI void pc_kv_unit(const Params& P, const Ctx& c, int l, int tok0, int hp, int tid, int lane) {
    const short* zbuf = (const short*)((char*)c.out);
    float* stat = (float*)(c.lds + LDS_STAT);
    const float2* ropetab = (const float2*)(c.ws + WS_ROPE);
    tile_rowstat<KVLR, 128 * NB>(c, tid, tok0, QLR, stat);
    const short* WKVT = (const short*)(c.ws + WS_WKVT) + ((size_t)l * 1024 + hp * 256) * 128;
    const float* kn = P.in[14] + l * DQK;
    gemm_tile<4, NB, 2, 4, false, false, (NB == 1 ? 2 : 1)>(c.lds + LDS_GEMM, 2,
        [&](int r) { return WKVT + (size_t)r * 128; },
        [&](int n) { return zbuf + (size_t)(tok0 + n) * ZLD + QLR; },
        [&](f32x16 (&acc)[4][NB], int wm, int wn) {
#pragma unroll
            for (int nb = 0; nb < NB; ++nb) {
                const int hi = lane >> 5, r32 = lane & 31; const int tl = (wn * NB + nb) * 32 + r32, row = tok0 + tl, h = hp * 2 + wm;
                const bool lat = row >= T_CTX; const int rr = lat ? row - T_CTX : row; const int b = lat ? (rr >> 14) : (rr >> 8); const int n = lat ? (rr & 16383) : (rr & 255);
                const int pos = lat ? NCTX + n : n;
                const float s1 = rsqrtf(stat[tl] + EPS);
                float kr[16];
#pragma unroll
                for (int g4 = 0; g4 < 4; ++g4) { const u32x2 w = *(const u32x2*)(zbuf + (size_t)row * ZLD + QLR + KVLR + 8 * g4 + 4 * hi);
                    kr[g4 * 4 + 0] = bflo(w[0]); kr[g4 * 4 + 1] = bfhi(w[0]); kr[g4 * 4 + 2] = bflo(w[1]); kr[g4 * 4 + 3] = bfhi(w[1]); }
                float ss = 0;
#pragma unroll
                for (int mb = 0; mb < 2; ++mb)
#pragma unroll
                    for (int r = 0; r < 16; ++r) { const float t = acc[mb][nb][r] * s1; ss += t * t; }
#pragma unroll
                for (int r = 0; r < 16; ++r) ss += kr[r] * kr[r];
                ss = half_sum(ss);
                const float s2 = rsqrtf(ss * (1.f / 96.f) + EPS);
                float x[3][16];
#pragma unroll
                for (int mb = 0; mb < 3; ++mb)
#pragma unroll
                    for (int g4 = 0; g4 < 4; ++g4) { const f32x4 g = *(const f32x4*)(kn + mb * 32 + 8 * g4 + 4 * hi);
#pragma unroll
                        for (int j = 0; j < 4; ++j) x[mb][g4 * 4 + j] = (mb < 2 ? acc[mb][nb][g4 * 4 + j] * s1 : kr[g4 * 4 + j]) * s2 * g[j]; }
                rope16(x[2], n, lat, hi, ropetab);
                short* kd = (short*)(c.ws + WS_KBUF) + ((size_t)(b * NH + h) * NKEY + pos) * DQK;
#pragma unroll
                for (int mb = 0; mb < 3; ++mb)
#pragma unroll
                    for (int s = 0; s < 2; ++s) *(u32x4*)(kd + mb * 32 + s * 16 + hi * 8) = pack8(&x[mb][s * 8]);
                short* vd = (short*)(c.ws + WS_VBUF) + ((size_t)(b * NH + h) * NKEY + pos) * DV;
                float vv[2][16];
#pragma unroll
                for (int mb = 0; mb < 2; ++mb)
#pragma unroll
                    for (int r = 0; r < 16; ++r) vv[mb][r] = acc[2 + mb][nb][r] * s1;
#pragma unroll
                for (int mb = 0; mb < 2; ++mb)
#pragma unroll
                    for (int s = 0; s < 2; ++s) *(u32x4*)(vd + mb * 32 + s * 16 + hi * 8) = pack8(&vv[mb][s * 8]);
            }
        });
}

DEVI void phase_proj2(const Params& P, const Ctx& c, int l) {
    TID_SETUP();
    const short* zbuf = (const short*)((char*)c.out);
    for (int u = c.vcu + PC_U0; u < (l < DEPTH - 1 ? 1072 : 1056); u += c.G) {
        __syncthreads();
        if (u < 512) pc_q_unit<2>(P, c, l, T_CTX + (u >> 2) * 256, u & 3, tid, lane);
        else if (u < 1024) pc_kv_unit<2>(P, c, l, T_CTX + ((u - 512) >> 2) * 256, u & 3, tid, lane);
        else if (u < 1040) pc_q_unit<1>(P, c, l, ((u - 1024) >> 2) * 128, u & 3, tid, lane);
        else if (u < 1056) pc_kv_unit<1>(P, c, l, ((u - 1040) >> 2) * 128, u & 3, tid, lane);
        else {
            const int uu = u - 1056; const int rt = uu >> 3, g = (uu >> 1) & 3, ct = uu & 1; const int row0 = rt * 256;
            const short* W = (const short*)(c.ws + WS_WCS) + ((size_t)(l * 4 + g) * 128) * 256 + ct * 128; short* U = (short*)(c.ws + WS_UCTX);
            gemm_tile<2, 2, 4, 2, true, true>(c.lds + LDS_GEMM, 2,
                [&](int r) { return zbuf + (size_t)(row0 + r) * ZLD + 416 + g * 128; },
                [&](int k) { return W + (size_t)k * 256; },
                [&](f32x16 (&acc)[2][2], int wm, int wn) {
                    for_acc_bf8<2, 2>(acc, wm, wn, lane, [&](int r, int cc, u32x4 v) { *(u32x4*)(U + (size_t)(row0 + r) * 1024 + g * 256 + ct * 128 + cc) = v; });
                });
        }
    }
}

constexpr int AT_VB = 64 * 64 * 2, AT_KB = 64 * 256, AT_V = 0, AT_K = 3 * AT_VB, AT_WS = AT_K + 3 * AT_KB;
#define KSWZ(row, colB) ((row) * 256 + ((colB) ^ (((row) & 15) << 4)))

DEVI void att_exp16(f32x16& p, float& l) {
#pragma unroll
    for (int r = 0; r < 16; ++r) { p[r] = __builtin_amdgcn_exp2f(p[r]); l += p[r]; }
}
DEVI void att_pack(const f32x16& p0, const f32x16& p1, bf16x8& pa0, bf16x8& pa1, bf16x8& pa2, bf16x8& pa3) {
#define PK4(P, BASE, OUT) do { u32x4 w = {cvtpk(P[BASE + 0], P[BASE + 1]), cvtpk(P[BASE + 2], P[BASE + 3]), cvtpk(P[BASE + 4], P[BASE + 5]), cvtpk(P[BASE + 6], P[BASE + 7])}; \
    OUT = *reinterpret_cast<bf16x8*>(&w); } while (0)
    PK4(p0, 0, pa0); PK4(p0, 8, pa1); PK4(p1, 0, pa2); PK4(p1, 8, pa3);
#undef PK4
}
template <bool SHIFT> DEVI void att_qkt(f32x16& p0, f32x16& p1, const char* Ks, const bf16x8* qr, int r32, int hi, float init) {
    if constexpr (SHIFT) {
#pragma unroll
        for (int r = 0; r < 16; ++r) { p0[r] = init; p1[r] = init; }
    } else { p0 = f32x16{}; p1 = f32x16{}; }
    bf16x8 b0 = *reinterpret_cast<const bf16x8*>(Ks + KSWZ(r32, hi * 16));
    bf16x8 b1 = *reinterpret_cast<const bf16x8*>(Ks + KSWZ(32 + r32, hi * 16));
#pragma unroll
    for (int d0 = 0; d0 < 6; ++d0) {
        bf16x8 n0 = b0, n1 = b1;
        if (d0 < 5) { const int cb = ((d0 + 1) * 16 + hi * 8) * 2;
            n0 = *reinterpret_cast<const bf16x8*>(Ks + KSWZ(r32, cb)); n1 = *reinterpret_cast<const bf16x8*>(Ks + KSWZ(32 + r32, cb)); }
        p0 = __builtin_amdgcn_mfma_f32_32x32x16_bf16(b0, qr[d0], p0, 0, 0, 0);
        p1 = __builtin_amdgcn_mfma_f32_32x32x16_bf16(b1, qr[d0], p1, 0, 0, 0);
        b0 = n0; b1 = n1; }
}
constexpr int att_v_off(int d0, int ks, int half) { return d0 * 512 + ks * 2048 + half * 1024; }
struct VFrag { s16x4 l0, h0, l1, h1, l2, h2, l3, h3; };
template <int D0> DEVI void att_vread(VFrag& f, int vb) {
    f.l0 = tr_read<att_v_off(D0, 0, 0)>(vb); f.h0 = tr_read<att_v_off(D0, 0, 1)>(vb); f.l1 = tr_read<att_v_off(D0, 1, 0)>(vb); f.h1 = tr_read<att_v_off(D0, 1, 1)>(vb);
    f.l2 = tr_read<att_v_off(D0, 2, 0)>(vb); f.h2 = tr_read<att_v_off(D0, 2, 1)>(vb); f.l3 = tr_read<att_v_off(D0, 3, 0)>(vb); f.h3 = tr_read<att_v_off(D0, 3, 1)>(vb);
}
DEVI void att_pv_mm(f32x16& od, const VFrag& f, bf16x8 pa0, bf16x8 pa1, bf16x8 pa2, bf16x8 pa3) {
    od = __builtin_amdgcn_mfma_f32_32x32x16_bf16(pa0, PK8(f.l0, f.h0), od, 0, 0, 0);
    od = __builtin_amdgcn_mfma_f32_32x32x16_bf16(pa1, PK8(f.l1, f.h1), od, 0, 0, 0);
    od = __builtin_amdgcn_mfma_f32_32x32x16_bf16(pa2, PK8(f.l2, f.h2), od, 0, 0, 0);
    od = __builtin_amdgcn_mfma_f32_32x32x16_bf16(pa3, PK8(f.l3, f.h3), od, 0, 0, 0);
}
DEVI void att_lsum(f32x16& l, bf16x8 pa, bf16x8 pb) {
    const bf16x8 ones = {(short)0x3F80, (short)0x3F80, (short)0x3F80, (short)0x3F80, (short)0x3F80, (short)0x3F80, (short)0x3F80, (short)0x3F80};
    l = __builtin_amdgcn_mfma_f32_32x32x16_bf16(pa, ones, l, 0, 0, 0);
    l = __builtin_amdgcn_mfma_f32_32x32x16_bf16(pb, ones, l, 0, 0, 0);
}

template <bool SHIFT> DEVI void attn_body(const short* __restrict__ Qb, const short* __restrict__ Kh, const short* __restrict__ Vh, short* __restrict__ Ob, int seq, float shift, char* lds) {
    int tid = threadIdx.x; asm volatile("" : "+v"(tid)); const int wid = __builtin_amdgcn_readfirstlane(tid >> 6), lane = tid & 63, r32 = lane & 31, hi = lane >> 5;
    char* V_lds = lds + AT_V; char* K_lds = lds + AT_K;
    if (wid >= 4) __builtin_amdgcn_s_setprio(1);
    f32x16 o[2] = {f32x16{}, f32x16{}}; float l_reg = 0.f; bf16x8 qr[6];
    const short* Qw = Qb + (size_t)(wid * 32 + r32) * DQK + hi * 8;
#pragma unroll
    for (int d0 = 0; d0 < 6; ++d0) qr[d0] = *(const bf16x8*)(Qw + d0 * 16);
    const int kc0 = tid, kc1 = (tid + 512 < 768) ? tid + 512 : 767;
    const int kst0 = KSWZ(kc0 / 12, (kc0 % 12) * 16), kst1 = KSWZ(kc1 / 12, (kc1 % 12) * 16);
    const int vkey = tid >> 3, vcol = (tid & 7) * 8;
    const int vkk = vkey;
    const int vst = ((vkk >> 3) * 2 + (vcol >> 5)) * 512 + ((vkk & 7) * 32 + (vcol & 31)) * 2;
    const int vb0 = (int)(uintptr_t)V_lds + nn_rd_base(lane);
    struct { bf16x8 vs, k0, k1; } sr_;
    const int NT = seq / 64; const float init = -shift;
#define SLOAD(t) do { const int tt_ = (t) < NT ? (t) : NT - 1; sr_.vs = *(const bf16x8*)(Vh + (size_t)tt_ * 64 * DV + tid * 8); \
    sr_.k0 = *(const bf16x8*)(Kh + (size_t)tt_ * 64 * DQK + kc0 * 8); sr_.k1 = *(const bf16x8*)(Kh + (size_t)tt_ * 64 * DQK + kc1 * 8); } while (0)
#define SWRITE(b) do { *(bf16x8*)(V_lds + (b) * AT_VB + vst) = sr_.vs; *(bf16x8*)(K_lds + (b) * AT_KB + kst0) = sr_.k0; *(bf16x8*)(K_lds + (b) * AT_KB + kst1) = sr_.k1; } while (0)
    f32x16 pA0, pA1, pB0, pB1; bf16x8 pa0, pa1, pa2, pa3; VFrag vf, vf1;
#define STEP(PC0, PC1, PP0, PP1, TNEXT2, DOWRITE) do {                                                            \
        int bn = bc + 1; if (bn == 3) bn = 0;                                                                      \
        if (DOWRITE) SWRITE(bn);                                                                                   \
        SBAR(); SLOAD(TNEXT2);                                                                                     \
        SBAR(); att_vread<0>(vf, vb0 + bp * AT_VB); att_vread<1>(vf1, vb0 + bp * AT_VB);                           \
        att_qkt<SHIFT>(PC0, PC1, K_lds + bc * AT_KB, qr, r32, hi, init);                                           \
        att_exp16(PP1, l_reg); att_pack(PP0, PP1, pa0, pa1, pa2, pa3); SBAR();                                     \
        asm volatile("s_waitcnt lgkmcnt(0)" ::: "memory"); SBAR();                                                 \
        att_pv_mm(o[0], vf, pa0, pa1, pa2, pa3); att_pv_mm(o[1], vf1, pa0, pa1, pa2, pa3);                         \
        att_exp16(PC0, l_reg);                                                                                     \
        __syncthreads();                                                                                           \
        bp = bc; bc = bn; } while (0)
    SLOAD(0); asm volatile("s_waitcnt vmcnt(0)" ::: "memory"); SWRITE(0); SBAR(); SLOAD(1); __syncthreads();
    SWRITE(1); SBAR(); SLOAD(2); SBAR();
    att_qkt<SHIFT>(pA0, pA1, K_lds, qr, r32, hi, init); att_exp16(pA0, l_reg);
    __syncthreads();
    int bc = 1, bp = 0;
    for (int j = 1; j + 1 < NT; j += 2) {
        STEP(pB0, pB1, pA0, pA1, j + 2, true);
        STEP(pA0, pA1, pB0, pB1, j + 3, (j + 2 < NT));
    }
    STEP(pB0, pB1, pA0, pA1, NT - 1, false);
    att_vread<0>(vf, vb0 + bp * AT_VB);
    att_exp16(pB1, l_reg); att_pack(pB0, pB1, pa0, pa1, pa2, pa3); SBAR();
    asm volatile("s_waitcnt lgkmcnt(0)" ::: "memory"); SBAR();
    att_pv_mm(o[0], vf, pa0, pa1, pa2, pa3); att_vread<1>(vf, vb0 + bp * AT_VB); SBAR();
    asm volatile("s_waitcnt lgkmcnt(0)" ::: "memory"); SBAR();
    att_pv_mm(o[1], vf, pa0, pa1, pa2, pa3);
    __builtin_amdgcn_s_setprio(0);
    short* Ow = Ob + (size_t)(wid * 32) * 1024;
    { auto rr = __builtin_amdgcn_permlane32_swap(__float_as_uint(l_reg), __float_as_uint(l_reg), false, false); l_reg = __uint_as_float(rr[0]) + __uint_as_float(rr[1]); }
    float* li_l = (float*)(lds + AT_WS) + wid * 32;
    __syncthreads();
    if (hi == 0) li_l[r32] = l_reg; asm volatile("s_waitcnt lgkmcnt(0)" ::: "memory");
#pragma unroll
    for (int r = 0; r < 16; ++r) { const int orow = crow(r, hi); const float rl = __builtin_amdgcn_rcpf(li_l[orow]);
#pragma unroll
        for (int d0 = 0; d0 < 2; ++d0) Ow[(size_t)orow * 1024 + d0 * 32 + r32] = (short)f2bf(o[d0][r] * rl); }
    __syncthreads();
#undef SLOAD
#undef SWRITE
#undef STEP
}

DEVI void phase_attn_fft1(const Params& P, const Ctx& c, int l) {
    TID_SETUP();
    short* mix = (short*)(c.ws + WS_HBUF);
    const short* qb = (const short*)(c.ws + WS_QBUF); const short* qc = (const short*)(c.ws + WS_QCTX);
    const short* kb = (const short*)(c.ws + WS_KBUF); const short* vb = (const short*)(c.ws + WS_VBUF);
    const int n_att = (l < DEPTH - 1) ? 1040 : 1024;
    float shift;
    { float mq = 0.f, mk = 0.f;
      for (int i = lane; i < DQK; i += 64) { mq = fmaxf(mq, fabsf(P.in[13][l * DQK + i])); mk = fmaxf(mk, fabsf(P.in[14][l * DQK + i])); }
#pragma unroll
      for (int o = 32; o > 0; o >>= 1) { mq = fmaxf(mq, __shfl_xor(mq, o, 64)); mk = fmaxf(mk, __shfl_xor(mk, o, 64)); }
      shift = 9.797958971132712f * 1.4426950408889634f * mq * mk * 1.0001f; }
    for (int u = c.vcu; u < n_att; u += c.G) {
        const short* Qp; short* Op; int bh, seq;
        if (u < 1024) {
            const int rnd = u >> 8, v = u & 255, xcd = v >> 5, j = v & 31; bh = xcd * 2 + (rnd >> 1); const int qblk = j + 32 * (rnd & 1);
            Qp = qb + ((size_t)bh * SEQ + qblk * 256) * DQK; Op = mix + (size_t)(T_CTX + (bh >> 3) * SEQ + qblk * 256) * 1024 + (bh & 7) * DV; seq = NKEY;
        } else {
            bh = u - 1024; Qp = qc + (size_t)bh * NCTX * DQK; Op = mix + (size_t)((bh >> 3) * NCTX) * 1024 + (bh & 7) * DV; seq = NCTX;
        }
        if (shift < 64.f) attn_body<false>(Qp, kb + (size_t)bh * NKEY * DQK, vb + (size_t)bh * NKEY * DV, Op, seq, shift, c.lds + LDS_GEMM);
        else attn_body<true>(Qp, kb + (size_t)bh * NKEY * DQK, vb + (size_t)bh * NKEY * DV, Op, seq, shift, c.lds + LDS_GEMM);
    }
#ifndef ATT_ONLY
    const short* zbuf = (const short*)((char*)c.out); const short* F1 = (const short*)(c.ws + WS_F1); short* P1 = (short*)(c.ws + WS_P1);
    const float2* tw = (const float2*)(c.ws + WS_TW);
    for (int u = c.vcu; u < 1024; u += c.G) {
        const int n2 = u & 127, g = (u >> 7) & 3, b = u >> 9;
        const short* Zb = zbuf + (size_t)(T_CTX + b * SEQ + n2) * ZLD + 416 + g * 128;
        const short* W = (const short*)(c.ws + WS_WCS) + ((size_t)(l * 4 + g) * 128) * 256;
        short* Pb = P1 + ((size_t)(b * 4 + g) * 128 * 128 + n2) * 256;
        LAS char* Sres = (LAS char*)(c.lds + LDS_GEMM) + 65536;
        gemm_tile<1, 4, 4, 2, true, true, 1>(c.lds + LDS_GEMM, 2,
            [&](int r) { return Zb + (size_t)r * (128 * ZLD); },
            [&](int k) { return W + (size_t)k * 256; },
            [&](f32x16 (&acc)[1][4], int wm, int wn) {
                for_acc_bf8<1, 4>(acc, wm, wn, lane, [&](int n1, int cc, u32x4 v) { const int kk = 2 * n1 + (cc >> 7), cp = cc & 127;
                    *(LAS u32x4*)(Sres + (kk >> 6) * 16384 + nn_st<128>(kk & 63, cp)) = v; });
            });
        gemm_tile<2, 2, 4, 2, true, true, 2, true>(c.lds + LDS_GEMM, 4,
            [&](int r) { return F1 + (size_t)r * 256; },
            [&](int kk) { return (const short*)nullptr; },
            [&](f32x16 (&acc)[2][2], int wm, int wn) {
                const int hi = lane >> 5, r32 = lane & 31; const int k1 = wm * 32 + r32;
                const float2 t = tw[(n2 * k1) & 16383];
                short* p = Pb + (size_t)k1 * (128 * 256);
#pragma unroll
                for (int nb = 0; nb < 2; ++nb)
#pragma unroll
                    for (int s = 0; s < 2; ++s) { float yr[8], yi[8];
#pragma unroll
                        for (int j = 0; j < 8; ++j) { const float a = acc[0][nb][8 * s + j], bb = acc[1][nb][8 * s + j]; yr[j] = a * t.x + bb * t.y; yi[j] = bb * t.x - a * t.y; }
                        const int cc = (wn * 2 + nb) * 32 + 16 * s + 8 * hi;
                        *(u32x4*)(p + cc) = pack8(yr); *(u32x4*)(p + 128 + cc) = pack8(yi); }
            });
    }
    if (l < DEPTH - 1) {
        const short* FC = (const short*)(c.ws + WS_FC);
        for (int u = c.vcu; u < 8; u += c.G) {
            const int g = u & 3, b = u >> 2;
            const short* Ub = (const short*)(c.ws + WS_UCTX) + (size_t)(b * NCTX) * 1024 + g * 256;
            gemm_tile<2, 2, 4, 2, true, true>(c.lds + LDS_GEMM, 8,
                [&](int r) { return FC + (size_t)r * 512; },
                [&](int kk) { return Ub + (size_t)(kk >> 1) * 1024 + (kk & 1) * 128; },
                [&](f32x16 (&acc)[2][2], int wm, int wn) {
                    for_acc_bf8<2, 2>(acc, wm, wn, lane, [&](int r, int cc, u32x4 v) { *(u32x4*)(mix + (size_t)(b * NCTX + r) * 1024 + 512 + g * 128 + cc) = v; });
                });
        }
    }
#endif
}

DEVI void phase_fft2(const Params& P, const Ctx& c, int l) {
    TID_SETUP();
    short* mix = (short*)(c.ws + WS_HBUF); const short* P1 = (const short*)(c.ws + WS_P1); const short* F2 = (const short*)(c.ws + WS_F2);
    for (int u = c.vcu; u < 1024; u += c.G) {
        const int k1 = u & 127, g = (u >> 7) & 3, b = u >> 9;
        const short* Pb = P1 + ((size_t)(b * 4 + g) * 128 + k1) * (128 * 256);
        gemm_tile<1, 2, 4, 2, true, true>(c.lds + LDS_GEMM, 4,
            [&](int r) { return F2 + (size_t)r * 256; },
            [&](int kk) { return Pb + (size_t)kk * 128; },
            [&](f32x16 (&acc)[1][2], int wm, int wn) {
                for_acc_bf8<1, 2>(acc, wm, wn, lane, [&](int k2, int cc, u32x4 v) { *(u32x4*)(mix + (size_t)(T_CTX + b * SEQ + k1 + 128 * k2) * 1024 + 512 + g * 128 + cc) = v; });
            });
    }
}

DEVI void phase_outproj(const Params& P, const Ctx& c, int l) {
    TID_SETUP();
    const short* mix = (const short*)(c.ws + WS_HBUF); const short* WT = (const short*)(c.ws + WS_WOUT) + (size_t)l * 1024 * 1024;
    const float* coef = (const float*)(c.ws + WS_COEF) + (size_t)l * 3 * 6 * 1024;
    if (l < DEPTH - 1) for (int u = c.vcu; u < 64; u += c.G) {
        const int rt = u >> 3, ct = u & 7; const int row0 = rt * 64, col0 = ct * 128;
        const float* g1 = coef + (size_t)(2 * 6 + 2) * 1024;
        gemm_tile<1, 1, 2, 4, false, true>(c.lds + LDS_GEMM, 16,
            [&](int r) { return mix + (size_t)(row0 + r) * 1024; },
            [&](int n) { return WT + (size_t)(col0 + n) * 1024; },
            [&](f32x16 (&acc)[1][1], int wm, int wn) {
                for_acc_f4<1, 1>(acc, wm, wn, lane, [&](int r, int cc, f32x4 v) { const int row = row0 + r, col = col0 + cc;
                    const f32x4 x = res_load4(P, c, row, col, l), g = *(const f32x4*)(g1 + col);
                    st_bf4(res_row(c, row) + col, f32x4{x[0] + g[0] * v[0], x[1] + g[1] * v[1], x[2] + g[2] * v[2], x[3] + g[3] * v[3]}); });
            });
    }
    for (int u = c.vcu; u < 512; u += c.G) {
        const int rt = 2 + (u >> 2), ct = u & 3; const int row0 = rt * 256, col0 = ct * 256;
        const float* g1 = coef + (size_t)(row_variant(row0) * 6 + 2) * 1024;
        __syncthreads();
        gemm256<false, 1>(c.lds + LDS_GEMM, 16, mix + (size_t)row0 * 1024, 1024, nullptr, WT + (size_t)col0 * 1024, 1024, 0, nullptr,
            [&](g8_acc& acc, int wr, int wc, int fr, int fq) {
                g8_for_acc8(acc, wr, wc, fr, fq, [&](int r, int cc, const float (&v)[8]) { const int row = row0 + r, col = col0 + cc;
                    float x[8]; res_load8(P, c, row, col, l, x); const f32x4 g0 = *(const f32x4*)(g1 + col), g4 = *(const f32x4*)(g1 + col + 4);
#pragma unroll
                    for (int j = 0; j < 4; ++j) { x[j] += g0[j] * v[j]; x[4 + j] += g4[j] * v[4 + j]; }
                    *(u32x4*)(res_row(c, row) + col) = u32x4{cvtpk(x[0], x[1]), cvtpk(x[2], x[3]), cvtpk(x[4], x[5]), cvtpk(x[6], x[7])}; });
            });
    }
}

DEVI void phase_norm_route(const Params& P, const Ctx& c, int l) {
    TID_SETUP();
    const float* coef = (const float*)(c.ws + WS_COEF) + (size_t)l * 3 * 6 * 1024;
    short* hbuf = (short*)(c.ws + WS_HBUF);
    constexpr int XP = 2064;
    char* xs_hi = c.lds + LDS_GEMM; char* xs_lo = xs_hi + 16 * XP;
    int* lcnt = (int*)(c.lds + LDS_GEMM + 66560);
    int* lrow = lcnt + 64;
    float* lgt = (float*)(c.lds + LDS_GEMM + 73728);
    float* part = (float*)(c.lds + LDS_GEMM + 90112);
    const int rows_per = (T + c.G - 1) / c.G; const int r_begin = c.vcu * rows_per; const int r_lim = (l == DEPTH - 1) ? T_CTX : 0;
    int r_end = r_begin + rows_per; if (r_end > T) r_end = T;
    __syncthreads();
    if (tid < 64) lcnt[tid] = 0;
    int* rcls = (int*)(c.ws + WS_RCLS); float2* rw = (float2*)(c.ws + WS_RW);
    const int e16 = lane & 15, kq = lane >> 4;
    bf16x8 wh[4], wl[4];
#pragma unroll
    for (int s = 0; s < 4; ++s) { float v[8];
#pragma unroll
        for (int j = 0; j < 8; ++j) v[j] = P.in[17][(size_t)(128 * wid + 32 * s + 8 * kq + j) * 16 + e16];
        u32x4 h = {cvtpk(v[0], v[1]), cvtpk(v[2], v[3]), cvtpk(v[4], v[5]), cvtpk(v[6], v[7])};
        u32x4 lo = {cvtpk(v[0] - bflo(h[0]), v[1] - bfhi(h[0])), cvtpk(v[2] - bflo(h[1]), v[3] - bfhi(h[1])), cvtpk(v[4] - bflo(h[2]), v[5] - bfhi(h[2])), cvtpk(v[6] - bflo(h[3]), v[7] - bfhi(h[3]))};
        wh[s] = *reinterpret_cast<bf16x8*>(&h); wl[s] = *reinterpret_cast<bf16x8*>(&lo); }
    const int nrows = r_end - r_begin; const int nch = (nrows + 15) >> 4;
    u32x4 xn[2][2];
#pragma unroll
    for (int h = 0; h < 2; ++h) { int i = 8 * h + wid; if (i > nrows - 1) i = nrows - 1; const short* x = res_row(c, r_begin + i);
#pragma unroll
        for (int q = 0; q < 2; ++q) xn[h][q] = *(const u32x4*)(x + q * 512 + lane * 8); }
    for (int ch = 0; ch < nch; ++ch) {
#pragma unroll
        for (int h = 0; h < 2; ++h) {
            const int i = 16 * ch + 8 * h + wid; const bool valid = i < nrows; const int r = r_begin + (valid ? i : nrows - 1); const int v = row_variant(r);
            const float* a2 = coef + (size_t)(v * 6 + 3) * 1024; const float* b2 = coef + (size_t)(v * 6 + 4) * 1024;
            float xv[2][8]; float ss = 0;
#pragma unroll
            for (int q = 0; q < 2; ++q)
#pragma unroll
                for (int j = 0; j < 4; ++j) { xv[q][2 * j] = bflo(xn[h][q][j]); xv[q][2 * j + 1] = bfhi(xn[h][q][j]); ss += xv[q][2 * j] * xv[q][2 * j] + xv[q][2 * j + 1] * xv[q][2 * j + 1]; }
            if (ch + 1 < nch) { int i2 = i + 16; if (i2 > nrows - 1) i2 = nrows - 1; const short* x = res_row(c, r_begin + i2);
#pragma unroll
                for (int q = 0; q < 2; ++q) xn[h][q] = *(const u32x4*)(x + q * 512 + lane * 8); }
            ss = wave_sum(ss); const float rstd = rsqrtf(ss * (1.f / 1024.f) + EPS);
#pragma unroll
            for (int q = 0; q < 2; ++q) { const int col = q * 512 + lane * 8; const f32x4 a0 = *(const f32x4*)(a2 + col), a4 = *(const f32x4*)(a2 + col + 4), b0 = *(const f32x4*)(b2 + col), b4 = *(const f32x4*)(b2 + col + 4);
                float y[8];
#pragma unroll
                for (int j = 0; j < 4; ++j) { y[j] = xv[q][j] * rstd * a0[j] + b0[j]; y[4 + j] = xv[q][4 + j] * rstd * a4[j] + b4[j]; }
                const u32x4 o = {cvtpk(y[0], y[1]), cvtpk(y[2], y[3]), cvtpk(y[4], y[5]), cvtpk(y[6], y[7])};
                if (valid) *(u32x4*)(hbuf + (size_t)r * 1024 + col) = o;
                const u32x4 ol = {cvtpk(y[0] - bflo(o[0]), y[1] - bfhi(o[0])), cvtpk(y[2] - bflo(o[1]), y[3] - bfhi(o[1])), cvtpk(y[4] - bflo(o[2]), y[5] - bfhi(o[2])), cvtpk(y[6] - bflo(o[3]), y[7] - bfhi(o[3]))};
                *(LAS u32x4*)((LAS char*)xs_hi + (8 * h + wid) * XP + col * 2) = o; *(LAS u32x4*)((LAS char*)xs_lo + (8 * h + wid) * XP + col * 2) = ol; }
        }
        __syncthreads();
        if (ch > 0 && tid < 256) { const float* pp = part + ((ch - 1) & 1) * 2048 + tid; float sum = pp[0];
#pragma unroll
            for (int w = 1; w < 8; ++w) sum += pp[w * 256];
            lgt[(16 * (ch - 1)) * 16 + tid] = sum; }
        f32x4 acc = {0, 0, 0, 0};
#pragma unroll
        for (int s = 0; s < 4; ++s) { const int off = e16 * XP + (128 * wid + 32 * s + 8 * kq) * 2;
            const bf16x8 ah = *(LAS const bf16x8*)((LAS char*)xs_hi + off), al = *(LAS const bf16x8*)((LAS char*)xs_lo + off);
            acc = __builtin_amdgcn_mfma_f32_16x16x32_bf16(ah, wh[s], acc, 0, 0, 0);
            acc = __builtin_amdgcn_mfma_f32_16x16x32_bf16(ah, wl[s], acc, 0, 0, 0);
            acc = __builtin_amdgcn_mfma_f32_16x16x32_bf16(al, wh[s], acc, 0, 0, 0); }
        { float* pw = part + (ch & 1) * 2048 + wid * 256;
#pragma unroll
          for (int j = 0; j < 4; ++j) pw[(4 * kq + j) * 16 + e16] = acc[j]; }
        __syncthreads();
    }
    if (tid < 256) { const float* pp = part + ((nch - 1) & 1) * 2048 + tid; float sum = pp[0];
#pragma unroll
        for (int w = 1; w < 8; ++w) sum += pp[w * 256];
        lgt[(16 * (nch - 1)) * 16 + tid] = sum; }
    __syncthreads();
    for (int i = tid; i < r_end - r_begin; i += NTHR) {
        const int r = r_begin + i; if (r < r_lim) continue;
        float lg[16];
        { const f32x4 t0 = *(const f32x4*)(lgt + i * 16), t1 = *(const f32x4*)(lgt + i * 16 + 4), t2 = *(const f32x4*)(lgt + i * 16 + 8), t3 = *(const f32x4*)(lgt + i * 16 + 12);
#pragma unroll
          for (int j = 0; j < 4; ++j) { lg[j] = t0[j]; lg[4 + j] = t1[j]; lg[8 + j] = t2[j]; lg[12 + j] = t3[j]; } }
        float sc[16], bi[16];
#pragma unroll
        for (int e = 0; e < 16; ++e) { sc[e] = __builtin_amdgcn_rcpf(1.f + __expf(-lg[e])); bi[e] = sc[e] + P.in[18][e]; }
        int bg = 0; float bgs = -1e30f;
#pragma unroll
        for (int g = 0; g < 4; ++g) { float m1 = -1e30f, m2 = -1e30f;
#pragma unroll
            for (int j = 0; j < 4; ++j) { const float t = bi[g * 4 + j]; if (t > m1) { m2 = m1; m1 = t; } else if (t > m2) m2 = t; }
            const float gs = m1 + m2; if (gs > bgs) { bgs = gs; bg = g; } }
        float b4[4], s4[4];
#pragma unroll
        for (int j = 0; j < 4; ++j) { b4[j] = bg == 0 ? bi[j] : bg == 1 ? bi[4 + j] : bg == 2 ? bi[8 + j] : bi[12 + j]; s4[j] = bg == 0 ? sc[j] : bg == 1 ? sc[4 + j] : bg == 2 ? sc[8 + j] : sc[12 + j]; }
        int i1 = 0;
#pragma unroll
        for (int j = 1; j < 4; ++j) if (b4[j] > b4[i1]) i1 = j;
        int i2 = (i1 == 0) ? 1 : 0;
#pragma unroll
        for (int j = 0; j < 4; ++j) if (j != i1 && b4[j] > b4[i2]) i2 = j;
        const int ea = i1 < i2 ? i1 : i2, eb = i1 < i2 ? i2 : i1;
        float wa = 0, wb = 0;
#pragma unroll
        for (int j = 0; j < 4; ++j) { if (j == ea) wa = s4[j]; if (j == eb) wb = s4[j]; }
        const float inv = 1.f / (wa + wb);
        const int pidx = ea == 0 ? eb - 1 : ea == 1 ? eb + 1 : 5;
        const int cls = bg * 6 + pidx;
        const int lp = atomicAdd(&lcnt[cls], 1); lrow[i] = cls | (lp << 8); rcls[r] = cls; rw[r] = make_float2(wa * inv, wb * inv);
    }
    __syncthreads();
    int* gcnt = (int*)(c.ws + WS_CTL + CTL_CNT_OFF) + l * 32;
    if (tid < NCLS) lcnt[32 + tid] = lcnt[tid] > 0 ? (int)__hip_atomic_fetch_add(&gcnt[tid], lcnt[tid], __ATOMIC_RELAXED, __HIP_MEMORY_SCOPE_AGENT) : 0;
    __syncthreads();
    int* clist = (int*)(c.ws + WS_CLIST);
    for (int i = tid; i < r_end - r_begin; i += NTHR) { const int r = r_begin + i; if (r < r_lim) continue; const int w = lrow[i]; const int cls = w & 255, lp = w >> 8; clist[(size_t)cls * T + lcnt[32 + cls] + lp] = r; }
}

DEVI bool moe_decode(const int* gcnt, int u, int per_rt, int& cls, int& rt, int& sub, int& hpad, int& ccnt) {
    int acc_t = 0, acc_h = 0;
    for (int cc = 0; cc < NCLS; ++cc) { const int n = __builtin_amdgcn_readfirstlane(gcnt[cc]);
        const int nrt = (n + 255) >> 8; const int nt = nrt * per_rt;
        if (u < acc_t + nt) { cls = cc; const int loc = u - acc_t; rt = loc / per_rt; sub = loc % per_rt; hpad = acc_h; ccnt = n; return true; }
        acc_t += nt; acc_h += nrt * 256; }
    return false;
}
DEVI void cls_experts(int cls, int& ea, int& eb) { const int g = cls / 6, p = cls % 6; const int a = p < 3 ? 0 : p < 5 ? 1 : 2; const int b = p < 3 ? p + 1 : p < 5 ? p - 1 : 3; ea = g * 4 + a; eb = g * 4 + b; }

DEVI int moe_total(const int* gcnt, int per_rt) { int t = 0; for (int cc = 0; cc < NCLS; ++cc) { const int n = __builtin_amdgcn_readfirstlane(gcnt[cc]); t += ((n + 255) >> 8) * per_rt; } return t; }
DEVI int moe_nfull(int utot, int G) { const int nf = (utot / G) * G; return ((utot - nf) * 4 > 2 * G) ? utot : nf; }

DEVI void phase_moe_up(const Params& P, const Ctx& c, int l) {
    TID_SETUP();
    const int* gcnt = (const int*)(c.ws + WS_CTL + CTL_CNT_OFF) + l * 32;
    const short* hbuf = (const short*)(c.ws + WS_HBUF); short* Hm = (short*)(c.ws + WS_KBUF);
    const int* clist = (const int*)(c.ws + WS_CLIST); const float2* rw = (const float2*)(c.ws + WS_RW);
    int* ltok = (int*)(c.lds + LDS_STAT); float* lw = (float*)(c.lds + LDS_STAT + 1024);
    const int utot = moe_total(gcnt, 4), nfull = moe_nfull(utot, c.G);
    for (int it = c.vcu; it < nfull + (utot - nfull) * 4; it += c.G) {
        const bool fast = it < nfull; const int u = fast ? it : nfull + ((it - nfull) >> 2); const int q = (it - nfull) & 3;
        int cls, rt, ct, hpad, ccnt; if (!moe_decode(gcnt, u, 4, cls, rt, ct, hpad, ccnt)) break;
        int ea, eb; cls_experts(cls, ea, eb); const int e = ct < 2 ? ea : eb;
        __syncthreads();
        { int t2 = threadIdx.x; asm volatile("" : "+v"(t2));
          if (t2 < 256) { int i = rt * 256 + t2; if (i > ccnt - 1) i = ccnt - 1; const int tok = clist[(size_t)cls * T + i]; ltok[t2] = tok; const float2 w = rw[tok]; lw[t2] = ct < 2 ? w.x : w.y; } }
        asm volatile("s_waitcnt vmcnt(0)" ::: "memory");
        __syncthreads();
        const short* WT = (const short*)(c.ws + WS_WGU) + ((size_t)(l * 16 + e) * 512 + (ct & 1) * 256) * 1024;
        short* Hrow = Hm + (size_t)(hpad + rt * 256) * 512 + (ct >> 1) * 256;
        if (fast) {
            gemm256<true, 1>(c.lds + LDS_GEMM, 16, hbuf, 1024, ltok, WT, 1024, 0, nullptr,
                [&](g8_acc& acc, int wr, int wc, int fr, int fq) {
#pragma unroll
                    for (int ai = 0; ai < 2; ++ai)
#pragma unroll
                        for (int m = 0; m < 4; ++m) { const int row = ai * 128 + wr * 64 + m * 16 + fr; const float w = lw[row];
#pragma unroll
                            for (int bj = 0; bj < 2; ++bj) { const f32x4 g = acc[ai][bj][m][0], uu = acc[ai][bj][m][1]; float hv[4];
#pragma unroll
                                for (int j = 0; j < 4; ++j) hv[j] = silu(g[j]) * uu[j] * w;
                                *(u32x2*)(Hrow + (size_t)row * 512 + ((ct & 1) * 8 + bj * 4 + wc) * 16 + fq * 4) = u32x2{cvtpk(hv[0], hv[1]), cvtpk(hv[2], hv[3])}; } }
                });
        } else {
            gemm_tile<1, 2, 8, 1, false, true>(c.lds + LDS_GEMM, 16,
                [&](int r) { return hbuf + (size_t)ltok[r] * 1024; },
                [&](int n) { return WT + (size_t)(q * 64 + n) * 1024; },
                [&](f32x16 (&acc)[1][2], int wm, int wn) {
                    const int hi = lane >> 5, r32 = lane & 31; const int row = wm * 32 + r32; const float w = lw[row];
#pragma unroll
                    for (int nb = 0; nb < 2; ++nb)
#pragma unroll
                        for (int s = 0; s < 2; ++s) { float hv[4];
#pragma unroll
                            for (int j = 0; j < 4; ++j) hv[j] = silu(acc[0][nb][4 * s + j]) * acc[0][nb][8 + 4 * s + j] * w;
                            *(u32x2*)(Hrow + (size_t)row * 512 + ((ct & 1) * 8 + q * 2 + nb) * 16 + 8 * s + 4 * hi) = u32x2{cvtpk(hv[0], hv[1]), cvtpk(hv[2], hv[3])}; }
                });
        }
    }
}
DEVI void phase_moe_down(const Params& P, const Ctx& c, int l) {
    TID_SETUP();
    const int* gcnt = (const int*)(c.ws + WS_CTL + CTL_CNT_OFF) + l * 32;
    const short* Hm = (const short*)(c.ws + WS_KBUF);
    const int* clist = (const int*)(c.ws + WS_CLIST);
    const float* coef = (const float*)(c.ws + WS_COEF) + (size_t)l * 3 * 6 * 1024;
    unsigned long long* lrp = (unsigned long long*)(c.lds + LDS_STAT);
    const int utot = moe_total(gcnt, 4), nfull = moe_nfull(utot, c.G);
    for (int it = c.vcu; it < nfull + (utot - nfull) * 4; it += c.G) {
        const bool fast = it < nfull; const int u = fast ? it : nfull + ((it - nfull) >> 2); const int q = (it - nfull) & 3;
        int cls, rt, ct, hpad, ccnt; if (!moe_decode(gcnt, u, 4, cls, rt, ct, hpad, ccnt)) break;
        __syncthreads();
        { int t2 = threadIdx.x; asm volatile("" : "+v"(t2));
          if (t2 < 256) { int i = rt * 256 + t2; if (i > ccnt - 1) i = ccnt - 1; const int tok = clist[(size_t)cls * T + i]; lrp[t2] = (unsigned long long)(uintptr_t)res_row(c, tok) | (unsigned long long)row_variant(tok); } }
        asm volatile("s_waitcnt vmcnt(0)" ::: "memory");
        __syncthreads();
        const short* WT = (const short*)(c.ws + WS_WDN) + ((size_t)(l * NCLS + cls) * 1024 + ct * 256) * 512;
        const short* Ab = Hm + (size_t)(hpad + rt * 256) * 512;
        auto rmw = [&](int rl, int col, f32x4 v) { const int i = rt * 256 + rl;
            if (i < ccnt) { const unsigned long long pv = lrp[rl]; short* xr = (short*)(uintptr_t)(pv & ~3ull) + col; const f32x4 g = *(const f32x4*)(coef + (size_t)((int)(pv & 3ull) * 6 + 5) * 1024 + col);
                const f32x4 x = ld_bf4(xr); const f32x4 y = f32x4{x[0] + g[0] * v[0], x[1] + g[1] * v[1], x[2] + g[2] * v[2], x[3] + g[3] * v[3]};
                if (l < DEPTH - 1) st_bf4(xr, y);
                else *(f32x4*)((char*)c.out + (((size_t)(uintptr_t)xr - (size_t)(uintptr_t)(c.ws + WS_RES)) - (size_t)T_CTX * D * 2) * 2) = y; } };
        if (fast) {
            gemm256<false, 1>(c.lds + LDS_GEMM, 8, Ab, 512, nullptr, WT, 512, 0, nullptr,
                [&](g8_acc& acc, int wr, int wc, int fr, int fq) { g8_for_acc8(acc, wr, wc, fr, fq, [&](int rl, int cc, const float (&v)[8]) { const int col = ct * 256 + cc; const int i = rt * 256 + rl;
                    if (i < ccnt) { const unsigned long long pv = lrp[rl]; short* xr = (short*)(uintptr_t)(pv & ~3ull) + col; const float* gp = coef + (size_t)((int)(pv & 3ull) * 6 + 5) * 1024 + col;
                        const f32x4 g0 = *(const f32x4*)gp, g4 = *(const f32x4*)(gp + 4); const u32x4 w = *(const u32x4*)xr; float y[8];
#pragma unroll
                        for (int j = 0; j < 4; ++j) { y[2 * j] = bflo(w[j]); y[2 * j + 1] = bfhi(w[j]); }
#pragma unroll
                        for (int j = 0; j < 4; ++j) { y[j] += g0[j] * v[j]; y[4 + j] += g4[j] * v[4 + j]; }
                        if (l < DEPTH - 1) *(u32x4*)xr = u32x4{cvtpk(y[0], y[1]), cvtpk(y[2], y[3]), cvtpk(y[4], y[5]), cvtpk(y[6], y[7])};
                        else { float* op = (float*)((char*)c.out + (((size_t)(uintptr_t)xr - (size_t)(uintptr_t)(c.ws + WS_RES)) - (size_t)T_CTX * D * 2) * 2);
                            *(f32x4*)op = f32x4{y[0], y[1], y[2], y[3]}; *(f32x4*)(op + 4) = f32x4{y[4], y[5], y[6], y[7]}; } } }); });
        } else {
            gemm_tile<1, 2, 8, 1, false, true>(c.lds + LDS_GEMM, 8,
                [&](int r) { return Ab + (size_t)r * 512; },
                [&](int n) { return WT + (size_t)(q * 64 + n) * 512; },
                [&](f32x16 (&acc)[1][2], int wm, int wn) { for_acc_f4<1, 2>(acc, wm, wn, lane, [&](int rl, int cc, f32x4 v) { rmw(rl, ct * 256 + q * 64 + cc, v); }); });
        }
    }
}

__global__ void __launch_bounds__(NTHR, 2) mega_fwd(Params P) {
    extern __shared__ __attribute__((aligned(16))) char lds[];
    Ctx c;
    c.out = P.out; c.ws = P.ws; c.lds = lds; c.G = gridDim.x;
    { const int bx = blockIdx.x; c.vcu = (c.G % 8 == 0) ? (bx % 8) * (c.G / 8) + bx / 8 : bx; }
    volatile LAS unsigned* st = (volatile LAS unsigned*)(lds + LDS_MISC);
    if (threadIdx.x < 4) st[threadIdx.x] = 0u;
    __syncthreads();
    XcdBarrier bar = xcd_barrier_post((unsigned*)(P.ws + WS_CTL), st);
    int ph = 0;
#define PHASE_END() do { if (++ph >= P.nphases) return; if (ph > P.ph_lo) xcd_barrier(bar); } while (0)
    if ((PHMASK & 1) && ph >= P.ph_lo) phase_prologue(P, c); PHASE_END();
    if ((PHMASK & 2) && ph >= P.ph_lo) phase_coef(P, c); PHASE_END();
    for (int l = 0; l < DEPTH; ++l) {
        if ((PHMASK & 4) && ph >= P.ph_lo) { phase_norm_mix(P, c, l); if (REPMASK & 4) { xcd_barrier(bar); phase_norm_mix(P, c, l); } } PHASE_END();
        if ((PHMASK & 8) && ph >= P.ph_lo) { phase_inproj(P, c, l); if (REPMASK & 8) { xcd_barrier(bar); phase_inproj(P, c, l); } } PHASE_END();
        if ((PHMASK & 16) && ph >= P.ph_lo) { phase_proj2(P, c, l); if (REPMASK & 16) { xcd_barrier(bar); phase_proj2(P, c, l); } } PHASE_END();
        if ((PHMASK & 32) && ph >= P.ph_lo) { phase_attn_fft1(P, c, l); if (REPMASK & 32) { xcd_barrier(bar); phase_attn_fft1(P, c, l); } } PHASE_END();
        if ((PHMASK & 64) && ph >= P.ph_lo) { phase_fft2(P, c, l); if (REPMASK & 64) { xcd_barrier(bar); phase_fft2(P, c, l); } } PHASE_END();
        if ((PHMASK & 128) && ph >= P.ph_lo) { phase_outproj(P, c, l); if (REPMASK & 128) { xcd_barrier(bar); phase_outproj(P, c, l); } } PHASE_END();
        if ((PHMASK & 256) && ph >= P.ph_lo) { phase_norm_route(P, c, l); if (REPMASK & 256) { xcd_barrier(bar); phase_norm_route(P, c, l); } } PHASE_END();
        if ((PHMASK & 512) && ph >= P.ph_lo) { phase_moe_up(P, c, l); if (REPMASK & 512) { xcd_barrier(bar); phase_moe_up(P, c, l); } } PHASE_END();
        if ((PHMASK & 1024) && ph >= P.ph_lo) { phase_moe_down(P, c, l); if (REPMASK & 1024) { xcd_barrier(bar); phase_moe_down(P, c, l); } } PHASE_END();
    }
}


#ifdef DUMPDBG
__global__ void dump_kernel(float* out, const char* ws, int keep_out) {
    const size_t n = (size_t)T_LAT * D;
    for (size_t i = (size_t)blockIdx.x * blockDim.x + threadIdx.x; i < n; i += (size_t)gridDim.x * blockDim.x) {
        float v = keep_out ? out[i] : 0.f;
        const size_t offs[8] = {WS_HBUF, WS_ZBUF, WS_QBUF, WS_KBUF, WS_VBUF, WS_UBUF, WS_WCS, WS_WIN};
        const size_t lens[8] = {(size_t)T * 1024, (size_t)T * 1024, (size_t)BATCH * NH * SEQ * DQK, (size_t)BATCH * NH * NKEY * DQK, (size_t)BATCH * NH * NKEY * DV, (size_t)T * 1024, (size_t)4 * 4 * 128 * 256, (size_t)4 * 1024 * 1024};
#pragma unroll
        for (int b = 0; b < 8; ++b) {
            if (!((DUMPMASK >> b) & 1)) continue;
            const unsigned short u = ((const unsigned short*)(ws + offs[b]))[i % lens[b]];
            float f = __uint_as_float(((unsigned)u) << 16);
            if (!(fabsf(f) < 1e30f)) f = 777.f;
            v += f;
        }
        if (!(fabsf(v) < 1e30f)) v = 999.f;
        out[i] = v;
    }
}
#endif

#ifdef CHECKDBG
constexpr size_t WS_CHK = WS_END;
__device__ inline float blk_sum(float v, float* red) {
    for (int o = 32; o > 0; o >>= 1) v += __shfl_xor(v, o, 64);
    __syncthreads(); if ((threadIdx.x & 63) == 0) red[threadIdx.x >> 6] = v; __syncthreads();
    float t = 0; for (int i = 0; i < (int)blockDim.x / 64; ++i) t += red[i]; return t;
}
__device__ inline float blk_max(float v, float* red) {
    for (int o = 32; o > 0; o >>= 1) v = fmaxf(v, __shfl_xor(v, o, 64));
    __syncthreads(); if ((threadIdx.x & 63) == 0) red[threadIdx.x >> 6] = v; __syncthreads();
    float t = -1e30f; for (int i = 0; i < (int)blockDim.x / 64; ++i) t = fmaxf(t, red[i]); return t;
}
__global__ void chk_qkv(Params P) {
    __shared__ float red[8]; __shared__ float xin[256]; __shared__ float outv[128]; __shared__ float kr[32];
    const int s = blockIdx.x, tid = threadIdx.x;
    const int row = (s * 7919 + 13) % T; const int h = s & 7;
    const short* z = (const short*)P.out + (size_t)row * ZLD;
    const bool lat = row >= T_CTX; const int rr = lat ? row - T_CTX : row; const int b = lat ? (rr >> 14) : (rr >> 8); const int n = lat ? (rr & 16383) : (rr & 255);
    float* err = (float*)(P.ws + WS_CHK);
    const float2* ropetab = (const float2*)(P.ws + WS_ROPE);
    { const float cq = bf2f((unsigned short)z[tid]); const float ms = blk_sum(cq * cq, red) / 256.f; xin[tid] = cq * rsqrtf(ms + EPS) * P.in[9][tid]; __syncthreads();
      float u = 0; if (tid < 96) for (int k = 0; k < 256; ++k) u += xin[k] * P.in[10][(size_t)k * 768 + h * 96 + tid];
      const float ms2 = blk_sum(tid < 96 ? u * u : 0.f, red) / 96.f; if (tid < 96) outv[tid] = u * rsqrtf(ms2 + EPS) * P.in[13][tid]; __syncthreads();
      float val = 0; if (tid < 96) { val = outv[tid];
        if (lat && tid >= 64) { const int m = tid - 64; const int ax = m >> 4, i = m & 7, second = (m >> 3) & 1; const int pos = ax == 0 ? (n >> 6) : (n & 63); const float2 cs = ropetab[pos * 8 + i];
            const float x1 = outv[64 + ax * 16 + i], x2 = outv[64 + ax * 16 + 8 + i]; val = second ? (x2 * cs.x + x1 * cs.y) : (x1 * cs.x - x2 * cs.y); }
        val *= ATT_QSCALE; }
      const short* qd = lat ? (const short*)(P.ws + WS_QBUF) + ((size_t)(b * NH + h) * SEQ + n) * DQK : (const short*)(P.ws + WS_QCTX) + ((size_t)(b * NH + h) * NCTX + n) * DQK;
      const float got = tid < 96 ? bf2f((unsigned short)qd[tid]) : 0.f;
      const float d2 = blk_sum(tid < 96 ? (got - val) * (got - val) : 0.f, red), r2 = blk_sum(tid < 96 ? val * val : 0.f, red);
      if (tid == 0) { atomicAdd(&err[0], d2); atomicAdd(&err[1], r2); } }
    { __syncthreads(); const float ck = tid < 128 ? bf2f((unsigned short)z[256 + tid]) : 0.f; const float ms = blk_sum(ck * ck, red) / 128.f; if (tid < 128) xin[tid] = ck * rsqrtf(ms + EPS) * P.in[11][tid];
      if (tid < 32) kr[tid] = bf2f((unsigned short)z[384 + tid]); __syncthreads();
      float u = 0; if (tid < 128) for (int k = 0; k < 128; ++k) u += xin[k] * P.in[12][(size_t)k * 1024 + h * 128 + tid];
      float sq = 0; if (tid < 64) sq = u * u; else if (tid >= 128 && tid < 160) sq = kr[tid - 128] * kr[tid - 128];
      const float ms2 = blk_sum(sq, red) / 96.f; const float rs = rsqrtf(ms2 + EPS);
      if (tid < 64) outv[tid] = u * rs * P.in[14][tid]; if (tid >= 128 && tid < 160) outv[64 + tid - 128] = kr[tid - 128] * rs * P.in[14][64 + tid - 128]; __syncthreads();
      const int pos = lat ? NCTX + n : n;
      float val = 0; if (tid < 96) { val = outv[tid];
        if (lat && tid >= 64) { const int m = tid - 64; const int ax = m >> 4, i = m & 7, second = (m >> 3) & 1; const int pp = ax == 0 ? (n >> 6) : (n & 63); const float2 cs = ropetab[pp * 8 + i];
            const float x1 = outv[64 + ax * 16 + i], x2 = outv[64 + ax * 16 + 8 + i]; val = second ? (x2 * cs.x + x1 * cs.y) : (x1 * cs.x - x2 * cs.y); } }
      const short* kd = (const short*)(P.ws + WS_KBUF) + ((size_t)(b * NH + h) * NKEY + pos) * DQK;
      const float gotk = tid < 96 ? bf2f((unsigned short)kd[tid]) : 0.f;
      float d2 = blk_sum(tid < 96 ? (gotk - val) * (gotk - val) : 0.f, red), r2 = blk_sum(tid < 96 ? val * val : 0.f, red);
      if (tid == 0) { atomicAdd(&err[2], d2); atomicAdd(&err[3], r2); }
      const short* vd = (const short*)(P.ws + WS_VBUF) + ((size_t)(b * NH + h) * NKEY + pos) * DV;
      const bool isv = tid >= 64 && tid < 128; const float gotv = isv ? bf2f((unsigned short)vd[tid - 64]) : 0.f; const float vv = isv ? u : 0.f;
      d2 = blk_sum((gotv - vv) * (gotv - vv), red); r2 = blk_sum(vv * vv, red);
      if (tid == 0) { atomicAdd(&err[4], d2); atomicAdd(&err[5], r2); } }
}
__global__ void chk_attn(Params P) {
    extern __shared__ float pbuf[];
    __shared__ float red[8]; __shared__ float qv[96];
    const int s = blockIdx.x, tid = threadIdx.x; const int b = s & 1, h = (s >> 1) & 7; const bool ctxq = (s % 5) == 4; const int n = ctxq ? (s * 37) % NCTX : (s * 4099 + 77) % SEQ;
    const int bh = b * NH + h; const int nk = ctxq ? NCTX : NKEY;
    const short* q = ctxq ? (const short*)(P.ws + WS_QCTX) + ((size_t)bh * NCTX + n) * DQK : (const short*)(P.ws + WS_QBUF) + ((size_t)bh * SEQ + n) * DQK;
    const short* K = (const short*)(P.ws + WS_KBUF) + (size_t)bh * NKEY * DQK; const short* V = (const short*)(P.ws + WS_VBUF) + (size_t)bh * NKEY * DV;
    if (tid < 96) qv[tid] = bf2f((unsigned short)q[tid]); __syncthreads();
    float mx = -1e30f;
    for (int k = tid; k < nk; k += blockDim.x) { float a = 0; for (int d = 0; d < 96; ++d) a += qv[d] * bf2f((unsigned short)K[(size_t)k * DQK + d]); pbuf[k] = a; mx = fmaxf(mx, a); }
    mx = blk_max(mx, red);
    float sm = 0; for (int k = tid; k < nk; k += blockDim.x) { const float p = exp2f(pbuf[k] - mx); pbuf[k] = p; sm += p; }
    sm = blk_sum(sm, red);
    float o = 0; if (tid < 64) for (int k = 0; k < nk; ++k) o += pbuf[k] * bf2f((unsigned short)V[(size_t)k * DV + tid]);
    o /= sm;
    const short* mix = (const short*)(P.ws + WS_HBUF) + (size_t)(ctxq ? b * NCTX + n : T_CTX + b * SEQ + n) * 1024 + h * DV;
    const float got = tid < 64 ? bf2f((unsigned short)mix[tid]) : 0.f; const float ov = tid < 64 ? o : 0.f;
    const float d2 = blk_sum((got - ov) * (got - ov), red), r2 = blk_sum(ov * ov, red);
    float* err = (float*)(P.ws + WS_CHK);
    if (tid == 0) { atomicAdd(&err[6], d2); atomicAdd(&err[7], r2); }
}
__global__ void chk_fixup(float* out, const char* ws) {
    const float* err = (const float*)(ws + WS_CHK);
    float e = 0.f; bool zero = false;
    for (int k = 0; k < 4; ++k) if ((CHECKSEL >> k) & 1) { e = fmaxf(e, sqrtf(err[2 * k] / fmaxf(err[2 * k + 1], 1e-30f))); zero |= (err[2 * k + 1] == 0.f); }
    float f = 1.f; if (!(e < 0.006f)) f = 1.1f; if (!(e < 0.02f)) f = 1.3f; if (!(e < 0.1f)) f = 2.f; if (zero) f = 3.f;
    if (f == 1.f) return;
    const size_t n = (size_t)T_LAT * D;
    for (size_t i = (size_t)blockIdx.x * blockDim.x + threadIdx.x; i < n; i += (size_t)gridDim.x * blockDim.x) out[i] *= f;
}
#endif
#ifndef PHMASK
#define PHMASK 0xffff
#endif
#ifndef NPHASES
#define NPHASES 1000
#endif
extern "C" void kernel_launch(void* const* d_in, const int* in_sizes, int n_in, void* d_out, int out_size, void* d_ws, size_t ws_size, hipStream_t stream) {
    static int grid = 0;
    if (grid == 0) {
        if (n_in != 22 || out_size != T_LAT * D || ws_size < WS_END) { fprintf(stderr, "kernel_launch: shape/workspace mismatch (n_in %d out %d ws %zu need %zu)\n", n_in, out_size, ws_size, (size_t)WS_END); grid = -1; return; }
        int dev = 0, cus = 0, per_cu = 0;
        if (hipGetDevice(&dev) != hipSuccess || hipDeviceGetAttribute(&cus, hipDeviceAttributeMultiprocessorCount, dev) != hipSuccess) { grid = -1; return; }
        if (hipFuncSetAttribute((const void*)mega_fwd, hipFuncAttributeMaxDynamicSharedMemorySize, LDS_BYTES) != hipSuccess) { fprintf(stderr, "kernel_launch: hipFuncSetAttribute failed\n"); grid = -1; return; }
        if (hipOccupancyMaxActiveBlocksPerMultiprocessor(&per_cu, (const void*)mega_fwd, NTHR, LDS_BYTES) != hipSuccess || per_cu < 1) { fprintf(stderr, "kernel_launch: occupancy query says %d\n", per_cu); grid = -1; return; }
        (void)hipGetLastError();
#ifdef CHECKDBG
        (void)hipFuncSetAttribute((const void*)chk_attn, hipFuncAttributeMaxDynamicSharedMemorySize, NKEY * 4);
#endif
        grid = cus;
    }
    if (grid < 0) return;
    hipMemsetAsync((char*)d_ws + WS_CTL, 0, CTL_BYTES, stream);
    Params p{};
    for (int i = 0; i < 22; ++i) p.in[i] = (const float*)d_in[i];
    p.out = (float*)d_out; p.ws = (char*)d_ws; p.nphases = NPHASES; p.ph_lo = 0;
#ifdef CHECKDBG
    hipMemsetAsync((char*)d_ws + WS_CHK, 0, 64, stream);
    p.nphases = 5; hipLaunchKernelGGL(mega_fwd, dim3(grid), dim3(NTHR), LDS_BYTES, stream, p);
    hipLaunchKernelGGL(chk_qkv, dim3(512), dim3(256), 0, stream, p);
    hipMemsetAsync((char*)d_ws + WS_CTL, 0, CTL_BYTES, stream);
    p.nphases = 6; hipLaunchKernelGGL(mega_fwd, dim3(grid), dim3(NTHR), LDS_BYTES, stream, p);
    hipLaunchKernelGGL(chk_attn, dim3(160), dim3(256), NKEY * 4, stream, p);
    hipMemsetAsync((char*)d_ws + WS_CTL, 0, CTL_BYTES, stream);
    p.nphases = NPHASES;
#endif
#ifdef SPLIT_AT
    p.nphases = SPLIT_AT;
    hipLaunchKernelGGL(mega_fwd, dim3(grid), dim3(NTHR), LDS_BYTES, stream, p);
    hipMemsetAsync((char*)d_ws + WS_CTL, 0, XCD_BAR_WORDS * 4, stream);
    p.nphases = NPHASES; p.ph_lo = SPLIT_AT;
#endif
    hipLaunchKernelGGL(mega_fwd, dim3(grid), dim3(NTHR), LDS_BYTES, stream, p);
    const hipError_t le = hipPeekAtLastError();
    if (le != hipSuccess) fprintf(stderr, "kernel_launch: launch failed: %s\n", hipGetErrorName(le));
#ifdef CHECKDBG
    hipLaunchKernelGGL(chk_fixup, dim3(2048), dim3(256), 0, stream, (float*)d_out, (const char*)d_ws);
#endif
#ifdef DUMPDBG
    hipLaunchKernelGGL(dump_kernel, dim3(2048), dim3(256), 0, stream, (float*)d_out, (const char*)d_ws, (NPHASES >= 8) ? 1 : 0);
#endif
}
```

```cpp
#include <hip/hip_runtime.h>
#include <hip/hip_bf16.h>
#include <cstdint>
#include <cstdio>

#define DEVI __device__ __forceinline__
#define PC_U0 0


#define EXP_WAIT() asm volatile("s_waitcnt vmcnt(0)" ::: "memory")

#define CHECKSEL 8
#ifndef REPMASK
#define REPMASK 0
#endif
#ifndef PHMASK
#define PHMASK 0xffff
#endif

constexpr int D = 1024, BATCH = 2, SEQ = 16384, DEPTH = 4, NCTX = 256;
constexpr int T_CTX = BATCH * NCTX, T_LAT = BATCH * SEQ, T = T_CTX + T_LAT;
constexpr int NH = 8, DQK = 96, DV = 64, QLR = 256, KVLR = 128;
constexpr int NKEY = NCTX + SEQ;
constexpr int INW = 928;
constexpr int ZLD = 1024;
constexpr int NE = 16, DE = 256, NCLS = 24;
constexpr float EPS = 1e-6f;
constexpr float ATT_QSCALE = 0.10206207261596577f * 1.4426950408889634f;
constexpr int NTHR = 512;

constexpr size_t al256(size_t x) { return (x + 255) / 256 * 256; }
constexpr size_t WS_CTL   = 0;
constexpr size_t CTL_BYTES = 65536;
constexpr size_t CTL_CNT_OFF = 32768;
constexpr size_t WS_COEF  = WS_CTL + CTL_BYTES;
constexpr size_t WS_F1    = WS_COEF + al256((size_t)4 * 3 * 6 * 1024 * 4);
constexpr size_t WS_F2    = WS_F1 + 256 * 256 * 2;
constexpr size_t WS_FC    = WS_F2 + 128 * 256 * 2;
constexpr size_t WS_TW    = WS_FC + 256 * 512 * 2;
constexpr size_t WS_ROPE  = WS_TW + 16384 * 8;
constexpr size_t WS_WIN   = WS_ROPE + 256 * 8 * 8;
constexpr size_t WS_WOUT  = WS_WIN + (size_t)4 * 1024 * 1024 * 2;
constexpr size_t WS_WGU   = WS_WOUT + (size_t)4 * 1024 * 1024 * 2;
constexpr size_t WS_WDN   = WS_WGU + (size_t)4 * 16 * 1024 * 512 * 2;
constexpr size_t WS_WQT   = WS_WDN + (size_t)4 * NCLS * 1024 * 512 * 2;
constexpr size_t WS_WKVT  = WS_WQT + (size_t)4 * 768 * 256 * 2;
constexpr size_t WS_WCS   = WS_WKVT + (size_t)4 * 1024 * 128 * 2;
constexpr size_t WS_CTXR  = WS_WCS + (size_t)4 * 4 * 128 * 256 * 2;
constexpr size_t WS_RCLS  = WS_CTXR + (size_t)T_CTX * 1024 * 4;
constexpr size_t WS_RW    = WS_RCLS + al256((size_t)T * 4);
constexpr size_t WS_CLIST = WS_RW + al256((size_t)T * 8);
constexpr size_t WS_HBUF  = WS_CLIST + al256((size_t)NCLS * T * 4);
constexpr size_t WS_MODP  = WS_HBUF;
constexpr size_t WS_RES   = WS_HBUF + (size_t)T * 1024 * 2;
constexpr size_t WS_ZBUF  = WS_RES;
constexpr size_t WS_QBUF  = WS_ZBUF + (size_t)T * 1024 * 2;
constexpr size_t WS_QCTX  = WS_QBUF + (size_t)BATCH * NH * SEQ * DQK * 2;
constexpr size_t WS_KBUF  = WS_QCTX + (size_t)BATCH * NH * NCTX * DQK * 2;
constexpr size_t WS_VBUF  = WS_KBUF + (size_t)BATCH * NH * NKEY * DQK * 2;
constexpr size_t WS_UBUF  = WS_VBUF + (size_t)BATCH * NH * NKEY * DV * 2;
constexpr size_t WS_P1    = WS_UBUF;
constexpr size_t WS_UCTX  = WS_UBUF + (size_t)2 * 4 * 128 * 128 * 256 * 2;
static_assert(WS_UCTX + (size_t)T_CTX * 1024 * 2 <= WS_UBUF + (size_t)T * 1024 * 2, "P1 + ctx U fit the U region");
constexpr size_t WS_END   = WS_UBUF + (size_t)T * 1024 * 2;
static_assert((size_t)2 * 4 * 128 * 128 * 256 * 2 <= (size_t)T * 1024 * 2, "P1 fits zbuf region");
static_assert((size_t)(T + NCLS * 256) * 512 * 2 <= (size_t)BATCH * NH * NKEY * DQK * 2, "Hmoe (class-padded rows) fits kbuf region");
static_assert(WS_END <= (size_t)4 * T_LAT * D * 4, "workspace map must fit 4 x the largest tensor (the guaranteed d_ws size)");

constexpr int LDS_GEMM = 0;
constexpr int LDS_STAT = 128 * 1024;
constexpr int LDS_MISC = 132 * 1024;
constexpr int LDS_BYTES = 133 * 1024;

#define XB_TMO      128
#define XB_XCNT(j)  (256  + 64 * (j))
#define XB_XSUB(j)  (1280 + 64 * (j))
#define XB_XGEN(j)  (2304 + 64 * (j))
#define XB_TOP      3328
#define XB_TOPGEN   3392
#define XCD_BAR_WORDS 3456
#define XB_SPIN_CAP (1u << 24)
#define LAS __attribute__((address_space(3)))

DEVI unsigned xb_ld(unsigned* p)              { return __hip_atomic_load(p, __ATOMIC_RELAXED, __HIP_MEMORY_SCOPE_AGENT); }
DEVI unsigned xb_add(unsigned* p, unsigned v) { return __hip_atomic_fetch_add(p, v, __ATOMIC_RELAXED, __HIP_MEMORY_SCOPE_AGENT); }
DEVI unsigned xb_xcc_id() { return (unsigned)__builtin_amdgcn_s_getreg((3 << 11) | 20) & 0xFu; }
#define XB_SPIN(cond, bar) do { unsigned _sp = 0; while (cond) { __builtin_amdgcn_s_sleep(1); \
    if ((++_sp & 255u) == 0u) { if (xb_ld(&(bar)[XB_TMO])) break; if (_sp > XB_SPIN_CAP) { atomicAdd(&(bar)[XB_TMO], 1u); break; } } } } while (0)

struct XcdBarrier { unsigned* bar; unsigned x; volatile LAS unsigned* st; };

DEVI XcdBarrier xcd_barrier_post(unsigned* bar, volatile LAS unsigned* st) {
    XcdBarrier b; b.bar = bar; b.x = xb_xcc_id(); b.st = st;
    if (threadIdx.x == 0) (void)xb_add(&bar[XB_XCNT(b.x)], 1u);
    return b;
}
DEVI void xcd_barrier_complete(unsigned* bar, unsigned x, unsigned& nloc, unsigned& nx) {
    const unsigned G = gridDim.x * gridDim.y * gridDim.z;
    unsigned sum, cnt, mine, sp = 0u;
    for (;;) {
        sum = 0u; cnt = 0u; mine = 0u;
#pragma unroll
        for (unsigned j = 0; j < 16; ++j) { const unsigned c = xb_ld(&bar[XB_XCNT(j)]); sum += c; cnt += (c > 0u) ? 1u : 0u; mine = (j == x) ? c : mine; }
        if (sum == G) break;
        __builtin_amdgcn_s_sleep(1);
        if ((++sp & 255u) == 0u) { if (xb_ld(&bar[XB_TMO])) break; if (sp > XB_SPIN_CAP) { atomicAdd(&bar[XB_TMO], 1u); break; } }
    }
    nloc = mine > 0u ? mine : 1u; nx = cnt > 0u ? cnt : 1u;
}
DEVI void xcd_barrier(const XcdBarrier& b) {
    asm volatile("s_waitcnt vmcnt(0)" ::: "memory");
    __syncthreads();
    if (threadIdx.x == 0) {
        unsigned* bar = b.bar;
        __builtin_amdgcn_s_waitcnt(0);
        unsigned nloc = b.st[0], nx = b.st[1];
        if (nloc == 0u) { xcd_barrier_complete(bar, b.x, nloc, nx); b.st[0] = nloc; b.st[1] = nx; }
        const unsigned old = xb_add(&bar[XB_XSUB(b.x)], 1u);
        const unsigned gen = old / nloc;
        if (old + 1u == (gen + 1u) * nloc) {
            __builtin_amdgcn_fence(__ATOMIC_RELEASE, "agent");
            asm volatile("s_waitcnt vmcnt(0)" ::: "memory");
            const unsigned og = xb_add(&bar[XB_TOP], 1u);
            const unsigned tg = og / nx;
            if (og + 1u == (tg + 1u) * nx) xb_add(&bar[XB_TOPGEN], 1u);
            else XB_SPIN(xb_ld(&bar[XB_TOPGEN]) == tg, bar);
            __builtin_amdgcn_fence(__ATOMIC_ACQUIRE, "agent");
            xb_add(&bar[XB_XGEN(b.x)], 1u);
            asm volatile("s_waitcnt vmcnt(0)" ::: "memory");
        } else {
            XB_SPIN(xb_ld(&bar[XB_XGEN(b.x)]) == gen, bar);
            __builtin_amdgcn_fence(__ATOMIC_ACQUIRE, "agent");
            asm volatile("s_waitcnt vmcnt(0)" ::: "memory");
        }
    }
    __syncthreads();
}

using bf16x8 = __attribute__((ext_vector_type(8))) short;
using s16x4  = __attribute__((ext_vector_type(4))) short;
using f32x16 = __attribute__((ext_vector_type(16))) float;
using f32x4  = __attribute__((ext_vector_type(4))) float;
using u32x4  = __attribute__((ext_vector_type(4))) unsigned;
using u32x2  = __attribute__((ext_vector_type(2))) unsigned;
#define SBAR() __builtin_amdgcn_sched_barrier(0)

DEVI int crow(int r, int hi) { return (r & 3) + 8 * (r >> 2) + 4 * hi; }
DEVI unsigned cvtpk(float lo, float hi) { unsigned r; asm volatile("v_cvt_pk_bf16_f32 %0, %1, %2" : "=v"(r) : "v"(lo), "v"(hi)); return r; }
DEVI unsigned short f2bf(float x) { return (unsigned short)(cvtpk(x, 0.f) & 0xffffu); }
DEVI float bf2f(unsigned short u) { return __uint_as_float(((unsigned)u) << 16); }
DEVI float bflo(unsigned u) { return __uint_as_float(u << 16); }
DEVI float bfhi(unsigned u) { return __uint_as_float(u & 0xffff0000u); }
DEVI float wave_sum(float v) {
#pragma unroll
    for (int o = 32; o > 0; o >>= 1) v += __shfl_xor(v, o, 64);
    return v;
}
DEVI float silu(float x) { return x * __builtin_amdgcn_rcpf(1.f + __expf(-x)); }

DEVI int row_variant(int r) { return r < T_CTX ? 2 : ((r - T_CTX) >> 14); }

template <int BN> DEVI int nn_st(int k, int c) {
    const int kk = (k & ~0xC) | ((k & 4) << 1) | ((k & 8) >> 1);
    return ((kk >> 3) * (BN / 32) + (c >> 5)) * 512 + ((kk & 7) * 32 + (c & 31)) * 2;
}
DEVI int nn_rd_base(int lane) { return ((lane & 3) << 3) | (((lane >> 2) & 3) << 6) | (((lane >> 4) & 1) << 5) | (((lane >> 5) & 1) << 8); }
template <int OFF> DEVI s16x4 tr_read(int vb) {
    s16x4 r; asm volatile("ds_read_b64_tr_b16 %0, %1 offset:%2" : "=&v"(r) : "v"(vb), "i"(OFF) : "memory"); return r;
}
#define PK8(L, H) (bf16x8){L[0], L[1], L[2], L[3], H[0], H[1], H[2], H[3]}

typedef s16x4 LAS * lds_s16x4_ptr;
template <int MB, int NB, int WM, int WN, bool BNN, bool SWAPC, int STAGES = 2, bool BRES = false, class AF, class BF, class EF>
DEVI void gemm_tile(char* lds, int nk_in, AF arow, BF brow, EF epi) {
    int nk = nk_in; asm volatile("" : "+s"(nk));
    constexpr int BM = 32 * MB * WM, BN = 32 * NB * WN;
    constexpr int ABYTES = BM * 128, BBYTES = BN * 128;
    constexpr int ACH = BM / 64, BCH = BN / 64;
    static_assert(WM * WN == 8, "8 waves");
    static_assert(2 * ABYTES + 2 * BBYTES <= 128 * 1024, "LDS");
    int tid = threadIdx.x; asm volatile("" : "+v"(tid)); const int lane = tid & 63, wid = __builtin_amdgcn_readfirstlane(tid >> 6);
    const int wm = wid / WN, wn = wid % WN, r32 = lane & 31, hi = lane >> 5;
    LAS char* Abase = (LAS char*)lds; LAS char* Bbase = BRES ? Abase + 65536 : Abase + 2 * ABYTES;
    static_assert(!BRES || 2 * ABYTES <= 65536, "resident B image sits at +64 KB");
    const short* ap[ACH]; int aoff[ACH];
#pragma unroll
    for (int i = 0; i < ACH; ++i) { const int id = tid + NTHR * i, row = id >> 3, c = id & 7; ap[i] = (const short*)arow(row) + c * 8; aoff[i] = row * 128 + ((c ^ ((row >> 1) & 7)) << 4); }
    const short* bp[BCH]; int boff[BCH];
#pragma unroll
    for (int i = 0; i < BCH; ++i) {
        const int id = tid + NTHR * i;
        if constexpr (!BNN) { const int row = id >> 3, c = id & 7; bp[i] = (const short*)brow(row) + c * 8; boff[i] = row * 128 + ((c ^ ((row >> 1) & 7)) << 4); }
        else { const int krow = id / (BN / 8), c = id % (BN / 8); boff[i] = nn_st<BN>(krow, c * 8); bp[i] = nullptr; }
    }
    const int swz = (r32 >> 1) & 7;
    const int afr0 = (wm * 32 * MB + r32) * 128, bfr0 = (wn * 32 * NB + r32) * 128;
    const int bvb = nn_rd_base(lane) + wn * NB * 512;

    f32x16 acc[MB][NB];
#pragma unroll
    for (int i = 0; i < MB; ++i)
#pragma unroll
        for (int j = 0; j < NB; ++j) acc[i][j] = f32x16{};
    bf16x8 ra0[ACH], rb0[BCH], ra1[ACH], rb1[BCH];
#define G_LOAD(RA, RB, T) do {                                                                                                     \
        _Pragma("unroll") for (int i = 0; i < ACH; ++i) RA[i] = *(const bf16x8*)(ap[i] + (T) * 64);                                \
        if constexpr (!BRES) { _Pragma("unroll") for (int i = 0; i < BCH; ++i) { if constexpr (!BNN) RB[i] = *(const bf16x8*)(bp[i] + (T) * 64);          \
            else { const int id = tid + NTHR * i; RB[i] = *(const bf16x8*)((const short*)brow((T) * 64 + id / (BN / 8)) + (id % (BN / 8)) * 8); } } } } while (0)
#define G_WRITE(RA, RB, BUF) do {                                                                                                  \
        _Pragma("unroll") for (int i = 0; i < ACH; ++i) *(LAS bf16x8*)(Abase + (BUF) * ABYTES + aoff[i]) = RA[i];                  \
        if constexpr (!BRES) { _Pragma("unroll") for (int i = 0; i < BCH; ++i) *(LAS bf16x8*)(Bbase + (BUF) * BBYTES + boff[i]) = RB[i]; } } while (0)
#define G_COMPUTE(BUF, KT) do {                                                                                                    \
        LAS const char* As = Abase + (BUF) * ABYTES; LAS const char* Bs = Bbase + (BRES ? (KT) : (BUF)) * BBYTES;                  \
        _Pragma("unroll") for (int ks = 0; ks < 4; ++ks) {                                                                         \
            bf16x8 a[MB], b[NB];                                                                                                   \
            const int so = ((ks * 2 + hi) ^ swz) << 4;                                                                             \
            _Pragma("unroll") for (int mb = 0; mb < MB; ++mb) a[mb] = *(LAS const bf16x8*)(As + afr0 + so + mb * 4096);            \
            _Pragma("unroll") for (int nb = 0; nb < NB; ++nb) {                                                                    \
                if constexpr (BNN) {                                                                                               \
                    const s16x4 l = __builtin_amdgcn_ds_read_tr16_b64_v4i16((lds_s16x4_ptr)(Bs + bvb + nb * 512 + ks * (2 * (BN / 32) * 512)));                        \
                    const s16x4 h = __builtin_amdgcn_ds_read_tr16_b64_v4i16((lds_s16x4_ptr)(Bs + bvb + nb * 512 + ks * (2 * (BN / 32) * 512) + (BN / 32) * 512));      \
                    b[nb] = PK8(l, h);                                                                                             \
                } else b[nb] = *(LAS const bf16x8*)(Bs + bfr0 + so + nb * 4096);                                                   \
            }                                                                                                                      \
            _Pragma("unroll") for (int mb = 0; mb < MB; ++mb)                                                                      \
                _Pragma("unroll") for (int nb = 0; nb < NB; ++nb) acc[mb][nb] = SWAPC ? __builtin_amdgcn_mfma_f32_32x32x16_bf16(b[nb], a[mb], acc[mb][nb], 0, 0, 0) : __builtin_amdgcn_mfma_f32_32x32x16_bf16(a[mb], b[nb], acc[mb][nb], 0, 0, 0); \
        } } while (0)
    if constexpr (STAGES == 2) {
    G_LOAD(ra0, rb0, 0); G_LOAD(ra1, rb1, 1); SBAR();
    G_WRITE(ra0, rb0, 0);
    __syncthreads();
    int kt = 0;
    for (; kt + 2 < nk; kt += 2) {
        SBAR(); G_LOAD(ra0, rb0, kt + 2); SBAR();
        G_COMPUTE(0, kt); SBAR();
        G_WRITE(ra1, rb1, 1);
        __syncthreads();
        SBAR(); G_LOAD(ra1, rb1, kt + 3); SBAR();
        G_COMPUTE(1, kt + 1); SBAR();
        G_WRITE(ra0, rb0, 0);
        __syncthreads();
    }
    SBAR(); G_COMPUTE(0, kt); SBAR();
    G_WRITE(ra1, rb1, 1);
    __syncthreads();
    SBAR(); G_COMPUTE(1, kt + 1); SBAR();
    __syncthreads();
    } else {
    G_LOAD(ra0, rb0, 0); SBAR();
    G_WRITE(ra0, rb0, 0);
    __syncthreads();
    for (int kt = 0; kt < nk; ++kt) {
        const int cur = kt & 1;
        if (kt + 1 < nk) { SBAR(); G_LOAD(ra0, rb0, kt + 1); SBAR(); }
        G_COMPUTE(cur, kt); SBAR();
        if (kt + 1 < nk) G_WRITE(ra0, rb0, cur ^ 1);
        __syncthreads();
    }
    }
#undef G_LOAD
#undef G_WRITE
#undef G_COMPUTE
    epi(acc, wm, wn);
}


typedef __attribute__((address_space(1))) const unsigned* g8_gptr;
typedef __attribute__((address_space(3))) unsigned* g8_lptr;
constexpr int G8_HT = 128 * 64;
DEVI int g8_lds_byte(int r, int c) { const int st = (r >> 4) * 2 + (c >> 5), rr = r & 15, cc = c & 31, ob = rr * 64 + cc * 2; return st * 1024 + (ob ^ (((ob >> 9) & 1) << 5)); }
DEVI void g8_stage_rc(int b, int& R, int& C) { const int st = b / 1024, sb = b % 1024, swz = sb ^ (((sb >> 9) & 1) << 5); R = (st >> 1) * 16 + swz / 64; C = (st & 1) * 32 + (swz % 64) / 2; }
typedef f32x4 g8_acc[2][2][4][2];

template <bool GATHER, int NPASS, class EPI>
DEVI void gemm256(char* ldsb, int nt, const short* A, int lda, const int* ltok, const short* Bt, int ldb, int apass, const short* Bt2, EPI epi) {
    short* shm = (short*)ldsb;
#define SA(b, h) (shm + ((b) * 2 + (h)) * G8_HT)
#define SB(b, h) (shm + (4 + (b) * 2 + (h)) * G8_HT)
#define STAGE_A(P_, h_, kt_) do { _Pragma("unroll") for (int _i = 0; _i < 2; ++_i) { \
        const unsigned _o = (GATHER ? ao[(h_) * 2 + _i] : ao[0] + (unsigned)(((h_) * 128 + _i * 64) * lda * 2)) + (unsigned)((kt_) * 128); \
        __builtin_amdgcn_global_load_lds((g8_gptr)((const char*)A + (size_t)_o), (g8_lptr)((char*)(P_) + tz * 16 + _i * 8192), 16, 0, 0); } } while (0)
#define STAGE_B(P_, h_, kt_) do { _Pragma("unroll") for (int _i = 0; _i < 2; ++_i) { \
        const unsigned _o = bo + (unsigned)(((h_) * 128 + _i * 64) * ldb * 2) + (unsigned)((kt_) * 128); \
        __builtin_amdgcn_global_load_lds((g8_gptr)((const char*)Bt + (size_t)_o), (g8_lptr)((char*)(P_) + tz * 16 + _i * 8192), 16, 0, 0); } } while (0)
#define LDA(dst, b, h) _Pragma("unroll") for (int m = 0; m < 4; ++m) _Pragma("unroll") for (int k = 0; k < 2; ++k) \
        dst[m][k] = *reinterpret_cast<const bf16x8*>((char*)SA(b, h) + g8_lds_byte(wr * 64 + m * 16 + fr, k * 32 + fq * 8))
#define LDB(dst, b, h) _Pragma("unroll") for (int n = 0; n < 2; ++n) _Pragma("unroll") for (int k = 0; k < 2; ++k) \
        dst[n][k] = *reinterpret_cast<const bf16x8*>((char*)SB(b, h) + g8_lds_byte(wc * 32 + n * 16 + fr, k * 32 + fq * 8))
#define MMA(ai, bj, At_, Bt_) do { __builtin_amdgcn_s_setprio(1); \
        _Pragma("unroll") for (int m = 0; m < 4; ++m) _Pragma("unroll") for (int n = 0; n < 2; ++n) _Pragma("unroll") for (int k = 0; k < 2; ++k) \
            acc[ai][bj][m][n] = __builtin_amdgcn_mfma_f32_16x16x32_bf16(Bt_[n][k], At_[m][k], acc[ai][bj][m][n], 0, 0, 0); \
        __builtin_amdgcn_s_setprio(0); } while (0)
#define WAIT_V(n) asm volatile("s_waitcnt vmcnt(" #n ")" ::: "memory")
#define WAIT_L(n) asm volatile("s_waitcnt lgkmcnt(" #n ")" ::: "memory")
#define BAR __builtin_amdgcn_s_barrier()
#define SCHED __builtin_amdgcn_sched_barrier(0)
    int tz = threadIdx.x; asm volatile("" : "+v"(tz));
    int wid = __builtin_amdgcn_readfirstlane(tz >> 6), lane = tz & 63, wr = wid >> 2, wc = wid & 3, fr = lane & 15, fq = lane >> 4;
    unsigned ao[4], bo;
    { int r0, c0; g8_stage_rc(tz * 16, r0, c0);
      if constexpr (GATHER) {
#pragma unroll
          for (int q = 0; q < 4; ++q) ao[q] = (unsigned)(ltok[(q >> 1) * 128 + (q & 1) * 64 + r0] * lda + c0) * 2u;
      } else { ao[0] = (unsigned)(r0 * lda + c0) * 2u; ao[1] = ao[2] = ao[3] = 0; }
      bo = (unsigned)(r0 * ldb + c0) * 2u; }
    g8_acc acc;
#pragma unroll
    for (int a = 0; a < 2; ++a)
#pragma unroll
        for (int b = 0; b < 2; ++b)
#pragma unroll
            for (int m = 0; m < 4; ++m)
#pragma unroll
                for (int n = 0; n < 2; ++n) acc[a][b][m][n] = f32x4{0, 0, 0, 0};
    bf16x8 At[4][2], B0[2][2], B1[2][2];
#pragma unroll 1
    for (int pass = 0; pass < NPASS; ++pass) {
    if (pass == 1) { A += apass; Bt = Bt2;
        tz = threadIdx.x; asm volatile("" : "+v"(tz)); wid = __builtin_amdgcn_readfirstlane(tz >> 6); lane = tz & 63; wr = wid >> 2; wc = wid & 3; fr = lane & 15; fq = lane >> 4; }
    STAGE_B(SB(0, 0), 0, 0); STAGE_A(SA(0, 0), 0, 0);
    STAGE_B(SB(0, 1), 1, 0); STAGE_A(SA(0, 1), 1, 0);
    if (wr == 1) BAR;
    WAIT_V(4); BAR;
    STAGE_B(SB(1, 0), 0, 1); STAGE_A(SA(1, 0), 0, 1); STAGE_B(SB(1, 1), 1, 1);
    WAIT_V(6); BAR;
    for (int t = 0; t < nt - 2; t += 2) {
        LDB(B0, 0, 0); SCHED; LDA(At, 0, 0); STAGE_A(SA(1, 1), 1, t + 1);
        WAIT_L(8); BAR; WAIT_L(0); MMA(0, 0, At, B0); BAR; SCHED;
        LDB(B1, 0, 1); STAGE_B(SB(0, 0), 0, t + 2);
        BAR; WAIT_L(0); MMA(0, 1, At, B1); BAR;
        LDA(At, 0, 1); STAGE_A(SA(0, 0), 0, t + 2);
        BAR; WAIT_L(0); MMA(1, 0, At, B0); BAR; SCHED;
        STAGE_B(SB(0, 1), 1, t + 2);
        WAIT_V(6); BAR; MMA(1, 1, At, B1); BAR;
        LDB(B0, 1, 0); SCHED; LDA(At, 1, 0); STAGE_A(SA(0, 1), 1, t + 2);
        WAIT_L(8); BAR; WAIT_L(0); MMA(0, 0, At, B0); BAR; SCHED;
        LDB(B1, 1, 1); STAGE_B(SB(1, 0), 0, t + 3);
        BAR; WAIT_L(0); MMA(0, 1, At, B1); BAR;
        LDA(At, 1, 1); STAGE_A(SA(1, 0), 0, t + 3);
        BAR; WAIT_L(0); MMA(1, 0, At, B0); BAR; SCHED;
        STAGE_B(SB(1, 1), 1, t + 3);
        WAIT_V(6); BAR; MMA(1, 1, At, B1); BAR;
    }
    tz = threadIdx.x; asm volatile("" : "+v"(tz)); wid = __builtin_amdgcn_readfirstlane(tz >> 6); lane = tz & 63; wr = wid >> 2; wc = wid & 3; fr = lane & 15; fq = lane >> 4;
    { int r0, c0; g8_stage_rc(tz * 16, r0, c0);
      if constexpr (GATHER) {
#pragma unroll
          for (int q = 2; q < 4; ++q) ao[q] = (unsigned)(ltok[(q >> 1) * 128 + (q & 1) * 64 + r0] * lda + c0) * 2u;
      } else ao[0] = (unsigned)(r0 * lda + c0) * 2u; }
    { LDB(B0, 0, 0); WAIT_V(0); LDA(At, 0, 0); STAGE_A(SA(1, 1), 1, nt - 1);
      BAR; WAIT_L(0); MMA(0, 0, At, B0); BAR;
      LDB(B1, 0, 1); BAR; WAIT_L(0); MMA(0, 1, At, B1); BAR;
      LDA(At, 0, 1); WAIT_V(4); BAR; WAIT_L(0); MMA(1, 0, At, B0); MMA(1, 1, At, B1); BAR; }
    { LDB(B0, 1, 0); LDA(At, 1, 0); WAIT_V(2); BAR; WAIT_L(0); MMA(0, 0, At, B0); BAR;
      LDB(B1, 1, 1); WAIT_V(0); BAR; WAIT_L(0); MMA(0, 1, At, B1); BAR;
      LDA(At, 1, 1); BAR; WAIT_L(0); MMA(1, 0, At, B0); MMA(1, 1, At, B1); BAR; }
    if (wr == 0) BAR;
    }
    SBAR();
    epi(acc, wr, wc, fr, fq);
#undef SA
#undef SB
#undef STAGE_A
#undef STAGE_B
#undef LDA
#undef LDB
#undef MMA
#undef WAIT_V
#undef WAIT_L
#undef BAR
#undef SCHED
}
template <class F> DEVI void g8_for_acc(g8_acc& acc, int wr, int wc, int fr, int fq, F f) {
#pragma unroll
    for (int ai = 0; ai < 2; ++ai)
#pragma unroll
        for (int m = 0; m < 4; ++m)
        {
#pragma unroll
            for (int bj = 0; bj < 2; ++bj) { SBAR();
#pragma unroll
                for (int n = 0; n < 2; ++n) f(ai * 128 + wr * 64 + m * 16 + fr, bj * 128 + wc * 32 + n * 16 + fq * 4, acc[ai][bj][m][n]); } }
}
template <class F> DEVI void g8_for_acc8(g8_acc& acc, int wr, int wc, int fr, int fq, F f) {
#pragma unroll
    for (int ai = 0; ai < 2; ++ai)
#pragma unroll
        for (int m = 0; m < 4; ++m)
        {
#pragma unroll
            for (int bj = 0; bj < 2; ++bj) { SBAR(); float v[8];
#pragma unroll
                for (int j = 0; j < 4; ++j) { auto rr = __builtin_amdgcn_permlane16_swap(__float_as_uint(acc[ai][bj][m][0][j]), __float_as_uint(acc[ai][bj][m][1][j]), false, false);
                    v[j] = __uint_as_float(rr[0]); v[4 + j] = __uint_as_float(rr[1]); }
                f(ai * 128 + wr * 64 + m * 16 + fr, bj * 128 + wc * 32 + (fq & 1) * 16 + (fq & ~1) * 4, v); } }
}

struct Params { const float* in[22]; float* out; char* ws; int nphases; int ph_lo; };

struct Ctx { float* out; char* ws; char* lds; int G, vcu; };
#define TID_SETUP() int tid = threadIdx.x; asm volatile("" : "+v"(tid)); const int lane = tid & 63; const int wid = __builtin_amdgcn_readfirstlane(tid >> 6); (void)lane; (void)wid

DEVI short* res_row(const Ctx& c, int r) { return (short*)(c.ws + WS_RES) + (size_t)r * D; }
DEVI const float* in_row(const Params& P, int r) { return r < T_CTX ? P.in[2] + (size_t)r * D : P.in[0] + (size_t)(r - T_CTX) * D; }
DEVI f32x4 ld_bf4(const short* p) { const u32x2 w = *(const u32x2*)p; return f32x4{bflo(w[0]), bfhi(w[0]), bflo(w[1]), bfhi(w[1])}; }
DEVI void st_bf4(short* p, f32x4 v) { *(u32x2*)p = u32x2{cvtpk(v[0], v[1]), cvtpk(v[2], v[3])}; }
DEVI void res_load8(const Params& P, const Ctx& c, int r, int col, int layer, float (&x)[8]) {
    if (layer == 0) { const float* p = in_row(P, r) + col; const f32x4 a = *(const f32x4*)p, b = *(const f32x4*)(p + 4);
#pragma unroll
        for (int j = 0; j < 4; ++j) { x[j] = a[j]; x[4 + j] = b[j]; } }
    else { const u32x4 w = *(const u32x4*)(res_row(c, r) + col);
#pragma unroll
        for (int j = 0; j < 4; ++j) { x[2 * j] = bflo(w[j]); x[2 * j + 1] = bfhi(w[j]); } }
}
DEVI f32x4 res_load4(const Params& P, const Ctx& c, int r, int col, int layer) { return layer == 0 ? *(const f32x4*)(in_row(P, r) + col) : ld_bf4(res_row(c, r) + col); }

DEVI void cls_experts(int cls, int& ea, int& eb);
DEVI void phase_prologue(const Params& P, const Ctx& c) {
    TID_SETUP();
    const long gtid = (long)blockIdx.x * NTHR + tid; const long gsz = (long)c.G * NTHR;
    float* sv = (float*)(c.lds + LDS_GEMM);
    for (int i = tid; i < 3 * 1024; i += NTHR) { const int v = i >> 10, k = i & 1023; const float x = (v < 2) ? P.in[1][v * 1024 + k] : P.in[3][k]; sv[i] = silu(x); }
    float* tc = sv + 3 * 1024;
    for (int i = tid; i < 128; i += NTHR) { tc[i] = cospif(i / 64.f); tc[128 + i] = sinpif(i / 64.f); }
    __syncthreads();
    {
        float* modp = (float*)(c.ws + WS_MODP);
        const float* w_ada = P.in[4];
        for (long it = gtid; it < (long)8 * 4 * 6144; it += gsz) {
            const int j = (int)(it % 6144); const int l = (int)((it / 6144) & 3); const int ks = (int)(it / (6144 * 4));
            const float* w = w_ada + ((size_t)l * 1024 + ks * 128) * 6144 + j;
            float a0 = 0, a1 = 0, a2 = 0;
            for (int k = 0; k < 128; ++k) { const float wv = w[(size_t)k * 6144]; const int kk = ks * 128 + k; a0 += sv[kk] * wv; a1 += sv[1024 + kk] * wv; a2 += sv[2048 + kk] * wv; }
            float* o = modp + ((size_t)(ks * 4 + l) * 3) * 6144 + j;
            o[0] = a0; o[6144] = a1; o[2 * 6144] = a2;
        }
    }
    {
        float* tl = (float*)(c.lds + LDS_GEMM + 16384);
        const int NT_IN = 4 * 16 * 15, NT_OUT = 4 * 16 * 16, NT_GU = 4 * 16 * 16 * 4 * 2, NT_DN = 4 * NCLS * 2 * 4 * 16;
        struct TD { const float* s; short* d; int sld, dld, k0, n0, nvalid, mode; };
        auto desc = [&](int tix) { TD t; t.mode = 0;
            if (tix < NT_IN) { const int l = tix / 240, r = tix % 240, kt = r / 15, nt2 = r % 15; t.s = P.in[8] + (size_t)l * 1024 * INW; t.sld = INW; t.d = (short*)(c.ws + WS_WIN) + (size_t)l * 1024 * 1024; t.dld = 1024; t.k0 = kt * 64; t.n0 = nt2 * 64; t.nvalid = INW; }
            else if (tix < NT_IN + NT_OUT) { const int t2 = tix - NT_IN; const int l = t2 >> 8, r = t2 & 255; t.s = P.in[16] + (size_t)l * 1024 * 1024; t.sld = 1024; t.d = (short*)(c.ws + WS_WOUT) + (size_t)l * 1024 * 1024; t.dld = 1024; t.k0 = (r >> 4) * 64; t.n0 = (r & 15) * 64; t.nvalid = 1024; }
            else if (tix < NT_IN + NT_OUT + NT_GU) { const int t2 = tix - NT_IN - NT_OUT; const int gu = t2 & 1, r = t2 >> 1; const int le = r >> 6, kt = (r >> 2) & 15, nt2 = r & 3;
                t.s = (gu ? P.in[20] : P.in[19]) + (size_t)le * 1024 * 256; t.sld = 256; t.d = (short*)(c.ws + WS_WGU) + (size_t)le * 512 * 1024; t.dld = 1024; t.k0 = kt * 64; t.n0 = nt2 * 64; t.nvalid = 256; t.mode = 1 + gu; }
            else { const int t2 = tix - NT_IN - NT_OUT - NT_GU; const int lch = t2 >> 6, kt = (t2 >> 4) & 3, nt2 = t2 & 15; const int half = lch & 1, lc = lch >> 1, cl = lc % NCLS, l = lc / NCLS;
                int ea, eb; cls_experts(cl, ea, eb); const int e = half ? eb : ea;
                t.s = P.in[21] + (size_t)(l * 16 + e) * 256 * 1024; t.sld = 1024; t.d = (short*)(c.ws + WS_WDN) + (size_t)lc * 1024 * 512 + half * 256; t.dld = 512; t.k0 = kt * 64; t.n0 = nt2 * 64; t.nvalid = 1024; }
            return t; };
        const int NTILES = NT_IN + NT_OUT + NT_GU + NT_DN;
        const int lkk = tid >> 3, lcg = (tid & 7) * 8;
        f32x4 x0 = {0, 0, 0, 0}, x1 = {0, 0, 0, 0};
        auto tload = [&](const TD& t) { x0 = f32x4{0, 0, 0, 0}; x1 = f32x4{0, 0, 0, 0};
            if (t.n0 + lcg < t.nvalid) { const float* sp = t.s + (size_t)(t.k0 + lkk) * t.sld + t.n0 + lcg; x0 = *(const f32x4*)sp; x1 = *(const f32x4*)(sp + 4); } };
        int tix = blockIdx.x, pb = 0;
        TD cur = desc(tix < NTILES ? tix : 0);
        __syncthreads();
        if (tix < NTILES) tload(cur);
        for (; tix < NTILES; tix += c.G, pb ^= 1) {
            float* tlb = tl + pb * (64 * 65);
#pragma unroll
            for (int j = 0; j < 4; ++j) { tlb[lkk * 65 + lcg + j] = x0[j]; tlb[lkk * 65 + lcg + 4 + j] = x1[j]; }
            const TD nxt = desc(tix + c.G < NTILES ? tix + c.G : 0);
            if (tix + c.G < NTILES) tload(nxt);
            __syncthreads();
            { const int n = tid >> 3, kg = (tid & 7) * 8; const int nn = cur.n0 + n;
              if (nn < cur.nvalid) { float v[8];
#pragma unroll
                for (int j = 0; j < 8; ++j) v[j] = tlb[(kg + j) * 65 + n];
                const int drow = cur.mode == 0 ? nn : ((nn >> 4) * 32 + (cur.mode - 1) * 16 + (nn & 15));
                *(u32x4*)(cur.d + (size_t)drow * cur.dld + cur.k0 + kg) = u32x4{cvtpk(v[0], v[1]), cvtpk(v[2], v[3]), cvtpk(v[4], v[5]), cvtpk(v[6], v[7])}; } }
            cur = nxt;
        }
        __syncthreads();
        { short* d = (short*)(c.ws + WS_WIN);
          for (long it = gtid; it < (long)4 * 96 * 128; it += gsz) { const int k8 = (int)(it & 127); const long lr = it >> 7; const int l = (int)(lr / 96), rr = (int)(lr % 96);
              *(u32x4*)(d + ((size_t)l * 1024 + INW + rr) * 1024 + k8 * 8) = u32x4{0, 0, 0, 0}; } }
    }
    {
        short* dst = (short*)(c.ws + WS_WQT);
        for (long it = gtid; it < (long)4 * 768 * 256; it += gsz) { const int k = (int)(it & 255); const long lf = it >> 8; const int f = (int)(lf % 768), l = (int)(lf / 768);
            dst[it] = (short)f2bf(P.in[9][l * 256 + k] * P.in[10][((size_t)l * 256 + k) * 768 + f]); }
        dst = (short*)(c.ws + WS_WKVT);
        for (long it = gtid; it < (long)4 * 1024 * 128; it += gsz) { const int k = (int)(it & 127); const long lf = it >> 7; const int f = (int)(lf & 1023), l = (int)(lf >> 10);
            dst[it] = (short)f2bf(P.in[11][l * 128 + k] * P.in[12][((size_t)l * 128 + k) * 1024 + f]); }
    }
    {
        short* dst = (short*)(c.ws + WS_WCS); const float* wf = P.in[15];
        for (long it = gtid; it < (long)4 * 4 * 128 * 256; it += gsz) {
            const int d = (int)(it & 127), ab = (int)((it >> 7) & 1), cc = (int)((it >> 8) & 127); const long lg = it >> 15;
            const float* w = wf + lg * 128 * 128 + d; const float* tt = tc + ab * 128;
            float a = 0;
            for (int j = 0; j < 128; ++j) a += tt[(cc * j) & 127] * w[j * 128];
            dst[it] = (short)f2bf(a * 0.08838834764831845f);
        }
    }
    {
        short* f1 = (short*)(c.ws + WS_F1);
        for (long it = gtid; it < 256 * 256; it += gsz) { const int kk = (int)(it & 255), m = (int)(it >> 8); const int k1 = (m >> 6) * 32 + (m & 31), ri = (m >> 5) & 1, n1 = kk >> 1, ab = kk & 1;
            const int a = (n1 * k1) & 127; const float cs = tc[a], sn = tc[128 + a];
            const float v = (ri == 0) ? (ab == 0 ? cs : -sn) : (ab == 0 ? -sn : -cs);
            f1[it] = (short)f2bf(v * 0.08838834764831845f); }
        short* f2 = (short*)(c.ws + WS_F2);
        for (long it = gtid; it < 128 * 256; it += gsz) { const int kk = (int)(it & 255), k2 = (int)(it >> 8); const int n2 = kk >> 1, ri = kk & 1;
            const int a = (n2 * k2) & 127; f2[it] = (short)f2bf((ri == 0 ? tc[a] : tc[128 + a]) * 0.08838834764831845f); }
        short* fc = (short*)(c.ws + WS_FC);
        for (long it = gtid; it < 256 * 512; it += gsz) { const int kk = (int)(it & 511), k = (int)(it >> 9); const int n = kk >> 1, ab = kk & 1;
            const int a = (n * k) & 255; const float v = ab == 0 ? cospif(a / 128.f) : -sinpif(a / 128.f); fc[it] = (short)f2bf(v * 0.0625f); }
        float2* tw = (float2*)(c.ws + WS_TW);
        for (long it = gtid; it < 16384; it += gsz) tw[it] = make_float2(cospif((float)it / 8192.f), sinpif((float)it / 8192.f));
        float2* rp = (float2*)(c.ws + WS_ROPE);
        for (long it = gtid; it < 256 * 8; it += gsz) { const int i = (int)(it & 7), pos = (int)(it >> 3); const float fr = powf(10000.f, -(float)i / 8.f); const float ang = (float)pos * fr;
            rp[it] = make_float2(cosf(ang), sinf(ang)); }
    }
}

DEVI void phase_coef(const Params& P, const Ctx& c) {
    TID_SETUP();
    const long gtid = (long)blockIdx.x * NTHR + tid; const long gsz = (long)c.G * NTHR;
    const float* modp = (const float*)(c.ws + WS_MODP); float* coef = (float*)(c.ws + WS_COEF);
    for (long it = gtid; it < (long)4 * 3 * 6144; it += gsz) {
        const int j = (int)(it % 6144); const int v = (int)((it / 6144) % 3); const int l = (int)(it / (6144 * 3));
        float m = P.in[5][l * 6144 + j];
        for (int ks = 0; ks < 8; ++ks) m += modp[((size_t)(ks * 4 + l) * 3 + v) * 6144 + j];
        const int chunk = j >> 10, col = j & 1023;
        float val; int slot;
        if (chunk == 0) { slot = 1; val = m; } else if (chunk == 1) { slot = 0; val = P.in[6][l * 1024 + col] * (1.f + m); } else if (chunk == 2) { slot = 2; val = m; }
        else if (chunk == 3) { slot = 4; val = m; } else if (chunk == 4) { slot = 3; val = P.in[7][l * 1024 + col] * (1.f + m); } else { slot = 5; val = m; }
        coef[((size_t)(l * 3 + v) * 6 + slot) * 1024 + col] = val;
    }
}

DEVI void phase_norm_mix(const Params& P, const Ctx& c, int l) {
    TID_SETUP();
    const float* coef = (const float*)(c.ws + WS_COEF) + (size_t)l * 3 * 6 * 1024;
    short* hbuf = (short*)(c.ws + WS_HBUF);
    for (int r = c.vcu * 8 + wid; r < T; r += c.G * 8) {
        const int v = row_variant(r);
        const float* a1 = coef + (size_t)(v * 6 + 0) * 1024; const float* b1 = coef + (size_t)(v * 6 + 1) * 1024;
        float xv[2][8]; float ss = 0;
        if (l == 0) { const float* x = in_row(P, r);
#pragma unroll
            for (int q = 0; q < 2; ++q) { const f32x4 t0 = *(const f32x4*)(x + q * 512 + lane * 8), t1 = *(const f32x4*)(x + q * 512 + lane * 8 + 4);
#pragma unroll
                for (int j = 0; j < 4; ++j) { xv[q][j] = t0[j]; xv[q][4 + j] = t1[j]; } } }
        else { const short* x = res_row(c, r);
#pragma unroll
            for (int q = 0; q < 2; ++q) { const u32x4 t = *(const u32x4*)(x + q * 512 + lane * 8);
#pragma unroll
                for (int j = 0; j < 4; ++j) { xv[q][2 * j] = bflo(t[j]); xv[q][2 * j + 1] = bfhi(t[j]); } } }
#pragma unroll
        for (int q = 0; q < 2; ++q)
#pragma unroll
            for (int j = 0; j < 8; ++j) ss += xv[q][j] * xv[q][j];
        ss = wave_sum(ss); const float rstd = rsqrtf(ss * (1.f / 1024.f) + EPS);
#pragma unroll
        for (int q = 0; q < 2; ++q) { const int col = q * 512 + lane * 8; const f32x4 a0 = *(const f32x4*)(a1 + col), a4 = *(const f32x4*)(a1 + col + 4), b0 = *(const f32x4*)(b1 + col), b4 = *(const f32x4*)(b1 + col + 4);
            float y[8];
#pragma unroll
            for (int j = 0; j < 4; ++j) { y[j] = xv[q][j] * rstd * a0[j] + b0[j]; y[4 + j] = xv[q][4 + j] * rstd * a4[j] + b4[j]; }
            *(u32x4*)(hbuf + (size_t)r * 1024 + col) = u32x4{cvtpk(y[0], y[1]), cvtpk(y[2], y[3]), cvtpk(y[4], y[5]), cvtpk(y[6], y[7])}; }
    }
}

DEVI u32x4 pack8(const float* p) {
    const unsigned a0 = cvtpk(p[0], p[1]), a1 = cvtpk(p[2], p[3]), b0 = cvtpk(p[4], p[5]), b1 = cvtpk(p[6], p[7]);
    auto r0 = __builtin_amdgcn_permlane32_swap(a0, b0, false, false); auto r1 = __builtin_amdgcn_permlane32_swap(a1, b1, false, false);
    return u32x4{r0[0], r1[0], r0[1], r1[1]};
}
template <int MB, int NB, class F> DEVI void for_acc_bf8(f32x16 (&acc)[MB][NB], int wm, int wn, int lane, F f) {
    const int r32 = lane & 31, hi = lane >> 5;
#pragma unroll
    for (int mb = 0; mb < MB; ++mb)
#pragma unroll
        for (int nb = 0; nb < NB; ++nb)
#pragma unroll
            for (int s = 0; s < 2; ++s) { float t[8];
#pragma unroll
                for (int j = 0; j < 8; ++j) t[j] = acc[mb][nb][8 * s + j];
                f((wm * MB + mb) * 32 + r32, (wn * NB + nb) * 32 + 16 * s + 8 * hi, pack8(t)); }
}
template <int MB, int NB, class F> DEVI void for_acc_f4(f32x16 (&acc)[MB][NB], int wm, int wn, int lane, F f) {
    const int r32 = lane & 31, hi = lane >> 5;
#pragma unroll
    for (int mb = 0; mb < MB; ++mb)
#pragma unroll
        for (int nb = 0; nb < NB; ++nb)
#pragma unroll
            for (int g = 0; g < 4; ++g) f((wm * MB + mb) * 32 + r32, (wn * NB + nb) * 32 + 8 * g + 4 * hi, f32x4{acc[mb][nb][4 * g], acc[mb][nb][4 * g + 1], acc[mb][nb][4 * g + 2], acc[mb][nb][4 * g + 3]});
}

DEVI void phase_inproj(const Params& P, const Ctx& c, int l) {
    TID_SETUP();
    const short* hbuf = (const short*)(c.ws + WS_HBUF); const short* WT = (const short*)(c.ws + WS_WIN) + (size_t)l * 1024 * 1024; short* zbuf = (short*)((char*)c.out);
    for (int u = c.vcu; u < 64; u += c.G) {
        const int rt = u >> 3, ct = u & 7; const int row0 = rt * 64, col0 = ct * 128;
        gemm_tile<1, 1, 2, 4, false, true>(c.lds + LDS_GEMM, 16,
            [&](int r) { return hbuf + (size_t)(row0 + r) * 1024; },
            [&](int n) { return WT + (size_t)(col0 + n) * 1024; },
            [&](f32x16 (&acc)[1][1], int wm, int wn) {
                for_acc_bf8<1, 1>(acc, wm, wn, lane, [&](int r, int cc, u32x4 v) { const int col = col0 + cc; if (col < INW) *(u32x4*)(zbuf + (size_t)(row0 + r) * ZLD + col) = v; });
            });
    }
    for (int u = c.vcu; u < 512; u += c.G) {
        const int rt = 2 + (u >> 2), ct = u & 3; const int row0 = rt * 256, col0 = ct * 256;
        __syncthreads();
        gemm256<false, 1>(c.lds + LDS_GEMM, 16, hbuf + (size_t)row0 * 1024, 1024, nullptr, WT + (size_t)col0 * 1024, 1024, 0, nullptr,
            [&](g8_acc& acc, int wr, int wc, int fr, int fq) {
                g8_for_acc8(acc, wr, wc, fr, fq, [&](int r, int cc, const float (&v)[8]) { const int col = col0 + cc;
                    if (col < INW) *(u32x4*)(zbuf + (size_t)(row0 + r) * ZLD + col) = u32x4{cvtpk(v[0], v[1]), cvtpk(v[2], v[3]), cvtpk(v[4], v[5]), cvtpk(v[6], v[7])}; });
            });
    }
}

template <int NCOL, int NTOK = 128> DEVI void tile_rowstat(const Ctx& c, int tid, int tok0, int col0, float* stat) {
    const short* zbuf = (const short*)((char*)c.out);
    constexpr int TPT = NTHR / NTOK, per = NCOL / TPT;
    const int t = tid / TPT, q = tid % TPT;
    const short* p = zbuf + (size_t)(tok0 + t) * ZLD + col0 + q * per;
    u32x4 w[per / 8];
#pragma unroll
    for (int i = 0; i < per / 8; ++i) w[i] = *(const u32x4*)(p + i * 8);
    float ss = 0;
#pragma unroll
    for (int i = 0; i < per / 8; ++i)
#pragma unroll
        for (int j = 0; j < 4; ++j) { const float a = bflo(w[i][j]), b = bfhi(w[i][j]); ss += a * a + b * b; }
    ss += __shfl_xor(ss, 1, 64); if constexpr (TPT == 4) ss += __shfl_xor(ss, 2, 64);
    if (q == 0) stat[t] = ss / (float)NCOL;
}
DEVI float half_sum(float v) { auto rr = __builtin_amdgcn_permlane32_swap(__float_as_uint(v), __float_as_uint(v), false, false); return __uint_as_float(rr[0]) + __uint_as_float(rr[1]); }

DEVI void rope16(float (&x)[16], int n, bool lat, int hi, const float2* ropetab) {
    if (!lat) return;
    const int prow = n >> 6, pcol = n & 63;
#pragma unroll
    for (int j = 0; j < 4; ++j) {
        const int i = j + 4 * hi;
        const float2 cr = ropetab[prow * 8 + i], cc = ropetab[pcol * 8 + i];
        const float a1 = x[j], a2 = x[j + 4]; x[j] = a1 * cr.x - a2 * cr.y; x[j + 4] = a2 * cr.x + a1 * cr.y;
        const float b1 = x[8 + j], b2 = x[12 + j]; x[8 + j] = b1 * cc.x - b2 * cc.y; x[12 + j] = b2 * cc.x + b1 * cc.y;
    }
}

template <int NB> DEVI void pc_q_unit(const Params& P, const Ctx& c, int l, int tok0, int hp, int tid, int lane) {
    const short* zbuf = (const short*)((char*)c.out);
    float* stat = (float*)(c.lds + LDS_STAT);
    const float2* ropetab = (const float2*)(c.ws + WS_ROPE);
    tile_rowstat<QLR, 128 * NB>(c, tid, tok0, 0, stat);
    const short* WQT = (const short*)(c.ws + WS_WQT) + ((size_t)l * 768 + hp * 192) * 256;
    const float* qn = P.in[13] + l * DQK;
    gemm_tile<3, NB, 2, 4, false, false>(c.lds + LDS_GEMM, 4,
        [&](int r) { return WQT + (size_t)r * 256; },
        [&](int n) { return zbuf + (size_t)(tok0 + n) * ZLD; },
        [&](f32x16 (&acc)[3][NB], int wm, int wn) {
#pragma unroll
            for (int nb = 0; nb < NB; ++nb) {
                const int hi = lane >> 5, r32 = lane & 31; const int tl = (wn * NB + nb) * 32 + r32, row = tok0 + tl, h = hp * 2 + wm;
                const bool lat = row >= T_CTX; const int rr = lat ? row - T_CTX : row; const int b = lat ? (rr >> 14) : (rr >> 8); const int n = lat ? (rr & 16383) : (rr & 255);
                const float s1 = rsqrtf(stat[tl] + EPS);
                float ss = 0;
#pragma unroll
                for (int mb = 0; mb < 3; ++mb)
#pragma unroll
                    for (int r = 0; r < 16; ++r) ss += acc[mb][nb][r] * acc[mb][nb][r];
                ss = half_sum(ss);
                const float s2 = rsqrtf(s1 * s1 * ss * (1.f / 96.f) + EPS); const float sc = s1 * s2 * ATT_QSCALE;
                float x[3][16];
#pragma unroll
                for (int mb = 0; mb < 3; ++mb)
#pragma unroll
                    for (int g4 = 0; g4 < 4; ++g4) { const f32x4 g = *(const f32x4*)(qn + mb * 32 + 8 * g4 + 4 * hi);
#pragma unroll
                        for (int j = 0; j < 4; ++j) x[mb][g4 * 4 + j] = acc[mb][nb][g4 * 4 + j] * sc * g[j]; }
                rope16(x[2], n, lat, hi, ropetab);
                short* dst = lat ? (short*)(c.ws + WS_QBUF) + ((size_t)(b * NH + h) * SEQ + n) * DQK : (short*)(c.ws + WS_QCTX) + ((size_t)(b * NH + h) * NCTX + n) * DQK;
#pragma unroll
                for (int mb = 0; mb < 3; ++mb)
#pragma unroll
                    for (int s = 0; s < 2; ++s) *(u32x4*)(dst + mb * 32 + s * 16 + hi * 8) = pack8(&x[mb][s * 8]);
            }
        });
}

template <int NB> DEVI void pc_kv_unit(const Params& P, const Ctx& c, int l, int tok0, int hp, int tid, int lane) {
    const short* zbuf = (const short*)((char*)c.out);
    float* stat = (float*)(c.lds + LDS_STAT);
    const float2* ropetab = (const float2*)(c.ws + WS_ROPE);
    tile_rowstat<KVLR, 128 * NB>(c, tid, tok0, QLR, stat);
    const short* WKVT = (const short*)(c.ws + WS_WKVT) + ((size_t)l * 1024 + hp * 256) * 128;
    const float* kn = P.in[14] + l * DQK;
    gemm_tile<4, NB, 2, 4, false, false, (NB == 1 ? 2 : 1)>(c.lds + LDS_GEMM, 2,
        [&](int r) { return WKVT + (size_t)r * 128; },
        [&](int n) { return zbuf + (size_t)(tok0 + n) * ZLD + QLR; },
        [&](f32x16 (&acc)[4][NB], int wm, int wn) {
#pragma unroll
            for (int nb = 0; nb < NB; ++nb) {
                const int hi = lane >> 5, r32 = lane & 31; const int tl = (wn * NB + nb) * 32 + r32, row = tok0 + tl, h = hp * 2 + wm;
                const bool lat = row >= T_CTX; const int rr = lat ? row - T_CTX : row; const int b = lat ? (rr >> 14) : (rr >> 8); const int n = lat ? (rr & 16383) : (rr & 255);
                const int pos = lat ? NCTX + n : n;
                const float s1 = rsqrtf(stat[tl] + EPS);
                float kr[16];
#pragma unroll
                for (int g4 = 0; g4 < 4; ++g4) { const u32x2 w = *(const u32x2*)(zbuf + (size_t)row * ZLD + QLR + KVLR + 8 * g4 + 4 * hi);
                    kr[g4 * 4 + 0] = bflo(w[0]); kr[g4 * 4 + 1] = bfhi(w[0]); kr[g4 * 4 + 2] = bflo(w[1]); kr[g4 * 4 + 3] = bfhi(w[1]); }
                float ss = 0;
#pragma unroll
                for (int mb = 0; mb < 2; ++mb)
#pragma unroll
                    for (int r = 0; r < 16; ++r) { const float t = acc[mb][nb][r] * s1; ss += t * t; }
#pragma unroll
                for (int r = 0; r < 16; ++r) ss += kr[r] * kr[r];
                ss = half_sum(ss);
                const float s2 = rsqrtf(ss * (1.f / 96.f) + EPS);
                float x[3][16];
#pragma unroll
                for (int mb = 0; mb < 3; ++mb)
#pragma unroll
                    for (int g4 = 0; g4 < 4; ++g4) { const f32x4 g = *(const f32x4*)(kn + mb * 32 + 8 * g4 + 4 * hi);
#pragma unroll
                        for (int j = 0; j < 4; ++j) x[mb][g4 * 4 + j] = (mb < 2 ? acc[mb][nb][g4 * 4 + j] * s1 : kr[g4 * 4 + j]) * s2 * g[j]; }
                rope16(x[2], n, lat, hi, ropetab);
                short* kd = (short*)(c.ws + WS_KBUF) + ((size_t)(b * NH + h) * NKEY + pos) * DQK;
#pragma unroll
                for (int mb = 0; mb < 3; ++mb)
#pragma unroll
                    for (int s = 0; s < 2; ++s) *(u32x4*)(kd + mb * 32 + s * 16 + hi * 8) = pack8(&x[mb][s * 8]);
                short* vd = (short*)(c.ws + WS_VBUF) + ((size_t)(b * NH + h) * NKEY + pos) * DV;
                float vv[2][16];
#pragma unroll
                for (int mb = 0; mb < 2; ++mb)
#pragma unroll
                    for (int r = 0; r < 16; ++r) vv[mb][r] = acc[2 + mb][nb][r] * s1;
#pragma unroll
                for (int mb = 0; mb < 2; ++mb)
#pragma unroll
                    for (int s = 0; s < 2; ++s) *(u32x4*)(vd + mb * 32 + s * 16 + hi * 8) = pack8(&vv[mb][s * 8]);
            }
        });
}

DEVI void phase_proj2(const Params& P, const Ctx& c, int l) {
    TID_SETUP();
    const short* zbuf = (const short*)((char*)c.out);
    for (int u = c.vcu + PC_U0; u < (l < DEPTH - 1 ? 1072 : 1056); u += c.G) {
        __syncthreads();
        if (u < 512) pc_q_unit<2>(P, c, l, T_CTX + (u >> 2) * 256, u & 3, tid, lane);
        else if (u < 1024) pc_kv_unit<2>(P, c, l, T_CTX + ((u - 512) >> 2) * 256, u & 3, tid, lane);
        else if (u < 1040) pc_q_unit<1>(P, c, l, ((u - 1024) >> 2) * 128, u & 3, tid, lane);
        else if (u < 1056) pc_kv_unit<1>(P, c, l, ((u - 1040) >> 2) * 128, u & 3, tid, lane);
        else {
            const int uu = u - 1056; const int rt = uu >> 3, g = (uu >> 1) & 3, ct = uu & 1; const int row0 = rt * 256;
            const short* W = (const short*)(c.ws + WS_WCS) + ((size_t)(l * 4 + g) * 128) * 256 + ct * 128; short* U = (short*)(c.ws + WS_UCTX);
            gemm_tile<2, 2, 4, 2, true, true>(c.lds + LDS_GEMM, 2,
                [&](int r) { return zbuf + (size_t)(row0 + r) * ZLD + 416 + g * 128; },
                [&](int k) { return W + (size_t)k * 256; },
                [&](f32x16 (&acc)[2][2], int wm, int wn) {
                    for_acc_bf8<2, 2>(acc, wm, wn, lane, [&](int r, int cc, u32x4 v) { *(u32x4*)(U + (size_t)(row0 + r) * 1024 + g * 256 + ct * 128 + cc) = v; });
                });
        }
    }
}

constexpr int AT_VB = 64 * 64 * 2, AT_KB = 64 * 256, AT_V = 0, AT_K = 3 * AT_VB, AT_WS = AT_K + 3 * AT_KB;
#define KSWZ(row, colB) ((row) * 256 + ((colB) ^ (((row) & 15) << 4)))

DEVI void att_exp16(f32x16& p, float& l) {
#pragma unroll
    for (int r = 0; r < 16; ++r) { p[r] = __builtin_amdgcn_exp2f(p[r]); l += p[r]; }
}
DEVI void att_pack(const f32x16& p0, const f32x16& p1, bf16x8& pa0, bf16x8& pa1, bf16x8& pa2, bf16x8& pa3) {
#define PK4(P, BASE, OUT) do { u32x4 w = {cvtpk(P[BASE + 0], P[BASE + 1]), cvtpk(P[BASE + 2], P[BASE + 3]), cvtpk(P[BASE + 4], P[BASE + 5]), cvtpk(P[BASE + 6], P[BASE + 7])}; \
    OUT = *reinterpret_cast<bf16x8*>(&w); } while (0)
    PK4(p0, 0, pa0); PK4(p0, 8, pa1); PK4(p1, 0, pa2); PK4(p1, 8, pa3);
#undef PK4
}
template <bool SHIFT> DEVI void att_qkt(f32x16& p0, f32x16& p1, const char* Ks, const bf16x8* qr, int r32, int hi, float init) {
    if constexpr (SHIFT) {
#pragma unroll
        for (int r = 0; r < 16; ++r) { p0[r] = init; p1[r] = init; }
    } else { p0 = f32x16{}; p1 = f32x16{}; }
    bf16x8 b0 = *reinterpret_cast<const bf16x8*>(Ks + KSWZ(r32, hi * 16));
    bf16x8 b1 = *reinterpret_cast<const bf16x8*>(Ks + KSWZ(32 + r32, hi * 16));
#pragma unroll
    for (int d0 = 0; d0 < 6; ++d0) {
        bf16x8 n0 = b0, n1 = b1;
        if (d0 < 5) { const int cb = ((d0 + 1) * 16 + hi * 8) * 2;
            n0 = *reinterpret_cast<const bf16x8*>(Ks + KSWZ(r32, cb)); n1 = *reinterpret_cast<const bf16x8*>(Ks + KSWZ(32 + r32, cb)); }
        p0 = __builtin_amdgcn_mfma_f32_32x32x16_bf16(b0, qr[d0], p0, 0, 0, 0);
        p1 = __builtin_amdgcn_mfma_f32_32x32x16_bf16(b1, qr[d0], p1, 0, 0, 0);
        b0 = n0; b1 = n1; }
}
constexpr int att_v_off(int d0, int ks, int half) { return d0 * 512 + ks * 2048 + half * 1024; }
struct VFrag { s16x4 l0, h0, l1, h1, l2, h2, l3, h3; };
template <int D0> DEVI void att_vread(VFrag& f, int vb) {
    f.l0 = tr_read<att_v_off(D0, 0, 0)>(vb); f.h0 = tr_read<att_v_off(D0, 0, 1)>(vb); f.l1 = tr_read<att_v_off(D0, 1, 0)>(vb); f.h1 = tr_read<att_v_off(D0, 1, 1)>(vb);
    f.l2 = tr_read<att_v_off(D0, 2, 0)>(vb); f.h2 = tr_read<att_v_off(D0, 2, 1)>(vb); f.l3 = tr_read<att_v_off(D0, 3, 0)>(vb); f.h3 = tr_read<att_v_off(D0, 3, 1)>(vb);
}
DEVI void att_pv_mm(f32x16& od, const VFrag& f, bf16x8 pa0, bf16x8 pa1, bf16x8 pa2, bf16x8 pa3) {
    od = __builtin_amdgcn_mfma_f32_32x32x16_bf16(pa0, PK8(f.l0, f.h0), od, 0, 0, 0);
    od = __builtin_amdgcn_mfma_f32_32x32x16_bf16(pa1, PK8(f.l1, f.h1), od, 0, 0, 0);
    od = __builtin_amdgcn_mfma_f32_32x32x16_bf16(pa2, PK8(f.l2, f.h2), od, 0, 0, 0);
    od = __builtin_amdgcn_mfma_f32_32x32x16_bf16(pa3, PK8(f.l3, f.h3), od, 0, 0, 0);
}
DEVI void att_lsum(f32x16& l, bf16x8 pa, bf16x8 pb) {
    const bf16x8 ones = {(short)0x3F80, (short)0x3F80, (short)0x3F80, (short)0x3F80, (short)0x3F80, (short)0x3F80, (short)0x3F80, (short)0x3F80};
    l = __builtin_amdgcn_mfma_f32_32x32x16_bf16(pa, ones, l, 0, 0, 0);
    l = __builtin_amdgcn_mfma_f32_32x32x16_bf16(pb, ones, l, 0, 0, 0);
}

template <bool SHIFT> DEVI void attn_body(const short* __restrict__ Qb, const short* __restrict__ Kh, const short* __restrict__ Vh, short* __restrict__ Ob, int seq, float shift, char* lds) {
    int tid = threadIdx.x; asm volatile("" : "+v"(tid)); const int wid = __builtin_amdgcn_readfirstlane(tid >> 6), lane = tid & 63, r32 = lane & 31, hi = lane >> 5;
    char* V_lds = lds + AT_V; char* K_lds = lds + AT_K;
    if (wid >= 4) __builtin_amdgcn_s_setprio(1);
    f32x16 o[2] = {f32x16{}, f32x16{}}; float l_reg = 0.f; bf16x8 qr[6];
    const short* Qw = Qb + (size_t)(wid * 32 + r32) * DQK + hi * 8;
#pragma unroll
    for (int d0 = 0; d0 < 6; ++d0) qr[d0] = *(const bf16x8*)(Qw + d0 * 16);
    const int kc0 = tid, kc1 = (tid + 512 < 768) ? tid + 512 : 767;
    const int kst0 = KSWZ(kc0 / 12, (kc0 % 12) * 16), kst1 = KSWZ(kc1 / 12, (kc1 % 12) * 16);
    const int vkey = tid >> 3, vcol = (tid & 7) * 8;
    const int vkk = vkey;
    const int vst = ((vkk >> 3) * 2 + (vcol >> 5)) * 512 + ((vkk & 7) * 32 + (vcol & 31)) * 2;
    const int vb0 = (int)(uintptr_t)V_lds + nn_rd_base(lane);
    struct { bf16x8 vs, k0, k1; } sr_;
    const int NT = seq / 64; const float init = -shift;
#define SLOAD(t) do { const int tt_ = (t) < NT ? (t) : NT - 1; sr_.vs = *(const bf16x8*)(Vh + (size_t)tt_ * 64 * DV + tid * 8); \
    sr_.k0 = *(const bf16x8*)(Kh + (size_t)tt_ * 64 * DQK + kc0 * 8); sr_.k1 = *(const bf16x8*)(Kh + (size_t)tt_ * 64 * DQK + kc1 * 8); } while (0)
#define SWRITE(b) do { *(bf16x8*)(V_lds + (b) * AT_VB + vst) = sr_.vs; *(bf16x8*)(K_lds + (b) * AT_KB + kst0) = sr_.k0; *(bf16x8*)(K_lds + (b) * AT_KB + kst1) = sr_.k1; } while (0)
    f32x16 pA0, pA1, pB0, pB1; bf16x8 pa0, pa1, pa2, pa3; VFrag vf, vf1;
#define STEP(PC0, PC1, PP0, PP1, TNEXT2, DOWRITE) do {                                                            \
        int bn = bc + 1; if (bn == 3) bn = 0;                                                                      \
        if (DOWRITE) SWRITE(bn);                                                                                   \
        SBAR(); SLOAD(TNEXT2);                                                                                     \
        SBAR(); att_vread<0>(vf, vb0 + bp * AT_VB); att_vread<1>(vf1, vb0 + bp * AT_VB);                           \
        att_qkt<SHIFT>(PC0, PC1, K_lds + bc * AT_KB, qr, r32, hi, init);                                           \
        att_exp16(PP1, l_reg); att_pack(PP0, PP1, pa0, pa1, pa2, pa3); SBAR();                                     \
        asm volatile("s_waitcnt lgkmcnt(0)" ::: "memory"); SBAR();                                                 \
        att_pv_mm(o[0], vf, pa0, pa1, pa2, pa3); att_pv_mm(o[1], vf1, pa0, pa1, pa2, pa3);                         \
        att_exp16(PC0, l_reg);                                                                                     \
        __syncthreads();                                                                                           \
        bp = bc; bc = bn; } while (0)
    SLOAD(0); asm volatile("s_waitcnt vmcnt(0)" ::: "memory"); SWRITE(0); SBAR(); SLOAD(1); __syncthreads();
    SWRITE(1); SBAR(); SLOAD(2); SBAR();
    att_qkt<SHIFT>(pA0, pA1, K_lds, qr, r32, hi, init); att_exp16(pA0, l_reg);
    __syncthreads();
    int bc = 1, bp = 0;
    for (int j = 1; j + 1 < NT; j += 2) {
        STEP(pB0, pB1, pA0, pA1, j + 2, true);
        STEP(pA0, pA1, pB0, pB1, j + 3, (j + 2 < NT));
    }
    STEP(pB0, pB1, pA0, pA1, NT - 1, false);
    att_vread<0>(vf, vb0 + bp * AT_VB);
    att_exp16(pB1, l_reg); att_pack(pB0, pB1, pa0, pa1, pa2, pa3); SBAR();
    asm volatile("s_waitcnt lgkmcnt(0)" ::: "memory"); SBAR();
    att_pv_mm(o[0], vf, pa0, pa1, pa2, pa3); att_vread<1>(vf, vb0 + bp * AT_VB); SBAR();
    asm volatile("s_waitcnt lgkmcnt(0)" ::: "memory"); SBAR();
    att_pv_mm(o[1], vf, pa0, pa1, pa2, pa3);
    __builtin_amdgcn_s_setprio(0);
    short* Ow = Ob + (size_t)(wid * 32) * 1024;
    { auto rr = __builtin_amdgcn_permlane32_swap(__float_as_uint(l_reg), __float_as_uint(l_reg), false, false); l_reg = __uint_as_float(rr[0]) + __uint_as_float(rr[1]); }
    float* li_l = (float*)(lds + AT_WS) + wid * 32;
    __syncthreads();
    if (hi == 0) li_l[r32] = l_reg; asm volatile("s_waitcnt lgkmcnt(0)" ::: "memory");
#pragma unroll
    for (int r = 0; r < 16; ++r) { const int orow = crow(r, hi); const float rl = __builtin_amdgcn_rcpf(li_l[orow]);
#pragma unroll
        for (int d0 = 0; d0 < 2; ++d0) Ow[(size_t)orow * 1024 + d0 * 32 + r32] = (short)f2bf(o[d0][r] * rl); }
    __syncthreads();
#undef SLOAD
#undef SWRITE
#undef STEP
}

DEVI void phase_attn_fft1(const Params& P, const Ctx& c, int l) {
    TID_SETUP();
    short* mix = (short*)(c.ws + WS_HBUF);
    const short* qb = (const short*)(c.ws + WS_QBUF); const short* qc = (const short*)(c.ws + WS_QCTX);
    const short* kb = (const short*)(c.ws + WS_KBUF); const short* vb = (const short*)(c.ws + WS_VBUF);
    const int n_att = (l < DEPTH - 1) ? 1040 : 1024;
    float shift;
    { float mq = 0.f, mk = 0.f;
      for (int i = lane; i < DQK; i += 64) { mq = fmaxf(mq, fabsf(P.in[13][l * DQK + i])); mk = fmaxf(mk, fabsf(P.in[14][l * DQK + i])); }
#pragma unroll
      for (int o = 32; o > 0; o >>= 1) { mq = fmaxf(mq, __shfl_xor(mq, o, 64)); mk = fmaxf(mk, __shfl_xor(mk, o, 64)); }
      shift = 9.797958971132712f * 1.4426950408889634f * mq * mk * 1.0001f; }
    for (int u = c.vcu; u < n_att; u += c.G) {
        const short* Qp; short* Op; int bh, seq;
        if (u < 1024) {
            const int rnd = u >> 8, v = u & 255, xcd = v >> 5, j = v & 31; bh = xcd * 2 + (rnd >> 1); const int qblk = j + 32 * (rnd & 1);
            Qp = qb + ((size_t)bh * SEQ + qblk * 256) * DQK; Op = mix + (size_t)(T_CTX + (bh >> 3) * SEQ + qblk * 256) * 1024 + (bh & 7) * DV; seq = NKEY;
        } else {
            bh = u - 1024; Qp = qc + (size_t)bh * NCTX * DQK; Op = mix + (size_t)((bh >> 3) * NCTX) * 1024 + (bh & 7) * DV; seq = NCTX;
        }
        if (shift < 64.f) attn_body<false>(Qp, kb + (size_t)bh * NKEY * DQK, vb + (size_t)bh * NKEY * DV, Op, seq, shift, c.lds + LDS_GEMM);
        else attn_body<true>(Qp, kb + (size_t)bh * NKEY * DQK, vb + (size_t)bh * NKEY * DV, Op, seq, shift, c.lds + LDS_GEMM);
    }
#ifndef ATT_ONLY
    const short* zbuf = (const short*)((char*)c.out); const short* F1 = (const short*)(c.ws + WS_F1); short* P1 = (short*)(c.ws + WS_P1);
    const float2* tw = (const float2*)(c.ws + WS_TW);
    for (int u = c.vcu; u < 1024; u += c.G) {
        const int n2 = u & 127, g = (u >> 7) & 3, b = u >> 9;
        const short* Zb = zbuf + (size_t)(T_CTX + b * SEQ + n2) * ZLD + 416 + g * 128;
        const short* W = (const short*)(c.ws + WS_WCS) + ((size_t)(l * 4 + g) * 128) * 256;
        short* Pb = P1 + ((size_t)(b * 4 + g) * 128 * 128 + n2) * 256;
        LAS char* Sres = (LAS char*)(c.lds + LDS_GEMM) + 65536;
        gemm_tile<1, 4, 4, 2, true, true, 1>(c.lds + LDS_GEMM, 2,
            [&](int r) { return Zb + (size_t)r * (128 * ZLD); },
            [&](int k) { return W + (size_t)k * 256; },
            [&](f32x16 (&acc)[1][4], int wm, int wn) {
                for_acc_bf8<1, 4>(acc, wm, wn, lane, [&](int n1, int cc, u32x4 v) { const int kk = 2 * n1 + (cc >> 7), cp = cc & 127;
                    *(LAS u32x4*)(Sres + (kk >> 6) * 16384 + nn_st<128>(kk & 63, cp)) = v; });
            });
        gemm_tile<2, 2, 4, 2, true, true, 2, true>(c.lds + LDS_GEMM, 4,
            [&](int r) { return F1 + (size_t)r * 256; },
            [&](int kk) { return (const short*)nullptr; },
            [&](f32x16 (&acc)[2][2], int wm, int wn) {
                const int hi = lane >> 5, r32 = lane & 31; const int k1 = wm * 32 + r32;
                const float2 t = tw[(n2 * k1) & 16383];
                short* p = Pb + (size_t)k1 * (128 * 256);
#pragma unroll
                for (int nb = 0; nb < 2; ++nb)
#pragma unroll
                    for (int s = 0; s < 2; ++s) { float yr[8], yi[8];
#pragma unroll
                        for (int j = 0; j < 8; ++j) { const float a = acc[0][nb][8 * s + j], bb = acc[1][nb][8 * s + j]; yr[j] = a * t.x + bb * t.y; yi[j] = bb * t.x - a * t.y; }
                        const int cc = (wn * 2 + nb) * 32 + 16 * s + 8 * hi;
                        *(u32x4*)(p + cc) = pack8(yr); *(u32x4*)(p + 128 + cc) = pack8(yi); }
            });
    }
    if (l < DEPTH - 1) {
        const short* FC = (const short*)(c.ws + WS_FC);
        for (int u = c.vcu; u < 8; u += c.G) {
            const int g = u & 3, b = u >> 2;
            const short* Ub = (const short*)(c.ws + WS_UCTX) + (size_t)(b * NCTX) * 1024 + g * 256;
            gemm_tile<2, 2, 4, 2, true, true>(c.lds + LDS_GEMM, 8,
                [&](int r) { return FC + (size_t)r * 512; },
                [&](int kk) { return Ub + (size_t)(kk >> 1) * 1024 + (kk & 1) * 128; },
                [&](f32x16 (&acc)[2][2], int wm, int wn) {
                    for_acc_bf8<2, 2>(acc, wm, wn, lane, [&](int r, int cc, u32x4 v) { *(u32x4*)(mix + (size_t)(b * NCTX + r) * 1024 + 512 + g * 128 + cc) = v; });
                });
        }
    }
#endif
}

DEVI void phase_fft2(const Params& P, const Ctx& c, int l) {
    TID_SETUP();
    short* mix = (short*)(c.ws + WS_HBUF); const short* P1 = (const short*)(c.ws + WS_P1); const short* F2 = (const short*)(c.ws + WS_F2);
    for (int u = c.vcu; u < 1024; u += c.G) {
        const int k1 = u & 127, g = (u >> 7) & 3, b = u >> 9;
        const short* Pb = P1 + ((size_t)(b * 4 + g) * 128 + k1) * (128 * 256);
        gemm_tile<1, 2, 4, 2, true, true>(c.lds + LDS_GEMM, 4,
            [&](int r) { return F2 + (size_t)r * 256; },
            [&](int kk) { return Pb + (size_t)kk * 128; },
            [&](f32x16 (&acc)[1][2], int wm, int wn) {
                for_acc_bf8<1, 2>(acc, wm, wn, lane, [&](int k2, int cc, u32x4 v) { *(u32x4*)(mix + (size_t)(T_CTX + b * SEQ + k1 + 128 * k2) * 1024 + 512 + g * 128 + cc) = v; });
            });
    }
}

DEVI void phase_outproj(const Params& P, const Ctx& c, int l) {
    TID_SETUP();
    const short* mix = (const short*)(c.ws + WS_HBUF); const short* WT = (const short*)(c.ws + WS_WOUT) + (size_t)l * 1024 * 1024;
    const float* coef = (const float*)(c.ws + WS_COEF) + (size_t)l * 3 * 6 * 1024;
    if (l < DEPTH - 1) for (int u = c.vcu; u < 64; u += c.G) {
        const int rt = u >> 3, ct = u & 7; const int row0 = rt * 64, col0 = ct * 128;
        const float* g1 = coef + (size_t)(2 * 6 + 2) * 1024;
        gemm_tile<1, 1, 2, 4, false, true>(c.lds + LDS_GEMM, 16,
            [&](int r) { return mix + (size_t)(row0 + r) * 1024; },
            [&](int n) { return WT + (size_t)(col0 + n) * 1024; },
            [&](f32x16 (&acc)[1][1], int wm, int wn) {
                for_acc_f4<1, 1>(acc, wm, wn, lane, [&](int r, int cc, f32x4 v) { const int row = row0 + r, col = col0 + cc;
                    const f32x4 x = res_load4(P, c, row, col, l), g = *(const f32x4*)(g1 + col);
                    st_bf4(res_row(c, row) + col, f32x4{x[0] + g[0] * v[0], x[1] + g[1] * v[1], x[2] + g[2] * v[2], x[3] + g[3] * v[3]}); });
            });
    }
    for (int u = c.vcu; u < 512; u += c.G) {
        const int rt = 2 + (u >> 2), ct = u & 3; const int row0 = rt * 256, col0 = ct * 256;
        const float* g1 = coef + (size_t)(row_variant(row0) * 6 + 2) * 1024;
        __syncthreads();
        gemm256<false, 1>(c.lds + LDS_GEMM, 16, mix + (size_t)row0 * 1024, 1024, nullptr, WT + (size_t)col0 * 1024, 1024, 0, nullptr,
            [&](g8_acc& acc, int wr, int wc, int fr, int fq) {
                g8_for_acc8(acc, wr, wc, fr, fq, [&](int r, int cc, const float (&v)[8]) { const int row = row0 + r, col = col0 + cc;
                    float x[8]; res_load8(P, c, row, col, l, x); const f32x4 g0 = *(const f32x4*)(g1 + col), g4 = *(const f32x4*)(g1 + col + 4);
#pragma unroll
                    for (int j = 0; j < 4; ++j) { x[j] += g0[j] * v[j]; x[4 + j] += g4[j] * v[4 + j]; }
                    *(u32x4*)(res_row(c, row) + col) = u32x4{cvtpk(x[0], x[1]), cvtpk(x[2], x[3]), cvtpk(x[4], x[5]), cvtpk(x[6], x[7])}; });
            });
    }
}

DEVI void phase_norm_route(const Params& P, const Ctx& c, int l) {
    TID_SETUP();
    const float* coef = (const float*)(c.ws + WS_COEF) + (size_t)l * 3 * 6 * 1024;
    short* hbuf = (short*)(c.ws + WS_HBUF);
    constexpr int XP = 2064;
    char* xs_hi = c.lds + LDS_GEMM; char* xs_lo = xs_hi + 16 * XP;
    int* lcnt = (int*)(c.lds + LDS_GEMM + 66560);
    int* lrow = lcnt + 64;
    float* lgt = (float*)(c.lds + LDS_GEMM + 73728);
    float* part = (float*)(c.lds + LDS_GEMM + 90112);
    const int rows_per = (T + c.G - 1) / c.G; const int r_begin = c.vcu * rows_per; const int r_lim = (l == DEPTH - 1) ? T_CTX : 0;
    int r_end = r_begin + rows_per; if (r_end > T) r_end = T;
    __syncthreads();
    if (tid < 64) lcnt[tid] = 0;
    int* rcls = (int*)(c.ws + WS_RCLS); float2* rw = (float2*)(c.ws + WS_RW);
    const int e16 = lane & 15, kq = lane >> 4;
    bf16x8 wh[4], wl[4];
#pragma unroll
    for (int s = 0; s < 4; ++s) { float v[8];
#pragma unroll
        for (int j = 0; j < 8; ++j) v[j] = P.in[17][(size_t)(128 * wid + 32 * s + 8 * kq + j) * 16 + e16];
        u32x4 h = {cvtpk(v[0], v[1]), cvtpk(v[2], v[3]), cvtpk(v[4], v[5]), cvtpk(v[6], v[7])};
        u32x4 lo = {cvtpk(v[0] - bflo(h[0]), v[1] - bfhi(h[0])), cvtpk(v[2] - bflo(h[1]), v[3] - bfhi(h[1])), cvtpk(v[4] - bflo(h[2]), v[5] - bfhi(h[2])), cvtpk(v[6] - bflo(h[3]), v[7] - bfhi(h[3]))};
        wh[s] = *reinterpret_cast<bf16x8*>(&h); wl[s] = *reinterpret_cast<bf16x8*>(&lo); }
    const int nrows = r_end - r_begin; const int nch = (nrows + 15) >> 4;
    u32x4 xn[2][2];
#pragma unroll
    for (int h = 0; h < 2; ++h) { int i = 8 * h + wid; if (i > nrows - 1) i = nrows - 1; const short* x = res_row(c, r_begin + i);
#pragma unroll
        for (int q = 0; q < 2; ++q) xn[h][q] = *(const u32x4*)(x + q * 512 + lane * 8); }
    for (int ch = 0; ch < nch; ++ch) {
#pragma unroll
        for (int h = 0; h < 2; ++h) {
            const int i = 16 * ch + 8 * h + wid; const bool valid = i < nrows; const int r = r_begin + (valid ? i : nrows - 1); const int v = row_variant(r);
            const float* a2 = coef + (size_t)(v * 6 + 3) * 1024; const float* b2 = coef + (size_t)(v * 6 + 4) * 1024;
            float xv[2][8]; float ss = 0;
#pragma unroll
            for (int q = 0; q < 2; ++q)
#pragma unroll
                for (int j = 0; j < 4; ++j) { xv[q][2 * j] = bflo(xn[h][q][j]); xv[q][2 * j + 1] = bfhi(xn[h][q][j]); ss += xv[q][2 * j] * xv[q][2 * j] + xv[q][2 * j + 1] * xv[q][2 * j + 1]; }
            if (ch + 1 < nch) { int i2 = i + 16; if (i2 > nrows - 1) i2 = nrows - 1; const short* x = res_row(c, r_begin + i2);
#pragma unroll
                for (int q = 0; q < 2; ++q) xn[h][q] = *(const u32x4*)(x + q * 512 + lane * 8); }
            ss = wave_sum(ss); const float rstd = rsqrtf(ss * (1.f / 1024.f) + EPS);
#pragma unroll
            for (int q = 0; q < 2; ++q) { const int col = q * 512 + lane * 8; const f32x4 a0 = *(const f32x4*)(a2 + col), a4 = *(const f32x4*)(a2 + col + 4), b0 = *(const f32x4*)(b2 + col), b4 = *(const f32x4*)(b2 + col + 4);
                float y[8];
#pragma unroll
                for (int j = 0; j < 4; ++j) { y[j] = xv[q][j] * rstd * a0[j] + b0[j]; y[4 + j] = xv[q][4 + j] * rstd * a4[j] + b4[j]; }
                const u32x4 o = {cvtpk(y[0], y[1]), cvtpk(y[2], y[3]), cvtpk(y[4], y[5]), cvtpk(y[6], y[7])};
                if (valid) *(u32x4*)(hbuf + (size_t)r * 1024 + col) = o;
                const u32x4 ol = {cvtpk(y[0] - bflo(o[0]), y[1] - bfhi(o[0])), cvtpk(y[2] - bflo(o[1]), y[3] - bfhi(o[1])), cvtpk(y[4] - bflo(o[2]), y[5] - bfhi(o[2])), cvtpk(y[6] - bflo(o[3]), y[7] - bfhi(o[3]))};
                *(LAS u32x4*)((LAS char*)xs_hi + (8 * h + wid) * XP + col * 2) = o; *(LAS u32x4*)((LAS char*)xs_lo + (8 * h + wid) * XP + col * 2) = ol; }
        }
        __syncthreads();
        if (ch > 0 && tid < 256) { const float* pp = part + ((ch - 1) & 1) * 2048 + tid; float sum = pp[0];
#pragma unroll
            for (int w = 1; w < 8; ++w) sum += pp[w * 256];
            lgt[(16 * (ch - 1)) * 16 + tid] = sum; }
        f32x4 acc = {0, 0, 0, 0};
#pragma unroll
        for (int s = 0; s < 4; ++s) { const int off = e16 * XP + (128 * wid + 32 * s + 8 * kq) * 2;
            const bf16x8 ah = *(LAS const bf16x8*)((LAS char*)xs_hi + off), al = *(LAS const bf16x8*)((LAS char*)xs_lo + off);
            acc = __builtin_amdgcn_mfma_f32_16x16x32_bf16(ah, wh[s], acc, 0, 0, 0);
            acc = __builtin_amdgcn_mfma_f32_16x16x32_bf16(ah, wl[s], acc, 0, 0, 0);
            acc = __builtin_amdgcn_mfma_f32_16x16x32_bf16(al, wh[s], acc, 0, 0, 0); }
        { float* pw = part + (ch & 1) * 2048 + wid * 256;
#pragma unroll
          for (int j = 0; j < 4; ++j) pw[(4 * kq + j) * 16 + e16] = acc[j]; }
        __syncthreads();
    }
    if (tid < 256) { const float* pp = part + ((nch - 1) & 1) * 2048 + tid; float sum = pp[0];
#pragma unroll
        for (int w = 1; w < 8; ++w) sum += pp[w * 256];
        lgt[(16 * (nch - 1)) * 16 + tid] = sum; }
    __syncthreads();
    for (int i = tid; i < r_end - r_begin; i += NTHR) {
        const int r = r_begin + i; if (r < r_lim) continue;
        float lg[16];
        { const f32x4 t0 = *(const f32x4*)(lgt + i * 16), t1 = *(const f32x4*)(lgt + i * 16 + 4), t2 = *(const f32x4*)(lgt + i * 16 + 8), t3 = *(const f32x4*)(lgt + i * 16 + 12);
#pragma unroll
          for (int j = 0; j < 4; ++j) { lg[j] = t0[j]; lg[4 + j] = t1[j]; lg[8 + j] = t2[j]; lg[12 + j] = t3[j]; } }
        float sc[16], bi[16];
#pragma unroll
        for (int e = 0; e < 16; ++e) { sc[e] = __builtin_amdgcn_rcpf(1.f + __expf(-lg[e])); bi[e] = sc[e] + P.in[18][e]; }
        int bg = 0; float bgs = -1e30f;
#pragma unroll
        for (int g = 0; g < 4; ++g) { float m1 = -1e30f, m2 = -1e30f;
#pragma unroll
            for (int j = 0; j < 4; ++j) { const float t = bi[g * 4 + j]; if (t > m1) { m2 = m1; m1 = t; } else if (t > m2) m2 = t; }
            const float gs = m1 + m2; if (gs > bgs) { bgs = gs; bg = g; } }
        float b4[4], s4[4];
#pragma unroll
        for (int j = 0; j < 4; ++j) { b4[j] = bg == 0 ? bi[j] : bg == 1 ? bi[4 + j] : bg == 2 ? bi[8 + j] : bi[12 + j]; s4[j] = bg == 0 ? sc[j] : bg == 1 ? sc[4 + j] : bg == 2 ? sc[8 + j] : sc[12 + j]; }
        int i1 = 0;
#pragma unroll
        for (int j = 1; j < 4; ++j) if (b4[j] > b4[i1]) i1 = j;
        int i2 = (i1 == 0) ? 1 : 0;
#pragma unroll
        for (int j = 0; j < 4; ++j) if (j != i1 && b4[j] > b4[i2]) i2 = j;
        const int ea = i1 < i2 ? i1 : i2, eb = i1 < i2 ? i2 : i1;
        float wa = 0, wb = 0;
#pragma unroll
        for (int j = 0; j < 4; ++j) { if (j == ea) wa = s4[j]; if (j == eb) wb = s4[j]; }
        const float inv = 1.f / (wa + wb);
        const int pidx = ea == 0 ? eb - 1 : ea == 1 ? eb + 1 : 5;
        const int cls = bg * 6 + pidx;
        const int lp = atomicAdd(&lcnt[cls], 1); lrow[i] = cls | (lp << 8); rcls[r] = cls; rw[r] = make_float2(wa * inv, wb * inv);
    }
    __syncthreads();
    int* gcnt = (int*)(c.ws + WS_CTL + CTL_CNT_OFF) + l * 32;
    if (tid < NCLS) lcnt[32 + tid] = lcnt[tid] > 0 ? (int)__hip_atomic_fetch_add(&gcnt[tid], lcnt[tid], __ATOMIC_RELAXED, __HIP_MEMORY_SCOPE_AGENT) : 0;
    __syncthreads();
    int* clist = (int*)(c.ws + WS_CLIST);
    for (int i = tid; i < r_end - r_begin; i += NTHR) { const int r = r_begin + i; if (r < r_lim) continue; const int w = lrow[i]; const int cls = w & 255, lp = w >> 8; clist[(size_t)cls * T + lcnt[32 + cls] + lp] = r; }
}

DEVI bool moe_decode(const int* gcnt, int u, int per_rt, int& cls, int& rt, int& sub, int& hpad, int& ccnt) {
    int acc_t = 0, acc_h = 0;
    for (int cc = 0; cc < NCLS; ++cc) { const int n = __builtin_amdgcn_readfirstlane(gcnt[cc]);
        const int nrt = (n + 255) >> 8; const int nt = nrt * per_rt;
        if (u < acc_t + nt) { cls = cc; const int loc = u - acc_t; rt = loc / per_rt; sub = loc % per_rt; hpad = acc_h; ccnt = n; return true; }
        acc_t += nt; acc_h += nrt * 256; }
    return false;
}
DEVI void cls_experts(int cls, int& ea, int& eb) { const int g = cls / 6, p = cls % 6; const int a = p < 3 ? 0 : p < 5 ? 1 : 2; const int b = p < 3 ? p + 1 : p < 5 ? p - 1 : 3; ea = g * 4 + a; eb = g * 4 + b; }

DEVI int moe_total(const int* gcnt, int per_rt) { int t = 0; for (int cc = 0; cc < NCLS; ++cc) { const int n = __builtin_amdgcn_readfirstlane(gcnt[cc]); t += ((n + 255) >> 8) * per_rt; } return t; }
DEVI int moe_nfull(int utot, int G) { const int nf = (utot / G) * G; return ((utot - nf) * 4 > 2 * G) ? utot : nf; }

DEVI void phase_moe_up(const Params& P, const Ctx& c, int l) {
    TID_SETUP();
    const int* gcnt = (const int*)(c.ws + WS_CTL + CTL_CNT_OFF) + l * 32;
    const short* hbuf = (const short*)(c.ws + WS_HBUF); short* Hm = (short*)(c.ws + WS_KBUF);
    const int* clist = (const int*)(c.ws + WS_CLIST); const float2* rw = (const float2*)(c.ws + WS_RW);
    int* ltok = (int*)(c.lds + LDS_STAT); float* lw = (float*)(c.lds + LDS_STAT + 1024);
    const int utot = moe_total(gcnt, 4), nfull = moe_nfull(utot, c.G);
    for (int it = c.vcu; it < nfull + (utot - nfull) * 4; it += c.G) {
        const bool fast = it < nfull; const int u = fast ? it : nfull + ((it - nfull) >> 2); const int q = (it - nfull) & 3;
        int cls, rt, ct, hpad, ccnt; if (!moe_decode(gcnt, u, 4, cls, rt, ct, hpad, ccnt)) break;
        int ea, eb; cls_experts(cls, ea, eb); const int e = ct < 2 ? ea : eb;
        __syncthreads();
        { int t2 = threadIdx.x; asm volatile("" : "+v"(t2));
          if (t2 < 256) { int i = rt * 256 + t2; if (i > ccnt - 1) i = ccnt - 1; const int tok = clist[(size_t)cls * T + i]; ltok[t2] = tok; const float2 w = rw[tok]; lw[t2] = ct < 2 ? w.x : w.y; } }
        asm volatile("s_waitcnt vmcnt(0)" ::: "memory");
        __syncthreads();
        const short* WT = (const short*)(c.ws + WS_WGU) + ((size_t)(l * 16 + e) * 512 + (ct & 1) * 256) * 1024;
        short* Hrow = Hm + (size_t)(hpad + rt * 256) * 512 + (ct >> 1) * 256;
        if (fast) {
            gemm256<true, 1>(c.lds + LDS_GEMM, 16, hbuf, 1024, ltok, WT, 1024, 0, nullptr,
                [&](g8_acc& acc, int wr, int wc, int fr, int fq) {
#pragma unroll
                    for (int ai = 0; ai < 2; ++ai)
#pragma unroll
                        for (int m = 0; m < 4; ++m) { SBAR(); const int row = ai * 128 + wr * 64 + m * 16 + fr; const float w = lw[row];
                            unsigned pk[2][2];
#pragma unroll
                            for (int bj = 0; bj < 2; ++bj) { const f32x4 g = acc[ai][bj][m][0], uu = acc[ai][bj][m][1]; float hv[4];
#pragma unroll
                                for (int j = 0; j < 4; ++j) hv[j] = silu(g[j]) * uu[j] * w;
                                pk[bj][0] = cvtpk(hv[0], hv[1]); pk[bj][1] = cvtpk(hv[2], hv[3]); }
                            auto r0 = __builtin_amdgcn_permlane16_swap(pk[0][0], pk[1][0], false, false); auto r1 = __builtin_amdgcn_permlane16_swap(pk[0][1], pk[1][1], false, false);
                            *(u32x4*)(Hrow + (size_t)row * 512 + ((ct & 1) * 8 + (fq & 1) * 4 + wc) * 16 + (fq & ~1) * 4) = u32x4{r0[0], r1[0], r0[1], r1[1]}; }
                });
        } else {
            gemm_tile<1, 2, 8, 1, false, true>(c.lds + LDS_GEMM, 16,
                [&](int r) { return hbuf + (size_t)ltok[r] * 1024; },
                [&](int n) { return WT + (size_t)(q * 64 + n) * 1024; },
                [&](f32x16 (&acc)[1][2], int wm, int wn) {
                    const int hi = lane >> 5, r32 = lane & 31; const int row = wm * 32 + r32; const float w = lw[row];
#pragma unroll
                    for (int nb = 0; nb < 2; ++nb)
#pragma unroll
                        for (int s = 0; s < 2; ++s) { float hv[4];
#pragma unroll
                            for (int j = 0; j < 4; ++j) hv[j] = silu(acc[0][nb][4 * s + j]) * acc[0][nb][8 + 4 * s + j] * w;
                            *(u32x2*)(Hrow + (size_t)row * 512 + ((ct & 1) * 8 + q * 2 + nb) * 16 + 8 * s + 4 * hi) = u32x2{cvtpk(hv[0], hv[1]), cvtpk(hv[2], hv[3])}; }
                });
        }
    }
}
DEVI void phase_moe_down(const Params& P, const Ctx& c, int l) {
    TID_SETUP();
    const int* gcnt = (const int*)(c.ws + WS_CTL + CTL_CNT_OFF) + l * 32;
    const short* Hm = (const short*)(c.ws + WS_KBUF);
    const int* clist = (const int*)(c.ws + WS_CLIST);
    const float* coef = (const float*)(c.ws + WS_COEF) + (size_t)l * 3 * 6 * 1024;
    unsigned long long* lrp = (unsigned long long*)(c.lds + LDS_STAT);
    const int utot = moe_total(gcnt, 4), nfull = moe_nfull(utot, c.G);
    for (int it = c.vcu; it < nfull + (utot - nfull) * 4; it += c.G) {
        const bool fast = it < nfull; const int u = fast ? it : nfull + ((it - nfull) >> 2); const int q = (it - nfull) & 3;
        int cls, rt, ct, hpad, ccnt; if (!moe_decode(gcnt, u, 4, cls, rt, ct, hpad, ccnt)) break;
        __syncthreads();
        { int t2 = threadIdx.x; asm volatile("" : "+v"(t2));
          if (t2 < 256) { int i = rt * 256 + t2; if (i > ccnt - 1) i = ccnt - 1; const int tok = clist[(size_t)cls * T + i]; lrp[t2] = (unsigned long long)(uintptr_t)res_row(c, tok) | (unsigned long long)row_variant(tok); } }
        asm volatile("s_waitcnt vmcnt(0)" ::: "memory");
        __syncthreads();
        const short* WT = (const short*)(c.ws + WS_WDN) + ((size_t)(l * NCLS + cls) * 1024 + ct * 256) * 512;
        const short* Ab = Hm + (size_t)(hpad + rt * 256) * 512;
        auto rmw = [&](int rl, int col, f32x4 v) { const int i = rt * 256 + rl;
            if (i < ccnt) { const unsigned long long pv = lrp[rl]; short* xr = (short*)(uintptr_t)(pv & ~3ull) + col; const f32x4 g = *(const f32x4*)(coef + (size_t)((int)(pv & 3ull) * 6 + 5) * 1024 + col);
                const f32x4 x = ld_bf4(xr); const f32x4 y = f32x4{x[0] + g[0] * v[0], x[1] + g[1] * v[1], x[2] + g[2] * v[2], x[3] + g[3] * v[3]};
                if (l < DEPTH - 1) st_bf4(xr, y);
                else *(f32x4*)((char*)c.out + (((size_t)(uintptr_t)xr - (size_t)(uintptr_t)(c.ws + WS_RES)) - (size_t)T_CTX * D * 2) * 2) = y; } };
        if (fast) {
            gemm256<false, 1>(c.lds + LDS_GEMM, 8, Ab, 512, nullptr, WT, 512, 0, nullptr,
                [&](g8_acc& acc, int wr, int wc, int fr, int fq) { g8_for_acc8(acc, wr, wc, fr, fq, [&](int rl, int cc, const float (&v)[8]) { const int col = ct * 256 + cc; const int i = rt * 256 + rl;
                    if (i < ccnt) { const unsigned long long pv = lrp[rl]; short* xr = (short*)(uintptr_t)(pv & ~3ull) + col; const float* gp = coef + (size_t)((int)(pv & 3ull) * 6 + 5) * 1024 + col;
                        const f32x4 g0 = *(const f32x4*)gp, g4 = *(const f32x4*)(gp + 4); const u32x4 w = *(const u32x4*)xr; float y[8];
#pragma unroll
                        for (int j = 0; j < 4; ++j) { y[2 * j] = bflo(w[j]); y[2 * j + 1] = bfhi(w[j]); }
#pragma unroll
                        for (int j = 0; j < 4; ++j) { y[j] += g0[j] * v[j]; y[4 + j] += g4[j] * v[4 + j]; }
                        if (l < DEPTH - 1) *(u32x4*)xr = u32x4{cvtpk(y[0], y[1]), cvtpk(y[2], y[3]), cvtpk(y[4], y[5]), cvtpk(y[6], y[7])};
                        else { float* op = (float*)((char*)c.out + (((size_t)(uintptr_t)xr - (size_t)(uintptr_t)(c.ws + WS_RES)) - (size_t)T_CTX * D * 2) * 2);
                            *(f32x4*)op = f32x4{y[0], y[1], y[2], y[3]}; *(f32x4*)(op + 4) = f32x4{y[4], y[5], y[6], y[7]}; } } }); });
        } else {
            gemm_tile<1, 2, 8, 1, false, true>(c.lds + LDS_GEMM, 8,
                [&](int r) { return Ab + (size_t)r * 512; },
                [&](int n) { return WT + (size_t)(q * 64 + n) * 512; },
                [&](f32x16 (&acc)[1][2], int wm, int wn) { for_acc_f4<1, 2>(acc, wm, wn, lane, [&](int rl, int cc, f32x4 v) { rmw(rl, ct * 256 + q * 64 + cc, v); }); });
        }
    }
}

__global__ void __launch_bounds__(NTHR, 2) mega_fwd(Params P) {
    extern __shared__ __attribute__((aligned(16))) char lds[];
    Ctx c;
    c.out = P.out; c.ws = P.ws; c.lds = lds; c.G = gridDim.x;
    { const int bx = blockIdx.x; c.vcu = (c.G % 8 == 0) ? (bx % 8) * (c.G / 8) + bx / 8 : bx; }
    volatile LAS unsigned* st = (volatile LAS unsigned*)(lds + LDS_MISC);
    if (threadIdx.x < 4) st[threadIdx.x] = 0u;
    __syncthreads();
    XcdBarrier bar = xcd_barrier_post((unsigned*)(P.ws + WS_CTL), st);
    int ph = 0;
#define PHASE_END() do { if (++ph >= P.nphases) return; if (ph > P.ph_lo) xcd_barrier(bar); } while (0)
    if ((PHMASK & 1) && ph >= P.ph_lo) phase_prologue(P, c); PHASE_END();
    if ((PHMASK & 2) && ph >= P.ph_lo) phase_coef(P, c); PHASE_END();
    for (int l = 0; l < DEPTH; ++l) {
        if ((PHMASK & 4) && ph >= P.ph_lo) { phase_norm_mix(P, c, l); if (REPMASK & 4) { xcd_barrier(bar); phase_norm_mix(P, c, l); } } PHASE_END();
        if ((PHMASK & 8) && ph >= P.ph_lo) { phase_inproj(P, c, l); if (REPMASK & 8) { xcd_barrier(bar); phase_inproj(P, c, l); } } PHASE_END();
        if ((PHMASK & 16) && ph >= P.ph_lo) { phase_proj2(P, c, l); if (REPMASK & 16) { xcd_barrier(bar); phase_proj2(P, c, l); } } PHASE_END();
        if ((PHMASK & 32) && ph >= P.ph_lo) { phase_attn_fft1(P, c, l); if (REPMASK & 32) { xcd_barrier(bar); phase_attn_fft1(P, c, l); } } PHASE_END();
        if ((PHMASK & 64) && ph >= P.ph_lo) { phase_fft2(P, c, l); if (REPMASK & 64) { xcd_barrier(bar); phase_fft2(P, c, l); } } PHASE_END();
        if ((PHMASK & 128) && ph >= P.ph_lo) { phase_outproj(P, c, l); if (REPMASK & 128) { xcd_barrier(bar); phase_outproj(P, c, l); } } PHASE_END();
        if ((PHMASK & 256) && ph >= P.ph_lo) { phase_norm_route(P, c, l); if (REPMASK & 256) { xcd_barrier(bar); phase_norm_route(P, c, l); } } PHASE_END();
        if ((PHMASK & 512) && ph >= P.ph_lo) { phase_moe_up(P, c, l); if (REPMASK & 512) { xcd_barrier(bar); phase_moe_up(P, c, l); } } PHASE_END();
        if ((PHMASK & 1024) && ph >= P.ph_lo) { phase_moe_down(P, c, l); if (REPMASK & 1024) { xcd_barrier(bar); phase_moe_down(P, c, l); } } PHASE_END();
    }
}


#ifdef DUMPDBG
__global__ void dump_kernel(float* out, const char* ws, int keep_out) {
    const size_t n = (size_t)T_LAT * D;
    for (size_t i = (size_t)blockIdx.x * blockDim.x + threadIdx.x; i < n; i += (size_t)gridDim.x * blockDim.x) {
        float v = keep_out ? out[i] : 0.f;
        const size_t offs[8] = {WS_HBUF, WS_ZBUF, WS_QBUF, WS_KBUF, WS_VBUF, WS_UBUF, WS_WCS, WS_WIN};
        const size_t lens[8] = {(size_t)T * 1024, (size_t)T * 1024, (size_t)BATCH * NH * SEQ * DQK, (size_t)BATCH * NH * NKEY * DQK, (size_t)BATCH * NH * NKEY * DV, (size_t)T * 1024, (size_t)4 * 4 * 128 * 256, (size_t)4 * 1024 * 1024};
#pragma unroll
        for (int b = 0; b < 8; ++b) {
            if (!((DUMPMASK >> b) & 1)) continue;
            const unsigned short u = ((const unsigned short*)(ws + offs[b]))[i % lens[b]];
            float f = __uint_as_float(((unsigned)u) << 16);
            if (!(fabsf(f) < 1e30f)) f = 777.f;
            v += f;
        }
        if (!(fabsf(v) < 1e30f)) v = 999.f;
        out[i] = v;
    }
}
#endif

#ifdef CHECKDBG
constexpr size_t WS_CHK = WS_END;
__device__ inline float blk_sum(float v, float* red) {
    for (int o = 32; o > 0; o >>= 1) v += __shfl_xor(v, o, 64);
    __syncthreads(); if ((threadIdx.x & 63) == 0) red[threadIdx.x >> 6] = v; __syncthreads();
    float t = 0; for (int i = 0; i < (int)blockDim.x / 64; ++i) t += red[i]; return t;
}
__device__ inline float blk_max(float v, float* red) {
    for (int o = 32; o > 0; o >>= 1) v = fmaxf(v, __shfl_xor(v, o, 64));
    __syncthreads(); if ((threadIdx.x & 63) == 0) red[threadIdx.x >> 6] = v; __syncthreads();
    float t = -1e30f; for (int i = 0; i < (int)blockDim.x / 64; ++i) t = fmaxf(t, red[i]); return t;
}
__global__ void chk_qkv(Params P) {
    __shared__ float red[8]; __shared__ float xin[256]; __shared__ float outv[128]; __shared__ float kr[32];
    const int s = blockIdx.x, tid = threadIdx.x;
    const int row = (s * 7919 + 13) % T; const int h = s & 7;
    const short* z = (const short*)P.out + (size_t)row * ZLD;
    const bool lat = row >= T_CTX; const int rr = lat ? row - T_CTX : row; const int b = lat ? (rr >> 14) : (rr >> 8); const int n = lat ? (rr & 16383) : (rr & 255);
    float* err = (float*)(P.ws + WS_CHK);
    const float2* ropetab = (const float2*)(P.ws + WS_ROPE);
    { const float cq = bf2f((unsigned short)z[tid]); const float ms = blk_sum(cq * cq, red) / 256.f; xin[tid] = cq * rsqrtf(ms + EPS) * P.in[9][tid]; __syncthreads();
      float u = 0; if (tid < 96) for (int k = 0; k < 256; ++k) u += xin[k] * P.in[10][(size_t)k * 768 + h * 96 + tid];
      const float ms2 = blk_sum(tid < 96 ? u * u : 0.f, red) / 96.f; if (tid < 96) outv[tid] = u * rsqrtf(ms2 + EPS) * P.in[13][tid]; __syncthreads();
      float val = 0; if (tid < 96) { val = outv[tid];
        if (lat && tid >= 64) { const int m = tid - 64; const int ax = m >> 4, i = m & 7, second = (m >> 3) & 1; const int pos = ax == 0 ? (n >> 6) : (n & 63); const float2 cs = ropetab[pos * 8 + i];
            const float x1 = outv[64 + ax * 16 + i], x2 = outv[64 + ax * 16 + 8 + i]; val = second ? (x2 * cs.x + x1 * cs.y) : (x1 * cs.x - x2 * cs.y); }
        val *= ATT_QSCALE; }
      const short* qd = lat ? (const short*)(P.ws + WS_QBUF) + ((size_t)(b * NH + h) * SEQ + n) * DQK : (const short*)(P.ws + WS_QCTX) + ((size_t)(b * NH + h) * NCTX + n) * DQK;
      const float got = tid < 96 ? bf2f((unsigned short)qd[tid]) : 0.f;
      const float d2 = blk_sum(tid < 96 ? (got - val) * (got - val) : 0.f, red), r2 = blk_sum(tid < 96 ? val * val : 0.f, red);
      if (tid == 0) { atomicAdd(&err[0], d2); atomicAdd(&err[1], r2); } }
    { __syncthreads(); const float ck = tid < 128 ? bf2f((unsigned short)z[256 + tid]) : 0.f; const float ms = blk_sum(ck * ck, red) / 128.f; if (tid < 128) xin[tid] = ck * rsqrtf(ms + EPS) * P.in[11][tid];
      if (tid < 32) kr[tid] = bf2f((unsigned short)z[384 + tid]); __syncthreads();
      float u = 0; if (tid < 128) for (int k = 0; k < 128; ++k) u += xin[k] * P.in[12][(size_t)k * 1024 + h * 128 + tid];
      float sq = 0; if (tid < 64) sq = u * u; else if (tid >= 128 && tid < 160) sq = kr[tid - 128] * kr[tid - 128];
      const float ms2 = blk_sum(sq, red) / 96.f; const float rs = rsqrtf(ms2 + EPS);
      if (tid < 64) outv[tid] = u * rs * P.in[14][tid]; if (tid >= 128 && tid < 160) outv[64 + tid - 128] = kr[tid - 128] * rs * P.in[14][64 + tid - 128]; __syncthreads();
      const int pos = lat ? NCTX + n : n;
      float val = 0; if (tid < 96) { val = outv[tid];
        if (lat && tid >= 64) { const int m = tid - 64; const int ax = m >> 4, i = m & 7, second = (m >> 3) & 1; const int pp = ax == 0 ? (n >> 6) : (n & 63); const float2 cs = ropetab[pp * 8 + i];
            const float x1 = outv[64 + ax * 16 + i], x2 = outv[64 + ax * 16 + 8 + i]; val = second ? (x2 * cs.x + x1 * cs.y) : (x1 * cs.x - x2 * cs.y); } }
      const short* kd = (const short*)(P.ws + WS_KBUF) + ((size_t)(b * NH + h) * NKEY + pos) * DQK;
      const float gotk = tid < 96 ? bf2f((unsigned short)kd[tid]) : 0.f;
      float d2 = blk_sum(tid < 96 ? (gotk - val) * (gotk - val) : 0.f, red), r2 = blk_sum(tid < 96 ? val * val : 0.f, red);
      if (tid == 0) { atomicAdd(&err[2], d2); atomicAdd(&err[3], r2); }
      const short* vd = (const short*)(P.ws + WS_VBUF) + ((size_t)(b * NH + h) * NKEY + pos) * DV;
      const bool isv = tid >= 64 && tid < 128; const float gotv = isv ? bf2f((unsigned short)vd[tid - 64]) : 0.f; const float vv = isv ? u : 0.f;
      d2 = blk_sum((gotv - vv) * (gotv - vv), red); r2 = blk_sum(vv * vv, red);
      if (tid == 0) { atomicAdd(&err[4], d2); atomicAdd(&err[5], r2); } }
}
__global__ void chk_attn(Params P) {
    extern __shared__ float pbuf[];
    __shared__ float red[8]; __shared__ float qv[96];
    const int s = blockIdx.x, tid = threadIdx.x; const int b = s & 1, h = (s >> 1) & 7; const bool ctxq = (s % 5) == 4; const int n = ctxq ? (s * 37) % NCTX : (s * 4099 + 77) % SEQ;
    const int bh = b * NH + h; const int nk = ctxq ? NCTX : NKEY;
    const short* q = ctxq ? (const short*)(P.ws + WS_QCTX) + ((size_t)bh * NCTX + n) * DQK : (const short*)(P.ws + WS_QBUF) + ((size_t)bh * SEQ + n) * DQK;
    const short* K = (const short*)(P.ws + WS_KBUF) + (size_t)bh * NKEY * DQK; const short* V = (const short*)(P.ws + WS_VBUF) + (size_t)bh * NKEY * DV;
    if (tid < 96) qv[tid] = bf2f((unsigned short)q[tid]); __syncthreads();
    float mx = -1e30f;
    for (int k = tid; k < nk; k += blockDim.x) { float a = 0; for (int d = 0; d < 96; ++d) a += qv[d] * bf2f((unsigned short)K[(size_t)k * DQK + d]); pbuf[k] = a; mx = fmaxf(mx, a); }
    mx = blk_max(mx, red);
    float sm = 0; for (int k = tid; k < nk; k += blockDim.x) { const float p = exp2f(pbuf[k] - mx); pbuf[k] = p; sm += p; }
    sm = blk_sum(sm, red);
    float o = 0; if (tid < 64) for (int k = 0; k < nk; ++k) o += pbuf[k] * bf2f((unsigned short)V[(size_t)k * DV + tid]);
    o /= sm;
    const short* mix = (const short*)(P.ws + WS_HBUF) + (size_t)(ctxq ? b * NCTX + n : T_CTX + b * SEQ + n) * 1024 + h * DV;
    const float got = tid < 64 ? bf2f((unsigned short)mix[tid]) : 0.f; const float ov = tid < 64 ? o : 0.f;
    const float d2 = blk_sum((got - ov) * (got - ov), red), r2 = blk_sum(ov * ov, red);
    float* err = (float*)(P.ws + WS_CHK);
    if (tid == 0) { atomicAdd(&err[6], d2); atomicAdd(&err[7], r2); }
}
__global__ void chk_fixup(float* out, const char* ws) {
    const float* err = (const float*)(ws + WS_CHK);
    float e = 0.f; bool zero = false;
    for (int k = 0; k < 4; ++k) if ((CHECKSEL >> k) & 1) { e = fmaxf(e, sqrtf(err[2 * k] / fmaxf(err[2 * k + 1], 1e-30f))); zero |= (err[2 * k + 1] == 0.f); }
    float f = 1.f; if (!(e < 0.006f)) f = 1.1f; if (!(e < 0.02f)) f = 1.3f; if (!(e < 0.1f)) f = 2.f; if (zero) f = 3.f;
    if (f == 1.f) return;
    const size_t n = (size_t)T_LAT * D;
    for (size_t i = (size_t)blockIdx.x * blockDim.x + threadIdx.x; i < n; i += (size_t)gridDim.x * blockDim.x) out[i] *= f;
}
#endif
#ifndef PHMASK
#define PHMASK 0xffff
#endif
#ifndef NPHASES
#define NPHASES 1000
#endif
extern "C" void kernel_launch(void* const* d_in, const int* in_sizes, int n_in, void* d_out, int out_size, void* d_ws, size_t ws_size, hipStream_t stream) {
    static int grid = 0;
    if (grid == 0) {
        if (n_in != 22 || out_size != T_LAT * D || ws_size < WS_END) { fprintf(stderr, "kernel_launch: shape/workspace mismatch (n_in %d out %d ws %zu need %zu)\n", n_in, out_size, ws_size, (size_t)WS_END); grid = -1; return; }
        int dev = 0, cus = 0, per_cu = 0;
        if (hipGetDevice(&dev) != hipSuccess || hipDeviceGetAttribute(&cus, hipDeviceAttributeMultiprocessorCount, dev) != hipSuccess) { grid = -1; return; }
        if (hipFuncSetAttribute((const void*)mega_fwd, hipFuncAttributeMaxDynamicSharedMemorySize, LDS_BYTES) != hipSuccess) { fprintf(stderr, "kernel_launch: hipFuncSetAttribute failed\n"); grid = -1; return; }
        if (hipOccupancyMaxActiveBlocksPerMultiprocessor(&per_cu, (const void*)mega_fwd, NTHR, LDS_BYTES) != hipSuccess || per_cu < 1) { fprintf(stderr, "kernel_launch: occupancy query says %d\n", per_cu); grid = -1; return; }
        (void)hipGetLastError();
#ifdef CHECKDBG
        (void)hipFuncSetAttribute((const void*)chk_attn, hipFuncAttributeMaxDynamicSharedMemorySize, NKEY * 4);
#endif
        grid = cus;
    }
    if (grid < 0) return;
    hipMemsetAsync((char*)d_ws + WS_CTL, 0, CTL_BYTES, stream);
    Params p{};
    for (int i = 0; i < 22; ++i) p.in[i] = (const float*)d_in[i];
    p.out = (float*)d_out; p.ws = (char*)d_ws; p.nphases = NPHASES; p.ph_lo = 0;
#ifdef CHECKDBG
    hipMemsetAsync((char*)d_ws + WS_CHK, 0, 64, stream);
    p.nphases = 5; hipLaunchKernelGGL(mega_fwd, dim3(grid), dim3(NTHR), LDS_BYTES, stream, p);
    hipLaunchKernelGGL(chk_qkv, dim3(512), dim3(256), 0, stream, p);
    hipMemsetAsync((char*)d_ws + WS_CTL, 0, CTL_BYTES, stream);
    p.nphases = 6; hipLaunchKernelGGL(mega_fwd, dim3(grid), dim3(NTHR), LDS_BYTES, stream, p);
    hipLaunchKernelGGL(chk_attn, dim3(160), dim3(256), NKEY * 4, stream, p);
    hipMemsetAsync((char*)d_ws + WS_CTL, 0, CTL_BYTES, stream);
    p.nphases = NPHASES;
#endif
#ifdef SPLIT_AT
    p.nphases = SPLIT_AT;
    hipLaunchKernelGGL(mega_fwd, dim3(grid), dim3(NTHR), LDS_BYTES, stream, p);
    hipMemsetAsync((char*)d_ws + WS_CTL, 0, XCD_BAR_WORDS * 4, stream);
    p.nphases = NPHASES; p.ph_lo = SPLIT_AT;
#endif
    hipLaunchKernelGGL(mega_fwd, dim3(grid), dim3(NTHR), LDS_BYTES, stream, p);
    const hipError_t le = hipPeekAtLastError();
    if (le != hipSuccess) fprintf(stderr, "kernel_launch: launch failed: %s\n", hipGetErrorName(le));
#ifdef CHECKDBG
    hipLaunchKernelGGL(chk_fixup, dim3(2048), dim3(256), 0, stream, (float*)d_out, (const char*)d_ws);
#endif
#ifdef DUMPDBG
    hipLaunchKernelGGL(dump_kernel, dim3(2048), dim3(256), 0, stream, (float*)d_out, (const char*)d_ws, (NPHASES >= 8) ? 1 : 0);
#endif
}
```

```cpp
#include <hip/hip_runtime.h>
#include <hip/hip_bf16.h>
#include <cstdint>
#include <cstdio>

#define DEVI __device__ __forceinline__
#define PC_U0 0


#define EXP_WAIT() asm volatile("s_waitcnt vmcnt(0)" ::: "memory")

#define CHECKSEL 8
#ifndef REPMASK
#define REPMASK 0
#endif
#ifndef PHMASK
#define PHMASK 0xffff
#endif

constexpr int D = 1024, BATCH = 2, SEQ = 16384, DEPTH = 4, NCTX = 256;
constexpr int T_CTX = BATCH * NCTX, T_LAT = BATCH * SEQ, T = T_CTX + T_LAT;
constexpr int NH = 8, DQK = 96, DV = 64, QLR = 256, KVLR = 128;
constexpr int NKEY = NCTX + SEQ;
constexpr int INW = 928;
constexpr int ZLD = 1024;
constexpr int NE = 16, DE = 256, NCLS = 24;
constexpr float EPS = 1e-6f;
constexpr float ATT_QSCALE = 0.10206207261596577f * 1.4426950408889634f;
constexpr int NTHR = 512;

constexpr size_t al256(size_t x) { return (x + 255) / 256 * 256; }
constexpr size_t WS_CTL   = 0;
constexpr size_t CTL_BYTES = 65536;
constexpr size_t CTL_CNT_OFF = 32768;
constexpr size_t WS_COEF  = WS_CTL + CTL_BYTES;
constexpr size_t WS_F1    = WS_COEF + al256((size_t)4 * 3 * 6 * 1024 * 4);
constexpr size_t WS_F2    = WS_F1 + 256 * 256 * 2;
constexpr size_t WS_FC    = WS_F2 + 128 * 256 * 2;
constexpr size_t WS_TW    = WS_FC + 256 * 512 * 2;
constexpr size_t WS_ROPE  = WS_TW + 16384 * 8;
constexpr size_t WS_WIN   = WS_ROPE + 256 * 8 * 8;
constexpr size_t WS_WOUT  = WS_WIN + (size_t)4 * 1024 * 1024 * 2;
constexpr size_t WS_WGU   = WS_WOUT + (size_t)4 * 1024 * 1024 * 2;
constexpr size_t WS_WDN   = WS_WGU + (size_t)4 * 16 * 1024 * 512 * 2;
constexpr size_t WS_WQT   = WS_WDN + (size_t)4 * NCLS * 1024 * 512 * 2;
constexpr size_t WS_WKVT  = WS_WQT + (size_t)4 * 768 * 256 * 2;
constexpr size_t WS_WCS   = WS_WKVT + (size_t)4 * 1024 * 128 * 2;
constexpr size_t WS_CTXR  = WS_WCS + (size_t)4 * 4 * 128 * 256 * 2;
constexpr size_t WS_RCLS  = WS_CTXR + (size_t)T_CTX * 1024 * 4;
constexpr size_t WS_RW    = WS_RCLS + al256((size_t)T * 4);
constexpr size_t WS_CLIST = WS_RW + al256((size_t)T * 8);
constexpr size_t WS_HBUF  = WS_CLIST + al256((size_t)NCLS * T * 4);
constexpr size_t WS_MODP  = WS_HBUF;
constexpr size_t WS_RES   = WS_HBUF + (size_t)T * 1024 * 2;
constexpr size_t WS_ZBUF  = WS_RES;
constexpr size_t WS_QBUF  = WS_ZBUF + (size_t)T * 1024 * 2;
constexpr size_t WS_QCTX  = WS_QBUF + (size_t)BATCH * NH * SEQ * DQK * 2;
constexpr size_t WS_KBUF  = WS_QCTX + (size_t)BATCH * NH * NCTX * DQK * 2;
constexpr size_t WS_VBUF  = WS_KBUF + (size_t)BATCH * NH * NKEY * DQK * 2;
constexpr size_t WS_UBUF  = WS_VBUF + (size_t)BATCH * NH * NKEY * DV * 2;
constexpr size_t WS_P1    = WS_UBUF;
constexpr size_t WS_UCTX  = WS_UBUF + (size_t)2 * 4 * 128 * 128 * 256 * 2;
static_assert(WS_UCTX + (size_t)T_CTX * 1024 * 2 <= WS_UBUF + (size_t)T * 1024 * 2, "P1 + ctx U fit the U region");
constexpr size_t WS_END   = WS_UBUF + (size_t)T * 1024 * 2;
static_assert((size_t)2 * 4 * 128 * 128 * 256 * 2 <= (size_t)T * 1024 * 2, "P1 fits zbuf region");
static_assert((size_t)(T + NCLS * 256) * 512 * 2 <= (size_t)BATCH * NH * NKEY * DQK * 2, "Hmoe (class-padded rows) fits kbuf region");
static_assert(WS_END <= (size_t)4 * T_LAT * D * 4, "workspace map must fit 4 x the largest tensor (the guaranteed d_ws size)");

constexpr int LDS_GEMM = 0;
constexpr int LDS_STAT = 128 * 1024;
constexpr int LDS_MISC = 132 * 1024;
constexpr int LDS_BYTES = 133 * 1024;

#define XB_TMO      128
#define XB_XCNT(j)  (256  + 64 * (j))
#define XB_XSUB(j)  (1280 + 64 * (j))
#define XB_XGEN(j)  (2304 + 64 * (j))
#define XB_TOP      3328
#define XB_TOPGEN   3392
#define XCD_BAR_WORDS 3456
#define XB_SPIN_CAP (1u << 24)
#define LAS __attribute__((address_space(3)))

DEVI unsigned xb_ld(unsigned* p)              { return __hip_atomic_load(p, __ATOMIC_RELAXED, __HIP_MEMORY_SCOPE_AGENT); }
DEVI unsigned xb_add(unsigned* p, unsigned v) { return __hip_atomic_fetch_add(p, v, __ATOMIC_RELAXED, __HIP_MEMORY_SCOPE_AGENT); }
DEVI unsigned xb_xcc_id() { return (unsigned)__builtin_amdgcn_s_getreg((3 << 11) | 20) & 0xFu; }
#define XB_SPIN(cond, bar) do { unsigned _sp = 0; while (cond) { __builtin_amdgcn_s_sleep(1); \
    if ((++_sp & 255u) == 0u) { if (xb_ld(&(bar)[XB_TMO])) break; if (_sp > XB_SPIN_CAP) { atomicAdd(&(bar)[XB_TMO], 1u); break; } } } } while (0)

struct XcdBarrier { unsigned* bar; unsigned x; volatile LAS unsigned* st; };

DEVI XcdBarrier xcd_barrier_post(unsigned* bar, volatile LAS unsigned* st) {
    XcdBarrier b; b.bar = bar; b.x = xb_xcc_id(); b.st = st;
    if (threadIdx.x == 0) (void)xb_add(&bar[XB_XCNT(b.x)], 1u);
    return b;
}
DEVI void xcd_barrier_complete(unsigned* bar, unsigned x, unsigned& nloc, unsigned& nx) {
    const unsigned G = gridDim.x * gridDim.y * gridDim.z;
    unsigned sum, cnt, mine, sp = 0u;
    for (;;) {
        sum = 0u; cnt = 0u; mine = 0u;
#pragma unroll
        for (unsigned j = 0; j < 16; ++j) { const unsigned c = xb_ld(&bar[XB_XCNT(j)]); sum += c; cnt += (c > 0u) ? 1u : 0u; mine = (j == x) ? c : mine; }
        if (sum == G) break;
        __builtin_amdgcn_s_sleep(1);
        if ((++sp & 255u) == 0u) { if (xb_ld(&bar[XB_TMO])) break; if (sp > XB_SPIN_CAP) { atomicAdd(&bar[XB_TMO], 1u); break; } }
    }
    nloc = mine > 0u ? mine : 1u; nx = cnt > 0u ? cnt : 1u;
}
DEVI void xcd_barrier(const XcdBarrier& b) {
    asm volatile("s_waitcnt vmcnt(0)" ::: "memory");
    __syncthreads();
    if (threadIdx.x == 0) {
        unsigned* bar = b.bar;
        __builtin_amdgcn_s_waitcnt(0);
        unsigned nloc = b.st[0], nx = b.st[1];
        if (nloc == 0u) { xcd_barrier_complete(bar, b.x, nloc, nx); b.st[0] = nloc; b.st[1] = nx; }
        const unsigned old = xb_add(&bar[XB_XSUB(b.x)], 1u);
        const unsigned gen = old / nloc;
        if (old + 1u == (gen + 1u) * nloc) {
            __builtin_amdgcn_fence(__ATOMIC_RELEASE, "agent");
            asm volatile("s_waitcnt vmcnt(0)" ::: "memory");
            const unsigned og = xb_add(&bar[XB_TOP], 1u);
            const unsigned tg = og / nx;
            if (og + 1u == (tg + 1u) * nx) xb_add(&bar[XB_TOPGEN], 1u);
            else XB_SPIN(xb_ld(&bar[XB_TOPGEN]) == tg, bar);
            __builtin_amdgcn_fence(__ATOMIC_ACQUIRE, "agent");
            xb_add(&bar[XB_XGEN(b.x)], 1u);
            asm volatile("s_waitcnt vmcnt(0)" ::: "memory");
        } else {
            XB_SPIN(xb_ld(&bar[XB_XGEN(b.x)]) == gen, bar);
            __builtin_amdgcn_fence(__ATOMIC_ACQUIRE, "agent");
            asm volatile("s_waitcnt vmcnt(0)" ::: "memory");
        }
    }
    __syncthreads();
}

using bf16x8 = __attribute__((ext_vector_type(8))) short;
using s16x4  = __attribute__((ext_vector_type(4))) short;
using f32x16 = __attribute__((ext_vector_type(16))) float;
using f32x4  = __attribute__((ext_vector_type(4))) float;
using u32x4  = __attribute__((ext_vector_type(4))) unsigned;
using u32x2  = __attribute__((ext_vector_type(2))) unsigned;
#define SBAR() __builtin_amdgcn_sched_barrier(0)

DEVI int crow(int r, int hi) { return (r & 3) + 8 * (r >> 2) + 4 * hi; }
DEVI unsigned cvtpk(float lo, float hi) { unsigned r; asm volatile("v_cvt_pk_bf16_f32 %0, %1, %2" : "=v"(r) : "v"(lo), "v"(hi)); return r; }
DEVI unsigned short f2bf(float x) { return (unsigned short)(cvtpk(x, 0.f) & 0xffffu); }
DEVI float bf2f(unsigned short u) { return __uint_as_float(((unsigned)u) << 16); }
DEVI float bflo(unsigned u) { return __uint_as_float(u << 16); }
DEVI float bfhi(unsigned u) { return __uint_as_float(u & 0xffff0000u); }
DEVI float wave_sum(float v) {
#pragma unroll
    for (int o = 32; o > 0; o >>= 1) v += __shfl_xor(v, o, 64);
    return v;
}
DEVI float silu(float x) { return x * __builtin_amdgcn_rcpf(1.f + __expf(-x)); }

DEVI int row_variant(int r) { return r < T_CTX ? 2 : ((r - T_CTX) >> 14); }

template <int BN> DEVI int nn_st(int k, int c) {
    const int kk = (k & ~0xC) | ((k & 4) << 1) | ((k & 8) >> 1);
    return ((kk >> 3) * (BN / 32) + (c >> 5)) * 512 + ((kk & 7) * 32 + (c & 31)) * 2;
}
DEVI int nn_rd_base(int lane) { return ((lane & 3) << 3) | (((lane >> 2) & 3) << 6) | (((lane >> 4) & 1) << 5) | (((lane >> 5) & 1) << 8); }
template <int OFF> DEVI s16x4 tr_read(int vb) {
    s16x4 r; asm volatile("ds_read_b64_tr_b16 %0, %1 offset:%2" : "=&v"(r) : "v"(vb), "i"(OFF) : "memory"); return r;
}
#define PK8(L, H) (bf16x8){L[0], L[1], L[2], L[3], H[0], H[1], H[2], H[3]}

typedef s16x4 LAS * lds_s16x4_ptr;
template <int MB, int NB, int WM, int WN, bool BNN, bool SWAPC, int STAGES = 2, bool BRES = false, class AF, class BF, class EF>
DEVI void gemm_tile(char* lds, int nk_in, AF arow, BF brow, EF epi) {
    int nk = nk_in; asm volatile("" : "+s"(nk));
    constexpr int BM = 32 * MB * WM, BN = 32 * NB * WN;
    constexpr int ABYTES = BM * 128, BBYTES = BN * 128;
    constexpr int ACH = BM / 64, BCH = BN / 64;
    static_assert(WM * WN == 8, "8 waves");
    static_assert(2 * ABYTES + 2 * BBYTES <= 128 * 1024, "LDS");
    int tid = threadIdx.x; asm volatile("" : "+v"(tid)); const int lane = tid & 63, wid = __builtin_amdgcn_readfirstlane(tid >> 6);
    const int wm = wid / WN, wn = wid % WN, r32 = lane & 31, hi = lane >> 5;
    LAS char* Abase = (LAS char*)lds; LAS char* Bbase = BRES ? Abase + 65536 : Abase + 2 * ABYTES;
    static_assert(!BRES || 2 * ABYTES <= 65536, "resident B image sits at +64 KB");
    const short* ap[ACH]; int aoff[ACH];
#pragma unroll
    for (int i = 0; i < ACH; ++i) { const int id = tid + NTHR * i, row = id >> 3, c = id & 7; ap[i] = (const short*)arow(row) + c * 8; aoff[i] = row * 128 + ((c ^ ((row >> 1) & 7)) << 4); }
    const short* bp[BCH]; int boff[BCH];
#pragma unroll
    for (int i = 0; i < BCH; ++i) {
        const int id = tid + NTHR * i;
        if constexpr (!BNN) { const int row = id >> 3, c = id & 7; bp[i] = (const short*)brow(row) + c * 8; boff[i] = row * 128 + ((c ^ ((row >> 1) & 7)) << 4); }
        else { const int krow = id / (BN / 8), c = id % (BN / 8); boff[i] = nn_st<BN>(krow, c * 8); bp[i] = nullptr; }
    }
    const int swz = (r32 >> 1) & 7;
    const int afr0 = (wm * 32 * MB + r32) * 128, bfr0 = (wn * 32 * NB + r32) * 128;
    const int bvb = nn_rd_base(lane) + wn * NB * 512;

    f32x16 acc[MB][NB];
#pragma unroll
    for (int i = 0; i < MB; ++i)
#pragma unroll
        for (int j = 0; j < NB; ++j) acc[i][j] = f32x16{};
    bf16x8 ra0[ACH], rb0[BCH], ra1[ACH], rb1[BCH];
#define G_LOAD(RA, RB, T) do {                                                                                                     \
        _Pragma("unroll") for (int i = 0; i < ACH; ++i) RA[i] = *(const bf16x8*)(ap[i] + (T) * 64);                                \
        if constexpr (!BRES) { _Pragma("unroll") for (int i = 0; i < BCH; ++i) { if constexpr (!BNN) RB[i] = *(const bf16x8*)(bp[i] + (T) * 64);          \
            else { const int id = tid + NTHR * i; RB[i] = *(const bf16x8*)((const short*)brow((T) * 64 + id / (BN / 8)) + (id % (BN / 8)) * 8); } } } } while (0)
#define G_WRITE(RA, RB, BUF) do {                                                                                                  \
        _Pragma("unroll") for (int i = 0; i < ACH; ++i) *(LAS bf16x8*)(Abase + (BUF) * ABYTES + aoff[i]) = RA[i];                  \
        if constexpr (!BRES) { _Pragma("unroll") for (int i = 0; i < BCH; ++i) *(LAS bf16x8*)(Bbase + (BUF) * BBYTES + boff[i]) = RB[i]; } } while (0)
#define G_COMPUTE(BUF, KT) do {                                                                                                    \
        LAS const char* As = Abase + (BUF) * ABYTES; LAS const char* Bs = Bbase + (BRES ? (KT) : (BUF)) * BBYTES;                  \
        _Pragma("unroll") for (int ks = 0; ks < 4; ++ks) {                                                                         \
            bf16x8 a[MB], b[NB];                                                                                                   \
            const int so = ((ks * 2 + hi) ^ swz) << 4;                                                                             \
            _Pragma("unroll") for (int mb = 0; mb < MB; ++mb) a[mb] = *(LAS const bf16x8*)(As + afr0 + so + mb * 4096);            \
            _Pragma("unroll") for (int nb = 0; nb < NB; ++nb) {                                                                    \
                if constexpr (BNN) {                                                                                               \
                    const s16x4 l = __builtin_amdgcn_ds_read_tr16_b64_v4i16((lds_s16x4_ptr)(Bs + bvb + nb * 512 + ks * (2 * (BN / 32) * 512)));                        \
                    const s16x4 h = __builtin_amdgcn_ds_read_tr16_b64_v4i16((lds_s16x4_ptr)(Bs + bvb + nb * 512 + ks * (2 * (BN / 32) * 512) + (BN / 32) * 512));      \
                    b[nb] = PK8(l, h);                                                                                             \
                } else b[nb] = *(LAS const bf16x8*)(Bs + bfr0 + so + nb * 4096);                                                   \
            }                                                                                                                      \
            _Pragma("unroll") for (int mb = 0; mb < MB; ++mb)                                                                      \
                _Pragma("unroll") for (int nb = 0; nb < NB; ++nb) acc[mb][nb] = SWAPC ? __builtin_amdgcn_mfma_f32_32x32x16_bf16(b[nb], a[mb], acc[mb][nb], 0, 0, 0) : __builtin_amdgcn_mfma_f32_32x32x16_bf16(a[mb], b[nb], acc[mb][nb], 0, 0, 0); \
        } } while (0)
    if constexpr (STAGES == 2) {
    G_LOAD(ra0, rb0, 0); G_LOAD(ra1, rb1, 1); SBAR();
    G_WRITE(ra0, rb0, 0);
    __syncthreads();
    int kt = 0;
    for (; kt + 2 < nk; kt += 2) {
        SBAR(); G_LOAD(ra0, rb0, kt + 2); SBAR();
        G_COMPUTE(0, kt); SBAR();
        G_WRITE(ra1, rb1, 1);
        __syncthreads();
        SBAR(); G_LOAD(ra1, rb1, kt + 3); SBAR();
        G_COMPUTE(1, kt + 1); SBAR();
        G_WRITE(ra0, rb0, 0);
        __syncthreads();
    }
    SBAR(); G_COMPUTE(0, kt); SBAR();
    G_WRITE(ra1, rb1, 1);
    __syncthreads();
    SBAR(); G_COMPUTE(1, kt + 1); SBAR();
    __syncthreads();
    } else {
    G_LOAD(ra0, rb0, 0); SBAR();
    G_WRITE(ra0, rb0, 0);
    __syncthreads();
    for (int kt = 0; kt < nk; ++kt) {
        const int cur = kt & 1;
        if (kt + 1 < nk) { SBAR(); G_LOAD(ra0, rb0, kt + 1); SBAR(); }
        G_COMPUTE(cur, kt); SBAR();
        if (kt + 1 < nk) G_WRITE(ra0, rb0, cur ^ 1);
        __syncthreads();
    }
    }
#undef G_LOAD
#undef G_WRITE
#undef G_COMPUTE
    epi(acc, wm, wn);
}


typedef __attribute__((address_space(1))) const unsigned* g8_gptr;
typedef __attribute__((address_space(3))) unsigned* g8_lptr;
constexpr int G8_HT = 128 * 64;
DEVI int g8_lds_byte(int r, int c) { const int st = (r >> 4) * 2 + (c >> 5), rr = r & 15, cc = c & 31, ob = rr * 64 + cc * 2; return st * 1024 + (ob ^ (((ob >> 9) & 1) << 5)); }
DEVI void g8_stage_rc(int b, int& R, int& C) { const int st = b / 1024, sb = b % 1024, swz = sb ^ (((sb >> 9) & 1) << 5); R = (st >> 1) * 16 + swz / 64; C = (st & 1) * 32 + (swz % 64) / 2; }
typedef f32x4 g8_acc[2][2][4][2];

template <bool GATHER, int NPASS, class EPI>
DEVI void gemm256(char* ldsb, int nt, const short* A, int lda, const int* ltok, const short* Bt, int ldb, int apass, const short* Bt2, EPI epi) {
    short* shm = (short*)ldsb;
#define SA(b, h) (shm + ((b) * 2 + (h)) * G8_HT)
#define SB(b, h) (shm + (4 + (b) * 2 + (h)) * G8_HT)
#define STAGE_A(P_, h_, kt_) do { _Pragma("unroll") for (int _i = 0; _i < 2; ++_i) { \
        const unsigned _o = (GATHER ? ao[(h_) * 2 + _i] : ao[0] + (unsigned)(((h_) * 128 + _i * 64) * lda * 2)) + (unsigned)((kt_) * 128); \
        __builtin_amdgcn_global_load_lds((g8_gptr)((const char*)A + (size_t)_o), (g8_lptr)((char*)(P_) + tz * 16 + _i * 8192), 16, 0, 0); } } while (0)
#define STAGE_B(P_, h_, kt_) do { _Pragma("unroll") for (int _i = 0; _i < 2; ++_i) { \
        const unsigned _o = bo + (unsigned)(((h_) * 128 + _i * 64) * ldb * 2) + (unsigned)((kt_) * 128); \
        __builtin_amdgcn_global_load_lds((g8_gptr)((const char*)Bt + (size_t)_o), (g8_lptr)((char*)(P_) + tz * 16 + _i * 8192), 16, 0, 0); } } while (0)
#define LDA(dst, b, h) _Pragma("unroll") for (int m = 0; m < 4; ++m) _Pragma("unroll") for (int k = 0; k < 2; ++k) \
        dst[m][k] = *reinterpret_cast<const bf16x8*>((char*)SA(b, h) + g8_lds_byte(wr * 64 + m * 16 + fr, k * 32 + fq * 8))
#define LDB(dst, b, h) _Pragma("unroll") for (int n = 0; n < 2; ++n) _Pragma("unroll") for (int k = 0; k < 2; ++k) \
        dst[n][k] = *reinterpret_cast<const bf16x8*>((char*)SB(b, h) + g8_lds_byte(wc * 32 + n * 16 + fr, k * 32 + fq * 8))
#define MMA(ai, bj, At_, Bt_) do { __builtin_amdgcn_s_setprio(1); \
        _Pragma("unroll") for (int m = 0; m < 4; ++m) _Pragma("unroll") for (int n = 0; n < 2; ++n) _Pragma("unroll") for (int k = 0; k < 2; ++k) \
            acc[ai][bj][m][n] = __builtin_amdgcn_mfma_f32_16x16x32_bf16(Bt_[n][k], At_[m][k], acc[ai][bj][m][n], 0, 0, 0); \
        __builtin_amdgcn_s_setprio(0); } while (0)
#define WAIT_V(n) asm volatile("s_waitcnt vmcnt(" #n ")" ::: "memory")
#define WAIT_L(n) asm volatile("s_waitcnt lgkmcnt(" #n ")" ::: "memory")
#define BAR __builtin_amdgcn_s_barrier()
#define SCHED __builtin_amdgcn_sched_barrier(0)
    int tz = threadIdx.x; asm volatile("" : "+v"(tz));
    int wid = __builtin_amdgcn_readfirstlane(tz >> 6), lane = tz & 63, wr = wid >> 2, wc = wid & 3, fr = lane & 15, fq = lane >> 4;
    unsigned ao[4], bo;
    { int r0, c0; g8_stage_rc(tz * 16, r0, c0);
      if constexpr (GATHER) {
#pragma unroll
          for (int q = 0; q < 4; ++q) ao[q] = (unsigned)(ltok[(q >> 1) * 128 + (q & 1) * 64 + r0] * lda + c0) * 2u;
      } else { ao[0] = (unsigned)(r0 * lda + c0) * 2u; ao[1] = ao[2] = ao[3] = 0; }
      bo = (unsigned)(r0 * ldb + c0) * 2u; }
    g8_acc acc;
#pragma unroll
    for (int a = 0; a < 2; ++a)
#pragma unroll
        for (int b = 0; b < 2; ++b)
#pragma unroll
            for (int m = 0; m < 4; ++m)
#pragma unroll
                for (int n = 0; n < 2; ++n) acc[a][b][m][n] = f32x4{0, 0, 0, 0};
    bf16x8 At[4][2], B0[2][2], B1[2][2];
#pragma unroll 1
    for (int pass = 0; pass < NPASS; ++pass) {
    if (pass == 1) { A += apass; Bt = Bt2;
        tz = threadIdx.x; asm volatile("" : "+v"(tz)); wid = __builtin_amdgcn_readfirstlane(tz >> 6); lane = tz & 63; wr = wid >> 2; wc = wid & 3; fr = lane & 15; fq = lane >> 4; }
    STAGE_B(SB(0, 0), 0, 0); STAGE_A(SA(0, 0), 0, 0);
    STAGE_B(SB(0, 1), 1, 0); STAGE_A(SA(0, 1), 1, 0);
    if (wr == 1) BAR;
    WAIT_V(4); BAR;
    STAGE_B(SB(1, 0), 0, 1); STAGE_A(SA(1, 0), 0, 1); STAGE_B(SB(1, 1), 1, 1);
    WAIT_V(6); BAR;
    for (int t = 0; t < nt - 2; t += 2) {
        LDB(B0, 0, 0); SCHED; LDA(At, 0, 0); STAGE_A(SA(1, 1), 1, t + 1);
        WAIT_L(8); BAR; WAIT_L(0); MMA(0, 0, At, B0); BAR; SCHED;
        LDB(B1, 0, 1); STAGE_B(SB(0, 0), 0, t + 2);
        BAR; WAIT_L(0); MMA(0, 1, At, B1); BAR;
        LDA(At, 0, 1); STAGE_A(SA(0, 0), 0, t + 2);
        BAR; WAIT_L(0); MMA(1, 0, At, B0); BAR; SCHED;
        STAGE_B(SB(0, 1), 1, t + 2);
        WAIT_V(6); BAR; MMA(1, 1, At, B1); BAR;
        LDB(B0, 1, 0); SCHED; LDA(At, 1, 0); STAGE_A(SA(0, 1), 1, t + 2);
        WAIT_L(8); BAR; WAIT_L(0); MMA(0, 0, At, B0); BAR; SCHED;
        LDB(B1, 1, 1); STAGE_B(SB(1, 0), 0, t + 3);
        BAR; WAIT_L(0); MMA(0, 1, At, B1); BAR;
        LDA(At, 1, 1); STAGE_A(SA(1, 0), 0, t + 3);
        BAR; WAIT_L(0); MMA(1, 0, At, B0); BAR; SCHED;
        STAGE_B(SB(1, 1), 1, t + 3);
        WAIT_V(6); BAR; MMA(1, 1, At, B1); BAR;
    }
    tz = threadIdx.x; asm volatile("" : "+v"(tz)); wid = __builtin_amdgcn_readfirstlane(tz >> 6); lane = tz & 63; wr = wid >> 2; wc = wid & 3; fr = lane & 15; fq = lane >> 4;
    { int r0, c0; g8_stage_rc(tz * 16, r0, c0);
      if constexpr (GATHER) {
#pragma unroll
          for (int q = 2; q < 4; ++q) ao[q] = (unsigned)(ltok[(q >> 1) * 128 + (q & 1) * 64 + r0] * lda + c0) * 2u;
      } else ao[0] = (unsigned)(r0 * lda + c0) * 2u; }
    { LDB(B0, 0, 0); WAIT_V(0); LDA(At, 0, 0); STAGE_A(SA(1, 1), 1, nt - 1);
      BAR; WAIT_L(0); MMA(0, 0, At, B0); BAR;
      LDB(B1, 0, 1); BAR; WAIT_L(0); MMA(0, 1, At, B1); BAR;
      LDA(At, 0, 1); WAIT_V(4); BAR; WAIT_L(0); MMA(1, 0, At, B0); MMA(1, 1, At, B1); BAR; }
    { LDB(B0, 1, 0); LDA(At, 1, 0); WAIT_V(2); BAR; WAIT_L(0); MMA(0, 0, At, B0); BAR;
      LDB(B1, 1, 1); WAIT_V(0); BAR; WAIT_L(0); MMA(0, 1, At, B1); BAR;
      LDA(At, 1, 1); BAR; WAIT_L(0); MMA(1, 0, At, B0); MMA(1, 1, At, B1); BAR; }
    if (wr == 0) BAR;
    }
    SBAR();
    epi(acc, wr, wc, fr, fq);
#undef SA
#undef SB
#undef STAGE_A
#undef STAGE_B
#undef LDA
#undef LDB
#undef MMA
#undef WAIT_V
#undef WAIT_L
#undef BAR
#undef SCHED
}
template <class F> DEVI void g8_for_acc(g8_acc& acc, int wr, int wc, int fr, int fq, F f) {
#pragma unroll
    for (int ai = 0; ai < 2; ++ai)
#pragma unroll
        for (int m = 0; m < 4; ++m)
        {
#pragma unroll
            for (int bj = 0; bj < 2; ++bj) { SBAR();
#pragma unroll
                for (int n = 0; n < 2; ++n) f(ai * 128 + wr * 64 + m * 16 + fr, bj * 128 + wc * 32 + n * 16 + fq * 4, acc[ai][bj][m][n]); } }
}
template <class F> DEVI void g8_for_acc8(g8_acc& acc, int wr, int wc, int fr, int fq, F f) {
#pragma unroll
    for (int ai = 0; ai < 2; ++ai)
#pragma unroll
        for (int m = 0; m < 4; ++m)
        {
#pragma unroll
            for (int bj = 0; bj < 2; ++bj) { SBAR(); float v[8];
#pragma unroll
                for (int j = 0; j < 4; ++j) { auto rr = __builtin_amdgcn_permlane16_swap(__float_as_uint(acc[ai][bj][m][0][j]), __float_as_uint(acc[ai][bj][m][1][j]), false, false);
                    v[j] = __uint_as_float(rr[0]); v[4 + j] = __uint_as_float(rr[1]); }
                f(ai * 128 + wr * 64 + m * 16 + fr, bj * 128 + wc * 32 + (fq & 1) * 16 + (fq & ~1) * 4, v); } }
}

struct Params { const float* in[22]; float* out; char* ws; int nphases; int ph_lo; };

struct Ctx { float* out; char* ws; char* lds; int G, vcu; };
#define TID_SETUP() int tid = threadIdx.x; asm volatile("" : "+v"(tid)); const int lane = tid & 63; const int wid = __builtin_amdgcn_readfirstlane(tid >> 6); (void)lane; (void)wid

DEVI short* res_row(const Ctx& c, int r) { return (short*)(c.ws + WS_RES) + (size_t)r * D; }
DEVI const float* in_row(const Params& P, int r) { return r < T_CTX ? P.in[2] + (size_t)r * D : P.in[0] + (size_t)(r - T_CTX) * D; }
DEVI f32x4 ld_bf4(const short* p) { const u32x2 w = *(const u32x2*)p; return f32x4{bflo(w[0]), bfhi(w[0]), bflo(w[1]), bfhi(w[1])}; }
DEVI void st_bf4(short* p, f32x4 v) { *(u32x2*)p = u32x2{cvtpk(v[0], v[1]), cvtpk(v[2], v[3])}; }
DEVI void res_load8(const Params& P, const Ctx& c, int r, int col, int layer, float (&x)[8]) {
    if (layer == 0) { const float* p = in_row(P, r) + col; const f32x4 a = *(const f32x4*)p, b = *(const f32x4*)(p + 4);
#pragma unroll
        for (int j = 0; j < 4; ++j) { x[j] = a[j]; x[4 + j] = b[j]; } }
    else { const u32x4 w = *(const u32x4*)(res_row(c, r) + col);
#pragma unroll
        for (int j = 0; j < 4; ++j) { x[2 * j] = bflo(w[j]); x[2 * j + 1] = bfhi(w[j]); } }
}
DEVI f32x4 res_load4(const Params& P, const Ctx& c, int r, int col, int layer) { return layer == 0 ? *(const f32x4*)(in_row(P, r) + col) : ld_bf4(res_row(c, r) + col); }

DEVI void cls_experts(int cls, int& ea, int& eb);
DEVI void phase_prologue(const Params& P, const Ctx& c) {
    TID_SETUP();
    const long gtid = (long)blockIdx.x * NTHR + tid; const long gsz = (long)c.G * NTHR;
    float* sv = (float*)(c.lds + LDS_GEMM);
    for (int i = tid; i < 3 * 1024; i += NTHR) { const int v = i >> 10, k = i & 1023; const float x = (v < 2) ? P.in[1][v * 1024 + k] : P.in[3][k]; sv[i] = silu(x); }
    float* tc = sv + 3 * 1024;
    for (int i = tid; i < 128; i += NTHR) { tc[i] = cospif(i / 64.f); tc[128 + i] = sinpif(i / 64.f); }
    __syncthreads();
    {
        float* modp = (float*)(c.ws + WS_MODP);
        const float* w_ada = P.in[4];
        for (long it = gtid; it < (long)8 * 4 * 6144; it += gsz) {
            const int j = (int)(it % 6144); const int l = (int)((it / 6144) & 3); const int ks = (int)(it / (6144 * 4));
            const float* w = w_ada + ((size_t)l * 1024 + ks * 128) * 6144 + j;
            float a0 = 0, a1 = 0, a2 = 0;
            for (int k = 0; k < 128; ++k) { const float wv = w[(size_t)k * 6144]; const int kk = ks * 128 + k; a0 += sv[kk] * wv; a1 += sv[1024 + kk] * wv; a2 += sv[2048 + kk] * wv; }
            float* o = modp + ((size_t)(ks * 4 + l) * 3) * 6144 + j;
            o[0] = a0; o[6144] = a1; o[2 * 6144] = a2;
        }
    }
    {
        float* tl = (float*)(c.lds + LDS_GEMM + 16384);
        const int NT_IN = 4 * 16 * 15, NT_OUT = 4 * 16 * 16, NT_GU = 4 * 16 * 16 * 4 * 2, NT_DN = 4 * NCLS * 2 * 4 * 16;
        struct TD { const float* s; short* d; int sld, dld, k0, n0, nvalid, mode; };
        auto desc = [&](int tix) { TD t; t.mode = 0;
            if (tix < NT_IN) { const int l = tix / 240, r = tix % 240, kt = r / 15, nt2 = r % 15; t.s = P.in[8] + (size_t)l * 1024 * INW; t.sld = INW; t.d = (short*)(c.ws + WS_WIN) + (size_t)l * 1024 * 1024; t.dld = 1024; t.k0 = kt * 64; t.n0 = nt2 * 64; t.nvalid = INW; }
            else if (tix < NT_IN + NT_OUT) { const int t2 = tix - NT_IN; const int l = t2 >> 8, r = t2 & 255; t.s = P.in[16] + (size_t)l * 1024 * 1024; t.sld = 1024; t.d = (short*)(c.ws + WS_WOUT) + (size_t)l * 1024 * 1024; t.dld = 1024; t.k0 = (r >> 4) * 64; t.n0 = (r & 15) * 64; t.nvalid = 1024; }
            else if (tix < NT_IN + NT_OUT + NT_GU) { const int t2 = tix - NT_IN - NT_OUT; const int gu = t2 & 1, r = t2 >> 1; const int le = r >> 6, kt = (r >> 2) & 15, nt2 = r & 3;
                t.s = (gu ? P.in[20] : P.in[19]) + (size_t)le * 1024 * 256; t.sld = 256; t.d = (short*)(c.ws + WS_WGU) + (size_t)le * 512 * 1024; t.dld = 1024; t.k0 = kt * 64; t.n0 = nt2 * 64; t.nvalid = 256; t.mode = 1 + gu; }
            else { const int t2 = tix - NT_IN - NT_OUT - NT_GU; const int lch = t2 >> 6, kt = (t2 >> 4) & 3, nt2 = t2 & 15; const int half = lch & 1, lc = lch >> 1, cl = lc % NCLS, l = lc / NCLS;
                int ea, eb; cls_experts(cl, ea, eb); const int e = half ? eb : ea;
                t.s = P.in[21] + (size_t)(l * 16 + e) * 256 * 1024; t.sld = 1024; t.d = (short*)(c.ws + WS_WDN) + (size_t)lc * 1024 * 512 + half * 256; t.dld = 512; t.k0 = kt * 64; t.n0 = nt2 * 64; t.nvalid = 1024; }
            return t; };
        const int NTILES = NT_IN + NT_OUT + NT_GU + NT_DN;
        const int lkk = tid >> 3, lcg = (tid & 7) * 8;
        f32x4 x0 = {0, 0, 0, 0}, x1 = {0, 0, 0, 0};
        auto tload = [&](const TD& t) { x0 = f32x4{0, 0, 0, 0}; x1 = f32x4{0, 0, 0, 0};
            if (t.n0 + lcg < t.nvalid) { const float* sp = t.s + (size_t)(t.k0 + lkk) * t.sld + t.n0 + lcg; x0 = *(const f32x4*)sp; x1 = *(const f32x4*)(sp + 4); } };
        int tix = blockIdx.x, pb = 0;
        TD cur = desc(tix < NTILES ? tix : 0);
        __syncthreads();
        if (tix < NTILES) tload(cur);
        for (; tix < NTILES; tix += c.G, pb ^= 1) {
            float* tlb = tl + pb * (64 * 65);
#pragma unroll
            for (int j = 0; j < 4; ++j) { tlb[lkk * 65 + lcg + j] = x0[j]; tlb[lkk * 65 + lcg + 4 + j] = x1[j]; }
            const TD nxt = desc(tix + c.G < NTILES ? tix + c.G : 0);
            if (tix + c.G < NTILES) tload(nxt);
            __syncthreads();
            { const int n = tid >> 3, kg = (tid & 7) * 8; const int nn = cur.n0 + n;
              if (nn < cur.nvalid) { float v[8];
#pragma unroll
                for (int j = 0; j < 8; ++j) v[j] = tlb[(kg + j) * 65 + n];
                const int drow = cur.mode == 0 ? nn : ((nn >> 4) * 32 + (cur.mode - 1) * 16 + (nn & 15));
                *(u32x4*)(cur.d + (size_t)drow * cur.dld + cur.k0 + kg) = u32x4{cvtpk(v[0], v[1]), cvtpk(v[2], v[3]), cvtpk(v[4], v[5]), cvtpk(v[6], v[7])}; } }
            cur = nxt;
        }
        __syncthreads();
        { short* d = (short*)(c.ws + WS_WIN);
          for (long it = gtid; it < (long)4 * 96 * 128; it += gsz) { const int k8 = (int)(it & 127); const long lr = it >> 7; const int l = (int)(lr / 96), rr = (int)(lr % 96);
              *(u32x4*)(d + ((size_t)l * 1024 + INW + rr) * 1024 + k8 * 8) = u32x4{0, 0, 0, 0}; } }
    }
    {
        short* dst = (short*)(c.ws + WS_WQT);
        for (long it = gtid; it < (long)4 * 768 * 256; it += gsz) { const int k = (int)(it & 255); const long lf = it >> 8; const int f = (int)(lf % 768), l = (int)(lf / 768);
            dst[it] = (short)f2bf(P.in[9][l * 256 + k] * P.in[10][((size_t)l * 256 + k) * 768 + f]); }
        dst = (short*)(c.ws + WS_WKVT);
        for (long it = gtid; it < (long)4 * 1024 * 128; it += gsz) { const int k = (int)(it & 127); const long lf = it >> 7; const int f = (int)(lf & 1023), l = (int)(lf >> 10);
            dst[it] = (short)f2bf(P.in[11][l * 128 + k] * P.in[12][((size_t)l * 128 + k) * 1024 + f]); }
    }
    {
        short* dst = (short*)(c.ws + WS_WCS); const float* wf = P.in[15];
        for (long it = gtid; it < (long)4 * 4 * 128 * 256; it += gsz) {
            const int d = (int)(it & 127), ab = (int)((it >> 7) & 1), cc = (int)((it >> 8) & 127); const long lg = it >> 15;
            const float* w = wf + lg * 128 * 128 + d; const float* tt = tc + ab * 128;
            float a = 0;
            for (int j = 0; j < 128; ++j) a += tt[(cc * j) & 127] * w[j * 128];
            dst[it] = (short)f2bf(a * 0.08838834764831845f);
        }
    }
    {
        short* f1 = (short*)(c.ws + WS_F1);
        for (long it = gtid; it < 256 * 256; it += gsz) { const int kk = (int)(it & 255), m = (int)(it >> 8); const int k1 = (m >> 6) * 32 + (m & 31), ri = (m >> 5) & 1, n1 = kk >> 1, ab = kk & 1;
            const int a = (n1 * k1) & 127; const float cs = tc[a], sn = tc[128 + a];
            const float v = (ri == 0) ? (ab == 0 ? cs : -sn) : (ab == 0 ? -sn : -cs);
            f1[it] = (short)f2bf(v * 0.08838834764831845f); }
        short* f2 = (short*)(c.ws + WS_F2);
        for (long it = gtid; it < 128 * 256; it += gsz) { const int kk = (int)(it & 255), k2 = (int)(it >> 8); const int n2 = kk >> 1, ri = kk & 1;
            const int a = (n2 * k2) & 127; f2[it] = (short)f2bf((ri == 0 ? tc[a] : tc[128 + a]) * 0.08838834764831845f); }
        short* fc = (short*)(c.ws + WS_FC);
        for (long it = gtid; it < 256 * 512; it += gsz) { const int kk = (int)(it & 511), k = (int)(it >> 9); const int n = kk >> 1, ab = kk & 1;
            const int a = (n * k) & 255; const float v = ab == 0 ? cospif(a / 128.f) : -sinpif(a / 128.f); fc[it] = (short)f2bf(v * 0.0625f); }
        float2* tw = (float2*)(c.ws + WS_TW);
        for (long it = gtid; it < 16384; it += gsz) tw[it] = make_float2(cospif((float)it / 8192.f), sinpif((float)it / 8192.f));
        float2* rp = (float2*)(c.ws + WS_ROPE);
        for (long it = gtid; it < 256 * 8; it += gsz) { const int i = (int)(it & 7), pos = (int)(it >> 3); const float fr = powf(10000.f, -(float)i / 8.f); const float ang = (float)pos * fr;
            rp[it] = make_float2(cosf(ang), sinf(ang)); }
    }
}

DEVI void phase_coef(const Params& P, const Ctx& c) {
    TID_SETUP();
    const long gtid = (long)blockIdx.x * NTHR + tid; const long gsz = (long)c.G * NTHR;
    const float* modp = (const float*)(c.ws + WS_MODP); float* coef = (float*)(c.ws + WS_COEF);
    for (long it = gtid; it < (long)4 * 3 * 6144; it += gsz) {
        const int j = (int)(it % 6144); const int v = (int)((it / 6144) % 3); const int l = (int)(it / (6144 * 3));
        float m = P.in[5][l * 6144 + j];
        for (int ks = 0; ks < 8; ++ks) m += modp[((size_t)(ks * 4 + l) * 3 + v) * 6144 + j];
        const int chunk = j >> 10, col = j & 1023;
        float val; int slot;
        if (chunk == 0) { slot = 1; val = m; } else if (chunk == 1) { slot = 0; val = P.in[6][l * 1024 + col] * (1.f + m); } else if (chunk == 2) { slot = 2; val = m; }
        else if (chunk == 3) { slot = 4; val = m; } else if (chunk == 4) { slot = 3; val = P.in[7][l * 1024 + col] * (1.f + m); } else { slot = 5; val = m; }
        coef[((size_t)(l * 3 + v) * 6 + slot) * 1024 + col] = val;
    }
}

DEVI void phase_norm_mix(const Params& P, const Ctx& c, int l) {
    TID_SETUP();
    const float* coef = (const float*)(c.ws + WS_COEF) + (size_t)l * 3 * 6 * 1024;
    short* hbuf = (short*)(c.ws + WS_HBUF);
    for (int r = c.vcu * 8 + wid; r < T; r += c.G * 8) {
        const int v = row_variant(r);
        const float* a1 = coef + (size_t)(v * 6 + 0) * 1024; const float* b1 = coef + (size_t)(v * 6 + 1) * 1024;
        float xv[2][8]; float ss = 0;
        if (l == 0) { const float* x = in_row(P, r);
#pragma unroll
            for (int q = 0; q < 2; ++q) { const f32x4 t0 = *(const f32x4*)(x + q * 512 + lane * 8), t1 = *(const f32x4*)(x + q * 512 + lane * 8 + 4);
#pragma unroll
                for (int j = 0; j < 4; ++j) { xv[q][j] = t0[j]; xv[q][4 + j] = t1[j]; } } }
        else { const short* x = res_row(c, r);
#pragma unroll
            for (int q = 0; q < 2; ++q) { const u32x4 t = *(const u32x4*)(x + q * 512 + lane * 8);
#pragma unroll
                for (int j = 0; j < 4; ++j) { xv[q][2 * j] = bflo(t[j]); xv[q][2 * j + 1] = bfhi(t[j]); } } }
#pragma unroll
        for (int q = 0; q < 2; ++q)
#pragma unroll
            for (int j = 0; j < 8; ++j) ss += xv[q][j] * xv[q][j];
        ss = wave_sum(ss); const float rstd = rsqrtf(ss * (1.f / 1024.f) + EPS);
#pragma unroll
        for (int q = 0; q < 2; ++q) { const int col = q * 512 + lane * 8; const f32x4 a0 = *(const f32x4*)(a1 + col), a4 = *(const f32x4*)(a1 + col + 4), b0 = *(const f32x4*)(b1 + col), b4 = *(const f32x4*)(b1 + col + 4);
            float y[8];
#pragma unroll
            for (int j = 0; j < 4; ++j) { y[j] = xv[q][j] * rstd * a0[j] + b0[j]; y[4 + j] = xv[q][4 + j] * rstd * a4[j] + b4[j]; }
            *(u32x4*)(hbuf + (size_t)r * 1024 + col) = u32x4{cvtpk(y[0], y[1]), cvtpk(y[2], y[3]), cvtpk(y[4], y[5]), cvtpk(y[6], y[7])}; }
    }
}

DEVI u32x4 pack8(const float* p) {
    const unsigned a0 = cvtpk(p[0], p[1]), a1 = cvtpk(p[2], p[3]), b0 = cvtpk(p[4], p[5]), b1 = cvtpk(p[6], p[7]);
    auto r0 = __builtin_amdgcn_permlane32_swap(a0, b0, false, false); auto r1 = __builtin_amdgcn_permlane32_swap(a1, b1, false, false);
    return u32x4{r0[0], r1[0], r0[1], r1[1]};
}
template <int MB, int NB, class F> DEVI void for_acc_bf8(f32x16 (&acc)[MB][NB], int wm, int wn, int lane, F f) {
    const int r32 = lane & 31, hi = lane >> 5;
#pragma unroll
    for (int mb = 0; mb < MB; ++mb)
#pragma unroll
        for (int nb = 0; nb < NB; ++nb)
#pragma unroll
            for (int s = 0; s < 2; ++s) { float t[8];
#pragma unroll
                for (int j = 0; j < 8; ++j) t[j] = acc[mb][nb][8 * s + j];
                f((wm * MB + mb) * 32 + r32, (wn * NB + nb) * 32 + 16 * s + 8 * hi, pack8(t)); }
}
template <int MB, int NB, class F> DEVI void for_acc_f4(f32x16 (&acc)[MB][NB], int wm, int wn, int lane, F f) {
    const int r32 = lane & 31, hi = lane >> 5;
#pragma unroll
    for (int mb = 0; mb < MB; ++mb)
#pragma unroll
        for (int nb = 0; nb < NB; ++nb)
#pragma unroll
            for (int g = 0; g < 4; ++g) f((wm * MB + mb) * 32 + r32, (wn * NB + nb) * 32 + 8 * g + 4 * hi, f32x4{acc[mb][nb][4 * g], acc[mb][nb][4 * g + 1], acc[mb][nb][4 * g + 2], acc[mb][nb][4 * g + 3]});
}

DEVI void phase_inproj(const Params& P, const Ctx& c, int l) {
    TID_SETUP();
    const short* hbuf = (const short*)(c.ws + WS_HBUF); const short* WT = (const short*)(c.ws + WS_WIN) + (size_t)l * 1024 * 1024; short* zbuf = (short*)((char*)c.out);
    for (int u = c.vcu; u < 64; u += c.G) {
        const int rt = u >> 3, ct = u & 7; const int row0 = rt * 64, col0 = ct * 128;
        gemm_tile<1, 1, 2, 4, false, true>(c.lds + LDS_GEMM, 16,
            [&](int r) { return hbuf + (size_t)(row0 + r) * 1024; },
            [&](int n) { return WT + (size_t)(col0 + n) * 1024; },
            [&](f32x16 (&acc)[1][1], int wm, int wn) {
                for_acc_bf8<1, 1>(acc, wm, wn, lane, [&](int r, int cc, u32x4 v) { const int col = col0 + cc; if (col < INW) *(u32x4*)(zbuf + (size_t)(row0 + r) * ZLD + col) = v; });
            });
    }
    for (int u = c.vcu; u < 512; u += c.G) {
        const int rt = 2 + (u >> 2), ct = u & 3; const int row0 = rt * 256, col0 = ct * 256;
        __syncthreads();
        gemm256<false, 1>(c.lds + LDS_GEMM, 16, hbuf + (size_t)row0 * 1024, 1024, nullptr, WT + (size_t)col0 * 1024, 1024, 0, nullptr,
            [&](g8_acc& acc, int wr, int wc, int fr, int fq) {
                g8_for_acc8(acc, wr, wc, fr, fq, [&](int r, int cc, const float (&v)[8]) { const int col = col0 + cc;
                    if (col < INW) *(u32x4*)(zbuf + (size_t)(row0 + r) * ZLD + col) = u32x4{cvtpk(v[0], v[1]), cvtpk(v[2], v[3]), cvtpk(v[4], v[5]), cvtpk(v[6], v[7])}; });
            });
    }
}

template <int NCOL, int NTOK = 128> DEVI void tile_rowstat(const Ctx& c, int tid, int tok0, int col0, float* stat) {
    const short* zbuf = (const short*)((char*)c.out);
    constexpr int TPT = NTHR / NTOK, per = NCOL / TPT;
    const int t = tid / TPT, q = tid % TPT;
    const short* p = zbuf + (size_t)(tok0 + t) * ZLD + col0 + q * per;
    u32x4 w[per / 8];
#pragma unroll
    for (int i = 0; i < per / 8; ++i) w[i] = *(const u32x4*)(p + i * 8);
    float ss = 0;
#pragma unroll
    for (int i = 0; i < per / 8; ++i)
#pragma unroll
        for (int j = 0; j < 4; ++j) { const float a = bflo(w[i][j]), b = bfhi(w[i][j]); ss += a * a + b * b; }
    ss += __shfl_xor(ss, 1, 64); if constexpr (TPT == 4) ss += __shfl_xor(ss, 2, 64);
    if (q == 0) stat[t] = ss / (float)NCOL;
}
DEVI float half_sum(float v) { auto rr = __builtin_amdgcn_permlane32_swap(__float_as_uint(v), __float_as_uint(v), false, false); return __uint_as_float(rr[0]) + __uint_as_float(rr[1]); }

DEVI void rope16(float (&x)[16], int n, bool lat, int hi, const float2* ropetab) {
    if (!lat) return;
    const int prow = n >> 6, pcol = n & 63;
#pragma unroll
    for (int j = 0; j < 4; ++j) {
        const int i = j + 4 * hi;
        const float2 cr = ropetab[prow * 8 + i], cc = ropetab[pcol * 8 + i];
        const float a1 = x[j], a2 = x[j + 4]; x[j] = a1 * cr.x - a2 * cr.y; x[j + 4] = a2 * cr.x + a1 * cr.y;
        const float b1 = x[8 + j], b2 = x[12 + j]; x[8 + j] = b1 * cc.x - b2 * cc.y; x[12 + j] = b2 * cc.x + b1 * cc.y;
    }
}

template <int NB> DEVI void pc_q_unit(const Params& P, const Ctx& c, int l, int tok0, int hp, int tid, int lane) {
    const short* zbuf = (const short*)((char*)c.out);
    float* stat = (float*)(c.lds + LDS_STAT);
    const float2* ropetab = (const float2*)(c.ws + WS_ROPE);
    tile_rowstat<QLR, 128 * NB>(c, tid, tok0, 0, stat);
    const short* WQT = (const short*)(c.ws + WS_WQT) + ((size_t)l * 768 + hp * 192) * 256;
    const float* qn = P.in[13] + l * DQK;
    gemm_tile<3, NB, 2, 4, false, false>(c.lds + LDS_GEMM, 4,
        [&](int r) { return WQT + (size_t)r * 256; },
        [&](int n) { return zbuf + (size_t)(tok0 + n) * ZLD; },
        [&](f32x16 (&acc)[3][NB], int wm, int wn) {
#pragma unroll
            for (int nb = 0; nb < NB; ++nb) {
                const int hi = lane >> 5, r32 = lane & 31; const int tl = (wn * NB + nb) * 32 + r32, row = tok0 + tl, h = hp * 2 + wm;
                const bool lat = row >= T_CTX; const int rr = lat ? row - T_CTX : row; const int b = lat ? (rr >> 14) : (rr >> 8); const int n = lat ? (rr & 16383) : (rr & 255);
                const float s1 = rsqrtf(stat[tl] + EPS);
                float ss = 0;
#pragma unroll
                for (int mb = 0; mb < 3; ++mb)
#pragma unroll
                    for (int r = 0; r < 16; ++r) ss += acc[mb][nb][r] * acc[mb][nb][r];
                ss = half_sum(ss);
                const float s2 = rsqrtf(s1 * s1 * ss * (1.f / 96.f) + EPS); const float sc = s1 * s2 * ATT_QSCALE;
                float x[3][16];
#pragma unroll
                for (int mb = 0; mb < 3; ++mb)
#pragma unroll
                    for (int g4 = 0; g4 < 4; ++g4) { const f32x4 g = *(const f32x4*)(qn + mb * 32 + 8 * g4 + 4 * hi);
#pragma unroll
                        for (int j = 0; j < 4; ++j) x[mb][g4 * 4 + j] = acc[mb][nb][g4 * 4 + j] * sc * g[j]; }
                rope16(x[2], n, lat, hi, ropetab);
                short* dst = lat ? (short*)(c.ws + WS_QBUF) + ((size_t)(b * NH + h) * SEQ + n) * DQK : (short*)(c.ws + WS_QCTX) + ((size_t)(b * NH + h) * NCTX + n) * DQK;
#pragma unroll
                for (int mb = 0; mb < 3; ++mb)
#pragma unroll
                    for (int s = 0; s < 2; ++s) *(u32x4*)(dst + mb * 32 + s * 16 + hi * 8) = pack8(&x[mb][s * 8]);
            }
        });
}

template <int NB> DEVI void pc_kv_unit(const Params& P, const Ctx& c, int l, int tok0, int hp, int tid, int lane) {
    const short* zbuf = (const short*)((char*)c.out);
    float* stat = (float*)(c.lds + LDS_STAT);
    const float2* ropetab = (const float2*)(c.ws + WS_ROPE);
    tile_rowstat<KVLR, 128 * NB>(c, tid, tok0, QLR, stat);
    const short* WKVT = (const short*)(c.ws + WS_WKVT) + ((size_t)l * 1024 + hp * 256) * 128;
    const float* kn = P.in[14] + l * DQK;
    gemm_tile<4, NB, 2, 4, false, false, (NB == 1 ? 2 : 1)>(c.lds + LDS_GEMM, 2,
        [&](int r) { return WKVT + (size_t)r * 128; },
        [&](int n) { return zbuf + (size_t)(tok0 + n) * ZLD + QLR; },
        [&](f32x16 (&acc)[4][NB], int wm, int wn) {
#pragma unroll
            for (int nb = 0; nb < NB; ++nb) {
                const int hi = lane >> 5, r32 = lane & 31; const int tl = (wn * NB + nb) * 32 + r32, row = tok0 + tl, h = hp * 2 + wm;
                const bool lat = row >= T_CTX; const int rr = lat ? row - T_CTX : row; const int b = lat ? (rr >> 14) : (rr >> 8); const int n = lat ? (rr & 16383) : (rr & 255);
                const int pos = lat ? NCTX + n : n;
                const float s1 = rsqrtf(stat[tl] + EPS);
                float kr[16];
#pragma unroll
                for (int g4 = 0; g4 < 4; ++g4) { const u32x2 w = *(const u32x2*)(zbuf + (size_t)row * ZLD + QLR + KVLR + 8 * g4 + 4 * hi);
                    kr[g4 * 4 + 0] = bflo(w[0]); kr[g4 * 4 + 1] = bfhi(w[0]); kr[g4 * 4 + 2] = bflo(w[1]); kr[g4 * 4 + 3] = bfhi(w[1]); }
                float ss = 0;
#pragma unroll
                for (int mb = 0; mb < 2; ++mb)
#pragma unroll
                    for (int r = 0; r < 16; ++r) { const float t = acc[mb][nb][r] * s1; ss += t * t; }
#pragma unroll
                for (int r = 0; r < 16; ++r) ss += kr[r] * kr[r];
                ss = half_sum(ss);
                const float s2 = rsqrtf(ss * (1.f / 96.f) + EPS);
                float x[3][16];
#pragma unroll
                for (int mb = 0; mb < 3; ++mb)
#pragma unroll
                    for (int g4 = 0; g4 < 4; ++g4) { const f32x4 g = *(const f32x4*)(kn + mb * 32 + 8 * g4 + 4 * hi);
#pragma unroll
                        for (int j = 0; j < 4; ++j) x[mb][g4 * 4 + j] = (mb < 2 ? acc[mb][nb][g4 * 4 + j] * s1 : kr[g4 * 4 + j]) * s2 * g[j]; }
                rope16(x[2], n, lat, hi, ropetab);
                short* kd = (short*)(c.ws + WS_KBUF) + ((size_t)(b * NH + h) * NKEY + pos) * DQK;
#pragma unroll
                for (int mb = 0; mb < 3; ++mb)
#pragma unroll
                    for (int s = 0; s < 2; ++s) *(u32x4*)(kd + mb * 32 + s * 16 + hi * 8) = pack8(&x[mb][s * 8]);
                short* vd = (short*)(c.ws + WS_VBUF) + ((size_t)(b * NH + h) * NKEY + pos) * DV;
                float vv[2][16];
#pragma unroll
                for (int mb = 0; mb < 2; ++mb)
#pragma unroll
                    for (int r = 0; r < 16; ++r) vv[mb][r] = acc[2 + mb][nb][r] * s1;
#pragma unroll
                for (int mb = 0; mb < 2; ++mb)
#pragma unroll
                    for (int s = 0; s < 2; ++s) *(u32x4*)(vd + mb * 32 + s * 16 + hi * 8) = pack8(&vv[mb][s * 8]);
            }
        });
}

DEVI void phase_proj2(const Params& P, const Ctx& c, int l) {
    TID_SETUP();
    const short* zbuf = (const short*)((char*)c.out);
    for (int u = c.vcu + PC_U0; u < (l < DEPTH - 1 ? 1072 : 1056); u += c.G) {
        __syncthreads();
        if (u < 512) pc_q_unit<2>(P, c, l, T_CTX + (u >> 2) * 256, u & 3, tid, lane);
        else if (u < 1024) pc_kv_unit<2>(P, c, l, T_CTX + ((u - 512) >> 2) * 256, u & 3, tid, lane);
        else if (u < 1040) pc_q_unit<1>(P, c, l, ((u - 1024) >> 2) * 128, u & 3, tid, lane);
        else if (u < 1056) pc_kv_unit<1>(P, c, l, ((u - 1040) >> 2) * 128, u & 3, tid, lane);
        else {
            const int uu = u - 1056; const int rt = uu >> 3, g = (uu >> 1) & 3, ct = uu & 1; const int row0 = rt * 256;
            const short* W = (const short*)(c.ws + WS_WCS) + ((size_t)(l * 4 + g) * 128) * 256 + ct * 128; short* U = (short*)(c.ws + WS_UCTX);
            gemm_tile<2, 2, 4, 2, true, true>(c.lds + LDS_GEMM, 2,
                [&](int r) { return zbuf + (size_t)(row0 + r) * ZLD + 416 + g * 128; },
                [&](int k) { return W + (size_t)k * 256; },
                [&](f32x16 (&acc)[2][2], int wm, int wn) {
                    for_acc_bf8<2, 2>(acc, wm, wn, lane, [&](int r, int cc, u32x4 v) { *(u32x4*)(U + (size_t)(row0 + r) * 1024 + g * 256 + ct * 128 + cc) = v; });
                });
        }
    }
}

constexpr int AT_VB = 64 * 64 * 2, AT_KB = 64 * 256, AT_V = 0, AT_K = 3 * AT_VB, AT_WS = AT_K + 3 * AT_KB;
#define KSWZ(row, colB) ((row) * 256 + ((colB) ^ (((row) & 15) << 4)))

DEVI void att_exp16(f32x16& p, float& l) {
#pragma unroll
    for (int r = 0; r < 16; ++r) { p[r] = __builtin_amdgcn_exp2f(p[r]); l += p[r]; }
}
DEVI void att_pack(const f32x16& p0, const f32x16& p1, bf16x8& pa0, bf16x8& pa1, bf16x8& pa2, bf16x8& pa3) {
#define PK4(P, BASE, OUT) do { u32x4 w = {cvtpk(P[BASE + 0], P[BASE + 1]), cvtpk(P[BASE + 2], P[BASE + 3]), cvtpk(P[BASE + 4], P[BASE + 5]), cvtpk(P[BASE + 6], P[BASE + 7])}; \
    OUT = *reinterpret_cast<bf16x8*>(&w); } while (0)
    PK4(p0, 0, pa0); PK4(p0, 8, pa1); PK4(p1, 0, pa2); PK4(p1, 8, pa3);
#undef PK4
}
template <bool SHIFT> DEVI void att_qkt(f32x16& p0, f32x16& p1, const char* Ks, const bf16x8* qr, int r32, int hi, float init) {
    if constexpr (SHIFT) {
#pragma unroll
        for (int r = 0; r < 16; ++r) { p0[r] = init; p1[r] = init; }
    } else { p0 = f32x16{}; p1 = f32x16{}; }
    bf16x8 b0 = *reinterpret_cast<const bf16x8*>(Ks + KSWZ(r32, hi * 16));
    bf16x8 b1 = *reinterpret_cast<const bf16x8*>(Ks + KSWZ(32 + r32, hi * 16));
#pragma unroll
    for (int d0 = 0; d0 < 6; ++d0) {
        bf16x8 n0 = b0, n1 = b1;
        if (d0 < 5) { const int cb = ((d0 + 1) * 16 + hi * 8) * 2;
            n0 = *reinterpret_cast<const bf16x8*>(Ks + KSWZ(r32, cb)); n1 = *reinterpret_cast<const bf16x8*>(Ks + KSWZ(32 + r32, cb)); }
        p0 = __builtin_amdgcn_mfma_f32_32x32x16_bf16(b0, qr[d0], p0, 0, 0, 0);
        p1 = __builtin_amdgcn_mfma_f32_32x32x16_bf16(b1, qr[d0], p1, 0, 0, 0);
        b0 = n0; b1 = n1; }
}
constexpr int att_v_off(int d0, int ks, int half) { return d0 * 512 + ks * 2048 + half * 1024; }
struct VFrag { s16x4 l0, h0, l1, h1, l2, h2, l3, h3; };
template <int D0> DEVI void att_vread(VFrag& f, int vb) {
    f.l0 = tr_read<att_v_off(D0, 0, 0)>(vb); f.h0 = tr_read<att_v_off(D0, 0, 1)>(vb); f.l1 = tr_read<att_v_off(D0, 1, 0)>(vb); f.h1 = tr_read<att_v_off(D0, 1, 1)>(vb);
    f.l2 = tr_read<att_v_off(D0, 2, 0)>(vb); f.h2 = tr_read<att_v_off(D0, 2, 1)>(vb); f.l3 = tr_read<att_v_off(D0, 3, 0)>(vb); f.h3 = tr_read<att_v_off(D0, 3, 1)>(vb);
}
DEVI void att_pv_mm(f32x16& od, const VFrag& f, bf16x8 pa0, bf16x8 pa1, bf16x8 pa2, bf16x8 pa3) {
    od = __builtin_amdgcn_mfma_f32_32x32x16_bf16(PK8(f.l0, f.h0), pa0, od, 0, 0, 0);
    od = __builtin_amdgcn_mfma_f32_32x32x16_bf16(PK8(f.l1, f.h1), pa1, od, 0, 0, 0);
    od = __builtin_amdgcn_mfma_f32_32x32x16_bf16(PK8(f.l2, f.h2), pa2, od, 0, 0, 0);
    od = __builtin_amdgcn_mfma_f32_32x32x16_bf16(PK8(f.l3, f.h3), pa3, od, 0, 0, 0);
}
DEVI void att_lsum(f32x16& l, bf16x8 pa, bf16x8 pb) {
    const bf16x8 ones = {(short)0x3F80, (short)0x3F80, (short)0x3F80, (short)0x3F80, (short)0x3F80, (short)0x3F80, (short)0x3F80, (short)0x3F80};
    l = __builtin_amdgcn_mfma_f32_32x32x16_bf16(pa, ones, l, 0, 0, 0);
    l = __builtin_amdgcn_mfma_f32_32x32x16_bf16(pb, ones, l, 0, 0, 0);
}

template <bool SHIFT> DEVI void attn_body(const short* __restrict__ Qb, const short* __restrict__ Kh, const short* __restrict__ Vh, short* __restrict__ Ob, int seq, float shift, char* lds) {
    int tid = threadIdx.x; asm volatile("" : "+v"(tid)); const int wid = __builtin_amdgcn_readfirstlane(tid >> 6), lane = tid & 63, r32 = lane & 31, hi = lane >> 5;
    char* V_lds = lds + AT_V; char* K_lds = lds + AT_K;
    if (wid >= 4) __builtin_amdgcn_s_setprio(1);
    f32x16 o[2] = {f32x16{}, f32x16{}}; float l_reg = 0.f; bf16x8 qr[6];
    const short* Qw = Qb + (size_t)(wid * 32 + r32) * DQK + hi * 8;
#pragma unroll
    for (int d0 = 0; d0 < 6; ++d0) qr[d0] = *(const bf16x8*)(Qw + d0 * 16);
    const int kc0 = tid, kc1 = (tid + 512 < 768) ? tid + 512 : 767;
    const int kst0 = KSWZ(kc0 / 12, (kc0 % 12) * 16), kst1 = KSWZ(kc1 / 12, (kc1 % 12) * 16);
    const int vkey = tid >> 3, vcol = (tid & 7) * 8;
    const int vkk = vkey;
    const int vst = ((vkk >> 3) * 2 + (vcol >> 5)) * 512 + ((vkk & 7) * 32 + (vcol & 31)) * 2;
    const int vb0 = (int)(uintptr_t)V_lds + nn_rd_base(lane);
    struct { bf16x8 vs, k0, k1; } sr_;
    const int NT = seq / 64; const float init = -shift;
#define SLOAD(t) do { const int tt_ = (t) < NT ? (t) : NT - 1; sr_.vs = *(const bf16x8*)(Vh + (size_t)tt_ * 64 * DV + tid * 8); \
    sr_.k0 = *(const bf16x8*)(Kh + (size_t)tt_ * 64 * DQK + kc0 * 8); sr_.k1 = *(const bf16x8*)(Kh + (size_t)tt_ * 64 * DQK + kc1 * 8); } while (0)
#define SWRITE(b) do { *(bf16x8*)(V_lds + (b) * AT_VB + vst) = sr_.vs; *(bf16x8*)(K_lds + (b) * AT_KB + kst0) = sr_.k0; *(bf16x8*)(K_lds + (b) * AT_KB + kst1) = sr_.k1; } while (0)
    f32x16 pA0, pA1, pB0, pB1; bf16x8 pa0, pa1, pa2, pa3; VFrag vf, vf1;
#define STEP(PC0, PC1, PP0, PP1, TNEXT2, DOWRITE) do {                                                            \
        int bn = bc + 1; if (bn == 3) bn = 0;                                                                      \
        if (DOWRITE) SWRITE(bn);                                                                                   \
        SBAR(); SLOAD(TNEXT2);                                                                                     \
        SBAR(); att_vread<0>(vf, vb0 + bp * AT_VB); att_vread<1>(vf1, vb0 + bp * AT_VB);                           \
        att_qkt<SHIFT>(PC0, PC1, K_lds + bc * AT_KB, qr, r32, hi, init);                                           \
        att_exp16(PP1, l_reg); att_pack(PP0, PP1, pa0, pa1, pa2, pa3); SBAR();                                     \
        asm volatile("s_waitcnt lgkmcnt(0)" ::: "memory"); SBAR();                                                 \
        att_pv_mm(o[0], vf, pa0, pa1, pa2, pa3); att_pv_mm(o[1], vf1, pa0, pa1, pa2, pa3);                         \
        att_exp16(PC0, l_reg);                                                                                     \
        __syncthreads();                                                                                           \
        bp = bc; bc = bn; } while (0)
    SLOAD(0); asm volatile("s_waitcnt vmcnt(0)" ::: "memory"); SWRITE(0); SBAR(); SLOAD(1); __syncthreads();
    SWRITE(1); SBAR(); SLOAD(2); SBAR();
    att_qkt<SHIFT>(pA0, pA1, K_lds, qr, r32, hi, init); att_exp16(pA0, l_reg);
    __syncthreads();
    int bc = 1, bp = 0;
    for (int j = 1; j + 1 < NT; j += 2) {
        STEP(pB0, pB1, pA0, pA1, j + 2, true);
        STEP(pA0, pA1, pB0, pB1, j + 3, (j + 2 < NT));
    }
    STEP(pB0, pB1, pA0, pA1, NT - 1, false);
    att_vread<0>(vf, vb0 + bp * AT_VB);
    att_exp16(pB1, l_reg); att_pack(pB0, pB1, pa0, pa1, pa2, pa3); SBAR();
    asm volatile("s_waitcnt lgkmcnt(0)" ::: "memory"); SBAR();
    att_pv_mm(o[0], vf, pa0, pa1, pa2, pa3); att_vread<1>(vf, vb0 + bp * AT_VB); SBAR();
    asm volatile("s_waitcnt lgkmcnt(0)" ::: "memory"); SBAR();
    att_pv_mm(o[1], vf, pa0, pa1, pa2, pa3);
    __builtin_amdgcn_s_setprio(0);
    { auto rr = __builtin_amdgcn_permlane32_swap(__float_as_uint(l_reg), __float_as_uint(l_reg), false, false); l_reg = __uint_as_float(rr[0]) + __uint_as_float(rr[1]); }
    const float rl = __builtin_amdgcn_rcpf(l_reg);
    short* Orow = Ob + (size_t)(wid * 32 + r32) * 1024;
#pragma unroll
    for (int d0 = 0; d0 < 2; ++d0)
#pragma unroll
        for (int s = 0; s < 2; ++s) { float t[8];
#pragma unroll
            for (int j = 0; j < 8; ++j) t[j] = o[d0][8 * s + j] * rl;
            *(u32x4*)(Orow + d0 * 32 + 16 * s + 8 * hi) = pack8(t); }
    __syncthreads();
#undef SLOAD
#undef SWRITE
#undef STEP
}

DEVI void phase_attn_fft1(const Params& P, const Ctx& c, int l) {
    TID_SETUP();
    short* mix = (short*)(c.ws + WS_HBUF);
    const short* qb = (const short*)(c.ws + WS_QBUF); const short* qc = (const short*)(c.ws + WS_QCTX);
    const short* kb = (const short*)(c.ws + WS_KBUF); const short* vb = (const short*)(c.ws + WS_VBUF);
    const int n_att = (l < DEPTH - 1) ? 1040 : 1024;
    float shift;
    { float mq = 0.f, mk = 0.f;
      for (int i = lane; i < DQK; i += 64) { mq = fmaxf(mq, fabsf(P.in[13][l * DQK + i])); mk = fmaxf(mk, fabsf(P.in[14][l * DQK + i])); }
#pragma unroll
      for (int o = 32; o > 0; o >>= 1) { mq = fmaxf(mq, __shfl_xor(mq, o, 64)); mk = fmaxf(mk, __shfl_xor(mk, o, 64)); }
      shift = 9.797958971132712f * 1.4426950408889634f * mq * mk * 1.0001f; }
    for (int u = c.vcu; u < n_att; u += c.G) {
        const short* Qp; short* Op; int bh, seq;
        if (u < 1024) {
            const int rnd = u >> 8, v = u & 255, xcd = v >> 5, j = v & 31; bh = xcd * 2 + (rnd >> 1); const int qblk = j + 32 * (rnd & 1);
            Qp = qb + ((size_t)bh * SEQ + qblk * 256) * DQK; Op = mix + (size_t)(T_CTX + (bh >> 3) * SEQ + qblk * 256) * 1024 + (bh & 7) * DV; seq = NKEY;
        } else {
            bh = u - 1024; Qp = qc + (size_t)bh * NCTX * DQK; Op = mix + (size_t)((bh >> 3) * NCTX) * 1024 + (bh & 7) * DV; seq = NCTX;
        }
        if (shift < 64.f) attn_body<false>(Qp, kb + (size_t)bh * NKEY * DQK, vb + (size_t)bh * NKEY * DV, Op, seq, shift, c.lds + LDS_GEMM);
        else attn_body<true>(Qp, kb + (size_t)bh * NKEY * DQK, vb + (size_t)bh * NKEY * DV, Op, seq, shift, c.lds + LDS_GEMM);
    }
#ifndef ATT_ONLY
    const short* zbuf = (const short*)((char*)c.out); const short* F1 = (const short*)(c.ws + WS_F1); short* P1 = (short*)(c.ws + WS_P1);
    const float2* tw = (const float2*)(c.ws + WS_TW);
    for (int u = c.vcu; u < 1024; u += c.G) {
        const int n2 = u & 127, g = (u >> 7) & 3, b = u >> 9;
        const short* Zb = zbuf + (size_t)(T_CTX + b * SEQ + n2) * ZLD + 416 + g * 128;
        const short* W = (const short*)(c.ws + WS_WCS) + ((size_t)(l * 4 + g) * 128) * 256;
        short* Pb = P1 + ((size_t)(b * 4 + g) * 128 * 128 + n2) * 256;
        LAS char* Sres = (LAS char*)(c.lds + LDS_GEMM) + 65536;
        gemm_tile<1, 4, 4, 2, true, true, 1>(c.lds + LDS_GEMM, 2,
            [&](int r) { return Zb + (size_t)r * (128 * ZLD); },
            [&](int k) { return W + (size_t)k * 256; },
            [&](f32x16 (&acc)[1][4], int wm, int wn) {
                for_acc_bf8<1, 4>(acc, wm, wn, lane, [&](int n1, int cc, u32x4 v) { const int kk = 2 * n1 + (cc >> 7), cp = cc & 127;
                    *(LAS u32x4*)(Sres + (kk >> 6) * 16384 + nn_st<128>(kk & 63, cp)) = v; });
            });
        gemm_tile<2, 2, 4, 2, true, true, 2, true>(c.lds + LDS_GEMM, 4,
            [&](int r) { return F1 + (size_t)r * 256; },
            [&](int kk) { return (const short*)nullptr; },
            [&](f32x16 (&acc)[2][2], int wm, int wn) {
                const int hi = lane >> 5, r32 = lane & 31; const int k1 = wm * 32 + r32;
                const float2 t = tw[(n2 * k1) & 16383];
                short* p = Pb + (size_t)k1 * (128 * 256);
#pragma unroll
                for (int nb = 0; nb < 2; ++nb)
#pragma unroll
                    for (int s = 0; s < 2; ++s) { float yr[8], yi[8];
#pragma unroll
                        for (int j = 0; j < 8; ++j) { const float a = acc[0][nb][8 * s + j], bb = acc[1][nb][8 * s + j]; yr[j] = a * t.x + bb * t.y; yi[j] = bb * t.x - a * t.y; }
                        const int cc = (wn * 2 + nb) * 32 + 16 * s + 8 * hi;
                        *(u32x4*)(p + cc) = pack8(yr); *(u32x4*)(p + 128 + cc) = pack8(yi); }
            });
    }
    if (l < DEPTH - 1) {
        const short* FC = (const short*)(c.ws + WS_FC);
        for (int u = c.vcu; u < 8; u += c.G) {
            const int g = u & 3, b = u >> 2;
            const short* Ub = (const short*)(c.ws + WS_UCTX) + (size_t)(b * NCTX) * 1024 + g * 256;
            gemm_tile<2, 2, 4, 2, true, true>(c.lds + LDS_GEMM, 8,
                [&](int r) { return FC + (size_t)r * 512; },
                [&](int kk) { return Ub + (size_t)(kk >> 1) * 1024 + (kk & 1) * 128; },
                [&](f32x16 (&acc)[2][2], int wm, int wn) {
                    for_acc_bf8<2, 2>(acc, wm, wn, lane, [&](int r, int cc, u32x4 v) { *(u32x4*)(mix + (size_t)(b * NCTX + r) * 1024 + 512 + g * 128 + cc) = v; });
                });
        }
    }
#endif
}

DEVI void phase_fft2(const Params& P, const Ctx& c, int l) {
    TID_SETUP();
    short* mix = (short*)(c.ws + WS_HBUF); const short* P1 = (const short*)(c.ws + WS_P1); const short* F2 = (const short*)(c.ws + WS_F2);
    for (int u = c.vcu; u < 1024; u += c.G) {
        const int k1 = u & 127, g = (u >> 7) & 3, b = u >> 9;
        const short* Pb = P1 + ((size_t)(b * 4 + g) * 128 + k1) * (128 * 256);
        gemm_tile<1, 2, 4, 2, true, true>(c.lds + LDS_GEMM, 4,
            [&](int r) { return F2 + (size_t)r * 256; },
            [&](int kk) { return Pb + (size_t)kk * 128; },
            [&](f32x16 (&acc)[1][2], int wm, int wn) {
                for_acc_bf8<1, 2>(acc, wm, wn, lane, [&](int k2, int cc, u32x4 v) { *(u32x4*)(mix + (size_t)(T_CTX + b * SEQ + k1 + 128 * k2) * 1024 + 512 + g * 128 + cc) = v; });
            });
    }
}

DEVI void phase_outproj(const Params& P, const Ctx& c, int l) {
    TID_SETUP();
    const short* mix = (const short*)(c.ws + WS_HBUF); const short* WT = (const short*)(c.ws + WS_WOUT) + (size_t)l * 1024 * 1024;
    const float* coef = (const float*)(c.ws + WS_COEF) + (size_t)l * 3 * 6 * 1024;
    if (l < DEPTH - 1) for (int u = c.vcu; u < 64; u += c.G) {
        const int rt = u >> 3, ct = u & 7; const int row0 = rt * 64, col0 = ct * 128;
        const float* g1 = coef + (size_t)(2 * 6 + 2) * 1024;
        gemm_tile<1, 1, 2, 4, false, true>(c.lds + LDS_GEMM, 16,
            [&](int r) { return mix + (size_t)(row0 + r) * 1024; },
            [&](int n) { return WT + (size_t)(col0 + n) * 1024; },
            [&](f32x16 (&acc)[1][1], int wm, int wn) {
                for_acc_f4<1, 1>(acc, wm, wn, lane, [&](int r, int cc, f32x4 v) { const int row = row0 + r, col = col0 + cc;
                    const f32x4 x = res_load4(P, c, row, col, l), g = *(const f32x4*)(g1 + col);
                    st_bf4(res_row(c, row) + col, f32x4{x[0] + g[0] * v[0], x[1] + g[1] * v[1], x[2] + g[2] * v[2], x[3] + g[3] * v[3]}); });
            });
    }
    for (int u = c.vcu; u < 512; u += c.G) {
        const int rt = 2 + (u >> 2), ct = u & 3; const int row0 = rt * 256, col0 = ct * 256;
        const float* g1 = coef + (size_t)(row_variant(row0) * 6 + 2) * 1024;
        __syncthreads();
        gemm256<false, 1>(c.lds + LDS_GEMM, 16, mix + (size_t)row0 * 1024, 1024, nullptr, WT + (size_t)col0 * 1024, 1024, 0, nullptr,
            [&](g8_acc& acc, int wr, int wc, int fr, int fq) {
                g8_for_acc8(acc, wr, wc, fr, fq, [&](int r, int cc, const float (&v)[8]) { const int row = row0 + r, col = col0 + cc;
                    float x[8]; res_load8(P, c, row, col, l, x); const f32x4 g0 = *(const f32x4*)(g1 + col), g4 = *(const f32x4*)(g1 + col + 4);
#pragma unroll
                    for (int j = 0; j < 4; ++j) { x[j] += g0[j] * v[j]; x[4 + j] += g4[j] * v[4 + j]; }
                    *(u32x4*)(res_row(c, row) + col) = u32x4{cvtpk(x[0], x[1]), cvtpk(x[2], x[3]), cvtpk(x[4], x[5]), cvtpk(x[6], x[7])}; });
            });
    }
}

DEVI void phase_norm_route(const Params& P, const Ctx& c, int l) {
    TID_SETUP();
    const float* coef = (const float*)(c.ws + WS_COEF) + (size_t)l * 3 * 6 * 1024;
    short* hbuf = (short*)(c.ws + WS_HBUF);
    constexpr int XP = 2064;
    char* xs_hi = c.lds + LDS_GEMM; char* xs_lo = xs_hi + 16 * XP;
    int* lcnt = (int*)(c.lds + LDS_GEMM + 66560);
    int* lrow = lcnt + 64;
    float* lgt = (float*)(c.lds + LDS_GEMM + 73728);
    float* part = (float*)(c.lds + LDS_GEMM + 90112);
    const int rows_per = (T + c.G - 1) / c.G; const int r_begin = c.vcu * rows_per; const int r_lim = (l == DEPTH - 1) ? T_CTX : 0;
    int r_end = r_begin + rows_per; if (r_end > T) r_end = T;
    __syncthreads();
    if (tid < 64) lcnt[tid] = 0;
    int* rcls = (int*)(c.ws + WS_RCLS); float2* rw = (float2*)(c.ws + WS_RW);
    const int e16 = lane & 15, kq = lane >> 4;
    bf16x8 wh[4], wl[4];
#pragma unroll
    for (int s = 0; s < 4; ++s) { float v[8];
#pragma unroll
        for (int j = 0; j < 8; ++j) v[j] = P.in[17][(size_t)(128 * wid + 32 * s + 8 * kq + j) * 16 + e16];
        u32x4 h = {cvtpk(v[0], v[1]), cvtpk(v[2], v[3]), cvtpk(v[4], v[5]), cvtpk(v[6], v[7])};
        u32x4 lo = {cvtpk(v[0] - bflo(h[0]), v[1] - bfhi(h[0])), cvtpk(v[2] - bflo(h[1]), v[3] - bfhi(h[1])), cvtpk(v[4] - bflo(h[2]), v[5] - bfhi(h[2])), cvtpk(v[6] - bflo(h[3]), v[7] - bfhi(h[3]))};
        wh[s] = *reinterpret_cast<bf16x8*>(&h); wl[s] = *reinterpret_cast<bf16x8*>(&lo); }
    const int nrows = r_end - r_begin; const int nch = (nrows + 15) >> 4;
    u32x4 xn[2][2];
#pragma unroll
    for (int h = 0; h < 2; ++h) { int i = 8 * h + wid; if (i > nrows - 1) i = nrows - 1; const short* x = res_row(c, r_begin + i);
#pragma unroll
        for (int q = 0; q < 2; ++q) xn[h][q] = *(const u32x4*)(x + q * 512 + lane * 8); }
    for (int ch = 0; ch < nch; ++ch) {
#pragma unroll
        for (int h = 0; h < 2; ++h) {
            const int i = 16 * ch + 8 * h + wid; const bool valid = i < nrows; const int r = r_begin + (valid ? i : nrows - 1); const int v = row_variant(r);
            const float* a2 = coef + (size_t)(v * 6 + 3) * 1024; const float* b2 = coef + (size_t)(v * 6 + 4) * 1024;
            float xv[2][8]; float ss = 0;
#pragma unroll
            for (int q = 0; q < 2; ++q)
#pragma unroll
                for (int j = 0; j < 4; ++j) { xv[q][2 * j] = bflo(xn[h][q][j]); xv[q][2 * j + 1] = bfhi(xn[h][q][j]); ss += xv[q][2 * j] * xv[q][2 * j] + xv[q][2 * j + 1] * xv[q][2 * j + 1]; }
            if (ch + 1 < nch) { int i2 = i + 16; if (i2 > nrows - 1) i2 = nrows - 1; const short* x = res_row(c, r_begin + i2);
#pragma unroll
                for (int q = 0; q < 2; ++q) xn[h][q] = *(const u32x4*)(x + q * 512 + lane * 8); }
            ss = wave_sum(ss); const float rstd = rsqrtf(ss * (1.f / 1024.f) + EPS);
#pragma unroll
            for (int q = 0; q < 2; ++q) { const int col = q * 512 + lane * 8; const f32x4 a0 = *(const f32x4*)(a2 + col), a4 = *(const f32x4*)(a2 + col + 4), b0 = *(const f32x4*)(b2 + col), b4 = *(const f32x4*)(b2 + col + 4);
                float y[8];
#pragma unroll
                for (int j = 0; j < 4; ++j) { y[j] = xv[q][j] * rstd * a0[j] + b0[j]; y[4 + j] = xv[q][4 + j] * rstd * a4[j] + b4[j]; }
                const u32x4 o = {cvtpk(y[0], y[1]), cvtpk(y[2], y[3]), cvtpk(y[4], y[5]), cvtpk(y[6], y[7])};
                if (valid) *(u32x4*)(hbuf + (size_t)r * 1024 + col) = o;
                const u32x4 ol = {cvtpk(y[0] - bflo(o[0]), y[1] - bfhi(o[0])), cvtpk(y[2] - bflo(o[1]), y[3] - bfhi(o[1])), cvtpk(y[4] - bflo(o[2]), y[5] - bfhi(o[2])), cvtpk(y[6] - bflo(o[3]), y[7] - bfhi(o[3]))};
                *(LAS u32x4*)((LAS char*)xs_hi + (8 * h + wid) * XP + col * 2) = o; *(LAS u32x4*)((LAS char*)xs_lo + (8 * h + wid) * XP + col * 2) = ol; }
        }
        __syncthreads();
        if (ch > 0 && tid < 256) { const float* pp = part + ((ch - 1) & 1) * 2048 + tid; float sum = pp[0];
#pragma unroll
            for (int w = 1; w < 8; ++w) sum += pp[w * 256];
            lgt[(16 * (ch - 1)) * 16 + tid] = sum; }
        f32x4 acc = {0, 0, 0, 0};
#pragma unroll
        for (int s = 0; s < 4; ++s) { const int off = e16 * XP + (128 * wid + 32 * s + 8 * kq) * 2;
            const bf16x8 ah = *(LAS const bf16x8*)((LAS char*)xs_hi + off), al = *(LAS const bf16x8*)((LAS char*)xs_lo + off);
            acc = __builtin_amdgcn_mfma_f32_16x16x32_bf16(ah, wh[s], acc, 0, 0, 0);
            acc = __builtin_amdgcn_mfma_f32_16x16x32_bf16(ah, wl[s], acc, 0, 0, 0);
            acc = __builtin_amdgcn_mfma_f32_16x16x32_bf16(al, wh[s], acc, 0, 0, 0); }
        { float* pw = part + (ch & 1) * 2048 + wid * 256;
#pragma unroll
          for (int j = 0; j < 4; ++j) pw[(4 * kq + j) * 16 + e16] = acc[j]; }
        __syncthreads();
    }
    if (tid < 256) { const float* pp = part + ((nch - 1) & 1) * 2048 + tid; float sum = pp[0];
#pragma unroll
        for (int w = 1; w < 8; ++w) sum += pp[w * 256];
        lgt[(16 * (nch - 1)) * 16 + tid] = sum; }
    __syncthreads();
    for (int i = tid; i < r_end - r_begin; i += NTHR) {
        const int r = r_begin + i; if (r < r_lim) continue;
        float lg[16];
        { const f32x4 t0 = *(const f32x4*)(lgt + i * 16), t1 = *(const f32x4*)(lgt + i * 16 + 4), t2 = *(const f32x4*)(lgt + i * 16 + 8), t3 = *(const f32x4*)(lgt + i * 16 + 12);
#pragma unroll
          for (int j = 0; j < 4; ++j) { lg[j] = t0[j]; lg[4 + j] = t1[j]; lg[8 + j] = t2[j]; lg[12 + j] = t3[j]; } }
        float sc[16], bi[16];
#pragma unroll
        for (int e = 0; e < 16; ++e) { sc[e] = __builtin_amdgcn_rcpf(1.f + __expf(-lg[e])); bi[e] = sc[e] + P.in[18][e]; }
        int bg = 0; float bgs = -1e30f;
#pragma unroll
        for (int g = 0; g < 4; ++g) { float m1 = -1e30f, m2 = -1e30f;
#pragma unroll
            for (int j = 0; j < 4; ++j) { const float t = bi[g * 4 + j]; if (t > m1) { m2 = m1; m1 = t; } else if (t > m2) m2 = t; }
            const float gs = m1 + m2; if (gs > bgs) { bgs = gs; bg = g; } }
        float b4[4], s4[4];
#pragma unroll
        for (int j = 0; j < 4; ++j) { b4[j] = bg == 0 ? bi[j] : bg == 1 ? bi[4 + j] : bg == 2 ? bi[8 + j] : bi[12 + j]; s4[j] = bg == 0 ? sc[j] : bg == 1 ? sc[4 + j] : bg == 2 ? sc[8 + j] : sc[12 + j]; }
        int i1 = 0;
#pragma unroll
        for (int j = 1; j < 4; ++j) if (b4[j] > b4[i1]) i1 = j;
        int i2 = (i1 == 0) ? 1 : 0;
#pragma unroll
        for (int j = 0; j < 4; ++j) if (j != i1 && b4[j] > b4[i2]) i2 = j;
        const int ea = i1 < i2 ? i1 : i2, eb = i1 < i2 ? i2 : i1;
        float wa = 0, wb = 0;
#pragma unroll
        for (int j = 0; j < 4; ++j) { if (j == ea) wa = s4[j]; if (j == eb) wb = s4[j]; }
        const float inv = 1.f / (wa + wb);
        const int pidx = ea == 0 ? eb - 1 : ea == 1 ? eb + 1 : 5;
        const int cls = bg * 6 + pidx;
        const int lp = atomicAdd(&lcnt[cls], 1); lrow[i] = cls | (lp << 8); rcls[r] = cls; rw[r] = make_float2(wa * inv, wb * inv);
    }
    __syncthreads();
    int* gcnt = (int*)(c.ws + WS_CTL + CTL_CNT_OFF) + l * 32;
    if (tid < NCLS) lcnt[32 + tid] = lcnt[tid] > 0 ? (int)__hip_atomic_fetch_add(&gcnt[tid], lcnt[tid], __ATOMIC_RELAXED, __HIP_MEMORY_SCOPE_AGENT) : 0;
    __syncthreads();
    int* clist = (int*)(c.ws + WS_CLIST);
    for (int i = tid; i < r_end - r_begin; i += NTHR) { const int r = r_begin + i; if (r < r_lim) continue; const int w = lrow[i]; const int cls = w & 255, lp = w >> 8; clist[(size_t)cls * T + lcnt[32 + cls] + lp] = r; }
}

DEVI bool moe_decode(const int* gcnt, int u, int per_rt, int& cls, int& rt, int& sub, int& hpad, int& ccnt) {
    int acc_t = 0, acc_h = 0;
    for (int cc = 0; cc < NCLS; ++cc) { const int n = __builtin_amdgcn_readfirstlane(gcnt[cc]);
        const int nrt = (n + 255) >> 8; const int nt = nrt * per_rt;
        if (u < acc_t + nt) { cls = cc; const int loc = u - acc_t; rt = loc / per_rt; sub = loc % per_rt; hpad = acc_h; ccnt = n; return true; }
        acc_t += nt; acc_h += nrt * 256; }
    return false;
}
DEVI void cls_experts(int cls, int& ea, int& eb) { const int g = cls / 6, p = cls % 6; const int a = p < 3 ? 0 : p < 5 ? 1 : 2; const int b = p < 3 ? p + 1 : p < 5 ? p - 1 : 3; ea = g * 4 + a; eb = g * 4 + b; }

DEVI int moe_total(const int* gcnt, int per_rt) { int t = 0; for (int cc = 0; cc < NCLS; ++cc) { const int n = __builtin_amdgcn_readfirstlane(gcnt[cc]); t += ((n + 255) >> 8) * per_rt; } return t; }
DEVI int moe_nfull(int utot, int G) { const int nf = (utot / G) * G; return ((utot - nf) * 4 > 2 * G) ? utot : nf; }

DEVI void phase_moe_up(const Params& P, const Ctx& c, int l) {
    TID_SETUP();
    const int* gcnt = (const int*)(c.ws + WS_CTL + CTL_CNT_OFF) + l * 32;
    const short* hbuf = (const short*)(c.ws + WS_HBUF); short* Hm = (short*)(c.ws + WS_KBUF);
    const int* clist = (const int*)(c.ws + WS_CLIST); const float2* rw = (const float2*)(c.ws + WS_RW);
    int* ltok = (int*)(c.lds + LDS_STAT); float* lw = (float*)(c.lds + LDS_STAT + 1024);
    const int utot = moe_total(gcnt, 4), nfull = moe_nfull(utot, c.G);
    for (int it = c.vcu; it < nfull + (utot - nfull) * 4; it += c.G) {
        const bool fast = it < nfull; const int u = fast ? it : nfull + ((it - nfull) >> 2); const int q = (it - nfull) & 3;
        int cls, rt, ct, hpad, ccnt; if (!moe_decode(gcnt, u, 4, cls, rt, ct, hpad, ccnt)) break;
        int ea, eb; cls_experts(cls, ea, eb); const int e = ct < 2 ? ea : eb;
        __syncthreads();
        { int t2 = threadIdx.x; asm volatile("" : "+v"(t2));
          if (t2 < 256) { int i = rt * 256 + t2; if (i > ccnt - 1) i = ccnt - 1; const int tok = clist[(size_t)cls * T + i]; ltok[t2] = tok; const float2 w = rw[tok]; lw[t2] = ct < 2 ? w.x : w.y; } }
        asm volatile("s_waitcnt vmcnt(0)" ::: "memory");
        __syncthreads();
        const short* WT = (const short*)(c.ws + WS_WGU) + ((size_t)(l * 16 + e) * 512 + (ct & 1) * 256) * 1024;
        short* Hrow = Hm + (size_t)(hpad + rt * 256) * 512 + (ct >> 1) * 256;
        if (fast) {
            gemm256<true, 1>(c.lds + LDS_GEMM, 16, hbuf, 1024, ltok, WT, 1024, 0, nullptr,
                [&](g8_acc& acc, int wr, int wc, int fr, int fq) {
#pragma unroll
                    for (int ai = 0; ai < 2; ++ai)
#pragma unroll
                        for (int m = 0; m < 4; ++m) { SBAR(); const int row = ai * 128 + wr * 64 + m * 16 + fr; const float w = lw[row];
                            unsigned pk[2][2];
#pragma unroll
                            for (int bj = 0; bj < 2; ++bj) { const f32x4 g = acc[ai][bj][m][0], uu = acc[ai][bj][m][1]; float hv[4];
#pragma unroll
                                for (int j = 0; j < 4; ++j) hv[j] = silu(g[j]) * uu[j] * w;
                                pk[bj][0] = cvtpk(hv[0], hv[1]); pk[bj][1] = cvtpk(hv[2], hv[3]); }
                            auto r0 = __builtin_amdgcn_permlane16_swap(pk[0][0], pk[1][0], false, false); auto r1 = __builtin_amdgcn_permlane16_swap(pk[0][1], pk[1][1], false, false);
                            *(u32x4*)(Hrow + (size_t)row * 512 + ((ct & 1) * 8 + (fq & 1) * 4 + wc) * 16 + (fq & ~1) * 4) = u32x4{r0[0], r1[0], r0[1], r1[1]}; }
                });
        } else {
            gemm_tile<1, 2, 8, 1, false, true>(c.lds + LDS_GEMM, 16,
                [&](int r) { return hbuf + (size_t)ltok[r] * 1024; },
                [&](int n) { return WT + (size_t)(q * 64 + n) * 1024; },
                [&](f32x16 (&acc)[1][2], int wm, int wn) {
                    const int hi = lane >> 5, r32 = lane & 31; const int row = wm * 32 + r32; const float w = lw[row];
#pragma unroll
                    for (int nb = 0; nb < 2; ++nb)
#pragma unroll
                        for (int s = 0; s < 2; ++s) { float hv[4];
#pragma unroll
                            for (int j = 0; j < 4; ++j) hv[j] = silu(acc[0][nb][4 * s + j]) * acc[0][nb][8 + 4 * s + j] * w;
                            *(u32x2*)(Hrow + (size_t)row * 512 + ((ct & 1) * 8 + q * 2 + nb) * 16 + 8 * s + 4 * hi) = u32x2{cvtpk(hv[0], hv[1]), cvtpk(hv[2], hv[3])}; }
                });
        }
    }
}
DEVI void phase_moe_down(const Params& P, const Ctx& c, int l) {
    TID_SETUP();
    const int* gcnt = (const int*)(c.ws + WS_CTL + CTL_CNT_OFF) + l * 32;
    const short* Hm = (const short*)(c.ws + WS_KBUF);
    const int* clist = (const int*)(c.ws + WS_CLIST);
    const float* coef = (const float*)(c.ws + WS_COEF) + (size_t)l * 3 * 6 * 1024;
    unsigned long long* lrp = (unsigned long long*)(c.lds + LDS_STAT);
    const int utot = moe_total(gcnt, 4), nfull = moe_nfull(utot, c.G);
    for (int it = c.vcu; it < nfull + (utot - nfull) * 4; it += c.G) {
        const bool fast = it < nfull; const int u = fast ? it : nfull + ((it - nfull) >> 2); const int q = (it - nfull) & 3;
        int cls, rt, ct, hpad, ccnt; if (!moe_decode(gcnt, u, 4, cls, rt, ct, hpad, ccnt)) break;
        __syncthreads();
        { int t2 = threadIdx.x; asm volatile("" : "+v"(t2));
          if (t2 < 256) { int i = rt * 256 + t2; if (i > ccnt - 1) i = ccnt - 1; const int tok = clist[(size_t)cls * T + i]; lrp[t2] = (unsigned long long)(uintptr_t)res_row(c, tok) | (unsigned long long)row_variant(tok); } }
        asm volatile("s_waitcnt vmcnt(0)" ::: "memory");
        __syncthreads();
        const short* WT = (const short*)(c.ws + WS_WDN) + ((size_t)(l * NCLS + cls) * 1024 + ct * 256) * 512;
        const short* Ab = Hm + (size_t)(hpad + rt * 256) * 512;
        auto rmw = [&](int rl, int col, f32x4 v) { const int i = rt * 256 + rl;
            if (i < ccnt) { const unsigned long long pv = lrp[rl]; short* xr = (short*)(uintptr_t)(pv & ~3ull) + col; const f32x4 g = *(const f32x4*)(coef + (size_t)((int)(pv & 3ull) * 6 + 5) * 1024 + col);
                const f32x4 x = ld_bf4(xr); const f32x4 y = f32x4{x[0] + g[0] * v[0], x[1] + g[1] * v[1], x[2] + g[2] * v[2], x[3] + g[3] * v[3]};
                if (l < DEPTH - 1) st_bf4(xr, y);
                else *(f32x4*)((char*)c.out + (((size_t)(uintptr_t)xr - (size_t)(uintptr_t)(c.ws + WS_RES)) - (size_t)T_CTX * D * 2) * 2) = y; } };
        if (fast) {
            gemm256<false, 1>(c.lds + LDS_GEMM, 8, Ab, 512, nullptr, WT, 512, 0, nullptr,
                [&](g8_acc& acc, int wr, int wc, int fr, int fq) { g8_for_acc8(acc, wr, wc, fr, fq, [&](int rl, int cc, const float (&v)[8]) { const int col = ct * 256 + cc; const int i = rt * 256 + rl;
                    if (i < ccnt) { const unsigned long long pv = lrp[rl]; short* xr = (short*)(uintptr_t)(pv & ~3ull) + col; const float* gp = coef + (size_t)((int)(pv & 3ull) * 6 + 5) * 1024 + col;
                        const f32x4 g0 = *(const f32x4*)gp, g4 = *(const f32x4*)(gp + 4); const u32x4 w = *(const u32x4*)xr; float y[8];
#pragma unroll
                        for (int j = 0; j < 4; ++j) { y[2 * j] = bflo(w[j]); y[2 * j + 1] = bfhi(w[j]); }
#pragma unroll
                        for (int j = 0; j < 4; ++j) { y[j] += g0[j] * v[j]; y[4 + j] += g4[j] * v[4 + j]; }
                        if (l < DEPTH - 1) *(u32x4*)xr = u32x4{cvtpk(y[0], y[1]), cvtpk(y[2], y[3]), cvtpk(y[4], y[5]), cvtpk(y[6], y[7])};
                        else { float* op = (float*)((char*)c.out + (((size_t)(uintptr_t)xr - (size_t)(uintptr_t)(c.ws + WS_RES)) - (size_t)T_CTX * D * 2) * 2);
                            *(f32x4*)op = f32x4{y[0], y[1], y[2], y[3]}; *(f32x4*)(op + 4) = f32x4{y[4], y[5], y[6], y[7]}; } } }); });
        } else {
            gemm_tile<1, 2, 8, 1, false, true>(c.lds + LDS_GEMM, 8,
                [&](int r) { return Ab + (size_t)r * 512; },
                [&](int n) { return WT + (size_t)(q * 64 + n) * 512; },
                [&](f32x16 (&acc)[1][2], int wm, int wn) { for_acc_f4<1, 2>(acc, wm, wn, lane, [&](int rl, int cc, f32x4 v) { rmw(rl, ct * 256 + q * 64 + cc, v); }); });
        }
    }
}

__global__ void __launch_bounds__(NTHR, 2) mega_fwd(Params P) {
    extern __shared__ __attribute__((aligned(16))) char lds[];
    Ctx c;
    c.out = P.out; c.ws = P.ws; c.lds = lds; c.G = gridDim.x;
    { const int bx = blockIdx.x; c.vcu = (c.G % 8 == 0) ? (bx % 8) * (c.G / 8) + bx / 8 : bx; }
    volatile LAS unsigned* st = (volatile LAS unsigned*)(lds + LDS_MISC);
    if (threadIdx.x < 4) st[threadIdx.x] = 0u;
    __syncthreads();
    XcdBarrier bar = xcd_barrier_post((unsigned*)(P.ws + WS_CTL), st);
    int ph = 0;
#define PHASE_END() do { if (++ph >= P.nphases) return; if (ph > P.ph_lo) xcd_barrier(bar); } while (0)
    if ((PHMASK & 1) && ph >= P.ph_lo) phase_prologue(P, c); PHASE_END();
    if ((PHMASK & 2) && ph >= P.ph_lo) phase_coef(P, c); PHASE_END();
    for (int l = 0; l < DEPTH; ++l) {
        if ((PHMASK & 4) && ph >= P.ph_lo) { phase_norm_mix(P, c, l); if (REPMASK & 4) { xcd_barrier(bar); phase_norm_mix(P, c, l); } } PHASE_END();
        if ((PHMASK & 8) && ph >= P.ph_lo) { phase_inproj(P, c, l); if (REPMASK & 8) { xcd_barrier(bar); phase_inproj(P, c, l); } } PHASE_END();
        if ((PHMASK & 16) && ph >= P.ph_lo) { phase_proj2(P, c, l); if (REPMASK & 16) { xcd_barrier(bar); phase_proj2(P, c, l); } } PHASE_END();
        if ((PHMASK & 32) && ph >= P.ph_lo) { phase_attn_fft1(P, c, l); if (REPMASK & 32) { xcd_barrier(bar); phase_attn_fft1(P, c, l); } } PHASE_END();
        if ((PHMASK & 64) && ph >= P.ph_lo) { phase_fft2(P, c, l); if (REPMASK & 64) { xcd_barrier(bar); phase_fft2(P, c, l); } } PHASE_END();
        if ((PHMASK & 128) && ph >= P.ph_lo) { phase_outproj(P, c, l); if (REPMASK & 128) { xcd_barrier(bar); phase_outproj(P, c, l); } } PHASE_END();
        if ((PHMASK & 256) && ph >= P.ph_lo) { phase_norm_route(P, c, l); if (REPMASK & 256) { xcd_barrier(bar); phase_norm_route(P, c, l); } } PHASE_END();
        if ((PHMASK & 512) && ph >= P.ph_lo) { phase_moe_up(P, c, l); if (REPMASK & 512) { xcd_barrier(bar); phase_moe_up(P, c, l); } } PHASE_END();
        if ((PHMASK & 1024) && ph >= P.ph_lo) { phase_moe_down(P, c, l); if (REPMASK & 1024) { xcd_barrier(bar); phase_moe_down(P, c, l); } } PHASE_END();
    }
}


#ifdef DUMPDBG
__global__ void dump_kernel(float* out, const char* ws, int keep_out) {
    const size_t n = (size_t)T_LAT * D;
    for (size_t i = (size_t)blockIdx.x * blockDim.x + threadIdx.x; i < n; i += (size_t)gridDim.x * blockDim.x) {
        float v = keep_out ? out[i] : 0.f;
        const size_t offs[8] = {WS_HBUF, WS_ZBUF, WS_QBUF, WS_KBUF, WS_VBUF, WS_UBUF, WS_WCS, WS_WIN};
        const size_t lens[8] = {(size_t)T * 1024, (size_t)T * 1024, (size_t)BATCH * NH * SEQ * DQK, (size_t)BATCH * NH * NKEY * DQK, (size_t)BATCH * NH * NKEY * DV, (size_t)T * 1024, (size_t)4 * 4 * 128 * 256, (size_t)4 * 1024 * 1024};
#pragma unroll
        for (int b = 0; b < 8; ++b) {
            if (!((DUMPMASK >> b) & 1)) continue;
            const unsigned short u = ((const unsigned short*)(ws + offs[b]))[i % lens[b]];
            float f = __uint_as_float(((unsigned)u) << 16);
            if (!(fabsf(f) < 1e30f)) f = 777.f;
            v += f;
        }
        if (!(fabsf(v) < 1e30f)) v = 999.f;
        out[i] = v;
    }
}
#endif

#ifdef CHECKDBG
constexpr size_t WS_CHK = WS_END;
__device__ inline float blk_sum(float v, float* red) {
    for (int o = 32; o > 0; o >>= 1) v += __shfl_xor(v, o, 64);
    __syncthreads(); if ((threadIdx.x & 63) == 0) red[threadIdx.x >> 6] = v; __syncthreads();
    float t = 0; for (int i = 0; i < (int)blockDim.x / 64; ++i) t += red[i]; return t;
}
__device__ inline float blk_max(float v, float* red) {
    for (int o = 32; o > 0; o >>= 1) v = fmaxf(v, __shfl_xor(v, o, 64));
    __syncthreads(); if ((threadIdx.x & 63) == 0) red[threadIdx.x >> 6] = v; __syncthreads();
    float t = -1e30f; for (int i = 0; i < (int)blockDim.x / 64; ++i) t = fmaxf(t, red[i]); return t;
}
__global__ void chk_qkv(Params P) {
    __shared__ float red[8]; __shared__ float xin[256]; __shared__ float outv[128]; __shared__ float kr[32];
    const int s = blockIdx.x, tid = threadIdx.x;
    const int row = (s * 7919 + 13) % T; const int h = s & 7;
    const short* z = (const short*)P.out + (size_t)row * ZLD;
    const bool lat = row >= T_CTX; const int rr = lat ? row - T_CTX : row; const int b = lat ? (rr >> 14) : (rr >> 8); const int n = lat ? (rr & 16383) : (rr & 255);
    float* err = (float*)(P.ws + WS_CHK);
    const float2* ropetab = (const float2*)(P.ws + WS_ROPE);
    { const float cq = bf2f((unsigned short)z[tid]); const float ms = blk_sum(cq * cq, red) / 256.f; xin[tid] = cq * rsqrtf(ms + EPS) * P.in[9][tid]; __syncthreads();
      float u = 0; if (tid < 96) for (int k = 0; k < 256; ++k) u += xin[k] * P.in[10][(size_t)k * 768 + h * 96 + tid];
      const float ms2 = blk_sum(tid < 96 ? u * u : 0.f, red) / 96.f; if (tid < 96) outv[tid] = u * rsqrtf(ms2 + EPS) * P.in[13][tid]; __syncthreads();
      float val = 0; if (tid < 96) { val = outv[tid];
        if (lat && tid >= 64) { const int m = tid - 64; const int ax = m >> 4, i = m & 7, second = (m >> 3) & 1; const int pos = ax == 0 ? (n >> 6) : (n & 63); const float2 cs = ropetab[pos * 8 + i];
            const float x1 = outv[64 + ax * 16 + i], x2 = outv[64 + ax * 16 + 8 + i]; val = second ? (x2 * cs.x + x1 * cs.y) : (x1 * cs.x - x2 * cs.y); }
        val *= ATT_QSCALE; }
      const short* qd = lat ? (const short*)(P.ws + WS_QBUF) + ((size_t)(b * NH + h) * SEQ + n) * DQK : (const short*)(P.ws + WS_QCTX) + ((size_t)(b * NH + h) * NCTX + n) * DQK;
      const float got = tid < 96 ? bf2f((unsigned short)qd[tid]) : 0.f;
      const float d2 = blk_sum(tid < 96 ? (got - val) * (got - val) : 0.f, red), r2 = blk_sum(tid < 96 ? val * val : 0.f, red);
      if (tid == 0) { atomicAdd(&err[0], d2); atomicAdd(&err[1], r2); } }
    { __syncthreads(); const float ck = tid < 128 ? bf2f((unsigned short)z[256 + tid]) : 0.f; const float ms = blk_sum(ck * ck, red) / 128.f; if (tid < 128) xin[tid] = ck * rsqrtf(ms + EPS) * P.in[11][tid];
      if (tid < 32) kr[tid] = bf2f((unsigned short)z[384 + tid]); __syncthreads();
      float u = 0; if (tid < 128) for (int k = 0; k < 128; ++k) u += xin[k] * P.in[12][(size_t)k * 1024 + h * 128 + tid];
      float sq = 0; if (tid < 64) sq = u * u; else if (tid >= 128 && tid < 160) sq = kr[tid - 128] * kr[tid - 128];
      const float ms2 = blk_sum(sq, red) / 96.f; const float rs = rsqrtf(ms2 + EPS);
      if (tid < 64) outv[tid] = u * rs * P.in[14][tid]; if (tid >= 128 && tid < 160) outv[64 + tid - 128] = kr[tid - 128] * rs * P.in[14][64 + tid - 128]; __syncthreads();
      const int pos = lat ? NCTX + n : n;
      float val = 0; if (tid < 96) { val = outv[tid];
        if (lat && tid >= 64) { const int m = tid - 64; const int ax = m >> 4, i = m & 7, second = (m >> 3) & 1; const int pp = ax == 0 ? (n >> 6) : (n & 63); const float2 cs = ropetab[pp * 8 + i];
            const float x1 = outv[64 + ax * 16 + i], x2 = outv[64 + ax * 16 + 8 + i]; val = second ? (x2 * cs.x + x1 * cs.y) : (x1 * cs.x - x2 * cs.y); } }
      const short* kd = (const short*)(P.ws + WS_KBUF) + ((size_t)(b * NH + h) * NKEY + pos) * DQK;
      const float gotk = tid < 96 ? bf2f((unsigned short)kd[tid]) : 0.f;
      float d2 = blk_sum(tid < 96 ? (gotk - val) * (gotk - val) : 0.f, red), r2 = blk_sum(tid < 96 ? val * val : 0.f, red);
      if (tid == 0) { atomicAdd(&err[2], d2); atomicAdd(&err[3], r2); }
      const short* vd = (const short*)(P.ws + WS_VBUF) + ((size_t)(b * NH + h) * NKEY + pos) * DV;
      const bool isv = tid >= 64 && tid < 128; const float gotv = isv ? bf2f((unsigned short)vd[tid - 64]) : 0.f; const float vv = isv ? u : 0.f;
      d2 = blk_sum((gotv - vv) * (gotv - vv), red); r2 = blk_sum(vv * vv, red);
      if (tid == 0) { atomicAdd(&err[4], d2); atomicAdd(&err[5], r2); } }
}
__global__ void chk_attn(Params P) {
    extern __shared__ float pbuf[];
    __shared__ float red[8]; __shared__ float qv[96];
    const int s = blockIdx.x, tid = threadIdx.x; const int b = s & 1, h = (s >> 1) & 7; const bool ctxq = (s % 5) == 4; const int n = ctxq ? (s * 37) % NCTX : (s * 4099 + 77) % SEQ;
    const int bh = b * NH + h; const int nk = ctxq ? NCTX : NKEY;
    const short* q = ctxq ? (const short*)(P.ws + WS_QCTX) + ((size_t)bh * NCTX + n) * DQK : (const short*)(P.ws + WS_QBUF) + ((size_t)bh * SEQ + n) * DQK;
    const short* K = (const short*)(P.ws + WS_KBUF) + (size_t)bh * NKEY * DQK; const short* V = (const short*)(P.ws + WS_VBUF) + (size_t)bh * NKEY * DV;
    if (tid < 96) qv[tid] = bf2f((unsigned short)q[tid]); __syncthreads();
    float mx = -1e30f;
    for (int k = tid; k < nk; k += blockDim.x) { float a = 0; for (int d = 0; d < 96; ++d) a += qv[d] * bf2f((unsigned short)K[(size_t)k * DQK + d]); pbuf[k] = a; mx = fmaxf(mx, a); }
    mx = blk_max(mx, red);
    float sm = 0; for (int k = tid; k < nk; k += blockDim.x) { const float p = exp2f(pbuf[k] - mx); pbuf[k] = p; sm += p; }
    sm = blk_sum(sm, red);
    float o = 0; if (tid < 64) for (int k = 0; k < nk; ++k) o += pbuf[k] * bf2f((unsigned short)V[(size_t)k * DV + tid]);
    o /= sm;
    const short* mix = (const short*)(P.ws + WS_HBUF) + (size_t)(ctxq ? b * NCTX + n : T_CTX + b * SEQ + n) * 1024 + h * DV;
    const float got = tid < 64 ? bf2f((unsigned short)mix[tid]) : 0.f; const float ov = tid < 64 ? o : 0.f;
    const float d2 = blk_sum((got - ov) * (got - ov), red), r2 = blk_sum(ov * ov, red);
    float* err = (float*)(P.ws + WS_CHK);
    if (tid == 0) { atomicAdd(&err[6], d2); atomicAdd(&err[7], r2); }
}
__global__ void chk_fixup(float* out, const char* ws) {
    const float* err = (const float*)(ws + WS_CHK);
    float e = 0.f; bool zero = false;
    for (int k = 0; k < 4; ++k) if ((CHECKSEL >> k) & 1) { e = fmaxf(e, sqrtf(err[2 * k] / fmaxf(err[2 * k + 1], 1e-30f))); zero |= (err[2 * k + 1] == 0.f); }
    float f = 1.f; if (!(e < 0.006f)) f = 1.1f; if (!(e < 0.02f)) f = 1.3f; if (!(e < 0.1f)) f = 2.f; if (zero) f = 3.f;
    if (f == 1.f) return;
    const size_t n = (size_t)T_LAT * D;
    for (size_t i = (size_t)blockIdx.x * blockDim.x + threadIdx.x; i < n; i += (size_t)gridDim.x * blockDim.x) out[i] *= f;
}
#endif
#ifndef PHMASK
#define PHMASK 0xffff
#endif
#ifndef NPHASES
#define NPHASES 1000
#endif
extern "C" void kernel_launch(void* const* d_in, const int* in_sizes, int n_in, void* d_out, int out_size, void* d_ws, size_t ws_size, hipStream_t stream) {
    static int grid = 0;
    if (grid == 0) {
        if (n_in != 22 || out_size != T_LAT * D || ws_size < WS_END) { fprintf(stderr, "kernel_launch: shape/workspace mismatch (n_in %d out %d ws %zu need %zu)\n", n_in, out_size, ws_size, (size_t)WS_END); grid = -1; return; }
        int dev = 0, cus = 0, per_cu = 0;
        if (hipGetDevice(&dev) != hipSuccess || hipDeviceGetAttribute(&cus, hipDeviceAttributeMultiprocessorCount, dev) != hipSuccess) { grid = -1; return; }
        if (hipFuncSetAttribute((const void*)mega_fwd, hipFuncAttributeMaxDynamicSharedMemorySize, LDS_BYTES) != hipSuccess) { fprintf(stderr, "kernel_launch: hipFuncSetAttribute failed\n"); grid = -1; return; }
        if (hipOccupancyMaxActiveBlocksPerMultiprocessor(&per_cu, (const void*)mega_fwd, NTHR, LDS_BYTES) != hipSuccess || per_cu < 1) { fprintf(stderr, "kernel_launch: occupancy query says %d\n", per_cu); grid = -1; return; }
        (void)hipGetLastError();
#ifdef CHECKDBG
        (void)hipFuncSetAttribute((const void*)chk_attn, hipFuncAttributeMaxDynamicSharedMemorySize, NKEY * 4);
#endif
        grid = cus;
    }
    if (grid < 0) return;
    hipMemsetAsync((char*)d_ws + WS_CTL, 0, CTL_BYTES, stream);
    Params p{};
    for (int i = 0; i < 22; ++i) p.in[i] = (const float*)d_in[i];
    p.out = (float*)d_out; p.ws = (char*)d_ws; p.nphases = NPHASES; p.ph_lo = 0;
#ifdef CHECKDBG
    hipMemsetAsync((char*)d_ws + WS_CHK, 0, 64, stream);
    p.nphases = 5; hipLaunchKernelGGL(mega_fwd, dim3(grid), dim3(NTHR), LDS_BYTES, stream, p);
    hipLaunchKernelGGL(chk_qkv, dim3(512), dim3(256), 0, stream, p);
    hipMemsetAsync((char*)d_ws + WS_CTL, 0, CTL_BYTES, stream);
    p.nphases = 6; hipLaunchKernelGGL(mega_fwd, dim3(grid), dim3(NTHR), LDS_BYTES, stream, p);
    hipLaunchKernelGGL(chk_attn, dim3(160), dim3(256), NKEY * 4, stream, p);
    hipMemsetAsync((char*)d_ws + WS_CTL, 0, CTL_BYTES, stream);
    p.nphases = NPHASES;
#endif
#ifdef SPLIT_AT
    p.nphases = SPLIT_AT;
    hipLaunchKernelGGL(mega_fwd, dim3(grid), dim3(NTHR), LDS_BYTES, stream, p);
    hipMemsetAsync((char*)d_ws + WS_CTL, 0, XCD_BAR_WORDS * 4, stream);
    p.nphases = NPHASES; p.ph_lo = SPLIT_AT;
#endif
    hipLaunchKernelGGL(mega_fwd, dim3(grid), dim3(NTHR), LDS_BYTES, stream, p);
    const hipError_t le = hipPeekAtLastError();
    if (le != hipSuccess) fprintf(stderr, "kernel_launch: launch failed: %s\n", hipGetErrorName(le));
#ifdef CHECKDBG
    hipLaunchKernelGGL(chk_fixup, dim3(2048), dim3(256), 0, stream, (float*)d_out, (const char*)d_ws);
#endif
#ifdef DUMPDBG
    hipLaunchKernelGGL(dump_kernel, dim3(2048), dim3(256), 0, stream, (float*)d_out, (const char*)d_ws, (NPHASES >= 8) ? 1 : 0);
#endif
}
```

```cpp
#include <hip/hip_runtime.h>
#include <hip/hip_bf16.h>
#include <cstdint>
#include <cstdio>

#define DEVI __device__ __forceinline__
#define PC_U0 0


#define EXP_WAIT() asm volatile("s_waitcnt vmcnt(0)" ::: "memory")

#define CHECKSEL 8
#ifndef REPMASK
#define REPMASK 0
#endif
#ifndef PHMASK
#define PHMASK 0xffff
#endif

constexpr int D = 1024, BATCH = 2, SEQ = 16384, DEPTH = 4, NCTX = 256;
constexpr int T_CTX = BATCH * NCTX, T_LAT = BATCH * SEQ, T = T_CTX + T_LAT;
constexpr int NH = 8, DQK = 96, DV = 64, QLR = 256, KVLR = 128;
constexpr int NKEY = NCTX + SEQ;
constexpr int INW = 928;
constexpr int ZLD = 1024;
constexpr int NE = 16, DE = 256, NCLS = 24;
constexpr float EPS = 1e-6f;
constexpr float ATT_QSCALE = 0.10206207261596577f * 1.4426950408889634f;
constexpr int NTHR = 512;

constexpr size_t al256(size_t x) { return (x + 255) / 256 * 256; }
constexpr size_t WS_CTL   = 0;
constexpr size_t CTL_BYTES = 65536;
constexpr size_t CTL_CNT_OFF = 32768;
constexpr size_t WS_COEF  = WS_CTL + CTL_BYTES;
constexpr size_t WS_F1    = WS_COEF + al256((size_t)4 * 3 * 6 * 1024 * 4);
constexpr size_t WS_F2    = WS_F1 + 256 * 256 * 2;
constexpr size_t WS_FC    = WS_F2 + 128 * 256 * 2;
constexpr size_t WS_TW    = WS_FC + 256 * 512 * 2;
constexpr size_t WS_ROPE  = WS_TW + 16384 * 8;
constexpr size_t WS_WIN   = WS_ROPE + 256 * 8 * 8;
constexpr size_t WS_WOUT  = WS_WIN + (size_t)4 * 1024 * 1024 * 2;
constexpr size_t WS_WGU   = WS_WOUT + (size_t)4 * 1024 * 1024 * 2;
constexpr size_t WS_WDN   = WS_WGU + (size_t)4 * 16 * 1024 * 512 * 2;
constexpr size_t WS_WQT   = WS_WDN + (size_t)4 * NCLS * 1024 * 512 * 2;
constexpr size_t WS_WKVT  = WS_WQT + (size_t)4 * 768 * 256 * 2;
constexpr size_t WS_WCS   = WS_WKVT + (size_t)4 * 1024 * 128 * 2;
constexpr size_t WS_CTXR  = WS_WCS + (size_t)4 * 4 * 128 * 256 * 2;
constexpr size_t WS_RCLS  = WS_CTXR + (size_t)T_CTX * 1024 * 4;
constexpr size_t WS_RW    = WS_RCLS + al256((size_t)T * 4);
constexpr size_t WS_CLIST = WS_RW + al256((size_t)T * 8);
constexpr size_t WS_HBUF  = WS_CLIST + al256((size_t)NCLS * T * 4);
constexpr size_t WS_MODP  = WS_HBUF;
constexpr size_t WS_RES   = WS_HBUF + (size_t)T * 1024 * 2;
constexpr size_t WS_ZBUF  = WS_RES;
constexpr size_t WS_QBUF  = WS_ZBUF + (size_t)T * 1024 * 2;
constexpr size_t WS_QCTX  = WS_QBUF + (size_t)BATCH * NH * SEQ * DQK * 2;
constexpr size_t WS_KBUF  = WS_QCTX + (size_t)BATCH * NH * NCTX * DQK * 2;
constexpr size_t WS_VBUF  = WS_KBUF + (size_t)BATCH * NH * NKEY * DQK * 2;
constexpr size_t WS_UBUF  = WS_VBUF + (size_t)BATCH * NH * NKEY * DV * 2;
constexpr size_t WS_P1    = WS_UBUF;
constexpr size_t WS_UCTX  = WS_UBUF + (size_t)2 * 4 * 128 * 128 * 256 * 2;
static_assert(WS_UCTX + (size_t)T_CTX * 1024 * 2 <= WS_UBUF + (size_t)T * 1024 * 2, "P1 + ctx U fit the U region");
constexpr size_t WS_END   = WS_UBUF + (size_t)T * 1024 * 2;
static_assert((size_t)2 * 4 * 128 * 128 * 256 * 2 <= (size_t)T * 1024 * 2, "P1 fits zbuf region");
static_assert((size_t)(T + NCLS * 256) * 512 * 2 <= (size_t)BATCH * NH * NKEY * DQK * 2, "Hmoe (class-padded rows) fits kbuf region");
static_assert(WS_END <= (size_t)4 * T_LAT * D * 4, "workspace map must fit 4 x the largest tensor (the guaranteed d_ws size)");

constexpr int LDS_GEMM = 0;
constexpr int LDS_STAT = 128 * 1024;
constexpr int LDS_MISC = 132 * 1024;
constexpr int LDS_BYTES = 133 * 1024;

#define XB_TMO      128
#define XB_XCNT(j)  (256  + 64 * (j))
#define XB_XSUB(j)  (1280 + 64 * (j))
#define XB_XGEN(j)  (2304 + 64 * (j))
#define XB_TOP      3328
#define XB_TOPGEN   3392
#define XCD_BAR_WORDS 3456
#define XB_SPIN_CAP (1u << 24)
#define LAS __attribute__((address_space(3)))

DEVI unsigned xb_ld(unsigned* p)              { return __hip_atomic_load(p, __ATOMIC_RELAXED, __HIP_MEMORY_SCOPE_AGENT); }
DEVI unsigned xb_add(unsigned* p, unsigned v) { return __hip_atomic_fetch_add(p, v, __ATOMIC_RELAXED, __HIP_MEMORY_SCOPE_AGENT); }
DEVI unsigned xb_xcc_id() { return (unsigned)__builtin_amdgcn_s_getreg((3 << 11) | 20) & 0xFu; }
#define XB_SPIN(cond, bar) do { unsigned _sp = 0; while (cond) { __builtin_amdgcn_s_sleep(1); \
    if ((++_sp & 255u) == 0u) { if (xb_ld(&(bar)[XB_TMO])) break; if (_sp > XB_SPIN_CAP) { atomicAdd(&(bar)[XB_TMO], 1u); break; } } } } while (0)

struct XcdBarrier { unsigned* bar; unsigned x; volatile LAS unsigned* st; };

DEVI XcdBarrier xcd_barrier_post(unsigned* bar, volatile LAS unsigned* st) {
    XcdBarrier b; b.bar = bar; b.x = xb_xcc_id(); b.st = st;
    if (threadIdx.x == 0) (void)xb_add(&bar[XB_XCNT(b.x)], 1u);
    return b;
}
DEVI void xcd_barrier_complete(unsigned* bar, unsigned x, unsigned& nloc, unsigned& nx) {
    const unsigned G = gridDim.x * gridDim.y * gridDim.z;
    unsigned sum, cnt, mine, sp = 0u;
    for (;;) {
        sum = 0u; cnt = 0u; mine = 0u;
#pragma unroll
        for (unsigned j = 0; j < 16; ++j) { const unsigned c = xb_ld(&bar[XB_XCNT(j)]); sum += c; cnt += (c > 0u) ? 1u : 0u; mine = (j == x) ? c : mine; }
        if (sum == G) break;
        __builtin_amdgcn_s_sleep(1);
        if ((++sp & 255u) == 0u) { if (xb_ld(&bar[XB_TMO])) break; if (sp > XB_SPIN_CAP) { atomicAdd(&bar[XB_TMO], 1u); break; } }
    }
    nloc = mine > 0u ? mine : 1u; nx = cnt > 0u ? cnt : 1u;
}
DEVI void xcd_barrier(const XcdBarrier& b) {
    asm volatile("s_waitcnt vmcnt(0)" ::: "memory");
    __syncthreads();
    if (threadIdx.x == 0) {
        unsigned* bar = b.bar;
        __builtin_amdgcn_s_waitcnt(0);
        unsigned nloc = b.st[0], nx = b.st[1];
        if (nloc == 0u) { xcd_barrier_complete(bar, b.x, nloc, nx); b.st[0] = nloc; b.st[1] = nx; }
        const unsigned old = xb_add(&bar[XB_XSUB(b.x)], 1u);
        const unsigned gen = old / nloc;
        if (old + 1u == (gen + 1u) * nloc) {
            __builtin_amdgcn_fence(__ATOMIC_RELEASE, "agent");
            asm volatile("s_waitcnt vmcnt(0)" ::: "memory");
            const unsigned og = xb_add(&bar[XB_TOP], 1u);
            const unsigned tg = og / nx;
            if (og + 1u == (tg + 1u) * nx) xb_add(&bar[XB_TOPGEN], 1u);
            else XB_SPIN(xb_ld(&bar[XB_TOPGEN]) == tg, bar);
            __builtin_amdgcn_fence(__ATOMIC_ACQUIRE, "agent");
            xb_add(&bar[XB_XGEN(b.x)], 1u);
            asm volatile("s_waitcnt vmcnt(0)" ::: "memory");
        } else {
            XB_SPIN(xb_ld(&bar[XB_XGEN(b.x)]) == gen, bar);
            __builtin_amdgcn_fence(__ATOMIC_ACQUIRE, "agent");
            asm volatile("s_waitcnt vmcnt(0)" ::: "memory");
        }
    }
    __syncthreads();
}

using bf16x8 = __attribute__((ext_vector_type(8))) short;
using s16x4  = __attribute__((ext_vector_type(4))) short;
using f32x16 = __attribute__((ext_vector_type(16))) float;
using f32x4  = __attribute__((ext_vector_type(4))) float;
using u32x4  = __attribute__((ext_vector_type(4))) unsigned;
using u32x2  = __attribute__((ext_vector_type(2))) unsigned;
#define SBAR() __builtin_amdgcn_sched_barrier(0)

DEVI int crow(int r, int hi) { return (r & 3) + 8 * (r >> 2) + 4 * hi; }
DEVI unsigned cvtpk(float lo, float hi) { unsigned r; asm volatile("v_cvt_pk_bf16_f32 %0, %1, %2" : "=v"(r) : "v"(lo), "v"(hi)); return r; }
DEVI unsigned short f2bf(float x) { return (unsigned short)(cvtpk(x, 0.f) & 0xffffu); }
DEVI float bf2f(unsigned short u) { return __uint_as_float(((unsigned)u) << 16); }
DEVI float bflo(unsigned u) { return __uint_as_float(u << 16); }
DEVI float bfhi(unsigned u) { return __uint_as_float(u & 0xffff0000u); }
DEVI float wave_sum(float v) {
#pragma unroll
    for (int o = 32; o > 0; o >>= 1) v += __shfl_xor(v, o, 64);
    return v;
}
DEVI float silu(float x) { return x * __builtin_amdgcn_rcpf(1.f + __expf(-x)); }

DEVI int row_variant(int r) { return r < T_CTX ? 2 : ((r - T_CTX) >> 14); }

template <int BN> DEVI int nn_st(int k, int c) {
    const int kk = (k & ~0xC) | ((k & 4) << 1) | ((k & 8) >> 1);
    return ((kk >> 3) * (BN / 32) + (c >> 5)) * 512 + ((kk & 7) * 32 + (c & 31)) * 2;
}
DEVI int nn_rd_base(int lane) { return ((lane & 3) << 3) | (((lane >> 2) & 3) << 6) | (((lane >> 4) & 1) << 5) | (((lane >> 5) & 1) << 8); }
template <int OFF> DEVI s16x4 tr_read(int vb) {
    s16x4 r; asm volatile("ds_read_b64_tr_b16 %0, %1 offset:%2" : "=&v"(r) : "v"(vb), "i"(OFF) : "memory"); return r;
}
#define PK8(L, H) (bf16x8){L[0], L[1], L[2], L[3], H[0], H[1], H[2], H[3]}

typedef s16x4 LAS * lds_s16x4_ptr;
template <int MB, int NB, int WM, int WN, bool BNN, bool SWAPC, int STAGES = 2, bool BRES = false, class AF, class BF, class EF>
DEVI void gemm_tile(char* lds, int nk_in, AF arow, BF brow, EF epi) {
    int nk = nk_in; asm volatile("" : "+s"(nk));
    constexpr int BM = 32 * MB * WM, BN = 32 * NB * WN;
    constexpr int ABYTES = BM * 128, BBYTES = BN * 128;
    constexpr int ACH = BM / 64, BCH = BN / 64;
    static_assert(WM * WN == 8, "8 waves");
    static_assert(2 * ABYTES + 2 * BBYTES <= 128 * 1024, "LDS");
    int tid = threadIdx.x; asm volatile("" : "+v"(tid)); const int lane = tid & 63, wid = __builtin_amdgcn_readfirstlane(tid >> 6);
    const int wm = wid / WN, wn = wid % WN, r32 = lane & 31, hi = lane >> 5;
    LAS char* Abase = (LAS char*)lds; LAS char* Bbase = BRES ? Abase + 65536 : Abase + 2 * ABYTES;
    static_assert(!BRES || 2 * ABYTES <= 65536, "resident B image sits at +64 KB");
    const short* ap[ACH]; int aoff[ACH];
#pragma unroll
    for (int i = 0; i < ACH; ++i) { const int id = tid + NTHR * i, row = id >> 3, c = id & 7; ap[i] = (const short*)arow(row) + c * 8; aoff[i] = row * 128 + ((c ^ ((row >> 1) & 7)) << 4); }
    const short* bp[BCH]; int boff[BCH];
#pragma unroll
    for (int i = 0; i < BCH; ++i) {
        const int id = tid + NTHR * i;
        if constexpr (!BNN) { const int row = id >> 3, c = id & 7; bp[i] = (const short*)brow(row) + c * 8; boff[i] = row * 128 + ((c ^ ((row >> 1) & 7)) << 4); }
        else { const int krow = id / (BN / 8), c = id % (BN / 8); boff[i] = nn_st<BN>(krow, c * 8); bp[i] = nullptr; }
    }
    const int swz = (r32 >> 1) & 7;
    const int afr0 = (wm * 32 * MB + r32) * 128, bfr0 = (wn * 32 * NB + r32) * 128;
    const int bvb = nn_rd_base(lane) + wn * NB * 512;

    f32x16 acc[MB][NB];
#pragma unroll
    for (int i = 0; i < MB; ++i)
#pragma unroll
        for (int j = 0; j < NB; ++j) acc[i][j] = f32x16{};
    bf16x8 ra0[ACH], rb0[BCH], ra1[ACH], rb1[BCH];
#define G_LOAD(RA, RB, T) do {                                                                                                     \
        _Pragma("unroll") for (int i = 0; i < ACH; ++i) RA[i] = *(const bf16x8*)(ap[i] + (T) * 64);                                \
        if constexpr (!BRES) { _Pragma("unroll") for (int i = 0; i < BCH; ++i) { if constexpr (!BNN) RB[i] = *(const bf16x8*)(bp[i] + (T) * 64);          \
            else { const int id = tid + NTHR * i; RB[i] = *(const bf16x8*)((const short*)brow((T) * 64 + id / (BN / 8)) + (id % (BN / 8)) * 8); } } } } while (0)
#define G_WRITE(RA, RB, BUF) do {                                                                                                  \
        _Pragma("unroll") for (int i = 0; i < ACH; ++i) *(LAS bf16x8*)(Abase + (BUF) * ABYTES + aoff[i]) = RA[i];                  \
        if constexpr (!BRES) { _Pragma("unroll") for (int i = 0; i < BCH; ++i) *(LAS bf16x8*)(Bbase + (BUF) * BBYTES + boff[i]) = RB[i]; } } while (0)
#define G_COMPUTE(BUF, KT) do {                                                                                                    \
        LAS const char* As = Abase + (BUF) * ABYTES; LAS const char* Bs = Bbase + (BRES ? (KT) : (BUF)) * BBYTES;                  \
        _Pragma("unroll") for (int ks = 0; ks < 4; ++ks) {                                                                         \
            bf16x8 a[MB], b[NB];                                                                                                   \
            const int so = ((ks * 2 + hi) ^ swz) << 4;                                                                             \
            _Pragma("unroll") for (int mb = 0; mb < MB; ++mb) a[mb] = *(LAS const bf16x8*)(As + afr0 + so + mb * 4096);            \
            _Pragma("unroll") for (int nb = 0; nb < NB; ++nb) {                                                                    \
                if constexpr (BNN) {                                                                                               \
                    const s16x4 l = __builtin_amdgcn_ds_read_tr16_b64_v4i16((lds_s16x4_ptr)(Bs + bvb + nb * 512 + ks * (2 * (BN / 32) * 512)));                        \
                    const s16x4 h = __builtin_amdgcn_ds_read_tr16_b64_v4i16((lds_s16x4_ptr)(Bs + bvb + nb * 512 + ks * (2 * (BN / 32) * 512) + (BN / 32) * 512));      \
                    b[nb] = PK8(l, h);                                                                                             \
                } else b[nb] = *(LAS const bf16x8*)(Bs + bfr0 + so + nb * 4096);                                                   \
            }                                                                                                                      \
            _Pragma("unroll") for (int mb = 0; mb < MB; ++mb)                                                                      \
                _Pragma("unroll") for (int nb = 0; nb < NB; ++nb) acc[mb][nb] = SWAPC ? __builtin_amdgcn_mfma_f32_32x32x16_bf16(b[nb], a[mb], acc[mb][nb], 0, 0, 0) : __builtin_amdgcn_mfma_f32_32x32x16_bf16(a[mb], b[nb], acc[mb][nb], 0, 0, 0); \
        } } while (0)
    if constexpr (STAGES == 2) {
    G_LOAD(ra0, rb0, 0); G_LOAD(ra1, rb1, 1); SBAR();
    G_WRITE(ra0, rb0, 0);
    __syncthreads();
    int kt = 0;
    for (; kt + 2 < nk; kt += 2) {
        SBAR(); G_LOAD(ra0, rb0, kt + 2); SBAR();
        G_COMPUTE(0, kt); SBAR();
        G_WRITE(ra1, rb1, 1);
        __syncthreads();
        SBAR(); G_LOAD(ra1, rb1, kt + 3); SBAR();
        G_COMPUTE(1, kt + 1); SBAR();
        G_WRITE(ra0, rb0, 0);
        __syncthreads();
    }
    SBAR(); G_COMPUTE(0, kt); SBAR();
    G_WRITE(ra1, rb1, 1);
    __syncthreads();
    SBAR(); G_COMPUTE(1, kt + 1); SBAR();
    __syncthreads();
    } else {
    G_LOAD(ra0, rb0, 0); SBAR();
    G_WRITE(ra0, rb0, 0);
    __syncthreads();
    for (int kt = 0; kt < nk; ++kt) {
        const int cur = kt & 1;
        if (kt + 1 < nk) { SBAR(); G_LOAD(ra0, rb0, kt + 1); SBAR(); }
        G_COMPUTE(cur, kt); SBAR();
        if (kt + 1 < nk) G_WRITE(ra0, rb0, cur ^ 1);
        __syncthreads();
    }
    }
#undef G_LOAD
#undef G_WRITE
#undef G_COMPUTE
    epi(acc, wm, wn);
}


typedef __attribute__((address_space(1))) const unsigned* g8_gptr;
typedef __attribute__((address_space(3))) unsigned* g8_lptr;
constexpr int G8_HT = 128 * 64;
DEVI int g8_lds_byte(int r, int c) { const int st = (r >> 4) * 2 + (c >> 5), rr = r & 15, cc = c & 31, ob = rr * 64 + cc * 2; return st * 1024 + (ob ^ (((ob >> 9) & 1) << 5)); }
DEVI void g8_stage_rc(int b, int& R, int& C) { const int st = b / 1024, sb = b % 1024, swz = sb ^ (((sb >> 9) & 1) << 5); R = (st >> 1) * 16 + swz / 64; C = (st & 1) * 32 + (swz % 64) / 2; }
typedef f32x4 g8_acc[2][2][4][2];

template <bool GATHER, int NPASS, class EPI>
DEVI void gemm256(char* ldsb, int nt, const short* A, int lda, const int* ltok, const short* Bt, int ldb, int apass, const short* Bt2, EPI epi) {
    short* shm = (short*)ldsb;
#define SA(b, h) (shm + ((b) * 2 + (h)) * G8_HT)
#define SB(b, h) (shm + (4 + (b) * 2 + (h)) * G8_HT)
#define STAGE_A(P_, h_, kt_) do { _Pragma("unroll") for (int _i = 0; _i < 2; ++_i) { \
        const unsigned _o = (GATHER ? ao[(h_) * 2 + _i] : ao[0] + (unsigned)(((h_) * 128 + _i * 64) * lda * 2)) + (unsigned)((kt_) * 128); \
        __builtin_amdgcn_global_load_lds((g8_gptr)((const char*)A + (size_t)_o), (g8_lptr)((char*)(P_) + tz * 16 + _i * 8192), 16, 0, 0); } } while (0)
#define STAGE_B(P_, h_, kt_) do { _Pragma("unroll") for (int _i = 0; _i < 2; ++_i) { \
        const unsigned _o = bo + (unsigned)(((h_) * 128 + _i * 64) * ldb * 2) + (unsigned)((kt_) * 128); \
        __builtin_amdgcn_global_load_lds((g8_gptr)((const char*)Bt + (size_t)_o), (g8_lptr)((char*)(P_) + tz * 16 + _i * 8192), 16, 0, 0); } } while (0)
#define LDA(dst, b, h) _Pragma("unroll") for (int m = 0; m < 4; ++m) _Pragma("unroll") for (int k = 0; k < 2; ++k) \
        dst[m][k] = *reinterpret_cast<const bf16x8*>((char*)SA(b, h) + g8_lds_byte(wr * 64 + m * 16 + fr, k * 32 + fq * 8))
#define LDB(dst, b, h) _Pragma("unroll") for (int n = 0; n < 2; ++n) _Pragma("unroll") for (int k = 0; k < 2; ++k) \
        dst[n][k] = *reinterpret_cast<const bf16x8*>((char*)SB(b, h) + g8_lds_byte(wc * 32 + n * 16 + fr, k * 32 + fq * 8))
#define MMA(ai, bj, At_, Bt_) do { __builtin_amdgcn_s_setprio(1); \
        _Pragma("unroll") for (int m = 0; m < 4; ++m) _Pragma("unroll") for (int n = 0; n < 2; ++n) _Pragma("unroll") for (int k = 0; k < 2; ++k) \
            acc[ai][bj][m][n] = __builtin_amdgcn_mfma_f32_16x16x32_bf16(Bt_[n][k], At_[m][k], acc[ai][bj][m][n], 0, 0, 0); \
        __builtin_amdgcn_s_setprio(0); } while (0)
#define WAIT_V(n) asm volatile("s_waitcnt vmcnt(" #n ")" ::: "memory")
#define WAIT_L(n) asm volatile("s_waitcnt lgkmcnt(" #n ")" ::: "memory")
#define BAR __builtin_amdgcn_s_barrier()
#define SCHED __builtin_amdgcn_sched_barrier(0)
    int tz = threadIdx.x; asm volatile("" : "+v"(tz));
    int wid = __builtin_amdgcn_readfirstlane(tz >> 6), lane = tz & 63, wr = wid >> 2, wc = wid & 3, fr = lane & 15, fq = lane >> 4;
    unsigned ao[4], bo;
    { int r0, c0; g8_stage_rc(tz * 16, r0, c0);
      if constexpr (GATHER) {
#pragma unroll
          for (int q = 0; q < 4; ++q) ao[q] = (unsigned)(ltok[(q >> 1) * 128 + (q & 1) * 64 + r0] * lda + c0) * 2u;
      } else { ao[0] = (unsigned)(r0 * lda + c0) * 2u; ao[1] = ao[2] = ao[3] = 0; }
      bo = (unsigned)(r0 * ldb + c0) * 2u; }
    g8_acc acc;
#pragma unroll
    for (int a = 0; a < 2; ++a)
#pragma unroll
        for (int b = 0; b < 2; ++b)
#pragma unroll
            for (int m = 0; m < 4; ++m)
#pragma unroll
                for (int n = 0; n < 2; ++n) acc[a][b][m][n] = f32x4{0, 0, 0, 0};
    bf16x8 At[4][2], B0[2][2], B1[2][2];
#pragma unroll 1
    for (int pass = 0; pass < NPASS; ++pass) {
    if (pass == 1) { A += apass; Bt = Bt2;
        tz = threadIdx.x; asm volatile("" : "+v"(tz)); wid = __builtin_amdgcn_readfirstlane(tz >> 6); lane = tz & 63; wr = wid >> 2; wc = wid & 3; fr = lane & 15; fq = lane >> 4; }
    STAGE_B(SB(0, 0), 0, 0); STAGE_A(SA(0, 0), 0, 0);
    STAGE_B(SB(0, 1), 1, 0); STAGE_A(SA(0, 1), 1, 0);
    if (wr == 1) BAR;
    WAIT_V(4); BAR;
    STAGE_B(SB(1, 0), 0, 1); STAGE_A(SA(1, 0), 0, 1); STAGE_B(SB(1, 1), 1, 1);
    WAIT_V(6); BAR;
    for (int t = 0; t < nt - 2; t += 2) {
        LDB(B0, 0, 0); SCHED; LDA(At, 0, 0); STAGE_A(SA(1, 1), 1, t + 1);
        WAIT_L(8); BAR; WAIT_L(0); MMA(0, 0, At, B0); BAR; SCHED;
        LDB(B1, 0, 1); STAGE_B(SB(0, 0), 0, t + 2);
        BAR; WAIT_L(0); MMA(0, 1, At, B1); BAR;
        LDA(At, 0, 1); STAGE_A(SA(0, 0), 0, t + 2);
        BAR; WAIT_L(0); MMA(1, 0, At, B0); BAR; SCHED;
        STAGE_B(SB(0, 1), 1, t + 2);
        WAIT_V(6); BAR; MMA(1, 1, At, B1); BAR;
        LDB(B0, 1, 0); SCHED; LDA(At, 1, 0); STAGE_A(SA(0, 1), 1, t + 2);
        WAIT_L(8); BAR; WAIT_L(0); MMA(0, 0, At, B0); BAR; SCHED;
        LDB(B1, 1, 1); STAGE_B(SB(1, 0), 0, t + 3);
        BAR; WAIT_L(0); MMA(0, 1, At, B1); BAR;
        LDA(At, 1, 1); STAGE_A(SA(1, 0), 0, t + 3);
        BAR; WAIT_L(0); MMA(1, 0, At, B0); BAR; SCHED;
        STAGE_B(SB(1, 1), 1, t + 3);
        WAIT_V(6); BAR; MMA(1, 1, At, B1); BAR;
    }
    tz = threadIdx.x; asm volatile("" : "+v"(tz)); wid = __builtin_amdgcn_readfirstlane(tz >> 6); lane = tz & 63; wr = wid >> 2; wc = wid & 3; fr = lane & 15; fq = lane >> 4;
    { int r0, c0; g8_stage_rc(tz * 16, r0, c0);
      if constexpr (GATHER) {
#pragma unroll
          for (int q = 2; q < 4; ++q) ao[q] = (unsigned)(ltok[(q >> 1) * 128 + (q & 1) * 64 + r0] * lda + c0) * 2u;
      } else ao[0] = (unsigned)(r0 * lda + c0) * 2u; }
    { LDB(B0, 0, 0); WAIT_V(0); LDA(At, 0, 0); STAGE_A(SA(1, 1), 1, nt - 1);
      BAR; WAIT_L(0); MMA(0, 0, At, B0); BAR;
      LDB(B1, 0, 1); BAR; WAIT_L(0); MMA(0, 1, At, B1); BAR;
      LDA(At, 0, 1); WAIT_V(4); BAR; WAIT_L(0); MMA(1, 0, At, B0); MMA(1, 1, At, B1); BAR; }
    { LDB(B0, 1, 0); LDA(At, 1, 0); WAIT_V(2); BAR; WAIT_L(0); MMA(0, 0, At, B0); BAR;
      LDB(B1, 1, 1); WAIT_V(0); BAR; WAIT_L(0); MMA(0, 1, At, B1); BAR;
      LDA(At, 1, 1); BAR; WAIT_L(0); MMA(1, 0, At, B0); MMA(1, 1, At, B1); BAR; }
    if (wr == 0) BAR;
    }
    SBAR();
    epi(acc, wr, wc, fr, fq);
#undef SA
#undef SB
#undef STAGE_A
#undef STAGE_B
#undef LDA
#undef LDB
#undef MMA
#undef WAIT_V
#undef WAIT_L
#undef BAR
#undef SCHED
}
template <class F> DEVI void g8_for_acc(g8_acc& acc, int wr, int wc, int fr, int fq, F f) {
#pragma unroll
    for (int ai = 0; ai < 2; ++ai)
#pragma unroll
        for (int m = 0; m < 4; ++m)
        {
#pragma unroll
            for (int bj = 0; bj < 2; ++bj) { SBAR();
#pragma unroll
                for (int n = 0; n < 2; ++n) f(ai * 128 + wr * 64 + m * 16 + fr, bj * 128 + wc * 32 + n * 16 + fq * 4, acc[ai][bj][m][n]); } }
}
template <class F> DEVI void g8_for_acc8(g8_acc& acc, int wr, int wc, int fr, int fq, F f) {
#pragma unroll
    for (int ai = 0; ai < 2; ++ai)
#pragma unroll
        for (int m = 0; m < 4; ++m)
        {
#pragma unroll
            for (int bj = 0; bj < 2; ++bj) { SBAR(); float v[8];
#pragma unroll
                for (int j = 0; j < 4; ++j) { auto rr = __builtin_amdgcn_permlane16_swap(__float_as_uint(acc[ai][bj][m][0][j]), __float_as_uint(acc[ai][bj][m][1][j]), false, false);
                    v[j] = __uint_as_float(rr[0]); v[4 + j] = __uint_as_float(rr[1]); }
                f(ai * 128 + wr * 64 + m * 16 + fr, bj * 128 + wc * 32 + (fq & 1) * 16 + (fq & ~1) * 4, v); } }
}

struct Params { const float* in[22]; float* out; char* ws; int nphases; int ph_lo; };

struct Ctx { float* out; char* ws; char* lds; int G, vcu; };
#define TID_SETUP() int tid = threadIdx.x; asm volatile("" : "+v"(tid)); const int lane = tid & 63; const int wid = __builtin_amdgcn_readfirstlane(tid >> 6); (void)lane; (void)wid

DEVI short* res_row(const Ctx& c, int r) { return (short*)(c.ws + WS_RES) + (size_t)r * D; }
DEVI const float* in_row(const Params& P, int r) { return r < T_CTX ? P.in[2] + (size_t)r * D : P.in[0] + (size_t)(r - T_CTX) * D; }
DEVI f32x4 ld_bf4(const short* p) { const u32x2 w = *(const u32x2*)p; return f32x4{bflo(w[0]), bfhi(w[0]), bflo(w[1]), bfhi(w[1])}; }
DEVI void st_bf4(short* p, f32x4 v) { *(u32x2*)p = u32x2{cvtpk(v[0], v[1]), cvtpk(v[2], v[3])}; }
DEVI void res_load8(const Params& P, const Ctx& c, int r, int col, int layer, float (&x)[8]) {
    if (layer == 0) { const float* p = in_row(P, r) + col; const f32x4 a = *(const f32x4*)p, b = *(const f32x4*)(p + 4);
#pragma unroll
        for (int j = 0; j < 4; ++j) { x[j] = a[j]; x[4 + j] = b[j]; } }
    else { const u32x4 w = *(const u32x4*)(res_row(c, r) + col);
#pragma unroll
        for (int j = 0; j < 4; ++j) { x[2 * j] = bflo(w[j]); x[2 * j + 1] = bfhi(w[j]); } }
}
DEVI f32x4 res_load4(const Params& P, const Ctx& c, int r, int col, int layer) { return layer == 0 ? *(const f32x4*)(in_row(P, r) + col) : ld_bf4(res_row(c, r) + col); }

DEVI void cls_experts(int cls, int& ea, int& eb);
DEVI void phase_prologue(const Params& P, const Ctx& c) {
    TID_SETUP();
    const long gtid = (long)blockIdx.x * NTHR + tid; const long gsz = (long)c.G * NTHR;
    float* sv = (float*)(c.lds + LDS_GEMM);
    for (int i = tid; i < 3 * 1024; i += NTHR) { const int v = i >> 10, k = i & 1023; const float x = (v < 2) ? P.in[1][v * 1024 + k] : P.in[3][k]; sv[i] = silu(x); }
    float* tc = sv + 3 * 1024;
    for (int i = tid; i < 128; i += NTHR) { tc[i] = cospif(i / 64.f); tc[128 + i] = sinpif(i / 64.f); }
    __syncthreads();
    {
        float* modp = (float*)(c.ws + WS_MODP);
        const float* w_ada = P.in[4];
        for (long it = gtid; it < (long)8 * 4 * 6144; it += gsz) {
            const int j = (int)(it % 6144); const int l = (int)((it / 6144) & 3); const int ks = (int)(it / (6144 * 4));
            const float* w = w_ada + ((size_t)l * 1024 + ks * 128) * 6144 + j;
            float a0 = 0, a1 = 0, a2 = 0;
            for (int k = 0; k < 128; ++k) { const float wv = w[(size_t)k * 6144]; const int kk = ks * 128 + k; a0 += sv[kk] * wv; a1 += sv[1024 + kk] * wv; a2 += sv[2048 + kk] * wv; }
            float* o = modp + ((size_t)(ks * 4 + l) * 3) * 6144 + j;
            o[0] = a0; o[6144] = a1; o[2 * 6144] = a2;
        }
    }
    {
        float* tl = (float*)(c.lds + LDS_GEMM + 16384);
        const int NT_IN = 4 * 16 * 15, NT_OUT = 4 * 16 * 16, NT_GU = 4 * 16 * 16 * 4 * 2, NT_DN = 4 * NCLS * 2 * 4 * 16, NT_Q = 4 * 4 * 12, NT_KV = 4 * 2 * 16;
        struct TD { const float* s; const float* sc; short* d; int sld, dld, k0, n0, nvalid, mode; };
        auto desc = [&](int tix) { TD t; t.mode = 0; t.sc = nullptr;
            if (tix < NT_IN) { const int l = tix / 240, r = tix % 240, kt = r / 15, nt2 = r % 15; t.s = P.in[8] + (size_t)l * 1024 * INW; t.sld = INW; t.d = (short*)(c.ws + WS_WIN) + (size_t)l * 1024 * 1024; t.dld = 1024; t.k0 = kt * 64; t.n0 = nt2 * 64; t.nvalid = INW; }
            else if (tix < NT_IN + NT_OUT) { const int t2 = tix - NT_IN; const int l = t2 >> 8, r = t2 & 255; t.s = P.in[16] + (size_t)l * 1024 * 1024; t.sld = 1024; t.d = (short*)(c.ws + WS_WOUT) + (size_t)l * 1024 * 1024; t.dld = 1024; t.k0 = (r >> 4) * 64; t.n0 = (r & 15) * 64; t.nvalid = 1024; }
            else if (tix < NT_IN + NT_OUT + NT_GU) { const int t2 = tix - NT_IN - NT_OUT; const int gu = t2 & 1, r = t2 >> 1; const int le = r >> 6, kt = (r >> 2) & 15, nt2 = r & 3;
                t.s = (gu ? P.in[20] : P.in[19]) + (size_t)le * 1024 * 256; t.sld = 256; t.d = (short*)(c.ws + WS_WGU) + (size_t)le * 512 * 1024; t.dld = 1024; t.k0 = kt * 64; t.n0 = nt2 * 64; t.nvalid = 256; t.mode = 1 + gu; }
            else if (tix >= NT_IN + NT_OUT + NT_GU + NT_DN) { int t2 = tix - (NT_IN + NT_OUT + NT_GU + NT_DN);
                if (t2 < NT_Q) { const int l = t2 / 48, r = t2 % 48, kt = r / 12, nt2 = r % 12; t.s = P.in[10] + (size_t)l * 256 * 768; t.sc = P.in[9] + l * 256; t.sld = 768; t.d = (short*)(c.ws + WS_WQT) + (size_t)l * 768 * 256; t.dld = 256; t.k0 = kt * 64; t.n0 = nt2 * 64; t.nvalid = 768; }
                else { t2 -= NT_Q; const int l = t2 >> 5, r = t2 & 31, kt = r >> 4, nt2 = r & 15; t.s = P.in[12] + (size_t)l * 128 * 1024; t.sc = P.in[11] + l * 128; t.sld = 1024; t.d = (short*)(c.ws + WS_WKVT) + (size_t)l * 1024 * 128; t.dld = 128; t.k0 = kt * 64; t.n0 = nt2 * 64; t.nvalid = 1024; } }
            else { const int t2 = tix - NT_IN - NT_OUT - NT_GU; const int lch = t2 >> 6, kt = (t2 >> 4) & 3, nt2 = t2 & 15; const int half = lch & 1, lc = lch >> 1, cl = lc % NCLS, l = lc / NCLS;
                int ea, eb; cls_experts(cl, ea, eb); const int e = half ? eb : ea;
                t.s = P.in[21] + (size_t)(l * 16 + e) * 256 * 1024; t.sld = 1024; t.d = (short*)(c.ws + WS_WDN) + (size_t)lc * 1024 * 512 + half * 256; t.dld = 512; t.k0 = kt * 64; t.n0 = nt2 * 64; t.nvalid = 1024; }
            return t; };
        const int NTILES = NT_IN + NT_OUT + NT_GU + NT_DN + NT_Q + NT_KV;
        const int lkk = tid >> 3, lcg = (tid & 7) * 8;
        f32x4 x0 = {0, 0, 0, 0}, x1 = {0, 0, 0, 0};
        auto tload = [&](const TD& t) { x0 = f32x4{0, 0, 0, 0}; x1 = f32x4{0, 0, 0, 0};
            if (t.n0 + lcg < t.nvalid) { const float* sp = t.s + (size_t)(t.k0 + lkk) * t.sld + t.n0 + lcg; x0 = *(const f32x4*)sp; x1 = *(const f32x4*)(sp + 4);
                if (t.sc) { const float s = t.sc[t.k0 + lkk]; x0 *= s; x1 *= s; } } };
        int tix = blockIdx.x, pb = 0;
        TD cur = desc(tix < NTILES ? tix : 0);
        __syncthreads();
        if (tix < NTILES) tload(cur);
        for (; tix < NTILES; tix += c.G, pb ^= 1) {
            float* tlb = tl + pb * (64 * 65);
#pragma unroll
            for (int j = 0; j < 4; ++j) { tlb[lkk * 65 + lcg + j] = x0[j]; tlb[lkk * 65 + lcg + 4 + j] = x1[j]; }
            const TD nxt = desc(tix + c.G < NTILES ? tix + c.G : 0);
            if (tix + c.G < NTILES) tload(nxt);
            __syncthreads();
            { const int n = tid >> 3, kg = (tid & 7) * 8; const int nn = cur.n0 + n;
              if (nn < cur.nvalid) { float v[8];
#pragma unroll
                for (int j = 0; j < 8; ++j) v[j] = tlb[(kg + j) * 65 + n];
                const int drow = cur.mode == 0 ? nn : ((nn >> 4) * 32 + (cur.mode - 1) * 16 + (nn & 15));
                *(u32x4*)(cur.d + (size_t)drow * cur.dld + cur.k0 + kg) = u32x4{cvtpk(v[0], v[1]), cvtpk(v[2], v[3]), cvtpk(v[4], v[5]), cvtpk(v[6], v[7])}; } }
            cur = nxt;
        }
        __syncthreads();
        { short* d = (short*)(c.ws + WS_WIN);
          for (long it = gtid; it < (long)4 * 96 * 128; it += gsz) { const int k8 = (int)(it & 127); const long lr = it >> 7; const int l = (int)(lr / 96), rr = (int)(lr % 96);
              *(u32x4*)(d + ((size_t)l * 1024 + INW + rr) * 1024 + k8 * 8) = u32x4{0, 0, 0, 0}; } }
    }
    {
        short* dst = (short*)(c.ws + WS_WCS); const float* wf = P.in[15];
        for (long it = gtid; it < (long)4 * 4 * 128 * 256; it += gsz) {
            const int d = (int)(it & 127), ab = (int)((it >> 7) & 1), cc = (int)((it >> 8) & 127); const long lg = it >> 15;
            const float* w = wf + lg * 128 * 128 + d; const float* tt = tc + ab * 128;
            float a = 0;
            for (int j = 0; j < 128; ++j) a += tt[(cc * j) & 127] * w[j * 128];
            dst[it] = (short)f2bf(a * 0.08838834764831845f);
        }
    }
    {
        short* f1 = (short*)(c.ws + WS_F1);
        for (long it = gtid; it < 256 * 256; it += gsz) { const int kk = (int)(it & 255), m = (int)(it >> 8); const int k1 = (m >> 6) * 32 + (m & 31), ri = (m >> 5) & 1, n1 = kk >> 1, ab = kk & 1;
            const int a = (n1 * k1) & 127; const float cs = tc[a], sn = tc[128 + a];
            const float v = (ri == 0) ? (ab == 0 ? cs : -sn) : (ab == 0 ? -sn : -cs);
            f1[it] = (short)f2bf(v * 0.08838834764831845f); }
        short* f2 = (short*)(c.ws + WS_F2);
        for (long it = gtid; it < 128 * 256; it += gsz) { const int kk = (int)(it & 255), k2 = (int)(it >> 8); const int n2 = kk >> 1, ri = kk & 1;
            const int a = (n2 * k2) & 127; f2[it] = (short)f2bf((ri == 0 ? tc[a] : tc[128 + a]) * 0.08838834764831845f); }
        short* fc = (short*)(c.ws + WS_FC);
        for (long it = gtid; it < 256 * 512; it += gsz) { const int kk = (int)(it & 511), k = (int)(it >> 9); const int n = kk >> 1, ab = kk & 1;
            const int a = (n * k) & 255; const float v = ab == 0 ? cospif(a / 128.f) : -sinpif(a / 128.f); fc[it] = (short)f2bf(v * 0.0625f); }
        float2* tw = (float2*)(c.ws + WS_TW);
        for (long it = gtid; it < 16384; it += gsz) tw[it] = make_float2(cospif((float)it / 8192.f), sinpif((float)it / 8192.f));
        float2* rp = (float2*)(c.ws + WS_ROPE);
        for (long it = gtid; it < 256 * 8; it += gsz) { const int i = (int)(it & 7), pos = (int)(it >> 3); const float fr = powf(10000.f, -(float)i / 8.f); const float ang = (float)pos * fr;
            rp[it] = make_float2(cosf(ang), sinf(ang)); }
    }
}

DEVI void phase_coef(const Params& P, const Ctx& c) {
    TID_SETUP();
    const long gtid = (long)blockIdx.x * NTHR + tid; const long gsz = (long)c.G * NTHR;
    const float* modp = (const float*)(c.ws + WS_MODP); float* coef = (float*)(c.ws + WS_COEF);
    for (long it = gtid; it < (long)4 * 3 * 6144; it += gsz) {
        const int j = (int)(it % 6144); const int v = (int)((it / 6144) % 3); const int l = (int)(it / (6144 * 3));
        float m = P.in[5][l * 6144 + j];
        for (int ks = 0; ks < 8; ++ks) m += modp[((size_t)(ks * 4 + l) * 3 + v) * 6144 + j];
        const int chunk = j >> 10, col = j & 1023;
        float val; int slot;
        if (chunk == 0) { slot = 1; val = m; } else if (chunk == 1) { slot = 0; val = P.in[6][l * 1024 + col] * (1.f + m); } else if (chunk == 2) { slot = 2; val = m; }
        else if (chunk == 3) { slot = 4; val = m; } else if (chunk == 4) { slot = 3; val = P.in[7][l * 1024 + col] * (1.f + m); } else { slot = 5; val = m; }
        coef[((size_t)(l * 3 + v) * 6 + slot) * 1024 + col] = val;
    }
}

DEVI void phase_norm_mix(const Params& P, const Ctx& c, int l) {
    TID_SETUP();
    const float* coef = (const float*)(c.ws + WS_COEF) + (size_t)l * 3 * 6 * 1024;
    short* hbuf = (short*)(c.ws + WS_HBUF);
    for (int r = c.vcu * 8 + wid; r < T; r += c.G * 8) {
        const int v = row_variant(r);
        const float* a1 = coef + (size_t)(v * 6 + 0) * 1024; const float* b1 = coef + (size_t)(v * 6 + 1) * 1024;
        float xv[2][8]; float ss = 0;
        if (l == 0) { const float* x = in_row(P, r);
#pragma unroll
            for (int q = 0; q < 2; ++q) { const f32x4 t0 = *(const f32x4*)(x + q * 512 + lane * 8), t1 = *(const f32x4*)(x + q * 512 + lane * 8 + 4);
#pragma unroll
                for (int j = 0; j < 4; ++j) { xv[q][j] = t0[j]; xv[q][4 + j] = t1[j]; } } }
        else { const short* x = res_row(c, r);
#pragma unroll
            for (int q = 0; q < 2; ++q) { const u32x4 t = *(const u32x4*)(x + q * 512 + lane * 8);
#pragma unroll
                for (int j = 0; j < 4; ++j) { xv[q][2 * j] = bflo(t[j]); xv[q][2 * j + 1] = bfhi(t[j]); } } }
#pragma unroll
        for (int q = 0; q < 2; ++q)
#pragma unroll
            for (int j = 0; j < 8; ++j) ss += xv[q][j] * xv[q][j];
        ss = wave_sum(ss); const float rstd = rsqrtf(ss * (1.f / 1024.f) + EPS);
#pragma unroll
        for (int q = 0; q < 2; ++q) { const int col = q * 512 + lane * 8; const f32x4 a0 = *(const f32x4*)(a1 + col), a4 = *(const f32x4*)(a1 + col + 4), b0 = *(const f32x4*)(b1 + col), b4 = *(const f32x4*)(b1 + col + 4);
            float y[8];
#pragma unroll
            for (int j = 0; j < 4; ++j) { y[j] = xv[q][j] * rstd * a0[j] + b0[j]; y[4 + j] = xv[q][4 + j] * rstd * a4[j] + b4[j]; }
            *(u32x4*)(hbuf + (size_t)r * 1024 + col) = u32x4{cvtpk(y[0], y[1]), cvtpk(y[2], y[3]), cvtpk(y[4], y[5]), cvtpk(y[6], y[7])}; }
    }
}

DEVI u32x4 pack8(const float* p) {
    const unsigned a0 = cvtpk(p[0], p[1]), a1 = cvtpk(p[2], p[3]), b0 = cvtpk(p[4], p[5]), b1 = cvtpk(p[6], p[7]);
    auto r0 = __builtin_amdgcn_permlane32_swap(a0, b0, false, false); auto r1 = __builtin_amdgcn_permlane32_swap(a1, b1, false, false);
    return u32x4{r0[0], r1[0], r0[1], r1[1]};
}
template <int MB, int NB, class F> DEVI void for_acc_bf8(f32x16 (&acc)[MB][NB], int wm, int wn, int lane, F f) {
    const int r32 = lane & 31, hi = lane >> 5;
#pragma unroll
    for (int mb = 0; mb < MB; ++mb)
#pragma unroll
        for (int nb = 0; nb < NB; ++nb)
#pragma unroll
            for (int s = 0; s < 2; ++s) { float t[8];
#pragma unroll
                for (int j = 0; j < 8; ++j) t[j] = acc[mb][nb][8 * s + j];
                f((wm * MB + mb) * 32 + r32, (wn * NB + nb) * 32 + 16 * s + 8 * hi, pack8(t)); }
}
template <int MB, int NB, class F> DEVI void for_acc_f4(f32x16 (&acc)[MB][NB], int wm, int wn, int lane, F f) {
    const int r32 = lane & 31, hi = lane >> 5;
#pragma unroll
    for (int mb = 0; mb < MB; ++mb)
#pragma unroll
        for (int nb = 0; nb < NB; ++nb)
#pragma unroll
            for (int g = 0; g < 4; ++g) f((wm * MB + mb) * 32 + r32, (wn * NB + nb) * 32 + 8 * g + 4 * hi, f32x4{acc[mb][nb][4 * g], acc[mb][nb][4 * g + 1], acc[mb][nb][4 * g + 2], acc[mb][nb][4 * g + 3]});
}

DEVI void phase_inproj(const Params& P, const Ctx& c, int l) {
    TID_SETUP();
    const short* hbuf = (const short*)(c.ws + WS_HBUF); const short* WT = (const short*)(c.ws + WS_WIN) + (size_t)l * 1024 * 1024; short* zbuf = (short*)((char*)c.out);
    for (int u = c.vcu; u < 64; u += c.G) {
        const int rt = u >> 3, ct = u & 7; const int row0 = rt * 64, col0 = ct * 128;
        gemm_tile<1, 1, 2, 4, false, true>(c.lds + LDS_GEMM, 16,
            [&](int r) { return hbuf + (size_t)(row0 + r) * 1024; },
            [&](int n) { return WT + (size_t)(col0 + n) * 1024; },
            [&](f32x16 (&acc)[1][1], int wm, int wn) {
                for_acc_bf8<1, 1>(acc, wm, wn, lane, [&](int r, int cc, u32x4 v) { const int col = col0 + cc; if (col < INW) *(u32x4*)(zbuf + (size_t)(row0 + r) * ZLD + col) = v; });
            });
    }
    for (int u = c.vcu; u < 512; u += c.G) {
        const int rt = 2 + (u >> 2), ct = u & 3; const int row0 = rt * 256, col0 = ct * 256;
        __syncthreads();
        gemm256<false, 1>(c.lds + LDS_GEMM, 16, hbuf + (size_t)row0 * 1024, 1024, nullptr, WT + (size_t)col0 * 1024, 1024, 0, nullptr,
            [&](g8_acc& acc, int wr, int wc, int fr, int fq) {
                g8_for_acc8(acc, wr, wc, fr, fq, [&](int r, int cc, const float (&v)[8]) { const int col = col0 + cc;
                    if (col < INW) *(u32x4*)(zbuf + (size_t)(row0 + r) * ZLD + col) = u32x4{cvtpk(v[0], v[1]), cvtpk(v[2], v[3]), cvtpk(v[4], v[5]), cvtpk(v[6], v[7])}; });
            });
    }
}

template <int NCOL, int NTOK = 128> DEVI void tile_rowstat(const Ctx& c, int tid, int tok0, int col0, float* stat) {
    const short* zbuf = (const short*)((char*)c.out);
    constexpr int TPT = NTHR / NTOK, per = NCOL / TPT;
    const int t = tid / TPT, q = tid % TPT;
    const short* p = zbuf + (size_t)(tok0 + t) * ZLD + col0 + q * per;
    u32x4 w[per / 8];
#pragma unroll
    for (int i = 0; i < per / 8; ++i) w[i] = *(const u32x4*)(p + i * 8);
    float ss = 0;
#pragma unroll
    for (int i = 0; i < per / 8; ++i)
#pragma unroll
        for (int j = 0; j < 4; ++j) { const float a = bflo(w[i][j]), b = bfhi(w[i][j]); ss += a * a + b * b; }
    ss += __shfl_xor(ss, 1, 64); if constexpr (TPT == 4) ss += __shfl_xor(ss, 2, 64);
    if (q == 0) stat[t] = ss / (float)NCOL;
}
DEVI float half_sum(float v) { auto rr = __builtin_amdgcn_permlane32_swap(__float_as_uint(v), __float_as_uint(v), false, false); return __uint_as_float(rr[0]) + __uint_as_float(rr[1]); }

DEVI void rope16(float (&x)[16], int n, bool lat, int hi, const float2* ropetab) {
    if (!lat) return;
    const int prow = n >> 6, pcol = n & 63;
#pragma unroll
    for (int j = 0; j < 4; ++j) {
        const int i = j + 4 * hi;
        const float2 cr = ropetab[prow * 8 + i], cc = ropetab[pcol * 8 + i];
        const float a1 = x[j], a2 = x[j + 4]; x[j] = a1 * cr.x - a2 * cr.y; x[j + 4] = a2 * cr.x + a1 * cr.y;
        const float b1 = x[8 + j], b2 = x[12 + j]; x[8 + j] = b1 * cc.x - b2 * cc.y; x[12 + j] = b2 * cc.x + b1 * cc.y;
    }
}

template <int NB> DEVI void pc_q_unit(const Params& P, const Ctx& c, int l, int tok0, int hp, int tid, int lane) {
    const short* zbuf = (const short*)((char*)c.out);
    float* stat = (float*)(c.lds + LDS_STAT);
    const float2* ropetab = (const float2*)(c.ws + WS_ROPE);
    tile_rowstat<QLR, 128 * NB>(c, tid, tok0, 0, stat);
    const short* WQT = (const short*)(c.ws + WS_WQT) + ((size_t)l * 768 + hp * 192) * 256;
    const float* qn = P.in[13] + l * DQK;
    gemm_tile<3, NB, 2, 4, false, false>(c.lds + LDS_GEMM, 4,
        [&](int r) { return WQT + (size_t)r * 256; },
        [&](int n) { return zbuf + (size_t)(tok0 + n) * ZLD; },
        [&](f32x16 (&acc)[3][NB], int wm, int wn) {
#pragma unroll
            for (int nb = 0; nb < NB; ++nb) {
                const int hi = lane >> 5, r32 = lane & 31; const int tl = (wn * NB + nb) * 32 + r32, row = tok0 + tl, h = hp * 2 + wm;
                const bool lat = row >= T_CTX; const int rr = lat ? row - T_CTX : row; const int b = lat ? (rr >> 14) : (rr >> 8); const int n = lat ? (rr & 16383) : (rr & 255);
                const float s1 = rsqrtf(stat[tl] + EPS);
                float ss = 0;
#pragma unroll
                for (int mb = 0; mb < 3; ++mb)
#pragma unroll
                    for (int r = 0; r < 16; ++r) ss += acc[mb][nb][r] * acc[mb][nb][r];
                ss = half_sum(ss);
                const float s2 = rsqrtf(s1 * s1 * ss * (1.f / 96.f) + EPS); const float sc = s1 * s2 * ATT_QSCALE;
                float x[3][16];
#pragma unroll
                for (int mb = 0; mb < 3; ++mb)
#pragma unroll
                    for (int g4 = 0; g4 < 4; ++g4) { const f32x4 g = *(const f32x4*)(qn + mb * 32 + 8 * g4 + 4 * hi);
#pragma unroll
                        for (int j = 0; j < 4; ++j) x[mb][g4 * 4 + j] = acc[mb][nb][g4 * 4 + j] * sc * g[j]; }
                rope16(x[2], n, lat, hi, ropetab);
                short* dst = lat ? (short*)(c.ws + WS_QBUF) + ((size_t)(b * NH + h) * SEQ + n) * DQK : (short*)(c.ws + WS_QCTX) + ((size_t)(b * NH + h) * NCTX + n) * DQK;
#pragma unroll
                for (int mb = 0; mb < 3; ++mb)
#pragma unroll
                    for (int s = 0; s < 2; ++s) *(u32x4*)(dst + mb * 32 + s * 16 + hi * 8) = pack8(&x[mb][s * 8]);
            }
        });
}

template <int NB> DEVI void pc_kv_unit(const Params& P, const Ctx& c, int l, int tok0, int hp, int tid, int lane) {
    const short* zbuf = (const short*)((char*)c.out);
    float* stat = (float*)(c.lds + LDS_STAT);
    const float2* ropetab = (const float2*)(c.ws + WS_ROPE);
    tile_rowstat<KVLR, 128 * NB>(c, tid, tok0, QLR, stat);
    const short* WKVT = (const short*)(c.ws + WS_WKVT) + ((size_t)l * 1024 + hp * 256) * 128;
    const float* kn = P.in[14] + l * DQK;
    gemm_tile<4, NB, 2, 4, false, false, (NB == 1 ? 2 : 1)>(c.lds + LDS_GEMM, 2,
        [&](int r) { return WKVT + (size_t)r * 128; },
        [&](int n) { return zbuf + (size_t)(tok0 + n) * ZLD + QLR; },
        [&](f32x16 (&acc)[4][NB], int wm, int wn) {
#pragma unroll
            for (int nb = 0; nb < NB; ++nb) {
                const int hi = lane >> 5, r32 = lane & 31; const int tl = (wn * NB + nb) * 32 + r32, row = tok0 + tl, h = hp * 2 + wm;
                const bool lat = row >= T_CTX; const int rr = lat ? row - T_CTX : row; const int b = lat ? (rr >> 14) : (rr >> 8); const int n = lat ? (rr & 16383) : (rr & 255);
                const int pos = lat ? NCTX + n : n;
                const float s1 = rsqrtf(stat[tl] + EPS);
                float kr[16];
#pragma unroll
                for (int g4 = 0; g4 < 4; ++g4) { const u32x2 w = *(const u32x2*)(zbuf + (size_t)row * ZLD + QLR + KVLR + 8 * g4 + 4 * hi);
                    kr[g4 * 4 + 0] = bflo(w[0]); kr[g4 * 4 + 1] = bfhi(w[0]); kr[g4 * 4 + 2] = bflo(w[1]); kr[g4 * 4 + 3] = bfhi(w[1]); }
                float ss = 0;
#pragma unroll
                for (int mb = 0; mb < 2; ++mb)
#pragma unroll
                    for (int r = 0; r < 16; ++r) { const float t = acc[mb][nb][r] * s1; ss += t * t; }
#pragma unroll
                for (int r = 0; r < 16; ++r) ss += kr[r] * kr[r];
                ss = half_sum(ss);
                const float s2 = rsqrtf(ss * (1.f / 96.f) + EPS);
                float x[3][16];
#pragma unroll
                for (int mb = 0; mb < 3; ++mb)
#pragma unroll
                    for (int g4 = 0; g4 < 4; ++g4) { const f32x4 g = *(const f32x4*)(kn + mb * 32 + 8 * g4 + 4 * hi);
#pragma unroll
                        for (int j = 0; j < 4; ++j) x[mb][g4 * 4 + j] = (mb < 2 ? acc[mb][nb][g4 * 4 + j] * s1 : kr[g4 * 4 + j]) * s2 * g[j]; }
                rope16(x[2], n, lat, hi, ropetab);
                short* kd = (short*)(c.ws + WS_KBUF) + ((size_t)(b * NH + h) * NKEY + pos) * DQK;
#pragma unroll
                for (int mb = 0; mb < 3; ++mb)
#pragma unroll
                    for (int s = 0; s < 2; ++s) *(u32x4*)(kd + mb * 32 + s * 16 + hi * 8) = pack8(&x[mb][s * 8]);
                short* vd = (short*)(c.ws + WS_VBUF) + ((size_t)(b * NH + h) * NKEY + pos) * DV;
                float vv[2][16];
#pragma unroll
                for (int mb = 0; mb < 2; ++mb)
#pragma unroll
                    for (int r = 0; r < 16; ++r) vv[mb][r] = acc[2 + mb][nb][r] * s1;
#pragma unroll
                for (int mb = 0; mb < 2; ++mb)
#pragma unroll
                    for (int s = 0; s < 2; ++s) *(u32x4*)(vd + mb * 32 + s * 16 + hi * 8) = pack8(&vv[mb][s * 8]);
            }
        });
}

DEVI void phase_proj2(const Params& P, const Ctx& c, int l) {
    TID_SETUP();
    const short* zbuf = (const short*)((char*)c.out);
    for (int u = c.vcu + PC_U0; u < (l < DEPTH - 1 ? 1072 : 1056); u += c.G) {
        __syncthreads();
        if (u < 512) pc_q_unit<2>(P, c, l, T_CTX + (u >> 2) * 256, u & 3, tid, lane);
        else if (u < 1024) pc_kv_unit<2>(P, c, l, T_CTX + ((u - 512) >> 2) * 256, u & 3, tid, lane);
        else if (u < 1040) pc_q_unit<1>(P, c, l, ((u - 1024) >> 2) * 128, u & 3, tid, lane);
        else if (u < 1056) pc_kv_unit<1>(P, c, l, ((u - 1040) >> 2) * 128, u & 3, tid, lane);
        else {
            const int uu = u - 1056; const int rt = uu >> 3, g = (uu >> 1) & 3, ct = uu & 1; const int row0 = rt * 256;
            const short* W = (const short*)(c.ws + WS_WCS) + ((size_t)(l * 4 + g) * 128) * 256 + ct * 128; short* U = (short*)(c.ws + WS_UCTX);
            gemm_tile<2, 2, 4, 2, true, true>(c.lds + LDS_GEMM, 2,
                [&](int r) { return zbuf + (size_t)(row0 + r) * ZLD + 416 + g * 128; },
                [&](int k) { return W + (size_t)k * 256; },
                [&](f32x16 (&acc)[2][2], int wm, int wn) {
                    for_acc_bf8<2, 2>(acc, wm, wn, lane, [&](int r, int cc, u32x4 v) { *(u32x4*)(U + (size_t)(row0 + r) * 1024 + g * 256 + ct * 128 + cc) = v; });
                });
        }
    }
}

constexpr int AT_VB = 64 * 64 * 2, AT_KB = 64 * 256, AT_V = 0, AT_K = 3 * AT_VB, AT_WS = AT_K + 3 * AT_KB;
#define KSWZ(row, colB) ((row) * 256 + ((colB) ^ (((row) & 15) << 4)))

DEVI void att_exp16(f32x16& p, float& l) {
#pragma unroll
    for (int r = 0; r < 16; ++r) { p[r] = __builtin_amdgcn_exp2f(p[r]); l += p[r]; }
}
DEVI void att_pack(const f32x16& p0, const f32x16& p1, bf16x8& pa0, bf16x8& pa1, bf16x8& pa2, bf16x8& pa3) {
#define PK4(P, BASE, OUT) do { u32x4 w = {cvtpk(P[BASE + 0], P[BASE + 1]), cvtpk(P[BASE + 2], P[BASE + 3]), cvtpk(P[BASE + 4], P[BASE + 5]), cvtpk(P[BASE + 6], P[BASE + 7])}; \
    OUT = *reinterpret_cast<bf16x8*>(&w); } while (0)
    PK4(p0, 0, pa0); PK4(p0, 8, pa1); PK4(p1, 0, pa2); PK4(p1, 8, pa3);
#undef PK4
}
template <bool SHIFT> DEVI void att_qkt(f32x16& p0, f32x16& p1, const char* Ks, const bf16x8* qr, int r32, int hi, float init) {
    if constexpr (SHIFT) {
#pragma unroll
        for (int r = 0; r < 16; ++r) { p0[r] = init; p1[r] = init; }
    } else { p0 = f32x16{}; p1 = f32x16{}; }
    bf16x8 b0 = *reinterpret_cast<const bf16x8*>(Ks + KSWZ(r32, hi * 16));
    bf16x8 b1 = *reinterpret_cast<const bf16x8*>(Ks + KSWZ(32 + r32, hi * 16));
#pragma unroll
    for (int d0 = 0; d0 < 6; ++d0) {
        bf16x8 n0 = b0, n1 = b1;
        if (d0 < 5) { const int cb = ((d0 + 1) * 16 + hi * 8) * 2;
            n0 = *reinterpret_cast<const bf16x8*>(Ks + KSWZ(r32, cb)); n1 = *reinterpret_cast<const bf16x8*>(Ks + KSWZ(32 + r32, cb)); }
        p0 = __builtin_amdgcn_mfma_f32_32x32x16_bf16(b0, qr[d0], p0, 0, 0, 0);
        p1 = __builtin_amdgcn_mfma_f32_32x32x16_bf16(b1, qr[d0], p1, 0, 0, 0);
        b0 = n0; b1 = n1; }
}
constexpr int att_v_off(int d0, int ks, int half) { return d0 * 512 + ks * 2048 + half * 1024; }
struct VFrag { s16x4 l0, h0, l1, h1, l2, h2, l3, h3; };
template <int D0> DEVI void att_vread(VFrag& f, int vb) {
    f.l0 = tr_read<att_v_off(D0, 0, 0)>(vb); f.h0 = tr_read<att_v_off(D0, 0, 1)>(vb); f.l1 = tr_read<att_v_off(D0, 1, 0)>(vb); f.h1 = tr_read<att_v_off(D0, 1, 1)>(vb);
    f.l2 = tr_read<att_v_off(D0, 2, 0)>(vb); f.h2 = tr_read<att_v_off(D0, 2, 1)>(vb); f.l3 = tr_read<att_v_off(D0, 3, 0)>(vb); f.h3 = tr_read<att_v_off(D0, 3, 1)>(vb);
}
DEVI void att_pv_mm(f32x16& od, const VFrag& f, bf16x8 pa0, bf16x8 pa1, bf16x8 pa2, bf16x8 pa3) {
    od = __builtin_amdgcn_mfma_f32_32x32x16_bf16(PK8(f.l0, f.h0), pa0, od, 0, 0, 0);
    od = __builtin_amdgcn_mfma_f32_32x32x16_bf16(PK8(f.l1, f.h1), pa1, od, 0, 0, 0);
    od = __builtin_amdgcn_mfma_f32_32x32x16_bf16(PK8(f.l2, f.h2), pa2, od, 0, 0, 0);
    od = __builtin_amdgcn_mfma_f32_32x32x16_bf16(PK8(f.l3, f.h3), pa3, od, 0, 0, 0);
}
DEVI void att_lsum(f32x16& l, bf16x8 pa, bf16x8 pb) {
    const bf16x8 ones = {(short)0x3F80, (short)0x3F80, (short)0x3F80, (short)0x3F80, (short)0x3F80, (short)0x3F80, (short)0x3F80, (short)0x3F80};
    l = __builtin_amdgcn_mfma_f32_32x32x16_bf16(pa, ones, l, 0, 0, 0);
    l = __builtin_amdgcn_mfma_f32_32x32x16_bf16(pb, ones, l, 0, 0, 0);
}

template <bool SHIFT> DEVI void attn_body(const short* __restrict__ Qb, const short* __restrict__ Kh, const short* __restrict__ Vh, short* __restrict__ Ob, int seq, float shift, char* lds) {
    int tid = threadIdx.x; asm volatile("" : "+v"(tid)); const int wid = __builtin_amdgcn_readfirstlane(tid >> 6), lane = tid & 63, r32 = lane & 31, hi = lane >> 5;
    char* V_lds = lds + AT_V; char* K_lds = lds + AT_K;
    if (wid >= 4) __builtin_amdgcn_s_setprio(1);
    f32x16 o[2] = {f32x16{}, f32x16{}}; float l_reg = 0.f; bf16x8 qr[6];
    const short* Qw = Qb + (size_t)(wid * 32 + r32) * DQK + hi * 8;
#pragma unroll
    for (int d0 = 0; d0 < 6; ++d0) qr[d0] = *(const bf16x8*)(Qw + d0 * 16);
    const int kc0 = tid, kc1 = (tid + 512 < 768) ? tid + 512 : 767;
    const int kst0 = KSWZ(kc0 / 12, (kc0 % 12) * 16), kst1 = KSWZ(kc1 / 12, (kc1 % 12) * 16);
    const int vkey = tid >> 3, vcol = (tid & 7) * 8;
    const int vkk = vkey;
    const int vst = ((vkk >> 3) * 2 + (vcol >> 5)) * 512 + ((vkk & 7) * 32 + (vcol & 31)) * 2;
    const int vb0 = (int)(uintptr_t)V_lds + nn_rd_base(lane);
    struct { bf16x8 vs, k0, k1; } sr_;
    const int NT = seq / 64; const float init = -shift;
#define SLOAD(t) do { const int tt_ = (t) < NT ? (t) : NT - 1; sr_.vs = *(const bf16x8*)(Vh + (size_t)tt_ * 64 * DV + tid * 8); \
    sr_.k0 = *(const bf16x8*)(Kh + (size_t)tt_ * 64 * DQK + kc0 * 8); sr_.k1 = *(const bf16x8*)(Kh + (size_t)tt_ * 64 * DQK + kc1 * 8); } while (0)
#define SWRITE(b) do { *(bf16x8*)(V_lds + (b) * AT_VB + vst) = sr_.vs; *(bf16x8*)(K_lds + (b) * AT_KB + kst0) = sr_.k0; *(bf16x8*)(K_lds + (b) * AT_KB + kst1) = sr_.k1; } while (0)
    f32x16 pA0, pA1, pB0, pB1; bf16x8 pa0, pa1, pa2, pa3; VFrag vf, vf1;
#define STEP(PC0, PC1, PP0, PP1, TNEXT2, DOWRITE) do {                                                            \
        int bn = bc + 1; if (bn == 3) bn = 0;                                                                      \
        if (DOWRITE) SWRITE(bn);                                                                                   \
        SBAR(); SLOAD(TNEXT2);                                                                                     \
        SBAR(); att_vread<0>(vf, vb0 + bp * AT_VB); att_vread<1>(vf1, vb0 + bp * AT_VB);                           \
        att_qkt<SHIFT>(PC0, PC1, K_lds + bc * AT_KB, qr, r32, hi, init);                                           \
        att_exp16(PP1, l_reg); att_pack(PP0, PP1, pa0, pa1, pa2, pa3); SBAR();                                     \
        asm volatile("s_waitcnt lgkmcnt(0)" ::: "memory"); SBAR();                                                 \
        att_pv_mm(o[0], vf, pa0, pa1, pa2, pa3); att_pv_mm(o[1], vf1, pa0, pa1, pa2, pa3);                         \
        att_exp16(PC0, l_reg);                                                                                     \
        __syncthreads();                                                                                           \
        bp = bc; bc = bn; } while (0)
    SLOAD(0); asm volatile("s_waitcnt vmcnt(0)" ::: "memory"); SWRITE(0); SBAR(); SLOAD(1); __syncthreads();
    SWRITE(1); SBAR(); SLOAD(2); SBAR();
    att_qkt<SHIFT>(pA0, pA1, K_lds, qr, r32, hi, init); att_exp16(pA0, l_reg);
    __syncthreads();
    int bc = 1, bp = 0;
    for (int j = 1; j + 1 < NT; j += 2) {
        STEP(pB0, pB1, pA0, pA1, j + 2, true);
        STEP(pA0, pA1, pB0, pB1, j + 3, (j + 2 < NT));
    }
    STEP(pB0, pB1, pA0, pA1, NT - 1, false);
    att_vread<0>(vf, vb0 + bp * AT_VB);
    att_exp16(pB1, l_reg); att_pack(pB0, pB1, pa0, pa1, pa2, pa3); SBAR();
    asm volatile("s_waitcnt lgkmcnt(0)" ::: "memory"); SBAR();
    att_pv_mm(o[0], vf, pa0, pa1, pa2, pa3); att_vread<1>(vf, vb0 + bp * AT_VB); SBAR();
    asm volatile("s_waitcnt lgkmcnt(0)" ::: "memory"); SBAR();
    att_pv_mm(o[1], vf, pa0, pa1, pa2, pa3);
    __builtin_amdgcn_s_setprio(0);
    { auto rr = __builtin_amdgcn_permlane32_swap(__float_as_uint(l_reg), __float_as_uint(l_reg), false, false); l_reg = __uint_as_float(rr[0]) + __uint_as_float(rr[1]); }
    const float rl = __builtin_amdgcn_rcpf(l_reg);
    short* Orow = Ob + (size_t)(wid * 32 + r32) * 1024;
#pragma unroll
    for (int d0 = 0; d0 < 2; ++d0)
#pragma unroll
        for (int s = 0; s < 2; ++s) { float t[8];
#pragma unroll
            for (int j = 0; j < 8; ++j) t[j] = o[d0][8 * s + j] * rl;
            *(u32x4*)(Orow + d0 * 32 + 16 * s + 8 * hi) = pack8(t); }
    __syncthreads();
#undef SLOAD
#undef SWRITE
#undef STEP
}

DEVI void phase_attn_fft1(const Params& P, const Ctx& c, int l) {
    TID_SETUP();
    short* mix = (short*)(c.ws + WS_HBUF);
    const short* qb = (const short*)(c.ws + WS_QBUF); const short* qc = (const short*)(c.ws + WS_QCTX);
    const short* kb = (const short*)(c.ws + WS_KBUF); const short* vb = (const short*)(c.ws + WS_VBUF);
    const int n_att = (l < DEPTH - 1) ? 1040 : 1024;
    float shift;
    { float mq = 0.f, mk = 0.f;
      for (int i = lane; i < DQK; i += 64) { mq = fmaxf(mq, fabsf(P.in[13][l * DQK + i])); mk = fmaxf(mk, fabsf(P.in[14][l * DQK + i])); }
#pragma unroll
      for (int o = 32; o > 0; o >>= 1) { mq = fmaxf(mq, __shfl_xor(mq, o, 64)); mk = fmaxf(mk, __shfl_xor(mk, o, 64)); }
      shift = 9.797958971132712f * 1.4426950408889634f * mq * mk * 1.0001f; }
    for (int u = c.vcu; u < n_att; u += c.G) {
        const short* Qp; short* Op; int bh, seq;
        if (u < 1024) {
            const int rnd = u >> 8, v = u & 255, xcd = v >> 5, j = v & 31; bh = xcd * 2 + (rnd >> 1); const int qblk = j + 32 * (rnd & 1);
            Qp = qb + ((size_t)bh * SEQ + qblk * 256) * DQK; Op = mix + (size_t)(T_CTX + (bh >> 3) * SEQ + qblk * 256) * 1024 + (bh & 7) * DV; seq = NKEY;
        } else {
            bh = u - 1024; Qp = qc + (size_t)bh * NCTX * DQK; Op = mix + (size_t)((bh >> 3) * NCTX) * 1024 + (bh & 7) * DV; seq = NCTX;
        }
        if (shift < 64.f) attn_body<false>(Qp, kb + (size_t)bh * NKEY * DQK, vb + (size_t)bh * NKEY * DV, Op, seq, shift, c.lds + LDS_GEMM);
        else attn_body<true>(Qp, kb + (size_t)bh * NKEY * DQK, vb + (size_t)bh * NKEY * DV, Op, seq, shift, c.lds + LDS_GEMM);
    }
#ifndef ATT_ONLY
    const short* zbuf = (const short*)((char*)c.out); const short* F1 = (const short*)(c.ws + WS_F1); short* P1 = (short*)(c.ws + WS_P1);
    const float2* tw = (const float2*)(c.ws + WS_TW);
    for (int u = c.vcu; u < 1024; u += c.G) {
        const int n2 = u & 127, g = (u >> 7) & 3, b = u >> 9;
        const short* Zb = zbuf + (size_t)(T_CTX + b * SEQ + n2) * ZLD + 416 + g * 128;
        const short* W = (const short*)(c.ws + WS_WCS) + ((size_t)(l * 4 + g) * 128) * 256;
        short* Pb = P1 + ((size_t)(b * 4 + g) * 128 * 128 + n2) * 256;
        LAS char* Sres = (LAS char*)(c.lds + LDS_GEMM) + 65536;
        gemm_tile<1, 4, 4, 2, true, true, 1>(c.lds + LDS_GEMM, 2,
            [&](int r) { return Zb + (size_t)r * (128 * ZLD); },
            [&](int k) { return W + (size_t)k * 256; },
            [&](f32x16 (&acc)[1][4], int wm, int wn) {
                for_acc_bf8<1, 4>(acc, wm, wn, lane, [&](int n1, int cc, u32x4 v) { const int kk = 2 * n1 + (cc >> 7), cp = cc & 127;
                    *(LAS u32x4*)(Sres + (kk >> 6) * 16384 + nn_st<128>(kk & 63, cp)) = v; });
            });
        gemm_tile<2, 2, 4, 2, true, true, 2, true>(c.lds + LDS_GEMM, 4,
            [&](int r) { return F1 + (size_t)r * 256; },
            [&](int kk) { return (const short*)nullptr; },
            [&](f32x16 (&acc)[2][2], int wm, int wn) {
                const int hi = lane >> 5, r32 = lane & 31; const int k1 = wm * 32 + r32;
                const float2 t = tw[(n2 * k1) & 16383];
                short* p = Pb + (size_t)k1 * (128 * 256);
#pragma unroll
                for (int nb = 0; nb < 2; ++nb)
#pragma unroll
                    for (int s = 0; s < 2; ++s) { float yr[8], yi[8];
#pragma unroll
                        for (int j = 0; j < 8; ++j) { const float a = acc[0][nb][8 * s + j], bb = acc[1][nb][8 * s + j]; yr[j] = a * t.x + bb * t.y; yi[j] = bb * t.x - a * t.y; }
                        const int cc = (wn * 2 + nb) * 32 + 16 * s + 8 * hi;
                        *(u32x4*)(p + cc) = pack8(yr); *(u32x4*)(p + 128 + cc) = pack8(yi); }
            });
    }
    if (l < DEPTH - 1) {
        const short* FC = (const short*)(c.ws + WS_FC);
        for (int u = c.vcu; u < 8; u += c.G) {
            const int g = u & 3, b = u >> 2;
            const short* Ub = (const short*)(c.ws + WS_UCTX) + (size_t)(b * NCTX) * 1024 + g * 256;
            gemm_tile<2, 2, 4, 2, true, true>(c.lds + LDS_GEMM, 8,
                [&](int r) { return FC + (size_t)r * 512; },
                [&](int kk) { return Ub + (size_t)(kk >> 1) * 1024 + (kk & 1) * 128; },
                [&](f32x16 (&acc)[2][2], int wm, int wn) {
                    for_acc_bf8<2, 2>(acc, wm, wn, lane, [&](int r, int cc, u32x4 v) { *(u32x4*)(mix + (size_t)(b * NCTX + r) * 1024 + 512 + g * 128 + cc) = v; });
                });
        }
    }
#endif
}

DEVI void phase_fft2(const Params& P, const Ctx& c, int l) {
    TID_SETUP();
    short* mix = (short*)(c.ws + WS_HBUF); const short* P1 = (const short*)(c.ws + WS_P1); const short* F2 = (const short*)(c.ws + WS_F2);
    for (int u = c.vcu; u < 1024; u += c.G) {
        const int k1 = u & 127, g = (u >> 7) & 3, b = u >> 9;
        const short* Pb = P1 + ((size_t)(b * 4 + g) * 128 + k1) * (128 * 256);
        gemm_tile<1, 2, 4, 2, true, true>(c.lds + LDS_GEMM, 4,
            [&](int r) { return F2 + (size_t)r * 256; },
            [&](int kk) { return Pb + (size_t)kk * 128; },
            [&](f32x16 (&acc)[1][2], int wm, int wn) {
                for_acc_bf8<1, 2>(acc, wm, wn, lane, [&](int k2, int cc, u32x4 v) { *(u32x4*)(mix + (size_t)(T_CTX + b * SEQ + k1 + 128 * k2) * 1024 + 512 + g * 128 + cc) = v; });
            });
    }
}

DEVI void phase_outproj(const Params& P, const Ctx& c, int l) {
    TID_SETUP();
    const short* mix = (const short*)(c.ws + WS_HBUF); const short* WT = (const short*)(c.ws + WS_WOUT) + (size_t)l * 1024 * 1024;
    const float* coef = (const float*)(c.ws + WS_COEF) + (size_t)l * 3 * 6 * 1024;
    if (l < DEPTH - 1) for (int u = c.vcu; u < 64; u += c.G) {
        const int rt = u >> 3, ct = u & 7; const int row0 = rt * 64, col0 = ct * 128;
        const float* g1 = coef + (size_t)(2 * 6 + 2) * 1024;
        gemm_tile<1, 1, 2, 4, false, true>(c.lds + LDS_GEMM, 16,
            [&](int r) { return mix + (size_t)(row0 + r) * 1024; },
            [&](int n) { return WT + (size_t)(col0 + n) * 1024; },
            [&](f32x16 (&acc)[1][1], int wm, int wn) {
                for_acc_f4<1, 1>(acc, wm, wn, lane, [&](int r, int cc, f32x4 v) { const int row = row0 + r, col = col0 + cc;
                    const f32x4 x = res_load4(P, c, row, col, l), g = *(const f32x4*)(g1 + col);
                    st_bf4(res_row(c, row) + col, f32x4{x[0] + g[0] * v[0], x[1] + g[1] * v[1], x[2] + g[2] * v[2], x[3] + g[3] * v[3]}); });
            });
    }
    for (int u = c.vcu; u < 512; u += c.G) {
        const int rt = 2 + (u >> 2), ct = u & 3; const int row0 = rt * 256, col0 = ct * 256;
        const float* g1 = coef + (size_t)(row_variant(row0) * 6 + 2) * 1024;
        __syncthreads();
        gemm256<false, 1>(c.lds + LDS_GEMM, 16, mix + (size_t)row0 * 1024, 1024, nullptr, WT + (size_t)col0 * 1024, 1024, 0, nullptr,
            [&](g8_acc& acc, int wr, int wc, int fr, int fq) {
                g8_for_acc8(acc, wr, wc, fr, fq, [&](int r, int cc, const float (&v)[8]) { const int row = row0 + r, col = col0 + cc;
                    float x[8]; res_load8(P, c, row, col, l, x); const f32x4 g0 = *(const f32x4*)(g1 + col), g4 = *(const f32x4*)(g1 + col + 4);
#pragma unroll
                    for (int j = 0; j < 4; ++j) { x[j] += g0[j] * v[j]; x[4 + j] += g4[j] * v[4 + j]; }
                    *(u32x4*)(res_row(c, row) + col) = u32x4{cvtpk(x[0], x[1]), cvtpk(x[2], x[3]), cvtpk(x[4], x[5]), cvtpk(x[6], x[7])}; });
            });
    }
}

DEVI void phase_norm_route(const Params& P, const Ctx& c, int l) {
    TID_SETUP();
    const float* coef = (const float*)(c.ws + WS_COEF) + (size_t)l * 3 * 6 * 1024;
    short* hbuf = (short*)(c.ws + WS_HBUF);
    constexpr int XP = 2064;
    char* xs_hi = c.lds + LDS_GEMM; char* xs_lo = xs_hi + 16 * XP;
    int* lcnt = (int*)(c.lds + LDS_GEMM + 66560);
    int* lrow = lcnt + 64;
    float* lgt = (float*)(c.lds + LDS_GEMM + 73728);
    float* part = (float*)(c.lds + LDS_GEMM + 90112);
    const int rows_per = (T + c.G - 1) / c.G; const int r_begin = c.vcu * rows_per; const int r_lim = (l == DEPTH - 1) ? T_CTX : 0;
    int r_end = r_begin + rows_per; if (r_end > T) r_end = T;
    __syncthreads();
    if (tid < 64) lcnt[tid] = 0;
    int* rcls = (int*)(c.ws + WS_RCLS); float2* rw = (float2*)(c.ws + WS_RW);
    const int e16 = lane & 15, kq = lane >> 4;
    bf16x8 wh[4], wl[4];
#pragma unroll
    for (int s = 0; s < 4; ++s) { float v[8];
#pragma unroll
        for (int j = 0; j < 8; ++j) v[j] = P.in[17][(size_t)(128 * wid + 32 * s + 8 * kq + j) * 16 + e16];
        u32x4 h = {cvtpk(v[0], v[1]), cvtpk(v[2], v[3]), cvtpk(v[4], v[5]), cvtpk(v[6], v[7])};
        u32x4 lo = {cvtpk(v[0] - bflo(h[0]), v[1] - bfhi(h[0])), cvtpk(v[2] - bflo(h[1]), v[3] - bfhi(h[1])), cvtpk(v[4] - bflo(h[2]), v[5] - bfhi(h[2])), cvtpk(v[6] - bflo(h[3]), v[7] - bfhi(h[3]))};
        wh[s] = *reinterpret_cast<bf16x8*>(&h); wl[s] = *reinterpret_cast<bf16x8*>(&lo); }
    const int nrows = r_end - r_begin; const int nch = (nrows + 15) >> 4;
    u32x4 xn[2][2];
#pragma unroll
    for (int h = 0; h < 2; ++h) { int i = 8 * h + wid; if (i > nrows - 1) i = nrows - 1; const short* x = res_row(c, r_begin + i);
#pragma unroll
        for (int q = 0; q < 2; ++q) xn[h][q] = *(const u32x4*)(x + q * 512 + lane * 8); }
    for (int ch = 0; ch < nch; ++ch) {
#pragma unroll
        for (int h = 0; h < 2; ++h) {
            const int i = 16 * ch + 8 * h + wid; const bool valid = i < nrows; const int r = r_begin + (valid ? i : nrows - 1); const int v = row_variant(r);
            const float* a2 = coef + (size_t)(v * 6 + 3) * 1024; const float* b2 = coef + (size_t)(v * 6 + 4) * 1024;
            float xv[2][8]; float ss = 0;
#pragma unroll
            for (int q = 0; q < 2; ++q)
#pragma unroll
                for (int j = 0; j < 4; ++j) { xv[q][2 * j] = bflo(xn[h][q][j]); xv[q][2 * j + 1] = bfhi(xn[h][q][j]); ss += xv[q][2 * j] * xv[q][2 * j] + xv[q][2 * j + 1] * xv[q][2 * j + 1]; }
            if (ch + 1 < nch) { int i2 = i + 16; if (i2 > nrows - 1) i2 = nrows - 1; const short* x = res_row(c, r_begin + i2);
#pragma unroll
                for (int q = 0; q < 2; ++q) xn[h][q] = *(const u32x4*)(x + q * 512 + lane * 8); }
            ss = wave_sum(ss); const float rstd = rsqrtf(ss * (1.f / 1024.f) + EPS);
#pragma unroll
            for (int q = 0; q < 2; ++q) { const int col = q * 512 + lane * 8; const f32x4 a0 = *(const f32x4*)(a2 + col), a4 = *(const f32x4*)(a2 + col + 4), b0 = *(const f32x4*)(b2 + col), b4 = *(const f32x4*)(b2 + col + 4);
                float y[8];
#pragma unroll
                for (int j = 0; j < 4; ++j) { y[j] = xv[q][j] * rstd * a0[j] + b0[j]; y[4 + j] = xv[q][4 + j] * rstd * a4[j] + b4[j]; }
                const u32x4 o = {cvtpk(y[0], y[1]), cvtpk(y[2], y[3]), cvtpk(y[4], y[5]), cvtpk(y[6], y[7])};
                if (valid) *(u32x4*)(hbuf + (size_t)r * 1024 + col) = o;
                const u32x4 ol = {cvtpk(y[0] - bflo(o[0]), y[1] - bfhi(o[0])), cvtpk(y[2] - bflo(o[1]), y[3] - bfhi(o[1])), cvtpk(y[4] - bflo(o[2]), y[5] - bfhi(o[2])), cvtpk(y[6] - bflo(o[3]), y[7] - bfhi(o[3]))};
                *(LAS u32x4*)((LAS char*)xs_hi + (8 * h + wid) * XP + col * 2) = o; *(LAS u32x4*)((LAS char*)xs_lo + (8 * h + wid) * XP + col * 2) = ol; }
        }
        __syncthreads();
        if (ch > 0 && tid < 256) { const float* pp = part + ((ch - 1) & 1) * 2048 + tid; float sum = pp[0];
#pragma unroll
            for (int w = 1; w < 8; ++w) sum += pp[w * 256];
            lgt[(16 * (ch - 1)) * 16 + tid] = sum; }
        f32x4 acc = {0, 0, 0, 0};
#pragma unroll
        for (int s = 0; s < 4; ++s) { const int off = e16 * XP + (128 * wid + 32 * s + 8 * kq) * 2;
            const bf16x8 ah = *(LAS const bf16x8*)((LAS char*)xs_hi + off), al = *(LAS const bf16x8*)((LAS char*)xs_lo + off);
            acc = __builtin_amdgcn_mfma_f32_16x16x32_bf16(ah, wh[s], acc, 0, 0, 0);
            acc = __builtin_amdgcn_mfma_f32_16x16x32_bf16(ah, wl[s], acc, 0, 0, 0);
            acc = __builtin_amdgcn_mfma_f32_16x16x32_bf16(al, wh[s], acc, 0, 0, 0); }
        { float* pw = part + (ch & 1) * 2048 + wid * 256;
#pragma unroll
          for (int j = 0; j < 4; ++j) pw[(4 * kq + j) * 16 + e16] = acc[j]; }
        __syncthreads();
    }
    if (tid < 256) { const float* pp = part + ((nch - 1) & 1) * 2048 + tid; float sum = pp[0];
#pragma unroll
        for (int w = 1; w < 8; ++w) sum += pp[w * 256];
        lgt[(16 * (nch - 1)) * 16 + tid] = sum; }
    __syncthreads();
    for (int i = tid; i < r_end - r_begin; i += NTHR) {
        const int r = r_begin + i; if (r < r_lim) continue;
        float lg[16];
        { const f32x4 t0 = *(const f32x4*)(lgt + i * 16), t1 = *(const f32x4*)(lgt + i * 16 + 4), t2 = *(const f32x4*)(lgt + i * 16 + 8), t3 = *(const f32x4*)(lgt + i * 16 + 12);
#pragma unroll
          for (int j = 0; j < 4; ++j) { lg[j] = t0[j]; lg[4 + j] = t1[j]; lg[8 + j] = t2[j]; lg[12 + j] = t3[j]; } }
        float sc[16], bi[16];
#pragma unroll
        for (int e = 0; e < 16; ++e) { sc[e] = __builtin_amdgcn_rcpf(1.f + __expf(-lg[e])); bi[e] = sc[e] + P.in[18][e]; }
        int bg = 0; float bgs = -1e30f;
#pragma unroll
        for (int g = 0; g < 4; ++g) { float m1 = -1e30f, m2 = -1e30f;
#pragma unroll
            for (int j = 0; j < 4; ++j) { const float t = bi[g * 4 + j]; if (t > m1) { m2 = m1; m1 = t; } else if (t > m2) m2 = t; }
            const float gs = m1 + m2; if (gs > bgs) { bgs = gs; bg = g; } }
        float b4[4], s4[4];
#pragma unroll
        for (int j = 0; j < 4; ++j) { b4[j] = bg == 0 ? bi[j] : bg == 1 ? bi[4 + j] : bg == 2 ? bi[8 + j] : bi[12 + j]; s4[j] = bg == 0 ? sc[j] : bg == 1 ? sc[4 + j] : bg == 2 ? sc[8 + j] : sc[12 + j]; }
        int i1 = 0;
#pragma unroll
        for (int j = 1; j < 4; ++j) if (b4[j] > b4[i1]) i1 = j;
        int i2 = (i1 == 0) ? 1 : 0;
#pragma unroll
        for (int j = 0; j < 4; ++j) if (j != i1 && b4[j] > b4[i2]) i2 = j;
        const int ea = i1 < i2 ? i1 : i2, eb = i1 < i2 ? i2 : i1;
        float wa = 0, wb = 0;
#pragma unroll
        for (int j = 0; j < 4; ++j) { if (j == ea) wa = s4[j]; if (j == eb) wb = s4[j]; }
        const float inv = 1.f / (wa + wb);
        const int pidx = ea == 0 ? eb - 1 : ea == 1 ? eb + 1 : 5;
        const int cls = bg * 6 + pidx;
        const int lp = atomicAdd(&lcnt[cls], 1); lrow[i] = cls | (lp << 8); rcls[r] = cls; rw[r] = make_float2(wa * inv, wb * inv);
    }
    __syncthreads();
    int* gcnt = (int*)(c.ws + WS_CTL + CTL_CNT_OFF) + l * 32;
    if (tid < NCLS) lcnt[32 + tid] = lcnt[tid] > 0 ? (int)__hip_atomic_fetch_add(&gcnt[tid], lcnt[tid], __ATOMIC_RELAXED, __HIP_MEMORY_SCOPE_AGENT) : 0;
    __syncthreads();
    int* clist = (int*)(c.ws + WS_CLIST);
    for (int i = tid; i < r_end - r_begin; i += NTHR) { const int r = r_begin + i; if (r < r_lim) continue; const int w = lrow[i]; const int cls = w & 255, lp = w >> 8; clist[(size_t)cls * T + lcnt[32 + cls] + lp] = r; }
}

DEVI bool moe_decode(const int* gcnt, int u, int per_rt, int& cls, int& rt, int& sub, int& hpad, int& ccnt) {
    int acc_t = 0, acc_h = 0;
    for (int cc = 0; cc < NCLS; ++cc) { const int n = __builtin_amdgcn_readfirstlane(gcnt[cc]);
        const int nrt = (n + 255) >> 8; const int nt = nrt * per_rt;
        if (u < acc_t + nt) { cls = cc; const int loc = u - acc_t; rt = loc / per_rt; sub = loc % per_rt; hpad = acc_h; ccnt = n; return true; }
        acc_t += nt; acc_h += nrt * 256; }
    return false;
}
DEVI void cls_experts(int cls, int& ea, int& eb) { const int g = cls / 6, p = cls % 6; const int a = p < 3 ? 0 : p < 5 ? 1 : 2; const int b = p < 3 ? p + 1 : p < 5 ? p - 1 : 3; ea = g * 4 + a; eb = g * 4 + b; }

DEVI int moe_total(const int* gcnt, int per_rt) { int t = 0; for (int cc = 0; cc < NCLS; ++cc) { const int n = __builtin_amdgcn_readfirstlane(gcnt[cc]); t += ((n + 255) >> 8) * per_rt; } return t; }
DEVI int moe_nfull(int utot, int G) { const int nf = (utot / G) * G; return ((utot - nf) * 4 > 2 * G) ? utot : nf; }

DEVI void phase_moe_up(const Params& P, const Ctx& c, int l) {
    TID_SETUP();
    const int* gcnt = (const int*)(c.ws + WS_CTL + CTL_CNT_OFF) + l * 32;
    const short* hbuf = (const short*)(c.ws + WS_HBUF); short* Hm = (short*)(c.ws + WS_KBUF);
    const int* clist = (const int*)(c.ws + WS_CLIST); const float2* rw = (const float2*)(c.ws + WS_RW);
    int* ltok = (int*)(c.lds + LDS_STAT); float* lw = (float*)(c.lds + LDS_STAT + 1024);
    const int utot = moe_total(gcnt, 4), nfull = moe_nfull(utot, c.G);
    for (int it = c.vcu; it < nfull + (utot - nfull) * 4; it += c.G) {
        const bool fast = it < nfull; const int u = fast ? it : nfull + ((it - nfull) >> 2); const int q = (it - nfull) & 3;
        int cls, rt, ct, hpad, ccnt; if (!moe_decode(gcnt, u, 4, cls, rt, ct, hpad, ccnt)) break;
        int ea, eb; cls_experts(cls, ea, eb); const int e = ct < 2 ? ea : eb;
        __syncthreads();
        { int t2 = threadIdx.x; asm volatile("" : "+v"(t2));
          if (t2 < 256) { int i = rt * 256 + t2; if (i > ccnt - 1) i = ccnt - 1; const int tok = clist[(size_t)cls * T + i]; ltok[t2] = tok; const float2 w = rw[tok]; lw[t2] = ct < 2 ? w.x : w.y; } }
        asm volatile("s_waitcnt vmcnt(0)" ::: "memory");
        __syncthreads();
        const short* WT = (const short*)(c.ws + WS_WGU) + ((size_t)(l * 16 + e) * 512 + (ct & 1) * 256) * 1024;
        short* Hrow = Hm + (size_t)(hpad + rt * 256) * 512 + (ct >> 1) * 256;
        if (fast) {
            gemm256<true, 1>(c.lds + LDS_GEMM, 16, hbuf, 1024, ltok, WT, 1024, 0, nullptr,
                [&](g8_acc& acc, int wr, int wc, int fr, int fq) {
#pragma unroll
                    for (int ai = 0; ai < 2; ++ai)
#pragma unroll
                        for (int m = 0; m < 4; ++m) { SBAR(); const int row = ai * 128 + wr * 64 + m * 16 + fr; const float w = lw[row];
                            unsigned pk[2][2];
#pragma unroll
                            for (int bj = 0; bj < 2; ++bj) { const f32x4 g = acc[ai][bj][m][0], uu = acc[ai][bj][m][1]; float hv[4];
#pragma unroll
                                for (int j = 0; j < 4; ++j) hv[j] = silu(g[j]) * uu[j] * w;
                                pk[bj][0] = cvtpk(hv[0], hv[1]); pk[bj][1] = cvtpk(hv[2], hv[3]); }
                            auto r0 = __builtin_amdgcn_permlane16_swap(pk[0][0], pk[1][0], false, false); auto r1 = __builtin_amdgcn_permlane16_swap(pk[0][1], pk[1][1], false, false);
                            *(u32x4*)(Hrow + (size_t)row * 512 + ((ct & 1) * 8 + (fq & 1) * 4 + wc) * 16 + (fq & ~1) * 4) = u32x4{r0[0], r1[0], r0[1], r1[1]}; }
                });
        } else {
            gemm_tile<1, 2, 8, 1, false, true>(c.lds + LDS_GEMM, 16,
                [&](int r) { return hbuf + (size_t)ltok[r] * 1024; },
                [&](int n) { return WT + (size_t)(q * 64 + n) * 1024; },
                [&](f32x16 (&acc)[1][2], int wm, int wn) {
                    const int hi = lane >> 5, r32 = lane & 31; const int row = wm * 32 + r32; const float w = lw[row];
#pragma unroll
                    for (int nb = 0; nb < 2; ++nb)
#pragma unroll
                        for (int s = 0; s < 2; ++s) { float hv[4];
#pragma unroll
                            for (int j = 0; j < 4; ++j) hv[j] = silu(acc[0][nb][4 * s + j]) * acc[0][nb][8 + 4 * s + j] * w;
                            *(u32x2*)(Hrow + (size_t)row * 512 + ((ct & 1) * 8 + q * 2 + nb) * 16 + 8 * s + 4 * hi) = u32x2{cvtpk(hv[0], hv[1]), cvtpk(hv[2], hv[3])}; }
                });
        }
    }
}
DEVI void phase_moe_down(const Params& P, const Ctx& c, int l) {
    TID_SETUP();
    const int* gcnt = (const int*)(c.ws + WS_CTL + CTL_CNT_OFF) + l * 32;
    const short* Hm = (const short*)(c.ws + WS_KBUF);
    const int* clist = (const int*)(c.ws + WS_CLIST);
    const float* coef = (const float*)(c.ws + WS_COEF) + (size_t)l * 3 * 6 * 1024;
    unsigned long long* lrp = (unsigned long long*)(c.lds + LDS_STAT);
    const int utot = moe_total(gcnt, 4), nfull = moe_nfull(utot, c.G);
    for (int it = c.vcu; it < nfull + (utot - nfull) * 4; it += c.G) {
        const bool fast = it < nfull; const int u = fast ? it : nfull + ((it - nfull) >> 2); const int q = (it - nfull) & 3;
        int cls, rt, ct, hpad, ccnt; if (!moe_decode(gcnt, u, 4, cls, rt, ct, hpad, ccnt)) break;
        __syncthreads();
        { int t2 = threadIdx.x; asm volatile("" : "+v"(t2));
          if (t2 < 256) { int i = rt * 256 + t2; if (i > ccnt - 1) i = ccnt - 1; const int tok = clist[(size_t)cls * T + i]; lrp[t2] = (unsigned long long)(uintptr_t)res_row(c, tok) | (unsigned long long)row_variant(tok); } }
        asm volatile("s_waitcnt vmcnt(0)" ::: "memory");
        __syncthreads();
        const short* WT = (const short*)(c.ws + WS_WDN) + ((size_t)(l * NCLS + cls) * 1024 + ct * 256) * 512;
        const short* Ab = Hm + (size_t)(hpad + rt * 256) * 512;
        auto rmw = [&](int rl, int col, f32x4 v) { const int i = rt * 256 + rl;
            if (i < ccnt) { const unsigned long long pv = lrp[rl]; short* xr = (short*)(uintptr_t)(pv & ~3ull) + col; const f32x4 g = *(const f32x4*)(coef + (size_t)((int)(pv & 3ull) * 6 + 5) * 1024 + col);
                const f32x4 x = ld_bf4(xr); const f32x4 y = f32x4{x[0] + g[0] * v[0], x[1] + g[1] * v[1], x[2] + g[2] * v[2], x[3] + g[3] * v[3]};
                if (l < DEPTH - 1) st_bf4(xr, y);
                else *(f32x4*)((char*)c.out + (((size_t)(uintptr_t)xr - (size_t)(uintptr_t)(c.ws + WS_RES)) - (size_t)T_CTX * D * 2) * 2) = y; } };
        if (fast) {
            gemm256<false, 1>(c.lds + LDS_GEMM, 8, Ab, 512, nullptr, WT, 512, 0, nullptr,
                [&](g8_acc& acc, int wr, int wc, int fr, int fq) { g8_for_acc8(acc, wr, wc, fr, fq, [&](int rl, int cc, const float (&v)[8]) { const int col = ct * 256 + cc; const int i = rt * 256 + rl;
                    if (i < ccnt) { const unsigned long long pv = lrp[rl]; short* xr = (short*)(uintptr_t)(pv & ~3ull) + col; const float* gp = coef + (size_t)((int)(pv & 3ull) * 6 + 5) * 1024 + col;
                        const f32x4 g0 = *(const f32x4*)gp, g4 = *(const f32x4*)(gp + 4); const u32x4 w = *(const u32x4*)xr; float y[8];
#pragma unroll
                        for (int j = 0; j < 4; ++j) { y[2 * j] = bflo(w[j]); y[2 * j + 1] = bfhi(w[j]); }
#pragma unroll
                        for (int j = 0; j < 4; ++j) { y[j] += g0[j] * v[j]; y[4 + j] += g4[j] * v[4 + j]; }
                        if (l < DEPTH - 1) *(u32x4*)xr = u32x4{cvtpk(y[0], y[1]), cvtpk(y[2], y[3]), cvtpk(y[4], y[5]), cvtpk(y[6], y[7])};
                        else { float* op = (float*)((char*)c.out + (((size_t)(uintptr_t)xr - (size_t)(uintptr_t)(c.ws + WS_RES)) - (size_t)T_CTX * D * 2) * 2);
                            *(f32x4*)op = f32x4{y[0], y[1], y[2], y[3]}; *(f32x4*)(op + 4) = f32x4{y[4], y[5], y[6], y[7]}; } } }); });
        } else {
            gemm_tile<1, 2, 8, 1, false, true>(c.lds + LDS_GEMM, 8,
                [&](int r) { return Ab + (size_t)r * 512; },
                [&](int n) { return WT + (size_t)(q * 64 + n) * 512; },
                [&](f32x16 (&acc)[1][2], int wm, int wn) { for_acc_f4<1, 2>(acc, wm, wn, lane, [&](int rl, int cc, f32x4 v) { rmw(rl, ct * 256 + q * 64 + cc, v); }); });
        }
    }
}

__global__ void __launch_bounds__(NTHR, 2) mega_fwd(Params P) {
    extern __shared__ __attribute__((aligned(16))) char lds[];
    Ctx c;
    c.out = P.out; c.ws = P.ws; c.lds = lds; c.G = gridDim.x;
    { const int bx = blockIdx.x; c.vcu = (c.G % 8 == 0) ? (bx % 8) * (c.G / 8) + bx / 8 : bx; }
    volatile LAS unsigned* st = (volatile LAS unsigned*)(lds + LDS_MISC);
    if (threadIdx.x < 4) st[threadIdx.x] = 0u;
    __syncthreads();
    XcdBarrier bar = xcd_barrier_post((unsigned*)(P.ws + WS_CTL), st);
    int ph = 0;
#define PHASE_END() do { if (++ph >= P.nphases) return; if (ph > P.ph_lo) xcd_barrier(bar); } while (0)
    if ((PHMASK & 1) && ph >= P.ph_lo) phase_prologue(P, c); PHASE_END();
    if ((PHMASK & 2) && ph >= P.ph_lo) phase_coef(P, c); PHASE_END();
    for (int l = 0; l < DEPTH; ++l) {
        if ((PHMASK & 4) && ph >= P.ph_lo) { phase_norm_mix(P, c, l); if (REPMASK & 4) { xcd_barrier(bar); phase_norm_mix(P, c, l); } } PHASE_END();
        if ((PHMASK & 8) && ph >= P.ph_lo) { phase_inproj(P, c, l); if (REPMASK & 8) { xcd_barrier(bar); phase_inproj(P, c, l); } } PHASE_END();
        if ((PHMASK & 16) && ph >= P.ph_lo) { phase_proj2(P, c, l); if (REPMASK & 16) { xcd_barrier(bar); phase_proj2(P, c, l); } } PHASE_END();
        if ((PHMASK & 32) && ph >= P.ph_lo) { phase_attn_fft1(P, c, l); if (REPMASK & 32) { xcd_barrier(bar); phase_attn_fft1(P, c, l); } } PHASE_END();
        if ((PHMASK & 64) && ph >= P.ph_lo) { phase_fft2(P, c, l); if (REPMASK & 64) { xcd_barrier(bar); phase_fft2(P, c, l); } } PHASE_END();
        if ((PHMASK & 128) && ph >= P.ph_lo) { phase_outproj(P, c, l); if (REPMASK & 128) { xcd_barrier(bar); phase_outproj(P, c, l); } } PHASE_END();
        if ((PHMASK & 256) && ph >= P.ph_lo) { phase_norm_route(P, c, l); if (REPMASK & 256) { xcd_barrier(bar); phase_norm_route(P, c, l); } } PHASE_END();
        if ((PHMASK & 512) && ph >= P.ph_lo) { phase_moe_up(P, c, l); if (REPMASK & 512) { xcd_barrier(bar); phase_moe_up(P, c, l); } } PHASE_END();
        if ((PHMASK & 1024) && ph >= P.ph_lo) { phase_moe_down(P, c, l); if (REPMASK & 1024) { xcd_barrier(bar); phase_moe_down(P, c, l); } } PHASE_END();
    }
}


#ifdef DUMPDBG
__global__ void dump_kernel(float* out, const char* ws, int keep_out) {
    const size_t n = (size_t)T_LAT * D;
    for (size_t i = (size_t)blockIdx.x * blockDim.x + threadIdx.x; i < n; i += (size_t)gridDim.x * blockDim.x) {
        float v = keep_out ? out[i] : 0.f;
        const size_t offs[8] = {WS_HBUF, WS_ZBUF, WS_QBUF, WS_KBUF, WS_VBUF, WS_UBUF, WS_WCS, WS_WIN};
        const size_t lens[8] = {(size_t)T * 1024, (size_t)T * 1024, (size_t)BATCH * NH * SEQ * DQK, (size_t)BATCH * NH * NKEY * DQK, (size_t)BATCH * NH * NKEY * DV, (size_t)T * 1024, (size_t)4 * 4 * 128 * 256, (size_t)4 * 1024 * 1024};
#pragma unroll
        for (int b = 0; b < 8; ++b) {
            if (!((DUMPMASK >> b) & 1)) continue;
            const unsigned short u = ((const unsigned short*)(ws + offs[b]))[i % lens[b]];
            float f = __uint_as_float(((unsigned)u) << 16);
            if (!(fabsf(f) < 1e30f)) f = 777.f;
            v += f;
        }
        if (!(fabsf(v) < 1e30f)) v = 999.f;
        out[i] = v;
    }
}
#endif

#ifdef CHECKDBG
constexpr size_t WS_CHK = WS_END;
__device__ inline float blk_sum(float v, float* red) {
    for (int o = 32; o > 0; o >>= 1) v += __shfl_xor(v, o, 64);
    __syncthreads(); if ((threadIdx.x & 63) == 0) red[threadIdx.x >> 6] = v; __syncthreads();
    float t = 0; for (int i = 0; i < (int)blockDim.x / 64; ++i) t += red[i]; return t;
}
__device__ inline float blk_max(float v, float* red) {
    for (int o = 32; o > 0; o >>= 1) v = fmaxf(v, __shfl_xor(v, o, 64));
    __syncthreads(); if ((threadIdx.x & 63) == 0) red[threadIdx.x >> 6] = v; __syncthreads();
    float t = -1e30f; for (int i = 0; i < (int)blockDim.x / 64; ++i) t = fmaxf(t, red[i]); return t;
}
__global__ void chk_qkv(Params P) {
    __shared__ float red[8]; __shared__ float xin[256]; __shared__ float outv[128]; __shared__ float kr[32];
    const int s = blockIdx.x, tid = threadIdx.x;
    const int row = (s * 7919 + 13) % T; const int h = s & 7;
    const short* z = (const short*)P.out + (size_t)row * ZLD;
    const bool lat = row >= T_CTX; const int rr = lat ? row - T_CTX : row; const int b = lat ? (rr >> 14) : (rr >> 8); const int n = lat ? (rr & 16383) : (rr & 255);
    float* err = (float*)(P.ws + WS_CHK);
    const float2* ropetab = (const float2*)(P.ws + WS_ROPE);
    { const float cq = bf2f((unsigned short)z[tid]); const float ms = blk_sum(cq * cq, red) / 256.f; xin[tid] = cq * rsqrtf(ms + EPS) * P.in[9][tid]; __syncthreads();
      float u = 0; if (tid < 96) for (int k = 0; k < 256; ++k) u += xin[k] * P.in[10][(size_t)k * 768 + h * 96 + tid];
      const float ms2 = blk_sum(tid < 96 ? u * u : 0.f, red) / 96.f; if (tid < 96) outv[tid] = u * rsqrtf(ms2 + EPS) * P.in[13][tid]; __syncthreads();
      float val = 0; if (tid < 96) { val = outv[tid];
        if (lat && tid >= 64) { const int m = tid - 64; const int ax = m >> 4, i = m & 7, second = (m >> 3) & 1; const int pos = ax == 0 ? (n >> 6) : (n & 63); const float2 cs = ropetab[pos * 8 + i];
            const float x1 = outv[64 + ax * 16 + i], x2 = outv[64 + ax * 16 + 8 + i]; val = second ? (x2 * cs.x + x1 * cs.y) : (x1 * cs.x - x2 * cs.y); }
        val *= ATT_QSCALE; }
      const short* qd = lat ? (const short*)(P.ws + WS_QBUF) + ((size_t)(b * NH + h) * SEQ + n) * DQK : (const short*)(P.ws + WS_QCTX) + ((size_t)(b * NH + h) * NCTX + n) * DQK;
      const float got = tid < 96 ? bf2f((unsigned short)qd[tid]) : 0.f;
      const float d2 = blk_sum(tid < 96 ? (got - val) * (got - val) : 0.f, red), r2 = blk_sum(tid < 96 ? val * val : 0.f, red);
      if (tid == 0) { atomicAdd(&err[0], d2); atomicAdd(&err[1], r2); } }
    { __syncthreads(); const float ck = tid < 128 ? bf2f((unsigned short)z[256 + tid]) : 0.f; const float ms = blk_sum(ck * ck, red) / 128.f; if (tid < 128) xin[tid] = ck * rsqrtf(ms + EPS) * P.in[11][tid];
      if (tid < 32) kr[tid] = bf2f((unsigned short)z[384 + tid]); __syncthreads();
      float u = 0; if (tid < 128) for (int k = 0; k < 128; ++k) u += xin[k] * P.in[12][(size_t)k * 1024 + h * 128 + tid];
      float sq = 0; if (tid < 64) sq = u * u; else if (tid >= 128 && tid < 160) sq = kr[tid - 128] * kr[tid - 128];
      const float ms2 = blk_sum(sq, red) / 96.f; const float rs = rsqrtf(ms2 + EPS);
      if (tid < 64) outv[tid] = u * rs * P.in[14][tid]; if (tid >= 128 && tid < 160) outv[64 + tid - 128] = kr[tid - 128] * rs * P.in[14][64 + tid - 128]; __syncthreads();
      const int pos = lat ? NCTX + n : n;
      float val = 0; if (tid < 96) { val = outv[tid];
        if (lat && tid >= 64) { const int m = tid - 64; const int ax = m >> 4, i = m & 7, second = (m >> 3) & 1; const int pp = ax == 0 ? (n >> 6) : (n & 63); const float2 cs = ropetab[pp * 8 + i];
            const float x1 = outv[64 + ax * 16 + i], x2 = outv[64 + ax * 16 + 8 + i]; val = second ? (x2 * cs.x + x1 * cs.y) : (x1 * cs.x - x2 * cs.y); } }
      const short* kd = (const short*)(P.ws + WS_KBUF) + ((size_t)(b * NH + h) * NKEY + pos) * DQK;
      const float gotk = tid < 96 ? bf2f((unsigned short)kd[tid]) : 0.f;
      float d2 = blk_sum(tid < 96 ? (gotk - val) * (gotk - val) : 0.f, red), r2 = blk_sum(tid < 96 ? val * val : 0.f, red);
      if (tid == 0) { atomicAdd(&err[2], d2); atomicAdd(&err[3], r2); }
      const short* vd = (const short*)(P.ws + WS_VBUF) + ((size_t)(b * NH + h) * NKEY + pos) * DV;
      const bool isv = tid >= 64 && tid < 128; const float gotv = isv ? bf2f((unsigned short)vd[tid - 64]) : 0.f; const float vv = isv ? u : 0.f;
      d2 = blk_sum((gotv - vv) * (gotv - vv), red); r2 = blk_sum(vv * vv, red);
      if (tid == 0) { atomicAdd(&err[4], d2); atomicAdd(&err[5], r2); } }
}
__global__ void chk_attn(Params P) {
    extern __shared__ float pbuf[];
    __shared__ float red[8]; __shared__ float qv[96];
    const int s = blockIdx.x, tid = threadIdx.x; const int b = s & 1, h = (s >> 1) & 7; const bool ctxq = (s % 5) == 4; const int n = ctxq ? (s * 37) % NCTX : (s * 4099 + 77) % SEQ;
    const int bh = b * NH + h; const int nk = ctxq ? NCTX : NKEY;
    const short* q = ctxq ? (const short*)(P.ws + WS_QCTX) + ((size_t)bh * NCTX + n) * DQK : (const short*)(P.ws + WS_QBUF) + ((size_t)bh * SEQ + n) * DQK;
    const short* K = (const short*)(P.ws + WS_KBUF) + (size_t)bh * NKEY * DQK; const short* V = (const short*)(P.ws + WS_VBUF) + (size_t)bh * NKEY * DV;
    if (tid < 96) qv[tid] = bf2f((unsigned short)q[tid]); __syncthreads();
    float mx = -1e30f;
    for (int k = tid; k < nk; k += blockDim.x) { float a = 0; for (int d = 0; d < 96; ++d) a += qv[d] * bf2f((unsigned short)K[(size_t)k * DQK + d]); pbuf[k] = a; mx = fmaxf(mx, a); }
    mx = blk_max(mx, red);
    float sm = 0; for (int k = tid; k < nk; k += blockDim.x) { const float p = exp2f(pbuf[k] - mx); pbuf[k] = p; sm += p; }
    sm = blk_sum(sm, red);
    float o = 0; if (tid < 64) for (int k = 0; k < nk; ++k) o += pbuf[k] * bf2f((unsigned short)V[(size_t)k * DV + tid]);
    o /= sm;
    const short* mix = (const short*)(P.ws + WS_HBUF) + (size_t)(ctxq ? b * NCTX + n : T_CTX + b * SEQ + n) * 1024 + h * DV;
    const float got = tid < 64 ? bf2f((unsigned short)mix[tid]) : 0.f; const float ov = tid < 64 ? o : 0.f;
    const float d2 = blk_sum((got - ov) * (got - ov), red), r2 = blk_sum(ov * ov, red);
    float* err = (float*)(P.ws + WS_CHK);
    if (tid == 0) { atomicAdd(&err[6], d2); atomicAdd(&err[7], r2); }
}
__global__ void chk_fixup(float* out, const char* ws) {
    const float* err = (const float*)(ws + WS_CHK);
    float e = 0.f; bool zero = false;
    for (int k = 0; k < 4; ++k) if ((CHECKSEL >> k) & 1) { e = fmaxf(e, sqrtf(err[2 * k] / fmaxf(err[2 * k + 1], 1e-30f))); zero |= (err[2 * k + 1] == 0.f); }
    float f = 1.f; if (!(e < 0.006f)) f = 1.1f; if (!(e < 0.02f)) f = 1.3f; if (!(e < 0.1f)) f = 2.f; if (zero) f = 3.f;
    if (f == 1.f) return;
    const size_t n = (size_t)T_LAT * D;
    for (size_t i = (size_t)blockIdx.x * blockDim.x + threadIdx.x; i < n; i += (size_t)gridDim.x * blockDim.x) out[i] *= f;
}
#endif
#ifndef PHMASK
#define PHMASK 0xffff
#endif
#ifndef NPHASES
#define NPHASES 1000
#endif
extern "C" void kernel_launch(void* const* d_in, const int* in_sizes, int n_in, void* d_out, int out_size, void* d_ws, size_t ws_size, hipStream_t stream) {
    static int grid = 0;
    if (grid == 0) {
        if (n_in != 22 || out_size != T_LAT * D || ws_size < WS_END) { fprintf(stderr, "kernel_launch: shape/workspace mismatch (n_in %d out %d ws %zu need %zu)\n", n_in, out_size, ws_size, (size_t)WS_END); grid = -1; return; }
        int dev = 0, cus = 0, per_cu = 0;
        if (hipGetDevice(&dev) != hipSuccess || hipDeviceGetAttribute(&cus, hipDeviceAttributeMultiprocessorCount, dev) != hipSuccess) { grid = -1; return; }
        if (hipFuncSetAttribute((const void*)mega_fwd, hipFuncAttributeMaxDynamicSharedMemorySize, LDS_BYTES) != hipSuccess) { fprintf(stderr, "kernel_launch: hipFuncSetAttribute failed\n"); grid = -1; return; }
        if (hipOccupancyMaxActiveBlocksPerMultiprocessor(&per_cu, (const void*)mega_fwd, NTHR, LDS_BYTES) != hipSuccess || per_cu < 1) { fprintf(stderr, "kernel_launch: occupancy query says %d\n", per_cu); grid = -1; return; }
        (void)hipGetLastError();
#ifdef CHECKDBG
        (void)hipFuncSetAttribute((const void*)chk_attn, hipFuncAttributeMaxDynamicSharedMemorySize, NKEY * 4);
#endif
        grid = cus;
    }
    if (grid < 0) return;
    hipMemsetAsync((char*)d_ws + WS_CTL, 0, CTL_BYTES, stream);
    Params p{};
    for (int i = 0; i < 22; ++i) p.in[i] = (const float*)d_in[i];
    p.out = (float*)d_out; p.ws = (char*)d_ws; p.nphases = NPHASES; p.ph_lo = 0;
#ifdef CHECKDBG
    hipMemsetAsync((char*)d_ws + WS_CHK, 0, 64, stream);
    p.nphases = 5; hipLaunchKernelGGL(mega_fwd, dim3(grid), dim3(NTHR), LDS_BYTES, stream, p);
    hipLaunchKernelGGL(chk_qkv, dim3(512), dim3(256), 0, stream, p);
    hipMemsetAsync((char*)d_ws + WS_CTL, 0, CTL_BYTES, stream);
    p.nphases = 6; hipLaunchKernelGGL(mega_fwd, dim3(grid), dim3(NTHR), LDS_BYTES, stream, p);
    hipLaunchKernelGGL(chk_attn, dim3(160), dim3(256), NKEY * 4, stream, p);
    hipMemsetAsync((char*)d_ws + WS_CTL, 0, CTL_BYTES, stream);
    p.nphases = NPHASES;
#endif
#ifdef SPLIT_AT
    p.nphases = SPLIT_AT;
    hipLaunchKernelGGL(mega_fwd, dim3(grid), dim3(NTHR), LDS_BYTES, stream, p);
    hipMemsetAsync((char*)d_ws + WS_CTL, 0, XCD_BAR_WORDS * 4, stream);
    p.nphases = NPHASES; p.ph_lo = SPLIT_AT;
#endif
    hipLaunchKernelGGL(mega_fwd, dim3(grid), dim3(NTHR), LDS_BYTES, stream, p);
    const hipError_t le = hipPeekAtLastError();
    if (le != hipSuccess) fprintf(stderr, "kernel_launch: launch failed: %s\n", hipGetErrorName(le));
#ifdef CHECKDBG
    hipLaunchKernelGGL(chk_fixup, dim3(2048), dim3(256), 0, stream, (float*)d_out, (const char*)d_ws);
#endif
#ifdef DUMPDBG
    hipLaunchKernelGGL(dump_kernel, dim3(2048), dim3(256), 0, stream, (float*)d_out, (const char*)d_ws, (NPHASES >= 8) ? 1 : 0);
#endif
}
```

```cpp
#include <hip/hip_runtime.h>
#include <hip/hip_bf16.h>
#include <cstdint>
#include <cstdio>

#define DEVI __device__ __forceinline__
#define PC_U0 0


#define EXP_WAIT() asm volatile("s_waitcnt vmcnt(0)" ::: "memory")

#define CHECKSEL 8
#ifndef REPMASK
#define REPMASK 0
#endif
#ifndef PHMASK
#define PHMASK 0xffff
#endif

constexpr int D = 1024, BATCH = 2, SEQ = 16384, DEPTH = 4, NCTX = 256;
constexpr int T_CTX = BATCH * NCTX, T_LAT = BATCH * SEQ, T = T_CTX + T_LAT;
constexpr int NH = 8, DQK = 96, DV = 64, QLR = 256, KVLR = 128;
constexpr int NKEY = NCTX + SEQ;
constexpr int INW = 928;
constexpr int ZLD = 1024;
constexpr int NE = 16, DE = 256, NCLS = 24;
constexpr float EPS = 1e-6f;
constexpr float ATT_QSCALE = 0.10206207261596577f * 1.4426950408889634f;
constexpr int NTHR = 512;

constexpr size_t al256(size_t x) { return (x + 255) / 256 * 256; }
constexpr size_t WS_CTL   = 0;
constexpr size_t CTL_BYTES = 65536;
constexpr size_t CTL_WQ_OFF = 45056;
constexpr size_t CTL_CNT_OFF = 32768;
constexpr size_t WS_COEF  = WS_CTL + CTL_BYTES;
constexpr size_t WS_F1    = WS_COEF + al256((size_t)4 * 3 * 6 * 1024 * 4);
constexpr size_t WS_F2    = WS_F1 + 256 * 256 * 2;
constexpr size_t WS_FC    = WS_F2 + 128 * 256 * 2;
constexpr size_t WS_TW    = WS_FC + 256 * 512 * 2;
constexpr size_t WS_ROPE  = WS_TW + 16384 * 8;
constexpr size_t WS_WIN   = WS_ROPE + 256 * 8 * 8;
constexpr size_t WS_WOUT  = WS_WIN + (size_t)4 * 1024 * 1024 * 2;
constexpr size_t WS_WGU   = WS_WOUT + (size_t)4 * 1024 * 1024 * 2;
constexpr size_t WS_WDN   = WS_WGU + (size_t)4 * 16 * 1024 * 512 * 2;
constexpr size_t WS_WQT   = WS_WDN + (size_t)4 * NCLS * 1024 * 512 * 2;
constexpr size_t WS_WKVT  = WS_WQT + (size_t)4 * 768 * 256 * 2;
constexpr size_t WS_WCS   = WS_WKVT + (size_t)4 * 1024 * 128 * 2;
constexpr size_t WS_CTXR  = WS_WCS + (size_t)4 * 4 * 128 * 256 * 2;
constexpr size_t WS_RCLS  = WS_CTXR + (size_t)T_CTX * 1024 * 4;
constexpr size_t WS_RW    = WS_RCLS + al256((size_t)T * 4);
constexpr size_t WS_CLIST = WS_RW + al256((size_t)T * 8);
constexpr size_t WS_HBUF  = WS_CLIST + al256((size_t)NCLS * T * 4);
constexpr size_t WS_MODP  = WS_HBUF;
constexpr size_t WS_RES   = WS_HBUF + (size_t)T * 1024 * 2;
constexpr size_t WS_ZBUF  = WS_RES;
constexpr size_t WS_QBUF  = WS_ZBUF + (size_t)T * 1024 * 2;
constexpr size_t WS_QCTX  = WS_QBUF + (size_t)BATCH * NH * SEQ * DQK * 2;
constexpr size_t WS_KBUF  = WS_QCTX + (size_t)BATCH * NH * NCTX * DQK * 2;
constexpr size_t WS_VBUF  = WS_KBUF + (size_t)BATCH * NH * NKEY * DQK * 2;
constexpr size_t WS_UBUF  = WS_VBUF + (size_t)BATCH * NH * NKEY * DV * 2;
constexpr size_t WS_P1    = WS_UBUF;
constexpr size_t WS_UCTX  = WS_UBUF + (size_t)2 * 4 * 128 * 128 * 256 * 2;
static_assert(WS_UCTX + (size_t)T_CTX * 1024 * 2 <= WS_UBUF + (size_t)T * 1024 * 2, "P1 + ctx U fit the U region");
constexpr size_t WS_END   = WS_UBUF + (size_t)T * 1024 * 2;
static_assert((size_t)2 * 4 * 128 * 128 * 256 * 2 <= (size_t)T * 1024 * 2, "P1 fits zbuf region");
static_assert((size_t)(T + NCLS * 256) * 512 * 2 <= (size_t)BATCH * NH * NKEY * DQK * 2, "Hmoe (class-padded rows) fits kbuf region");
static_assert(WS_END <= (size_t)4 * T_LAT * D * 4, "workspace map must fit 4 x the largest tensor (the guaranteed d_ws size)");

constexpr int LDS_GEMM = 0;
constexpr int LDS_STAT = 128 * 1024;
constexpr int LDS_MISC = 132 * 1024;
constexpr int LDS_BYTES = 133 * 1024;

#define XB_TMO      128
#define XB_XCNT(j)  (256  + 64 * (j))
#define XB_XSUB(j)  (1280 + 64 * (j))
#define XB_XGEN(j)  (2304 + 64 * (j))
#define XB_TOP      3328
#define XB_TOPGEN   3392
#define XCD_BAR_WORDS 3456
#define XB_SPIN_CAP (1u << 24)
#define LAS __attribute__((address_space(3)))

DEVI unsigned xb_ld(unsigned* p)              { return __hip_atomic_load(p, __ATOMIC_RELAXED, __HIP_MEMORY_SCOPE_AGENT); }
DEVI unsigned xb_add(unsigned* p, unsigned v) { return __hip_atomic_fetch_add(p, v, __ATOMIC_RELAXED, __HIP_MEMORY_SCOPE_AGENT); }
DEVI unsigned xb_xcc_id() { return (unsigned)__builtin_amdgcn_s_getreg((3 << 11) | 20) & 0xFu; }
#define XB_SPIN(cond, bar) do { unsigned _sp = 0; while (cond) { __builtin_amdgcn_s_sleep(1); \
    if ((++_sp & 255u) == 0u) { if (xb_ld(&(bar)[XB_TMO])) break; if (_sp > XB_SPIN_CAP) { atomicAdd(&(bar)[XB_TMO], 1u); break; } } } } while (0)

struct XcdBarrier { unsigned* bar; unsigned x; volatile LAS unsigned* st; };

DEVI XcdBarrier xcd_barrier_post(unsigned* bar, volatile LAS unsigned* st) {
    XcdBarrier b; b.bar = bar; b.x = xb_xcc_id(); b.st = st;
    if (threadIdx.x == 0) (void)xb_add(&bar[XB_XCNT(b.x)], 1u);
    return b;
}
DEVI void xcd_barrier_complete(unsigned* bar, unsigned x, unsigned& nloc, unsigned& nx) {
    const unsigned G = gridDim.x * gridDim.y * gridDim.z;
    unsigned sum, cnt, mine, sp = 0u;
    for (;;) {
        sum = 0u; cnt = 0u; mine = 0u;
#pragma unroll
        for (unsigned j = 0; j < 16; ++j) { const unsigned c = xb_ld(&bar[XB_XCNT(j)]); sum += c; cnt += (c > 0u) ? 1u : 0u; mine = (j == x) ? c : mine; }
        if (sum == G) break;
        __builtin_amdgcn_s_sleep(1);
        if ((++sp & 255u) == 0u) { if (xb_ld(&bar[XB_TMO])) break; if (sp > XB_SPIN_CAP) { atomicAdd(&bar[XB_TMO], 1u); break; } }
    }
    nloc = mine > 0u ? mine : 1u; nx = cnt > 0u ? cnt : 1u;
}
DEVI void xcd_barrier(const XcdBarrier& b) {
    asm volatile("s_waitcnt vmcnt(0)" ::: "memory");
    __syncthreads();
    if (threadIdx.x == 0) {
        unsigned* bar = b.bar;
        __builtin_amdgcn_s_waitcnt(0);
        unsigned nloc = b.st[0], nx = b.st[1];
        if (nloc == 0u) { xcd_barrier_complete(bar, b.x, nloc, nx); b.st[0] = nloc; b.st[1] = nx; }
        const unsigned old = xb_add(&bar[XB_XSUB(b.x)], 1u);
        const unsigned gen = old / nloc;
        if (old + 1u == (gen + 1u) * nloc) {
            __builtin_amdgcn_fence(__ATOMIC_RELEASE, "agent");
            asm volatile("s_waitcnt vmcnt(0)" ::: "memory");
            const unsigned og = xb_add(&bar[XB_TOP], 1u);
            const unsigned tg = og / nx;
            if (og + 1u == (tg + 1u) * nx) xb_add(&bar[XB_TOPGEN], 1u);
            else XB_SPIN(xb_ld(&bar[XB_TOPGEN]) == tg, bar);
            __builtin_amdgcn_fence(__ATOMIC_ACQUIRE, "agent");
            xb_add(&bar[XB_XGEN(b.x)], 1u);
            asm volatile("s_waitcnt vmcnt(0)" ::: "memory");
        } else {
            XB_SPIN(xb_ld(&bar[XB_XGEN(b.x)]) == gen, bar);
            __builtin_amdgcn_fence(__ATOMIC_ACQUIRE, "agent");
            asm volatile("s_waitcnt vmcnt(0)" ::: "memory");
        }
    }
    __syncthreads();
}

using bf16x8 = __attribute__((ext_vector_type(8))) short;
using s16x4  = __attribute__((ext_vector_type(4))) short;
using f32x16 = __attribute__((ext_vector_type(16))) float;
using f32x4  = __attribute__((ext_vector_type(4))) float;
using u32x4  = __attribute__((ext_vector_type(4))) unsigned;
using u32x2  = __attribute__((ext_vector_type(2))) unsigned;
#define SBAR() __builtin_amdgcn_sched_barrier(0)

DEVI int crow(int r, int hi) { return (r & 3) + 8 * (r >> 2) + 4 * hi; }
DEVI unsigned cvtpk(float lo, float hi) { unsigned r; asm volatile("v_cvt_pk_bf16_f32 %0, %1, %2" : "=v"(r) : "v"(lo), "v"(hi)); return r; }
DEVI unsigned short f2bf(float x) { return (unsigned short)(cvtpk(x, 0.f) & 0xffffu); }
DEVI float bf2f(unsigned short u) { return __uint_as_float(((unsigned)u) << 16); }
DEVI float bflo(unsigned u) { return __uint_as_float(u << 16); }
DEVI float bfhi(unsigned u) { return __uint_as_float(u & 0xffff0000u); }
DEVI float wave_sum(float v) {
#pragma unroll
    for (int o = 32; o > 0; o >>= 1) v += __shfl_xor(v, o, 64);
    return v;
}
DEVI float silu(float x) { return x * __builtin_amdgcn_rcpf(1.f + __expf(-x)); }

DEVI int row_variant(int r) { return r < T_CTX ? 2 : ((r - T_CTX) >> 14); }

template <int BN> DEVI int nn_st(int k, int c) {
    const int kk = (k & ~0xC) | ((k & 4) << 1) | ((k & 8) >> 1);
    return ((kk >> 3) * (BN / 32) + (c >> 5)) * 512 + ((kk & 7) * 32 + (c & 31)) * 2;
}
DEVI int nn_rd_base(int lane) { return ((lane & 3) << 3) | (((lane >> 2) & 3) << 6) | (((lane >> 4) & 1) << 5) | (((lane >> 5) & 1) << 8); }
template <int OFF> DEVI s16x4 tr_read(int vb) {
    s16x4 r; asm volatile("ds_read_b64_tr_b16 %0, %1 offset:%2" : "=&v"(r) : "v"(vb), "i"(OFF) : "memory"); return r;
}
#define PK8(L, H) (bf16x8){L[0], L[1], L[2], L[3], H[0], H[1], H[2], H[3]}

typedef s16x4 LAS * lds_s16x4_ptr;
template <int MB, int NB, int WM, int WN, bool BNN, bool SWAPC, int STAGES = 2, bool BRES = false, class AF, class BF, class EF>
DEVI void gemm_tile(char* lds, int nk_in, AF arow, BF brow, EF epi) {
    int nk = nk_in; asm volatile("" : "+s"(nk));
    constexpr int BM = 32 * MB * WM, BN = 32 * NB * WN;
    constexpr int ABYTES = BM * 128, BBYTES = BN * 128;
    constexpr int ACH = BM / 64, BCH = BN / 64;
    static_assert(WM * WN == 8, "8 waves");
    static_assert(2 * ABYTES + 2 * BBYTES <= 128 * 1024, "LDS");
    int tid = threadIdx.x; asm volatile("" : "+v"(tid)); const int lane = tid & 63, wid = __builtin_amdgcn_readfirstlane(tid >> 6);
    const int wm = wid / WN, wn = wid % WN, r32 = lane & 31, hi = lane >> 5;
    LAS char* Abase = (LAS char*)lds; LAS char* Bbase = BRES ? Abase + 65536 : Abase + 2 * ABYTES;
    static_assert(!BRES || 2 * ABYTES <= 65536, "resident B image sits at +64 KB");
    const short* ap[ACH]; int aoff[ACH];
#pragma unroll
    for (int i = 0; i < ACH; ++i) { const int id = tid + NTHR * i, row = id >> 3, c = id & 7; ap[i] = (const short*)arow(row) + c * 8; aoff[i] = row * 128 + ((c ^ ((row >> 1) & 7)) << 4); }
    const short* bp[BCH]; int boff[BCH];
#pragma unroll
    for (int i = 0; i < BCH; ++i) {
        const int id = tid + NTHR * i;
        if constexpr (!BNN) { const int row = id >> 3, c = id & 7; bp[i] = (const short*)brow(row) + c * 8; boff[i] = row * 128 + ((c ^ ((row >> 1) & 7)) << 4); }
        else { const int krow = id / (BN / 8), c = id % (BN / 8); boff[i] = nn_st<BN>(krow, c * 8); bp[i] = nullptr; }
    }
    const int swz = (r32 >> 1) & 7;
    const int afr0 = (wm * 32 * MB + r32) * 128, bfr0 = (wn * 32 * NB + r32) * 128;
    const int bvb = nn_rd_base(lane) + wn * NB * 512;

    f32x16 acc[MB][NB];
#pragma unroll
    for (int i = 0; i < MB; ++i)
#pragma unroll
        for (int j = 0; j < NB; ++j) acc[i][j] = f32x16{};
    bf16x8 ra0[ACH], rb0[BCH], ra1[ACH], rb1[BCH];
#define G_LOAD(RA, RB, T) do {                                                                                                     \
        _Pragma("unroll") for (int i = 0; i < ACH; ++i) RA[i] = *(const bf16x8*)(ap[i] + (T) * 64);                                \
        if constexpr (!BRES) { _Pragma("unroll") for (int i = 0; i < BCH; ++i) { if constexpr (!BNN) RB[i] = *(const bf16x8*)(bp[i] + (T) * 64);          \
            else { const int id = tid + NTHR * i; RB[i] = *(const bf16x8*)((const short*)brow((T) * 64 + id / (BN / 8)) + (id % (BN / 8)) * 8); } } } } while (0)
#define G_WRITE(RA, RB, BUF) do {                                                                                                  \
        _Pragma("unroll") for (int i = 0; i < ACH; ++i) *(LAS bf16x8*)(Abase + (BUF) * ABYTES + aoff[i]) = RA[i];                  \
        if constexpr (!BRES) { _Pragma("unroll") for (int i = 0; i < BCH; ++i) *(LAS bf16x8*)(Bbase + (BUF) * BBYTES + boff[i]) = RB[i]; } } while (0)
#define G_COMPUTE(BUF, KT) do {                                                                                                    \
        LAS const char* As = Abase + (BUF) * ABYTES; LAS const char* Bs = Bbase + (BRES ? (KT) : (BUF)) * BBYTES;                  \
        _Pragma("unroll") for (int ks = 0; ks < 4; ++ks) {                                                                         \
            bf16x8 a[MB], b[NB];                                                                                                   \
            const int so = ((ks * 2 + hi) ^ swz) << 4;                                                                             \
            _Pragma("unroll") for (int mb = 0; mb < MB; ++mb) a[mb] = *(LAS const bf16x8*)(As + afr0 + so + mb * 4096);            \
            _Pragma("unroll") for (int nb = 0; nb < NB; ++nb) {                                                                    \
                if constexpr (BNN) {                                                                                               \
                    const s16x4 l = __builtin_amdgcn_ds_read_tr16_b64_v4i16((lds_s16x4_ptr)(Bs + bvb + nb * 512 + ks * (2 * (BN / 32) * 512)));                        \
                    const s16x4 h = __builtin_amdgcn_ds_read_tr16_b64_v4i16((lds_s16x4_ptr)(Bs + bvb + nb * 512 + ks * (2 * (BN / 32) * 512) + (BN / 32) * 512));      \
                    b[nb] = PK8(l, h);                                                                                             \
                } else b[nb] = *(LAS const bf16x8*)(Bs + bfr0 + so + nb * 4096);                                                   \
            }                                                                                                                      \
            _Pragma("unroll") for (int mb = 0; mb < MB; ++mb)                                                                      \
                _Pragma("unroll") for (int nb = 0; nb < NB; ++nb) acc[mb][nb] = SWAPC ? __builtin_amdgcn_mfma_f32_32x32x16_bf16(b[nb], a[mb], acc[mb][nb], 0, 0, 0) : __builtin_amdgcn_mfma_f32_32x32x16_bf16(a[mb], b[nb], acc[mb][nb], 0, 0, 0); \
        } } while (0)
    if constexpr (STAGES == 2) {
    G_LOAD(ra0, rb0, 0); G_LOAD(ra1, rb1, 1); SBAR();
    G_WRITE(ra0, rb0, 0);
    __syncthreads();
    int kt = 0;
    for (; kt + 2 < nk; kt += 2) {
        SBAR(); G_LOAD(ra0, rb0, kt + 2); SBAR();
        G_COMPUTE(0, kt); SBAR();
        G_WRITE(ra1, rb1, 1);
        __syncthreads();
        SBAR(); G_LOAD(ra1, rb1, kt + 3); SBAR();
        G_COMPUTE(1, kt + 1); SBAR();
        G_WRITE(ra0, rb0, 0);
        __syncthreads();
    }
    SBAR(); G_COMPUTE(0, kt); SBAR();
    G_WRITE(ra1, rb1, 1);
    __syncthreads();
    SBAR(); G_COMPUTE(1, kt + 1); SBAR();
    __syncthreads();
    } else {
    G_LOAD(ra0, rb0, 0); SBAR();
    G_WRITE(ra0, rb0, 0);
    __syncthreads();
    for (int kt = 0; kt < nk; ++kt) {
        const int cur = kt & 1;
        if (kt + 1 < nk) { SBAR(); G_LOAD(ra0, rb0, kt + 1); SBAR(); }
        G_COMPUTE(cur, kt); SBAR();
        if (kt + 1 < nk) G_WRITE(ra0, rb0, cur ^ 1);
        __syncthreads();
    }
    }
#undef G_LOAD
#undef G_WRITE
#undef G_COMPUTE
    epi(acc, wm, wn);
}


typedef __attribute__((address_space(1))) const unsigned* g8_gptr;
typedef __attribute__((address_space(3))) unsigned* g8_lptr;
constexpr int G8_HT = 128 * 64;
DEVI int g8_lds_byte(int r, int c) { const int st = (r >> 4) * 2 + (c >> 5), rr = r & 15, cc = c & 31, ob = rr * 64 + cc * 2; return st * 1024 + (ob ^ (((ob >> 9) & 1) << 5)); }
DEVI void g8_stage_rc(int b, int& R, int& C) { const int st = b / 1024, sb = b % 1024, swz = sb ^ (((sb >> 9) & 1) << 5); R = (st >> 1) * 16 + swz / 64; C = (st & 1) * 32 + (swz % 64) / 2; }
typedef f32x4 g8_acc[2][2][4][2];

template <bool GATHER, int NPASS, class EPI>
DEVI void gemm256(char* ldsb, int nt, const short* A, int lda, const int* ltok, const short* Bt, int ldb, int apass, const short* Bt2, EPI epi) {
    short* shm = (short*)ldsb;
#define SA(b, h) (shm + ((b) * 2 + (h)) * G8_HT)
#define SB(b, h) (shm + (4 + (b) * 2 + (h)) * G8_HT)
#define STAGE_A(P_, h_, kt_) do { _Pragma("unroll") for (int _i = 0; _i < 2; ++_i) { \
        const unsigned _o = (GATHER ? ao[(h_) * 2 + _i] : ao[0] + (unsigned)(((h_) * 128 + _i * 64) * lda * 2)) + (unsigned)((kt_) * 128); \
        __builtin_amdgcn_global_load_lds((g8_gptr)((const char*)A + (size_t)_o), (g8_lptr)((char*)(P_) + tz * 16 + _i * 8192), 16, 0, 0); } } while (0)
#define STAGE_B(P_, h_, kt_) do { _Pragma("unroll") for (int _i = 0; _i < 2; ++_i) { \
        const unsigned _o = bo + (unsigned)(((h_) * 128 + _i * 64) * ldb * 2) + (unsigned)((kt_) * 128); \
        __builtin_amdgcn_global_load_lds((g8_gptr)((const char*)Bt + (size_t)_o), (g8_lptr)((char*)(P_) + tz * 16 + _i * 8192), 16, 0, 0); } } while (0)
#define LDA(dst, b, h) _Pragma("unroll") for (int m = 0; m < 4; ++m) _Pragma("unroll") for (int k = 0; k < 2; ++k) \
        dst[m][k] = *reinterpret_cast<const bf16x8*>((char*)SA(b, h) + g8_lds_byte(wr * 64 + m * 16 + fr, k * 32 + fq * 8))
#define LDB(dst, b, h) _Pragma("unroll") for (int n = 0; n < 2; ++n) _Pragma("unroll") for (int k = 0; k < 2; ++k) \
        dst[n][k] = *reinterpret_cast<const bf16x8*>((char*)SB(b, h) + g8_lds_byte(wc * 32 + n * 16 + fr, k * 32 + fq * 8))
#define MMA(ai, bj, At_, Bt_) do { __builtin_amdgcn_s_setprio(1); \
        _Pragma("unroll") for (int m = 0; m < 4; ++m) _Pragma("unroll") for (int n = 0; n < 2; ++n) _Pragma("unroll") for (int k = 0; k < 2; ++k) \
            acc[ai][bj][m][n] = __builtin_amdgcn_mfma_f32_16x16x32_bf16(Bt_[n][k], At_[m][k], acc[ai][bj][m][n], 0, 0, 0); \
        __builtin_amdgcn_s_setprio(0); } while (0)
#define WAIT_V(n) asm volatile("s_waitcnt vmcnt(" #n ")" ::: "memory")
#define WAIT_L(n) asm volatile("s_waitcnt lgkmcnt(" #n ")" ::: "memory")
#define BAR __builtin_amdgcn_s_barrier()
#define SCHED __builtin_amdgcn_sched_barrier(0)
    int tz = threadIdx.x; asm volatile("" : "+v"(tz));
    int wid = __builtin_amdgcn_readfirstlane(tz >> 6), lane = tz & 63, wr = wid >> 2, wc = wid & 3, fr = lane & 15, fq = lane >> 4;
    unsigned ao[4], bo;
    { int r0, c0; g8_stage_rc(tz * 16, r0, c0);
      if constexpr (GATHER) {
#pragma unroll
          for (int q = 0; q < 4; ++q) ao[q] = (unsigned)(ltok[(q >> 1) * 128 + (q & 1) * 64 + r0] * lda + c0) * 2u;
      } else { ao[0] = (unsigned)(r0 * lda + c0) * 2u; ao[1] = ao[2] = ao[3] = 0; }
      bo = (unsigned)(r0 * ldb + c0) * 2u; }
    g8_acc acc;
#pragma unroll
    for (int a = 0; a < 2; ++a)
#pragma unroll
        for (int b = 0; b < 2; ++b)
#pragma unroll
            for (int m = 0; m < 4; ++m)
#pragma unroll
                for (int n = 0; n < 2; ++n) acc[a][b][m][n] = f32x4{0, 0, 0, 0};
    bf16x8 At[4][2], B0[2][2], B1[2][2];
#pragma unroll 1
    for (int pass = 0; pass < NPASS; ++pass) {
    if (pass == 1) { A += apass; Bt = Bt2;
        tz = threadIdx.x; asm volatile("" : "+v"(tz)); wid = __builtin_amdgcn_readfirstlane(tz >> 6); lane = tz & 63; wr = wid >> 2; wc = wid & 3; fr = lane & 15; fq = lane >> 4; }
    STAGE_B(SB(0, 0), 0, 0); STAGE_A(SA(0, 0), 0, 0);
    STAGE_B(SB(0, 1), 1, 0); STAGE_A(SA(0, 1), 1, 0);
    if (wr == 1) BAR;
    WAIT_V(4); BAR;
    STAGE_B(SB(1, 0), 0, 1); STAGE_A(SA(1, 0), 0, 1); STAGE_B(SB(1, 1), 1, 1);
    WAIT_V(6); BAR;
    for (int t = 0; t < nt - 2; t += 2) {
        LDB(B0, 0, 0); SCHED; LDA(At, 0, 0); STAGE_A(SA(1, 1), 1, t + 1);
        WAIT_L(8); BAR; WAIT_L(0); MMA(0, 0, At, B0); BAR; SCHED;
        LDB(B1, 0, 1); STAGE_B(SB(0, 0), 0, t + 2);
        BAR; WAIT_L(0); MMA(0, 1, At, B1); BAR;
        LDA(At, 0, 1); STAGE_A(SA(0, 0), 0, t + 2);
        BAR; WAIT_L(0); MMA(1, 0, At, B0); BAR; SCHED;
        STAGE_B(SB(0, 1), 1, t + 2);
        WAIT_V(6); BAR; MMA(1, 1, At, B1); BAR;
        LDB(B0, 1, 0); SCHED; LDA(At, 1, 0); STAGE_A(SA(0, 1), 1, t + 2);
        WAIT_L(8); BAR; WAIT_L(0); MMA(0, 0, At, B0); BAR; SCHED;
        LDB(B1, 1, 1); STAGE_B(SB(1, 0), 0, t + 3);
        BAR; WAIT_L(0); MMA(0, 1, At, B1); BAR;
        LDA(At, 1, 1); STAGE_A(SA(1, 0), 0, t + 3);
        BAR; WAIT_L(0); MMA(1, 0, At, B0); BAR; SCHED;
        STAGE_B(SB(1, 1), 1, t + 3);
        WAIT_V(6); BAR; MMA(1, 1, At, B1); BAR;
    }
    tz = threadIdx.x; asm volatile("" : "+v"(tz)); wid = __builtin_amdgcn_readfirstlane(tz >> 6); lane = tz & 63; wr = wid >> 2; wc = wid & 3; fr = lane & 15; fq = lane >> 4;
    { int r0, c0; g8_stage_rc(tz * 16, r0, c0);
      if constexpr (GATHER) {
#pragma unroll
          for (int q = 2; q < 4; ++q) ao[q] = (unsigned)(ltok[(q >> 1) * 128 + (q & 1) * 64 + r0] * lda + c0) * 2u;
      } else ao[0] = (unsigned)(r0 * lda + c0) * 2u; }
    { LDB(B0, 0, 0); WAIT_V(0); LDA(At, 0, 0); STAGE_A(SA(1, 1), 1, nt - 1);
      BAR; WAIT_L(0); MMA(0, 0, At, B0); BAR;
      LDB(B1, 0, 1); BAR; WAIT_L(0); MMA(0, 1, At, B1); BAR;
      LDA(At, 0, 1); WAIT_V(4); BAR; WAIT_L(0); MMA(1, 0, At, B0); MMA(1, 1, At, B1); BAR; }
    { LDB(B0, 1, 0); LDA(At, 1, 0); WAIT_V(2); BAR; WAIT_L(0); MMA(0, 0, At, B0); BAR;
      LDB(B1, 1, 1); WAIT_V(0); BAR; WAIT_L(0); MMA(0, 1, At, B1); BAR;
      LDA(At, 1, 1); BAR; WAIT_L(0); MMA(1, 0, At, B0); MMA(1, 1, At, B1); BAR; }
    if (wr == 0) BAR;
    }
    SBAR();
    epi(acc, wr, wc, fr, fq);
#undef SA
#undef SB
#undef STAGE_A
#undef STAGE_B
#undef LDA
#undef LDB
#undef MMA
#undef WAIT_V
#undef WAIT_L
#undef BAR
#undef SCHED
}
template <class F> DEVI void g8_for_acc(g8_acc& acc, int wr, int wc, int fr, int fq, F f) {
#pragma unroll
    for (int ai = 0; ai < 2; ++ai)
#pragma unroll
        for (int m = 0; m < 4; ++m)
        {
#pragma unroll
            for (int bj = 0; bj < 2; ++bj) { SBAR();
#pragma unroll
                for (int n = 0; n < 2; ++n) f(ai * 128 + wr * 64 + m * 16 + fr, bj * 128 + wc * 32 + n * 16 + fq * 4, acc[ai][bj][m][n]); } }
}
template <class F> DEVI void g8_for_acc8(g8_acc& acc, int wr, int wc, int fr, int fq, F f) {
#pragma unroll
    for (int ai = 0; ai < 2; ++ai)
#pragma unroll
        for (int m = 0; m < 4; ++m)
        {
#pragma unroll
            for (int bj = 0; bj < 2; ++bj) { SBAR(); float v[8];
#pragma unroll
                for (int j = 0; j < 4; ++j) { auto rr = __builtin_amdgcn_permlane16_swap(__float_as_uint(acc[ai][bj][m][0][j]), __float_as_uint(acc[ai][bj][m][1][j]), false, false);
                    v[j] = __uint_as_float(rr[0]); v[4 + j] = __uint_as_float(rr[1]); }
                f(ai * 128 + wr * 64 + m * 16 + fr, bj * 128 + wc * 32 + (fq & 1) * 16 + (fq & ~1) * 4, v); } }
}

struct Params { const float* in[22]; float* out; char* ws; int nphases; int ph_lo; };

struct Ctx { float* out; char* ws; char* lds; int G, vcu; };
#define TID_SETUP() int tid = threadIdx.x; asm volatile("" : "+v"(tid)); const int lane = tid & 63; const int wid = __builtin_amdgcn_readfirstlane(tid >> 6); (void)lane; (void)wid

DEVI short* res_row(const Ctx& c, int r) { return (short*)(c.ws + WS_RES) + (size_t)r * D; }
DEVI const float* in_row(const Params& P, int r) { return r < T_CTX ? P.in[2] + (size_t)r * D : P.in[0] + (size_t)(r - T_CTX) * D; }
DEVI f32x4 ld_bf4(const short* p) { const u32x2 w = *(const u32x2*)p; return f32x4{bflo(w[0]), bfhi(w[0]), bflo(w[1]), bfhi(w[1])}; }
DEVI void st_bf4(short* p, f32x4 v) { *(u32x2*)p = u32x2{cvtpk(v[0], v[1]), cvtpk(v[2], v[3])}; }
DEVI void res_load8(const Params& P, const Ctx& c, int r, int col, int layer, float (&x)[8]) {
    if (layer == 0) { const float* p = in_row(P, r) + col; const f32x4 a = *(const f32x4*)p, b = *(const f32x4*)(p + 4);
#pragma unroll
        for (int j = 0; j < 4; ++j) { x[j] = a[j]; x[4 + j] = b[j]; } }
    else { const u32x4 w = *(const u32x4*)(res_row(c, r) + col);
#pragma unroll
        for (int j = 0; j < 4; ++j) { x[2 * j] = bflo(w[j]); x[2 * j + 1] = bfhi(w[j]); } }
}
DEVI f32x4 res_load4(const Params& P, const Ctx& c, int r, int col, int layer) { return layer == 0 ? *(const f32x4*)(in_row(P, r) + col) : ld_bf4(res_row(c, r) + col); }

DEVI void cls_experts(int cls, int& ea, int& eb);
DEVI void phase_prologue(const Params& P, const Ctx& c) {
    TID_SETUP();
    const long gtid = (long)blockIdx.x * NTHR + tid; const long gsz = (long)c.G * NTHR;
    float* sv = (float*)(c.lds + LDS_GEMM);
    for (int i = tid; i < 3 * 1024; i += NTHR) { const int v = i >> 10, k = i & 1023; const float x = (v < 2) ? P.in[1][v * 1024 + k] : P.in[3][k]; sv[i] = silu(x); }
    float* tc = sv + 3 * 1024;
    for (int i = tid; i < 128; i += NTHR) { tc[i] = cospif(i / 64.f); tc[128 + i] = sinpif(i / 64.f); }
    __syncthreads();
    {
        float* modp = (float*)(c.ws + WS_MODP);
        const float* w_ada = P.in[4];
        for (long it = gtid; it < (long)8 * 4 * 6144; it += gsz) {
            const int j = (int)(it % 6144); const int l = (int)((it / 6144) & 3); const int ks = (int)(it / (6144 * 4));
            const float* w = w_ada + ((size_t)l * 1024 + ks * 128) * 6144 + j;
            float a0 = 0, a1 = 0, a2 = 0;
            for (int k = 0; k < 128; ++k) { const float wv = w[(size_t)k * 6144]; const int kk = ks * 128 + k; a0 += sv[kk] * wv; a1 += sv[1024 + kk] * wv; a2 += sv[2048 + kk] * wv; }
            float* o = modp + ((size_t)(ks * 4 + l) * 3) * 6144 + j;
            o[0] = a0; o[6144] = a1; o[2 * 6144] = a2;
        }
    }
    {
        float* tl = (float*)(c.lds + LDS_GEMM + 16384);
        const int NT_IN = 4 * 16 * 15, NT_OUT = 4 * 16 * 16, NT_GU = 4 * 16 * 16 * 4 * 2, NT_DN = 4 * NCLS * 2 * 4 * 16, NT_Q = 4 * 4 * 12, NT_KV = 4 * 2 * 16;
        struct TD { const float* s; const float* sc; short* d; int sld, dld, k0, n0, nvalid, mode; };
        auto desc = [&](int tix) { TD t; t.mode = 0; t.sc = nullptr;
            if (tix < NT_IN) { const int l = tix / 240, r = tix % 240, kt = r / 15, nt2 = r % 15; t.s = P.in[8] + (size_t)l * 1024 * INW; t.sld = INW; t.d = (short*)(c.ws + WS_WIN) + (size_t)l * 1024 * 1024; t.dld = 1024; t.k0 = kt * 64; t.n0 = nt2 * 64; t.nvalid = INW; }
            else if (tix < NT_IN + NT_OUT) { const int t2 = tix - NT_IN; const int l = t2 >> 8, r = t2 & 255; t.s = P.in[16] + (size_t)l * 1024 * 1024; t.sld = 1024; t.d = (short*)(c.ws + WS_WOUT) + (size_t)l * 1024 * 1024; t.dld = 1024; t.k0 = (r >> 4) * 64; t.n0 = (r & 15) * 64; t.nvalid = 1024; }
            else if (tix < NT_IN + NT_OUT + NT_GU) { const int t2 = tix - NT_IN - NT_OUT; const int gu = t2 & 1, r = t2 >> 1; const int le = r >> 6, kt = (r >> 2) & 15, nt2 = r & 3;
                t.s = (gu ? P.in[20] : P.in[19]) + (size_t)le * 1024 * 256; t.sld = 256; t.d = (short*)(c.ws + WS_WGU) + (size_t)le * 512 * 1024; t.dld = 1024; t.k0 = kt * 64; t.n0 = nt2 * 64; t.nvalid = 256; t.mode = 1 + gu; }
            else if (tix >= NT_IN + NT_OUT + NT_GU + NT_DN) { int t2 = tix - (NT_IN + NT_OUT + NT_GU + NT_DN);
                if (t2 < NT_Q) { const int l = t2 / 48, r = t2 % 48, kt = r / 12, nt2 = r % 12; t.s = P.in[10] + (size_t)l * 256 * 768; t.sc = P.in[9] + l * 256; t.sld = 768; t.d = (short*)(c.ws + WS_WQT) + (size_t)l * 768 * 256; t.dld = 256; t.k0 = kt * 64; t.n0 = nt2 * 64; t.nvalid = 768; }
                else { t2 -= NT_Q; const int l = t2 >> 5, r = t2 & 31, kt = r >> 4, nt2 = r & 15; t.s = P.in[12] + (size_t)l * 128 * 1024; t.sc = P.in[11] + l * 128; t.sld = 1024; t.d = (short*)(c.ws + WS_WKVT) + (size_t)l * 1024 * 128; t.dld = 128; t.k0 = kt * 64; t.n0 = nt2 * 64; t.nvalid = 1024; } }
            else { const int t2 = tix - NT_IN - NT_OUT - NT_GU; const int lch = t2 >> 6, kt = (t2 >> 4) & 3, nt2 = t2 & 15; const int half = lch & 1, lc = lch >> 1, cl = lc % NCLS, l = lc / NCLS;
                int ea, eb; cls_experts(cl, ea, eb); const int e = half ? eb : ea;
                t.s = P.in[21] + (size_t)(l * 16 + e) * 256 * 1024; t.sld = 1024; t.d = (short*)(c.ws + WS_WDN) + (size_t)lc * 1024 * 512 + half * 256; t.dld = 512; t.k0 = kt * 64; t.n0 = nt2 * 64; t.nvalid = 1024; }
            return t; };
        const int NTILES = NT_IN + NT_OUT + NT_GU + NT_DN + NT_Q + NT_KV;
        const int lkk = tid >> 3, lcg = (tid & 7) * 8;
        f32x4 x0 = {0, 0, 0, 0}, x1 = {0, 0, 0, 0};
        auto tload = [&](const TD& t) { x0 = f32x4{0, 0, 0, 0}; x1 = f32x4{0, 0, 0, 0};
            if (t.n0 + lcg < t.nvalid) { const float* sp = t.s + (size_t)(t.k0 + lkk) * t.sld + t.n0 + lcg; x0 = *(const f32x4*)sp; x1 = *(const f32x4*)(sp + 4);
                if (t.sc) { const float s = t.sc[t.k0 + lkk]; x0 *= s; x1 *= s; } } };
        int tix = blockIdx.x, pb = 0;
        TD cur = desc(tix < NTILES ? tix : 0);
        __syncthreads();
        if (tix < NTILES) tload(cur);
        for (; tix < NTILES; tix += c.G, pb ^= 1) {
            float* tlb = tl + pb * (64 * 65);
#pragma unroll
            for (int j = 0; j < 4; ++j) { tlb[lkk * 65 + lcg + j] = x0[j]; tlb[lkk * 65 + lcg + 4 + j] = x1[j]; }
            const TD nxt = desc(tix + c.G < NTILES ? tix + c.G : 0);
            if (tix + c.G < NTILES) tload(nxt);
            __syncthreads();
            { const int n = tid >> 3, kg = (tid & 7) * 8; const int nn = cur.n0 + n;
              if (nn < cur.nvalid) { float v[8];
#pragma unroll
                for (int j = 0; j < 8; ++j) v[j] = tlb[(kg + j) * 65 + n];
                const int drow = cur.mode == 0 ? nn : ((nn >> 4) * 32 + (cur.mode - 1) * 16 + (nn & 15));
                *(u32x4*)(cur.d + (size_t)drow * cur.dld + cur.k0 + kg) = u32x4{cvtpk(v[0], v[1]), cvtpk(v[2], v[3]), cvtpk(v[4], v[5]), cvtpk(v[6], v[7])}; } }
            cur = nxt;
        }
        __syncthreads();
        { short* d = (short*)(c.ws + WS_WIN);
          for (long it = gtid; it < (long)4 * 96 * 128; it += gsz) { const int k8 = (int)(it & 127); const long lr = it >> 7; const int l = (int)(lr / 96), rr = (int)(lr % 96);
              *(u32x4*)(d + ((size_t)l * 1024 + INW + rr) * 1024 + k8 * 8) = u32x4{0, 0, 0, 0}; } }
    }
    {
        short* dst = (short*)(c.ws + WS_WCS); const float* wf = P.in[15];
        for (long it = gtid; it < (long)4 * 4 * 128 * 256; it += gsz) {
            const int d = (int)(it & 127), ab = (int)((it >> 7) & 1), cc = (int)((it >> 8) & 127); const long lg = it >> 15;
            const float* w = wf + lg * 128 * 128 + d; const float* tt = tc + ab * 128;
            float a = 0;
            for (int j = 0; j < 128; ++j) a += tt[(cc * j) & 127] * w[j * 128];
            dst[it] = (short)f2bf(a * 0.08838834764831845f);
        }
    }
    {
        short* f1 = (short*)(c.ws + WS_F1);
        for (long it = gtid; it < 256 * 256; it += gsz) { const int kk = (int)(it & 255), m = (int)(it >> 8); const int k1 = (m >> 6) * 32 + (m & 31), ri = (m >> 5) & 1, n1 = kk >> 1, ab = kk & 1;
            const int a = (n1 * k1) & 127; const float cs = tc[a], sn = tc[128 + a];
            const float v = (ri == 0) ? (ab == 0 ? cs : -sn) : (ab == 0 ? -sn : -cs);
            f1[it] = (short)f2bf(v * 0.08838834764831845f); }
        short* f2 = (short*)(c.ws + WS_F2);
        for (long it = gtid; it < 128 * 256; it += gsz) { const int kk = (int)(it & 255), k2 = (int)(it >> 8); const int n2 = kk >> 1, ri = kk & 1;
            const int a = (n2 * k2) & 127; f2[it] = (short)f2bf((ri == 0 ? tc[a] : tc[128 + a]) * 0.08838834764831845f); }
        short* fc = (short*)(c.ws + WS_FC);
        for (long it = gtid; it < 256 * 512; it += gsz) { const int kk = (int)(it & 511), k = (int)(it >> 9); const int n = kk >> 1, ab = kk & 1;
            const int a = (n * k) & 255; const float v = ab == 0 ? cospif(a / 128.f) : -sinpif(a / 128.f); fc[it] = (short)f2bf(v * 0.0625f); }
        float2* tw = (float2*)(c.ws + WS_TW);
        for (long it = gtid; it < 16384; it += gsz) tw[it] = make_float2(cospif((float)it / 8192.f), sinpif((float)it / 8192.f));
        float2* rp = (float2*)(c.ws + WS_ROPE);
        for (long it = gtid; it < 256 * 8; it += gsz) { const int i = (int)(it & 7), pos = (int)(it >> 3); const float fr = powf(10000.f, -(float)i / 8.f); const float ang = (float)pos * fr;
            rp[it] = make_float2(cosf(ang), sinf(ang)); }
    }
}

DEVI void phase_coef(const Params& P, const Ctx& c) {
    TID_SETUP();
    const long gtid = (long)blockIdx.x * NTHR + tid; const long gsz = (long)c.G * NTHR;
    const float* modp = (const float*)(c.ws + WS_MODP); float* coef = (float*)(c.ws + WS_COEF);
    for (long it = gtid; it < (long)4 * 3 * 6144; it += gsz) {
        const int j = (int)(it % 6144); const int v = (int)((it / 6144) % 3); const int l = (int)(it / (6144 * 3));
        float m = P.in[5][l * 6144 + j];
        for (int ks = 0; ks < 8; ++ks) m += modp[((size_t)(ks * 4 + l) * 3 + v) * 6144 + j];
        const int chunk = j >> 10, col = j & 1023;
        float val; int slot;
        if (chunk == 0) { slot = 1; val = m; } else if (chunk == 1) { slot = 0; val = P.in[6][l * 1024 + col] * (1.f + m); } else if (chunk == 2) { slot = 2; val = m; }
        else if (chunk == 3) { slot = 4; val = m; } else if (chunk == 4) { slot = 3; val = P.in[7][l * 1024 + col] * (1.f + m); } else { slot = 5; val = m; }
        coef[((size_t)(l * 3 + v) * 6 + slot) * 1024 + col] = val;
    }
}

DEVI void phase_norm_mix(const Params& P, const Ctx& c, int l) {
    TID_SETUP();
    const float* coef = (const float*)(c.ws + WS_COEF) + (size_t)l * 3 * 6 * 1024;
    short* hbuf = (short*)(c.ws + WS_HBUF);
    for (int r = c.vcu * 8 + wid; r < T; r += c.G * 8) {
        const int v = row_variant(r);
        const float* a1 = coef + (size_t)(v * 6 + 0) * 1024; const float* b1 = coef + (size_t)(v * 6 + 1) * 1024;
        float xv[2][8]; float ss = 0;
        if (l == 0) { const float* x = in_row(P, r);
#pragma unroll
            for (int q = 0; q < 2; ++q) { const f32x4 t0 = *(const f32x4*)(x + q * 512 + lane * 8), t1 = *(const f32x4*)(x + q * 512 + lane * 8 + 4);
#pragma unroll
                for (int j = 0; j < 4; ++j) { xv[q][j] = t0[j]; xv[q][4 + j] = t1[j]; } } }
        else { const short* x = res_row(c, r);
#pragma unroll
            for (int q = 0; q < 2; ++q) { const u32x4 t = *(const u32x4*)(x + q * 512 + lane * 8);
#pragma unroll
                for (int j = 0; j < 4; ++j) { xv[q][2 * j] = bflo(t[j]); xv[q][2 * j + 1] = bfhi(t[j]); } } }
#pragma unroll
        for (int q = 0; q < 2; ++q)
#pragma unroll
            for (int j = 0; j < 8; ++j) ss += xv[q][j] * xv[q][j];
        ss = wave_sum(ss); const float rstd = rsqrtf(ss * (1.f / 1024.f) + EPS);
#pragma unroll
        for (int q = 0; q < 2; ++q) { const int col = q * 512 + lane * 8; const f32x4 a0 = *(const f32x4*)(a1 + col), a4 = *(const f32x4*)(a1 + col + 4), b0 = *(const f32x4*)(b1 + col), b4 = *(const f32x4*)(b1 + col + 4);
            float y[8];
#pragma unroll
            for (int j = 0; j < 4; ++j) { y[j] = xv[q][j] * rstd * a0[j] + b0[j]; y[4 + j] = xv[q][4 + j] * rstd * a4[j] + b4[j]; }
            *(u32x4*)(hbuf + (size_t)r * 1024 + col) = u32x4{cvtpk(y[0], y[1]), cvtpk(y[2], y[3]), cvtpk(y[4], y[5]), cvtpk(y[6], y[7])}; }
    }
}

DEVI u32x4 pack8(const float* p) {
    const unsigned a0 = cvtpk(p[0], p[1]), a1 = cvtpk(p[2], p[3]), b0 = cvtpk(p[4], p[5]), b1 = cvtpk(p[6], p[7]);
    auto r0 = __builtin_amdgcn_permlane32_swap(a0, b0, false, false); auto r1 = __builtin_amdgcn_permlane32_swap(a1, b1, false, false);
    return u32x4{r0[0], r1[0], r0[1], r1[1]};
}
template <int MB, int NB, class F> DEVI void for_acc_bf8(f32x16 (&acc)[MB][NB], int wm, int wn, int lane, F f) {
    const int r32 = lane & 31, hi = lane >> 5;
#pragma unroll
    for (int mb = 0; mb < MB; ++mb)
#pragma unroll
        for (int nb = 0; nb < NB; ++nb)
#pragma unroll
            for (int s = 0; s < 2; ++s) { float t[8];
#pragma unroll
                for (int j = 0; j < 8; ++j) t[j] = acc[mb][nb][8 * s + j];
                f((wm * MB + mb) * 32 + r32, (wn * NB + nb) * 32 + 16 * s + 8 * hi, pack8(t)); }
}
template <int MB, int NB, class F> DEVI void for_acc_f4(f32x16 (&acc)[MB][NB], int wm, int wn, int lane, F f) {
    const int r32 = lane & 31, hi = lane >> 5;
#pragma unroll
    for (int mb = 0; mb < MB; ++mb)
#pragma unroll
        for (int nb = 0; nb < NB; ++nb)
#pragma unroll
            for (int g = 0; g < 4; ++g) f((wm * MB + mb) * 32 + r32, (wn * NB + nb) * 32 + 8 * g + 4 * hi, f32x4{acc[mb][nb][4 * g], acc[mb][nb][4 * g + 1], acc[mb][nb][4 * g + 2], acc[mb][nb][4 * g + 3]});
}

DEVI void phase_inproj(const Params& P, const Ctx& c, int l) {
    TID_SETUP();
    const short* hbuf = (const short*)(c.ws + WS_HBUF); const short* WT = (const short*)(c.ws + WS_WIN) + (size_t)l * 1024 * 1024; short* zbuf = (short*)((char*)c.out);
    for (int u = c.vcu; u < 64; u += c.G) {
        const int rt = u >> 3, ct = u & 7; const int row0 = rt * 64, col0 = ct * 128;
        gemm_tile<1, 1, 2, 4, false, true>(c.lds + LDS_GEMM, 16,
            [&](int r) { return hbuf + (size_t)(row0 + r) * 1024; },
            [&](int n) { return WT + (size_t)(col0 + n) * 1024; },
            [&](f32x16 (&acc)[1][1], int wm, int wn) {
                for_acc_bf8<1, 1>(acc, wm, wn, lane, [&](int r, int cc, u32x4 v) { const int col = col0 + cc; if (col < INW) *(u32x4*)(zbuf + (size_t)(row0 + r) * ZLD + col) = v; });
            });
    }
    for (int u = c.vcu; u < 512; u += c.G) {
        const int rt = 2 + (u >> 2), ct = u & 3; const int row0 = rt * 256, col0 = ct * 256;
        __syncthreads();
        gemm256<false, 1>(c.lds + LDS_GEMM, 16, hbuf + (size_t)row0 * 1024, 1024, nullptr, WT + (size_t)col0 * 1024, 1024, 0, nullptr,
            [&](g8_acc& acc, int wr, int wc, int fr, int fq) {
                g8_for_acc8(acc, wr, wc, fr, fq, [&](int r, int cc, const float (&v)[8]) { const int col = col0 + cc;
                    if (col < INW) *(u32x4*)(zbuf + (size_t)(row0 + r) * ZLD + col) = u32x4{cvtpk(v[0], v[1]), cvtpk(v[2], v[3]), cvtpk(v[4], v[5]), cvtpk(v[6], v[7])}; });
            });
    }
}

template <int NCOL, int NTOK = 128> DEVI void tile_rowstat(const Ctx& c, int tid, int tok0, int col0, float* stat) {
    const short* zbuf = (const short*)((char*)c.out);
    constexpr int TPT = NTHR / NTOK, per = NCOL / TPT;
    const int t = tid / TPT, q = tid % TPT;
    const short* p = zbuf + (size_t)(tok0 + t) * ZLD + col0 + q * per;
    u32x4 w[per / 8];
#pragma unroll
    for (int i = 0; i < per / 8; ++i) w[i] = *(const u32x4*)(p + i * 8);
    float ss = 0;
#pragma unroll
    for (int i = 0; i < per / 8; ++i)
#pragma unroll
        for (int j = 0; j < 4; ++j) { const float a = bflo(w[i][j]), b = bfhi(w[i][j]); ss += a * a + b * b; }
    ss += __shfl_xor(ss, 1, 64); if constexpr (TPT == 4) ss += __shfl_xor(ss, 2, 64);
    if (q == 0) stat[t] = ss / (float)NCOL;
}
DEVI float half_sum(float v) { auto rr = __builtin_amdgcn_permlane32_swap(__float_as_uint(v), __float_as_uint(v), false, false); return __uint_as_float(rr[0]) + __uint_as_float(rr[1]); }

DEVI void rope16(float (&x)[16], int n, bool lat, int hi, const float2* ropetab) {
    if (!lat) return;
    const int prow = n >> 6, pcol = n & 63;
#pragma unroll
    for (int j = 0; j < 4; ++j) {
        const int i = j + 4 * hi;
        const float2 cr = ropetab[prow * 8 + i], cc = ropetab[pcol * 8 + i];
        const float a1 = x[j], a2 = x[j + 4]; x[j] = a1 * cr.x - a2 * cr.y; x[j + 4] = a2 * cr.x + a1 * cr.y;
        const float b1 = x[8 + j], b2 = x[12 + j]; x[8 + j] = b1 * cc.x - b2 * cc.y; x[12 + j] = b2 * cc.x + b1 * cc.y;
    }
}

template <int NB> DEVI void pc_q_unit(const Params& P, const Ctx& c, int l, int tok0, int hp, int tid, int lane) {
    const short* zbuf = (const short*)((char*)c.out);
    float* stat = (float*)(c.lds + LDS_STAT);
    const float2* ropetab = (const float2*)(c.ws + WS_ROPE);
    tile_rowstat<QLR, 128 * NB>(c, tid, tok0, 0, stat);
    const short* WQT = (const short*)(c.ws + WS_WQT) + ((size_t)l * 768 + hp * 192) * 256;
    const float* qn = P.in[13] + l * DQK;
    gemm_tile<3, NB, 2, 4, false, false>(c.lds + LDS_GEMM, 4,
        [&](int r) { return WQT + (size_t)r * 256; },
        [&](int n) { return zbuf + (size_t)(tok0 + n) * ZLD; },
        [&](f32x16 (&acc)[3][NB], int wm, int wn) {
#pragma unroll
            for (int nb = 0; nb < NB; ++nb) {
                const int hi = lane >> 5, r32 = lane & 31; const int tl = (wn * NB + nb) * 32 + r32, row = tok0 + tl, h = hp * 2 + wm;
                const bool lat = row >= T_CTX; const int rr = lat ? row - T_CTX : row; const int b = lat ? (rr >> 14) : (rr >> 8); const int n = lat ? (rr & 16383) : (rr & 255);
                const float s1 = rsqrtf(stat[tl] + EPS);
                float ss = 0;
#pragma unroll
                for (int mb = 0; mb < 3; ++mb)
#pragma unroll
                    for (int r = 0; r < 16; ++r) ss += acc[mb][nb][r] * acc[mb][nb][r];
                ss = half_sum(ss);
                const float s2 = rsqrtf(s1 * s1 * ss * (1.f / 96.f) + EPS); const float sc = s1 * s2 * ATT_QSCALE;
                float x[3][16];
#pragma unroll
                for (int mb = 0; mb < 3; ++mb)
#pragma unroll
                    for (int g4 = 0; g4 < 4; ++g4) { const f32x4 g = *(const f32x4*)(qn + mb * 32 + 8 * g4 + 4 * hi);
#pragma unroll
                        for (int j = 0; j < 4; ++j) x[mb][g4 * 4 + j] = acc[mb][nb][g4 * 4 + j] * sc * g[j]; }
                rope16(x[2], n, lat, hi, ropetab);
                short* dst = lat ? (short*)(c.ws + WS_QBUF) + ((size_t)(b * NH + h) * SEQ + n) * DQK : (short*)(c.ws + WS_QCTX) + ((size_t)(b * NH + h) * NCTX + n) * DQK;
#pragma unroll
                for (int mb = 0; mb < 3; ++mb)
#pragma unroll
                    for (int s = 0; s < 2; ++s) *(u32x4*)(dst + mb * 32 + s * 16 + hi * 8) = pack8(&x[mb][s * 8]);
            }
        });
}

template <int NB> DEVI void pc_kv_unit(const Params& P, const Ctx& c, int l, int tok0, int hp, int tid, int lane) {
    const short* zbuf = (const short*)((char*)c.out);
    float* stat = (float*)(c.lds + LDS_STAT);
    const float2* ropetab = (const float2*)(c.ws + WS_ROPE);
    tile_rowstat<KVLR, 128 * NB>(c, tid, tok0, QLR, stat);
    const short* WKVT = (const short*)(c.ws + WS_WKVT) + ((size_t)l * 1024 + hp * 256) * 128;
    const float* kn = P.in[14] + l * DQK;
    gemm_tile<4, NB, 2, 4, false, false, (NB == 1 ? 2 : 1)>(c.lds + LDS_GEMM, 2,
        [&](int r) { return WKVT + (size_t)r * 128; },
        [&](int n) { return zbuf + (size_t)(tok0 + n) * ZLD + QLR; },
        [&](f32x16 (&acc)[4][NB], int wm, int wn) {
#pragma unroll
            for (int nb = 0; nb < NB; ++nb) {
                const int hi = lane >> 5, r32 = lane & 31; const int tl = (wn * NB + nb) * 32 + r32, row = tok0 + tl, h = hp * 2 + wm;
                const bool lat = row >= T_CTX; const int rr = lat ? row - T_CTX : row; const int b = lat ? (rr >> 14) : (rr >> 8); const int n = lat ? (rr & 16383) : (rr & 255);
                const int pos = lat ? NCTX + n : n;
                const float s1 = rsqrtf(stat[tl] + EPS);
                float kr[16];
#pragma unroll
                for (int g4 = 0; g4 < 4; ++g4) { const u32x2 w = *(const u32x2*)(zbuf + (size_t)row * ZLD + QLR + KVLR + 8 * g4 + 4 * hi);
                    kr[g4 * 4 + 0] = bflo(w[0]); kr[g4 * 4 + 1] = bfhi(w[0]); kr[g4 * 4 + 2] = bflo(w[1]); kr[g4 * 4 + 3] = bfhi(w[1]); }
                float ss = 0;
#pragma unroll
                for (int mb = 0; mb < 2; ++mb)
#pragma unroll
                    for (int r = 0; r < 16; ++r) { const float t = acc[mb][nb][r] * s1; ss += t * t; }
#pragma unroll
                for (int r = 0; r < 16; ++r) ss += kr[r] * kr[r];
                ss = half_sum(ss);
                const float s2 = rsqrtf(ss * (1.f / 96.f) + EPS);
                float x[3][16];
#pragma unroll
                for (int mb = 0; mb < 3; ++mb)
#pragma unroll
                    for (int g4 = 0; g4 < 4; ++g4) { const f32x4 g = *(const f32x4*)(kn + mb * 32 + 8 * g4 + 4 * hi);
#pragma unroll
                        for (int j = 0; j < 4; ++j) x[mb][g4 * 4 + j] = (mb < 2 ? acc[mb][nb][g4 * 4 + j] * s1 : kr[g4 * 4 + j]) * s2 * g[j]; }
                rope16(x[2], n, lat, hi, ropetab);
                short* kd = (short*)(c.ws + WS_KBUF) + ((size_t)(b * NH + h) * NKEY + pos) * DQK;
#pragma unroll
                for (int mb = 0; mb < 3; ++mb)
#pragma unroll
                    for (int s = 0; s < 2; ++s) *(u32x4*)(kd + mb * 32 + s * 16 + hi * 8) = pack8(&x[mb][s * 8]);
                short* vd = (short*)(c.ws + WS_VBUF) + ((size_t)(b * NH + h) * NKEY + pos) * DV;
                float vv[2][16];
#pragma unroll
                for (int mb = 0; mb < 2; ++mb)
#pragma unroll
                    for (int r = 0; r < 16; ++r) vv[mb][r] = acc[2 + mb][nb][r] * s1;
#pragma unroll
                for (int mb = 0; mb < 2; ++mb)
#pragma unroll
                    for (int s = 0; s < 2; ++s) *(u32x4*)(vd + mb * 32 + s * 16 + hi * 8) = pack8(&vv[mb][s * 8]);
            }
        });
}

DEVI void phase_proj2(const Params& P, const Ctx& c, int l) {
    TID_SETUP();
    const short* zbuf = (const short*)((char*)c.out);
    for (int u = c.vcu + PC_U0; u < (l < DEPTH - 1 ? 1072 : 1056); u += c.G) {
        __syncthreads();
        if (u < 512) pc_q_unit<2>(P, c, l, T_CTX + (u >> 2) * 256, u & 3, tid, lane);
        else if (u < 1024) pc_kv_unit<2>(P, c, l, T_CTX + ((u - 512) >> 2) * 256, u & 3, tid, lane);
        else if (u < 1040) pc_q_unit<1>(P, c, l, ((u - 1024) >> 2) * 128, u & 3, tid, lane);
        else if (u < 1056) pc_kv_unit<1>(P, c, l, ((u - 1040) >> 2) * 128, u & 3, tid, lane);
        else {
            const int uu = u - 1056; const int rt = uu >> 3, g = (uu >> 1) & 3, ct = uu & 1; const int row0 = rt * 256;
            const short* W = (const short*)(c.ws + WS_WCS) + ((size_t)(l * 4 + g) * 128) * 256 + ct * 128; short* U = (short*)(c.ws + WS_UCTX);
            gemm_tile<2, 2, 4, 2, true, true>(c.lds + LDS_GEMM, 2,
                [&](int r) { return zbuf + (size_t)(row0 + r) * ZLD + 416 + g * 128; },
                [&](int k) { return W + (size_t)k * 256; },
                [&](f32x16 (&acc)[2][2], int wm, int wn) {
                    for_acc_bf8<2, 2>(acc, wm, wn, lane, [&](int r, int cc, u32x4 v) { *(u32x4*)(U + (size_t)(row0 + r) * 1024 + g * 256 + ct * 128 + cc) = v; });
                });
        }
    }
}

constexpr int AT_VB = 64 * 64 * 2, AT_KB = 64 * 256, AT_V = 0, AT_K = 3 * AT_VB, AT_WS = AT_K + 3 * AT_KB;
#define KSWZ(row, colB) ((row) * 256 + ((colB) ^ (((row) & 15) << 4)))

DEVI void att_exp16(f32x16& p, float& l) {
#pragma unroll
    for (int r = 0; r < 16; ++r) { p[r] = __builtin_amdgcn_exp2f(p[r]); l += p[r]; }
}
DEVI void att_pack(const f32x16& p0, const f32x16& p1, bf16x8& pa0, bf16x8& pa1, bf16x8& pa2, bf16x8& pa3) {
#define PK4(P, BASE, OUT) do { u32x4 w = {cvtpk(P[BASE + 0], P[BASE + 1]), cvtpk(P[BASE + 2], P[BASE + 3]), cvtpk(P[BASE + 4], P[BASE + 5]), cvtpk(P[BASE + 6], P[BASE + 7])}; \
    OUT = *reinterpret_cast<bf16x8*>(&w); } while (0)
    PK4(p0, 0, pa0); PK4(p0, 8, pa1); PK4(p1, 0, pa2); PK4(p1, 8, pa3);
#undef PK4
}
template <bool SHIFT> DEVI void att_qkt(f32x16& p0, f32x16& p1, const char* Ks, const bf16x8* qr, int r32, int hi, float init) {
    if constexpr (SHIFT) {
#pragma unroll
        for (int r = 0; r < 16; ++r) { p0[r] = init; p1[r] = init; }
    } else { p0 = f32x16{}; p1 = f32x16{}; }
    bf16x8 b0 = *reinterpret_cast<const bf16x8*>(Ks + KSWZ(r32, hi * 16));
    bf16x8 b1 = *reinterpret_cast<const bf16x8*>(Ks + KSWZ(32 + r32, hi * 16));
#pragma unroll
    for (int d0 = 0; d0 < 6; ++d0) {
        bf16x8 n0 = b0, n1 = b1;
        if (d0 < 5) { const int cb = ((d0 + 1) * 16 + hi * 8) * 2;
            n0 = *reinterpret_cast<const bf16x8*>(Ks + KSWZ(r32, cb)); n1 = *reinterpret_cast<const bf16x8*>(Ks + KSWZ(32 + r32, cb)); }
        p0 = __builtin_amdgcn_mfma_f32_32x32x16_bf16(b0, qr[d0], p0, 0, 0, 0);
        p1 = __builtin_amdgcn_mfma_f32_32x32x16_bf16(b1, qr[d0], p1, 0, 0, 0);
        b0 = n0; b1 = n1; }
}
constexpr int att_v_off(int d0, int ks, int half) { return d0 * 512 + ks * 2048 + half * 1024; }
struct VFrag { s16x4 l0, h0, l1, h1, l2, h2, l3, h3; };
template <int D0> DEVI void att_vread(VFrag& f, int vb) {
    f.l0 = tr_read<att_v_off(D0, 0, 0)>(vb); f.h0 = tr_read<att_v_off(D0, 0, 1)>(vb); f.l1 = tr_read<att_v_off(D0, 1, 0)>(vb); f.h1 = tr_read<att_v_off(D0, 1, 1)>(vb);
    f.l2 = tr_read<att_v_off(D0, 2, 0)>(vb); f.h2 = tr_read<att_v_off(D0, 2, 1)>(vb); f.l3 = tr_read<att_v_off(D0, 3, 0)>(vb); f.h3 = tr_read<att_v_off(D0, 3, 1)>(vb);
}
DEVI void att_pv_mm(f32x16& od, const VFrag& f, bf16x8 pa0, bf16x8 pa1, bf16x8 pa2, bf16x8 pa3) {
    od = __builtin_amdgcn_mfma_f32_32x32x16_bf16(PK8(f.l0, f.h0), pa0, od, 0, 0, 0);
    od = __builtin_amdgcn_mfma_f32_32x32x16_bf16(PK8(f.l1, f.h1), pa1, od, 0, 0, 0);
    od = __builtin_amdgcn_mfma_f32_32x32x16_bf16(PK8(f.l2, f.h2), pa2, od, 0, 0, 0);
    od = __builtin_amdgcn_mfma_f32_32x32x16_bf16(PK8(f.l3, f.h3), pa3, od, 0, 0, 0);
}
DEVI void att_lsum(f32x16& l, bf16x8 pa, bf16x8 pb) {
    const bf16x8 ones = {(short)0x3F80, (short)0x3F80, (short)0x3F80, (short)0x3F80, (short)0x3F80, (short)0x3F80, (short)0x3F80, (short)0x3F80};
    l = __builtin_amdgcn_mfma_f32_32x32x16_bf16(pa, ones, l, 0, 0, 0);
    l = __builtin_amdgcn_mfma_f32_32x32x16_bf16(pb, ones, l, 0, 0, 0);
}

template <bool SHIFT> DEVI void attn_body(const short* __restrict__ Qb, const short* __restrict__ Kh, const short* __restrict__ Vh, short* __restrict__ Ob, int seq, float shift, char* lds) {
    int tid = threadIdx.x; asm volatile("" : "+v"(tid)); const int wid = __builtin_amdgcn_readfirstlane(tid >> 6), lane = tid & 63, r32 = lane & 31, hi = lane >> 5;
    char* V_lds = lds + AT_V; char* K_lds = lds + AT_K;
    if (wid >= 4) __builtin_amdgcn_s_setprio(1);
    f32x16 o[2] = {f32x16{}, f32x16{}}; float l_reg = 0.f; bf16x8 qr[6];
    const short* Qw = Qb + (size_t)(wid * 32 + r32) * DQK + hi * 8;
#pragma unroll
    for (int d0 = 0; d0 < 6; ++d0) qr[d0] = *(const bf16x8*)(Qw + d0 * 16);
    const int kc0 = tid, kc1 = (tid + 512 < 768) ? tid + 512 : 767;
    const int kst0 = KSWZ(kc0 / 12, (kc0 % 12) * 16), kst1 = KSWZ(kc1 / 12, (kc1 % 12) * 16);
    const int vkey = tid >> 3, vcol = (tid & 7) * 8;
    const int vkk = vkey;
    const int vst = ((vkk >> 3) * 2 + (vcol >> 5)) * 512 + ((vkk & 7) * 32 + (vcol & 31)) * 2;
    const int vb0 = (int)(uintptr_t)V_lds + nn_rd_base(lane);
    struct { bf16x8 vs, k0, k1; } sr_;
    const int NT = seq / 64; const float init = -shift;
#define SLOAD(t) do { const int tt_ = (t) < NT ? (t) : NT - 1; sr_.vs = *(const bf16x8*)(Vh + (size_t)tt_ * 64 * DV + tid * 8); \
    sr_.k0 = *(const bf16x8*)(Kh + (size_t)tt_ * 64 * DQK + kc0 * 8); sr_.k1 = *(const bf16x8*)(Kh + (size_t)tt_ * 64 * DQK + kc1 * 8); } while (0)
#define SWRITE(b) do { *(bf16x8*)(V_lds + (b) * AT_VB + vst) = sr_.vs; *(bf16x8*)(K_lds + (b) * AT_KB + kst0) = sr_.k0; *(bf16x8*)(K_lds + (b) * AT_KB + kst1) = sr_.k1; } while (0)
    f32x16 pA0, pA1, pB0, pB1; bf16x8 pa0, pa1, pa2, pa3; VFrag vf, vf1;
#define STEP(PC0, PC1, PP0, PP1, TNEXT2, DOWRITE) do {                                                            \
        int bn = bc + 1; if (bn == 3) bn = 0;                                                                      \
        if (DOWRITE) SWRITE(bn);                                                                                   \
        SBAR(); SLOAD(TNEXT2);                                                                                     \
        SBAR(); att_vread<0>(vf, vb0 + bp * AT_VB); att_vread<1>(vf1, vb0 + bp * AT_VB);                           \
        att_qkt<SHIFT>(PC0, PC1, K_lds + bc * AT_KB, qr, r32, hi, init);                                           \
        att_exp16(PP1, l_reg); att_pack(PP0, PP1, pa0, pa1, pa2, pa3); SBAR();                                     \
        asm volatile("s_waitcnt lgkmcnt(0)" ::: "memory"); SBAR();                                                 \
        att_pv_mm(o[0], vf, pa0, pa1, pa2, pa3); att_pv_mm(o[1], vf1, pa0, pa1, pa2, pa3);                         \
        att_exp16(PC0, l_reg);                                                                                     \
        __syncthreads();                                                                                           \
        bp = bc; bc = bn; } while (0)
    SLOAD(0); asm volatile("s_waitcnt vmcnt(0)" ::: "memory"); SWRITE(0); SBAR(); SLOAD(1); __syncthreads();
    SWRITE(1); SBAR(); SLOAD(2); SBAR();
    att_qkt<SHIFT>(pA0, pA1, K_lds, qr, r32, hi, init); att_exp16(pA0, l_reg);
    __syncthreads();
    int bc = 1, bp = 0;
    for (int j = 1; j + 1 < NT; j += 2) {
        STEP(pB0, pB1, pA0, pA1, j + 2, true);
        STEP(pA0, pA1, pB0, pB1, j + 3, (j + 2 < NT));
    }
    STEP(pB0, pB1, pA0, pA1, NT - 1, false);
    att_vread<0>(vf, vb0 + bp * AT_VB);
    att_exp16(pB1, l_reg); att_pack(pB0, pB1, pa0, pa1, pa2, pa3); SBAR();
    asm volatile("s_waitcnt lgkmcnt(0)" ::: "memory"); SBAR();
    att_pv_mm(o[0], vf, pa0, pa1, pa2, pa3); att_vread<1>(vf, vb0 + bp * AT_VB); SBAR();
    asm volatile("s_waitcnt lgkmcnt(0)" ::: "memory"); SBAR();
    att_pv_mm(o[1], vf, pa0, pa1, pa2, pa3);
    __builtin_amdgcn_s_setprio(0);
    { auto rr = __builtin_amdgcn_permlane32_swap(__float_as_uint(l_reg), __float_as_uint(l_reg), false, false); l_reg = __uint_as_float(rr[0]) + __uint_as_float(rr[1]); }
    const float rl = __builtin_amdgcn_rcpf(l_reg);
    short* Orow = Ob + (size_t)(wid * 32 + r32) * 1024;
#pragma unroll
    for (int d0 = 0; d0 < 2; ++d0)
#pragma unroll
        for (int s = 0; s < 2; ++s) { float t[8];
#pragma unroll
            for (int j = 0; j < 8; ++j) t[j] = o[d0][8 * s + j] * rl;
            *(u32x4*)(Orow + d0 * 32 + 16 * s + 8 * hi) = pack8(t); }
    __syncthreads();
#undef SLOAD
#undef SWRITE
#undef STEP
}

DEVI void phase_attn_fft1(const Params& P, const Ctx& c, int l) {
    TID_SETUP();
    short* mix = (short*)(c.ws + WS_HBUF);
    const short* qb = (const short*)(c.ws + WS_QBUF); const short* qc = (const short*)(c.ws + WS_QCTX);
    const short* kb = (const short*)(c.ws + WS_KBUF); const short* vb = (const short*)(c.ws + WS_VBUF);
    const int n_att = (l < DEPTH - 1) ? 1040 : 1024;
    float shift;
    { float mq = 0.f, mk = 0.f;
      for (int i = lane; i < DQK; i += 64) { mq = fmaxf(mq, fabsf(P.in[13][l * DQK + i])); mk = fmaxf(mk, fabsf(P.in[14][l * DQK + i])); }
#pragma unroll
      for (int o = 32; o > 0; o >>= 1) { mq = fmaxf(mq, __shfl_xor(mq, o, 64)); mk = fmaxf(mk, __shfl_xor(mk, o, 64)); }
      shift = 9.797958971132712f * 1.4426950408889634f * mq * mk * 1.0001f; }
    for (int u = c.vcu; u < n_att; u += c.G) {
        const short* Qp; short* Op; int bh, seq;
        if (u < 1024) {
            const int rnd = u >> 8, v = u & 255, xcd = v >> 5, j = v & 31; bh = xcd * 2 + (rnd >> 1); const int qblk = j + 32 * (rnd & 1);
            Qp = qb + ((size_t)bh * SEQ + qblk * 256) * DQK; Op = mix + (size_t)(T_CTX + (bh >> 3) * SEQ + qblk * 256) * 1024 + (bh & 7) * DV; seq = NKEY;
        } else {
            bh = u - 1024; Qp = qc + (size_t)bh * NCTX * DQK; Op = mix + (size_t)((bh >> 3) * NCTX) * 1024 + (bh & 7) * DV; seq = NCTX;
        }
        if (shift < 64.f) attn_body<false>(Qp, kb + (size_t)bh * NKEY * DQK, vb + (size_t)bh * NKEY * DV, Op, seq, shift, c.lds + LDS_GEMM);
        else attn_body<true>(Qp, kb + (size_t)bh * NKEY * DQK, vb + (size_t)bh * NKEY * DV, Op, seq, shift, c.lds + LDS_GEMM);
    }
#ifndef ATT_ONLY
    const short* zbuf = (const short*)((char*)c.out); const short* F1 = (const short*)(c.ws + WS_F1); short* P1 = (short*)(c.ws + WS_P1);
    const float2* tw = (const float2*)(c.ws + WS_TW);
    if (l < DEPTH - 1) {
        const short* FC = (const short*)(c.ws + WS_FC);
        for (int u = c.vcu; u < 8; u += c.G) {
            const int g = u & 3, b = u >> 2;
            const short* Ub = (const short*)(c.ws + WS_UCTX) + (size_t)(b * NCTX) * 1024 + g * 256;
            gemm_tile<2, 2, 4, 2, true, true>(c.lds + LDS_GEMM, 8,
                [&](int r) { return FC + (size_t)r * 512; },
                [&](int kk) { return Ub + (size_t)(kk >> 1) * 1024 + (kk & 1) * 128; },
                [&](f32x16 (&acc)[2][2], int wm, int wn) {
                    for_acc_bf8<2, 2>(acc, wm, wn, lane, [&](int r, int cc, u32x4 v) { *(u32x4*)(mix + (size_t)(b * NCTX + r) * 1024 + 512 + g * 128 + cc) = v; });
                });
        }
    }
    unsigned* wq = (unsigned*)(c.ws + WS_CTL + CTL_WQ_OFF) + l;
    volatile LAS int* qslot = (volatile LAS int*)(c.lds + LDS_MISC + 64);
    __syncthreads();
    if (tid == 0) *qslot = (int)__hip_atomic_fetch_add(wq, 1u, __ATOMIC_RELAXED, __HIP_MEMORY_SCOPE_AGENT);
    __syncthreads();
    for (int u = __builtin_amdgcn_readfirstlane(*qslot); u < 1024; ) {
        __syncthreads();
        int pre = 0; if (tid == 0) pre = (int)__hip_atomic_fetch_add(wq, 1u, __ATOMIC_RELAXED, __HIP_MEMORY_SCOPE_AGENT);
        const int n2 = u & 127, g = (u >> 7) & 3, b = u >> 9;
        const short* Zb = zbuf + (size_t)(T_CTX + b * SEQ + n2) * ZLD + 416 + g * 128;
        const short* W = (const short*)(c.ws + WS_WCS) + ((size_t)(l * 4 + g) * 128) * 256;
        short* Pb = P1 + ((size_t)(b * 4 + g) * 128 * 128 + n2) * 256;
        LAS char* Sres = (LAS char*)(c.lds + LDS_GEMM) + 65536;
        gemm_tile<1, 4, 4, 2, true, true, 1>(c.lds + LDS_GEMM, 2,
            [&](int r) { return Zb + (size_t)r * (128 * ZLD); },
            [&](int k) { return W + (size_t)k * 256; },
            [&](f32x16 (&acc)[1][4], int wm, int wn) {
                for_acc_bf8<1, 4>(acc, wm, wn, lane, [&](int n1, int cc, u32x4 v) { const int kk = 2 * n1 + (cc >> 7), cp = cc & 127;
                    *(LAS u32x4*)(Sres + (kk >> 6) * 16384 + nn_st<128>(kk & 63, cp)) = v; });
            });
        gemm_tile<2, 2, 4, 2, true, true, 2, true>(c.lds + LDS_GEMM, 4,
            [&](int r) { return F1 + (size_t)r * 256; },
            [&](int kk) { return (const short*)nullptr; },
            [&](f32x16 (&acc)[2][2], int wm, int wn) {
                const int hi = lane >> 5, r32 = lane & 31; const int k1 = wm * 32 + r32;
                const float2 t = tw[(n2 * k1) & 16383];
                short* p = Pb + (size_t)k1 * (128 * 256);
#pragma unroll
                for (int nb = 0; nb < 2; ++nb)
#pragma unroll
                    for (int s = 0; s < 2; ++s) { float yr[8], yi[8];
#pragma unroll
                        for (int j = 0; j < 8; ++j) { const float a = acc[0][nb][8 * s + j], bb = acc[1][nb][8 * s + j]; yr[j] = a * t.x + bb * t.y; yi[j] = bb * t.x - a * t.y; }
                        const int cc = (wn * 2 + nb) * 32 + 16 * s + 8 * hi;
                        *(u32x4*)(p + cc) = pack8(yr); *(u32x4*)(p + 128 + cc) = pack8(yi); }
            });
        if (tid == 0) *qslot = pre;
        __syncthreads();
        u = __builtin_amdgcn_readfirstlane(*qslot);
    }
#endif
}

DEVI void phase_fft2(const Params& P, const Ctx& c, int l) {
    TID_SETUP();
    short* mix = (short*)(c.ws + WS_HBUF); const short* P1 = (const short*)(c.ws + WS_P1); const short* F2 = (const short*)(c.ws + WS_F2);
    for (int u = c.vcu; u < 1024; u += c.G) {
        const int k1 = u & 127, g = (u >> 7) & 3, b = u >> 9;
        const short* Pb = P1 + ((size_t)(b * 4 + g) * 128 + k1) * (128 * 256);
        gemm_tile<1, 2, 4, 2, true, true>(c.lds + LDS_GEMM, 4,
            [&](int r) { return F2 + (size_t)r * 256; },
            [&](int kk) { return Pb + (size_t)kk * 128; },
            [&](f32x16 (&acc)[1][2], int wm, int wn) {
                for_acc_bf8<1, 2>(acc, wm, wn, lane, [&](int k2, int cc, u32x4 v) { *(u32x4*)(mix + (size_t)(T_CTX + b * SEQ + k1 + 128 * k2) * 1024 + 512 + g * 128 + cc) = v; });
            });
    }
}

DEVI void phase_outproj(const Params& P, const Ctx& c, int l) {
    TID_SETUP();
    const short* mix = (const short*)(c.ws + WS_HBUF); const short* WT = (const short*)(c.ws + WS_WOUT) + (size_t)l * 1024 * 1024;
    const float* coef = (const float*)(c.ws + WS_COEF) + (size_t)l * 3 * 6 * 1024;
    if (l < DEPTH - 1) for (int u = c.vcu; u < 64; u += c.G) {
        const int rt = u >> 3, ct = u & 7; const int row0 = rt * 64, col0 = ct * 128;
        const float* g1 = coef + (size_t)(2 * 6 + 2) * 1024;
        gemm_tile<1, 1, 2, 4, false, true>(c.lds + LDS_GEMM, 16,
            [&](int r) { return mix + (size_t)(row0 + r) * 1024; },
            [&](int n) { return WT + (size_t)(col0 + n) * 1024; },
            [&](f32x16 (&acc)[1][1], int wm, int wn) {
                for_acc_f4<1, 1>(acc, wm, wn, lane, [&](int r, int cc, f32x4 v) { const int row = row0 + r, col = col0 + cc;
                    const f32x4 x = res_load4(P, c, row, col, l), g = *(const f32x4*)(g1 + col);
                    st_bf4(res_row(c, row) + col, f32x4{x[0] + g[0] * v[0], x[1] + g[1] * v[1], x[2] + g[2] * v[2], x[3] + g[3] * v[3]}); });
            });
    }
    for (int u = c.vcu; u < 512; u += c.G) {
        const int rt = 2 + (u >> 2), ct = u & 3; const int row0 = rt * 256, col0 = ct * 256;
        const float* g1 = coef + (size_t)(row_variant(row0) * 6 + 2) * 1024;
        __syncthreads();
        gemm256<false, 1>(c.lds + LDS_GEMM, 16, mix + (size_t)row0 * 1024, 1024, nullptr, WT + (size_t)col0 * 1024, 1024, 0, nullptr,
            [&](g8_acc& acc, int wr, int wc, int fr, int fq) {
                g8_for_acc8(acc, wr, wc, fr, fq, [&](int r, int cc, const float (&v)[8]) { const int row = row0 + r, col = col0 + cc;
                    float x[8]; res_load8(P, c, row, col, l, x); const f32x4 g0 = *(const f32x4*)(g1 + col), g4 = *(const f32x4*)(g1 + col + 4);
#pragma unroll
                    for (int j = 0; j < 4; ++j) { x[j] += g0[j] * v[j]; x[4 + j] += g4[j] * v[4 + j]; }
                    *(u32x4*)(res_row(c, row) + col) = u32x4{cvtpk(x[0], x[1]), cvtpk(x[2], x[3]), cvtpk(x[4], x[5]), cvtpk(x[6], x[7])}; });
            });
    }
}

DEVI void phase_norm_route(const Params& P, const Ctx& c, int l) {
    TID_SETUP();
    const float* coef = (const float*)(c.ws + WS_COEF) + (size_t)l * 3 * 6 * 1024;
    short* hbuf = (short*)(c.ws + WS_HBUF);
    constexpr int XP = 2064;
    char* xs_hi = c.lds + LDS_GEMM; char* xs_lo = xs_hi + 16 * XP;
    int* lcnt = (int*)(c.lds + LDS_GEMM + 66560);
    int* lrow = lcnt + 64;
    float* lgt = (float*)(c.lds + LDS_GEMM + 73728);
    float* part = (float*)(c.lds + LDS_GEMM + 90112);
    const int rows_per = (T + c.G - 1) / c.G; const int r_begin = c.vcu * rows_per; const int r_lim = (l == DEPTH - 1) ? T_CTX : 0;
    int r_end = r_begin + rows_per; if (r_end > T) r_end = T;
    __syncthreads();
    if (tid < 64) lcnt[tid] = 0;
    int* rcls = (int*)(c.ws + WS_RCLS); float2* rw = (float2*)(c.ws + WS_RW);
    const int e16 = lane & 15, kq = lane >> 4;
    bf16x8 wh[4], wl[4];
#pragma unroll
    for (int s = 0; s < 4; ++s) { float v[8];
#pragma unroll
        for (int j = 0; j < 8; ++j) v[j] = P.in[17][(size_t)(128 * wid + 32 * s + 8 * kq + j) * 16 + e16];
        u32x4 h = {cvtpk(v[0], v[1]), cvtpk(v[2], v[3]), cvtpk(v[4], v[5]), cvtpk(v[6], v[7])};
        u32x4 lo = {cvtpk(v[0] - bflo(h[0]), v[1] - bfhi(h[0])), cvtpk(v[2] - bflo(h[1]), v[3] - bfhi(h[1])), cvtpk(v[4] - bflo(h[2]), v[5] - bfhi(h[2])), cvtpk(v[6] - bflo(h[3]), v[7] - bfhi(h[3]))};
        wh[s] = *reinterpret_cast<bf16x8*>(&h); wl[s] = *reinterpret_cast<bf16x8*>(&lo); }
    const int nrows = r_end - r_begin; const int nch = (nrows + 15) >> 4;
    u32x4 xn[2][2];
#pragma unroll
    for (int h = 0; h < 2; ++h) { int i = 8 * h + wid; if (i > nrows - 1) i = nrows - 1; const short* x = res_row(c, r_begin + i);
#pragma unroll
        for (int q = 0; q < 2; ++q) xn[h][q] = *(const u32x4*)(x + q * 512 + lane * 8); }
    for (int ch = 0; ch < nch; ++ch) {
#pragma unroll
        for (int h = 0; h < 2; ++h) {
            const int i = 16 * ch + 8 * h + wid; const bool valid = i < nrows; const int r = r_begin + (valid ? i : nrows - 1); const int v = row_variant(r);
            const float* a2 = coef + (size_t)(v * 6 + 3) * 1024; const float* b2 = coef + (size_t)(v * 6 + 4) * 1024;
            float xv[2][8]; float ss = 0;
#pragma unroll
            for (int q = 0; q < 2; ++q)
#pragma unroll
                for (int j = 0; j < 4; ++j) { xv[q][2 * j] = bflo(xn[h][q][j]); xv[q][2 * j + 1] = bfhi(xn[h][q][j]); ss += xv[q][2 * j] * xv[q][2 * j] + xv[q][2 * j + 1] * xv[q][2 * j + 1]; }
            if (ch + 1 < nch) { int i2 = i + 16; if (i2 > nrows - 1) i2 = nrows - 1; const short* x = res_row(c, r_begin + i2);
#pragma unroll
                for (int q = 0; q < 2; ++q) xn[h][q] = *(const u32x4*)(x + q * 512 + lane * 8); }
            ss = wave_sum(ss); const float rstd = rsqrtf(ss * (1.f / 1024.f) + EPS);
#pragma unroll
            for (int q = 0; q < 2; ++q) { const int col = q * 512 + lane * 8; const f32x4 a0 = *(const f32x4*)(a2 + col), a4 = *(const f32x4*)(a2 + col + 4), b0 = *(const f32x4*)(b2 + col), b4 = *(const f32x4*)(b2 + col + 4);
                float y[8];
#pragma unroll
                for (int j = 0; j < 4; ++j) { y[j] = xv[q][j] * rstd * a0[j] + b0[j]; y[4 + j] = xv[q][4 + j] * rstd * a4[j] + b4[j]; }
                const u32x4 o = {cvtpk(y[0], y[1]), cvtpk(y[2], y[3]), cvtpk(y[4], y[5]), cvtpk(y[6], y[7])};
                if (valid) *(u32x4*)(hbuf + (size_t)r * 1024 + col) = o;
                const u32x4 ol = {cvtpk(y[0] - bflo(o[0]), y[1] - bfhi(o[0])), cvtpk(y[2] - bflo(o[1]), y[3] - bfhi(o[1])), cvtpk(y[4] - bflo(o[2]), y[5] - bfhi(o[2])), cvtpk(y[6] - bflo(o[3]), y[7] - bfhi(o[3]))};
                *(LAS u32x4*)((LAS char*)xs_hi + (8 * h + wid) * XP + col * 2) = o; *(LAS u32x4*)((LAS char*)xs_lo + (8 * h + wid) * XP + col * 2) = ol; }
        }
        __syncthreads();
        if (ch > 0 && tid < 256) { const float* pp = part + ((ch - 1) & 1) * 2048 + tid; float sum = pp[0];
#pragma unroll
            for (int w = 1; w < 8; ++w) sum += pp[w * 256];
            lgt[(16 * (ch - 1)) * 16 + tid] = sum; }
        f32x4 acc = {0, 0, 0, 0};
#pragma unroll
        for (int s = 0; s < 4; ++s) { const int off = e16 * XP + (128 * wid + 32 * s + 8 * kq) * 2;
            const bf16x8 ah = *(LAS const bf16x8*)((LAS char*)xs_hi + off), al = *(LAS const bf16x8*)((LAS char*)xs_lo + off);
            acc = __builtin_amdgcn_mfma_f32_16x16x32_bf16(ah, wh[s], acc, 0, 0, 0);
            acc = __builtin_amdgcn_mfma_f32_16x16x32_bf16(ah, wl[s], acc, 0, 0, 0);
            acc = __builtin_amdgcn_mfma_f32_16x16x32_bf16(al, wh[s], acc, 0, 0, 0); }
        { float* pw = part + (ch & 1) * 2048 + wid * 256;
#pragma unroll
          for (int j = 0; j < 4; ++j) pw[(4 * kq + j) * 16 + e16] = acc[j]; }
        __syncthreads();
    }
    if (tid < 256) { const float* pp = part + ((nch - 1) & 1) * 2048 + tid; float sum = pp[0];
#pragma unroll
        for (int w = 1; w < 8; ++w) sum += pp[w * 256];
        lgt[(16 * (nch - 1)) * 16 + tid] = sum; }
    __syncthreads();
    for (int i = tid; i < r_end - r_begin; i += NTHR) {
        const int r = r_begin + i; if (r < r_lim) continue;
        float lg[16];
        { const f32x4 t0 = *(const f32x4*)(lgt + i * 16), t1 = *(const f32x4*)(lgt + i * 16 + 4), t2 = *(const f32x4*)(lgt + i * 16 + 8), t3 = *(const f32x4*)(lgt + i * 16 + 12);
#pragma unroll
          for (int j = 0; j < 4; ++j) { lg[j] = t0[j]; lg[4 + j] = t1[j]; lg[8 + j] = t2[j]; lg[12 + j] = t3[j]; } }
        float sc[16], bi[16];
#pragma unroll
        for (int e = 0; e < 16; ++e) { sc[e] = __builtin_amdgcn_rcpf(1.f + __expf(-lg[e])); bi[e] = sc[e] + P.in[18][e]; }
        int bg = 0; float bgs = -1e30f;
#pragma unroll
        for (int g = 0; g < 4; ++g) { float m1 = -1e30f, m2 = -1e30f;
#pragma unroll
            for (int j = 0; j < 4; ++j) { const float t = bi[g * 4 + j]; if (t > m1) { m2 = m1; m1 = t; } else if (t > m2) m2 = t; }
            const float gs = m1 + m2; if (gs > bgs) { bgs = gs; bg = g; } }
        float b4[4], s4[4];
#pragma unroll
        for (int j = 0; j < 4; ++j) { b4[j] = bg == 0 ? bi[j] : bg == 1 ? bi[4 + j] : bg == 2 ? bi[8 + j] : bi[12 + j]; s4[j] = bg == 0 ? sc[j] : bg == 1 ? sc[4 + j] : bg == 2 ? sc[8 + j] : sc[12 + j]; }
        int i1 = 0;
#pragma unroll
        for (int j = 1; j < 4; ++j) if (b4[j] > b4[i1]) i1 = j;
        int i2 = (i1 == 0) ? 1 : 0;
#pragma unroll
        for (int j = 0; j < 4; ++j) if (j != i1 && b4[j] > b4[i2]) i2 = j;
        const int ea = i1 < i2 ? i1 : i2, eb = i1 < i2 ? i2 : i1;
        float wa = 0, wb = 0;
#pragma unroll
        for (int j = 0; j < 4; ++j) { if (j == ea) wa = s4[j]; if (j == eb) wb = s4[j]; }
        const float inv = 1.f / (wa + wb);
        const int pidx = ea == 0 ? eb - 1 : ea == 1 ? eb + 1 : 5;
        const int cls = bg * 6 + pidx;
        const int lp = atomicAdd(&lcnt[cls], 1); lrow[i] = cls | (lp << 8); rcls[r] = cls; rw[r] = make_float2(wa * inv, wb * inv);
    }
    __syncthreads();
    int* gcnt = (int*)(c.ws + WS_CTL + CTL_CNT_OFF) + l * 32;
    if (tid < NCLS) lcnt[32 + tid] = lcnt[tid] > 0 ? (int)__hip_atomic_fetch_add(&gcnt[tid], lcnt[tid], __ATOMIC_RELAXED, __HIP_MEMORY_SCOPE_AGENT) : 0;
    __syncthreads();
    int* clist = (int*)(c.ws + WS_CLIST);
    for (int i = tid; i < r_end - r_begin; i += NTHR) { const int r = r_begin + i; if (r < r_lim) continue; const int w = lrow[i]; const int cls = w & 255, lp = w >> 8; clist[(size_t)cls * T + lcnt[32 + cls] + lp] = r; }
}

DEVI bool moe_decode(const int* gcnt, int u, int per_rt, int& cls, int& rt, int& sub, int& hpad, int& ccnt) {
    int acc_t = 0, acc_h = 0;
    for (int cc = 0; cc < NCLS; ++cc) { const int n = __builtin_amdgcn_readfirstlane(gcnt[cc]);
        const int nrt = (n + 255) >> 8; const int nt = nrt * per_rt;
        if (u < acc_t + nt) { cls = cc; const int loc = u - acc_t; rt = loc / per_rt; sub = loc % per_rt; hpad = acc_h; ccnt = n; return true; }
        acc_t += nt; acc_h += nrt * 256; }
    return false;
}
DEVI void cls_experts(int cls, int& ea, int& eb) { const int g = cls / 6, p = cls % 6; const int a = p < 3 ? 0 : p < 5 ? 1 : 2; const int b = p < 3 ? p + 1 : p < 5 ? p - 1 : 3; ea = g * 4 + a; eb = g * 4 + b; }

DEVI int moe_total(const int* gcnt, int per_rt) { int t = 0; for (int cc = 0; cc < NCLS; ++cc) { const int n = __builtin_amdgcn_readfirstlane(gcnt[cc]); t += ((n + 255) >> 8) * per_rt; } return t; }
DEVI int moe_nfull(int utot, int G) { const int nf = (utot / G) * G; return ((utot - nf) * 4 > 2 * G) ? utot : nf; }

DEVI void phase_moe_up(const Params& P, const Ctx& c, int l) {
    TID_SETUP();
    const int* gcnt = (const int*)(c.ws + WS_CTL + CTL_CNT_OFF) + l * 32;
    const short* hbuf = (const short*)(c.ws + WS_HBUF); short* Hm = (short*)(c.ws + WS_KBUF);
    const int* clist = (const int*)(c.ws + WS_CLIST); const float2* rw = (const float2*)(c.ws + WS_RW);
    int* ltok = (int*)(c.lds + LDS_STAT); float* lw = (float*)(c.lds + LDS_STAT + 1024);
    const int utot = moe_total(gcnt, 4), nfull = moe_nfull(utot, c.G);
    for (int it = c.vcu; it < nfull + (utot - nfull) * 4; it += c.G) {
        const bool fast = it < nfull; const int u = fast ? it : nfull + ((it - nfull) >> 2); const int q = (it - nfull) & 3;
        int cls, rt, ct, hpad, ccnt; if (!moe_decode(gcnt, u, 4, cls, rt, ct, hpad, ccnt)) break;
        int ea, eb; cls_experts(cls, ea, eb); const int e = ct < 2 ? ea : eb;
        __syncthreads();
        { int t2 = threadIdx.x; asm volatile("" : "+v"(t2));
          if (t2 < 256) { int i = rt * 256 + t2; if (i > ccnt - 1) i = ccnt - 1; const int tok = clist[(size_t)cls * T + i]; ltok[t2] = tok; const float2 w = rw[tok]; lw[t2] = ct < 2 ? w.x : w.y; } }
        asm volatile("s_waitcnt vmcnt(0)" ::: "memory");
        __syncthreads();
        const short* WT = (const short*)(c.ws + WS_WGU) + ((size_t)(l * 16 + e) * 512 + (ct & 1) * 256) * 1024;
        short* Hrow = Hm + (size_t)(hpad + rt * 256) * 512 + (ct >> 1) * 256;
        if (fast) {
            gemm256<true, 1>(c.lds + LDS_GEMM, 16, hbuf, 1024, ltok, WT, 1024, 0, nullptr,
                [&](g8_acc& acc, int wr, int wc, int fr, int fq) {
#pragma unroll
                    for (int ai = 0; ai < 2; ++ai)
#pragma unroll
                        for (int m = 0; m < 4; ++m) { SBAR(); const int row = ai * 128 + wr * 64 + m * 16 + fr; const float w = lw[row];
                            unsigned pk[2][2];
#pragma unroll
                            for (int bj = 0; bj < 2; ++bj) { const f32x4 g = acc[ai][bj][m][0], uu = acc[ai][bj][m][1]; float hv[4];
#pragma unroll
                                for (int j = 0; j < 4; ++j) hv[j] = silu(g[j]) * uu[j] * w;
                                pk[bj][0] = cvtpk(hv[0], hv[1]); pk[bj][1] = cvtpk(hv[2], hv[3]); }
                            auto r0 = __builtin_amdgcn_permlane16_swap(pk[0][0], pk[1][0], false, false); auto r1 = __builtin_amdgcn_permlane16_swap(pk[0][1], pk[1][1], false, false);
                            *(u32x4*)(Hrow + (size_t)row * 512 + ((ct & 1) * 8 + (fq & 1) * 4 + wc) * 16 + (fq & ~1) * 4) = u32x4{r0[0], r1[0], r0[1], r1[1]}; }
                });
        } else {
            gemm_tile<1, 2, 8, 1, false, true>(c.lds + LDS_GEMM, 16,
                [&](int r) { return hbuf + (size_t)ltok[r] * 1024; },
                [&](int n) { return WT + (size_t)(q * 64 + n) * 1024; },
                [&](f32x16 (&acc)[1][2], int wm, int wn) {
                    const int hi = lane >> 5, r32 = lane & 31; const int row = wm * 32 + r32; const float w = lw[row];
#pragma unroll
                    for (int nb = 0; nb < 2; ++nb)
#pragma unroll
                        for (int s = 0; s < 2; ++s) { float hv[4];
#pragma unroll
                            for (int j = 0; j < 4; ++j) hv[j] = silu(acc[0][nb][4 * s + j]) * acc[0][nb][8 + 4 * s + j] * w;
                            *(u32x2*)(Hrow + (size_t)row * 512 + ((ct & 1) * 8 + q * 2 + nb) * 16 + 8 * s + 4 * hi) = u32x2{cvtpk(hv[0], hv[1]), cvtpk(hv[2], hv[3])}; }
                });
        }
    }
}
DEVI void phase_moe_down(const Params& P, const Ctx& c, int l) {
    TID_SETUP();
    const int* gcnt = (const int*)(c.ws + WS_CTL + CTL_CNT_OFF) + l * 32;
    const short* Hm = (const short*)(c.ws + WS_KBUF);
    const int* clist = (const int*)(c.ws + WS_CLIST);
    const float* coef = (const float*)(c.ws + WS_COEF) + (size_t)l * 3 * 6 * 1024;
    unsigned long long* lrp = (unsigned long long*)(c.lds + LDS_STAT);
    const int utot = moe_total(gcnt, 4), nfull = moe_nfull(utot, c.G);
    for (int it = c.vcu; it < nfull + (utot - nfull) * 4; it += c.G) {
        const bool fast = it < nfull; const int u = fast ? it : nfull + ((it - nfull) >> 2); const int q = (it - nfull) & 3;
        int cls, rt, ct, hpad, ccnt; if (!moe_decode(gcnt, u, 4, cls, rt, ct, hpad, ccnt)) break;
        __syncthreads();
        { int t2 = threadIdx.x; asm volatile("" : "+v"(t2));
          if (t2 < 256) { int i = rt * 256 + t2; if (i > ccnt - 1) i = ccnt - 1; const int tok = clist[(size_t)cls * T + i]; lrp[t2] = (unsigned long long)(uintptr_t)res_row(c, tok) | (unsigned long long)row_variant(tok); } }
        asm volatile("s_waitcnt vmcnt(0)" ::: "memory");
        __syncthreads();
        const short* WT = (const short*)(c.ws + WS_WDN) + ((size_t)(l * NCLS + cls) * 1024 + ct * 256) * 512;
        const short* Ab = Hm + (size_t)(hpad + rt * 256) * 512;
        auto rmw = [&](int rl, int col, f32x4 v) { const int i = rt * 256 + rl;
            if (i < ccnt) { const unsigned long long pv = lrp[rl]; short* xr = (short*)(uintptr_t)(pv & ~3ull) + col; const f32x4 g = *(const f32x4*)(coef + (size_t)((int)(pv & 3ull) * 6 + 5) * 1024 + col);
                const f32x4 x = ld_bf4(xr); const f32x4 y = f32x4{x[0] + g[0] * v[0], x[1] + g[1] * v[1], x[2] + g[2] * v[2], x[3] + g[3] * v[3]};
                if (l < DEPTH - 1) st_bf4(xr, y);
                else *(f32x4*)((char*)c.out + (((size_t)(uintptr_t)xr - (size_t)(uintptr_t)(c.ws + WS_RES)) - (size_t)T_CTX * D * 2) * 2) = y; } };
        if (fast) {
            gemm256<false, 1>(c.lds + LDS_GEMM, 8, Ab, 512, nullptr, WT, 512, 0, nullptr,
                [&](g8_acc& acc, int wr, int wc, int fr, int fq) { g8_for_acc8(acc, wr, wc, fr, fq, [&](int rl, int cc, const float (&v)[8]) { const int col = ct * 256 + cc; const int i = rt * 256 + rl;
                    if (i < ccnt) { const unsigned long long pv = lrp[rl]; short* xr = (short*)(uintptr_t)(pv & ~3ull) + col; const float* gp = coef + (size_t)((int)(pv & 3ull) * 6 + 5) * 1024 + col;
                        const f32x4 g0 = *(const f32x4*)gp, g4 = *(const f32x4*)(gp + 4); const u32x4 w = *(const u32x4*)xr; float y[8];
#pragma unroll
                        for (int j = 0; j < 4; ++j) { y[2 * j] = bflo(w[j]); y[2 * j + 1] = bfhi(w[j]); }
#pragma unroll
                        for (int j = 0; j < 4; ++j) { y[j] += g0[j] * v[j]; y[4 + j] += g4[j] * v[4 + j]; }
                        if (l < DEPTH - 1) *(u32x4*)xr = u32x4{cvtpk(y[0], y[1]), cvtpk(y[2], y[3]), cvtpk(y[4], y[5]), cvtpk(y[6], y[7])};
                        else { float* op = (float*)((char*)c.out + (((size_t)(uintptr_t)xr - (size_t)(uintptr_t)(c.ws + WS_RES)) - (size_t)T_CTX * D * 2) * 2);
                            *(f32x4*)op = f32x4{y[0], y[1], y[2], y[3]}; *(f32x4*)(op + 4) = f32x4{y[4], y[5], y[6], y[7]}; } } }); });
        } else {
            gemm_tile<1, 2, 8, 1, false, true>(c.lds + LDS_GEMM, 8,
                [&](int r) { return Ab + (size_t)r * 512; },
                [&](int n) { return WT + (size_t)(q * 64 + n) * 512; },
                [&](f32x16 (&acc)[1][2], int wm, int wn) { for_acc_f4<1, 2>(acc, wm, wn, lane, [&](int rl, int cc, f32x4 v) { rmw(rl, ct * 256 + q * 64 + cc, v); }); });
        }
    }
}

__global__ void __launch_bounds__(NTHR, 2) mega_fwd(Params P) {
    extern __shared__ __attribute__((aligned(16))) char lds[];
    Ctx c;
    c.out = P.out; c.ws = P.ws; c.lds = lds; c.G = gridDim.x;
    { const int bx = blockIdx.x; c.vcu = (c.G % 8 == 0) ? (bx % 8) * (c.G / 8) + bx / 8 : bx; }
    volatile LAS unsigned* st = (volatile LAS unsigned*)(lds + LDS_MISC);
    if (threadIdx.x < 4) st[threadIdx.x] = 0u;
    __syncthreads();
    XcdBarrier bar = xcd_barrier_post((unsigned*)(P.ws + WS_CTL), st);
    int ph = 0;
#define PHASE_END() do { if (++ph >= P.nphases) return; if (ph > P.ph_lo) xcd_barrier(bar); } while (0)
    if ((PHMASK & 1) && ph >= P.ph_lo) phase_prologue(P, c); PHASE_END();
    if ((PHMASK & 2) && ph >= P.ph_lo) phase_coef(P, c); PHASE_END();
    for (int l = 0; l < DEPTH; ++l) {
        if ((PHMASK & 4) && ph >= P.ph_lo) { phase_norm_mix(P, c, l); if (REPMASK & 4) { xcd_barrier(bar); phase_norm_mix(P, c, l); } } PHASE_END();
        if ((PHMASK & 8) && ph >= P.ph_lo) { phase_inproj(P, c, l); if (REPMASK & 8) { xcd_barrier(bar); phase_inproj(P, c, l); } } PHASE_END();
        if ((PHMASK & 16) && ph >= P.ph_lo) { phase_proj2(P, c, l); if (REPMASK & 16) { xcd_barrier(bar); phase_proj2(P, c, l); } } PHASE_END();
        if ((PHMASK & 32) && ph >= P.ph_lo) { phase_attn_fft1(P, c, l); if (REPMASK & 32) { xcd_barrier(bar); phase_attn_fft1(P, c, l); } } PHASE_END();
        if ((PHMASK & 64) && ph >= P.ph_lo) { phase_fft2(P, c, l); if (REPMASK & 64) { xcd_barrier(bar); phase_fft2(P, c, l); } } PHASE_END();
        if ((PHMASK & 128) && ph >= P.ph_lo) { phase_outproj(P, c, l); if (REPMASK & 128) { xcd_barrier(bar); phase_outproj(P, c, l); } } PHASE_END();
        if ((PHMASK & 256) && ph >= P.ph_lo) { phase_norm_route(P, c, l); if (REPMASK & 256) { xcd_barrier(bar); phase_norm_route(P, c, l); } } PHASE_END();
        if ((PHMASK & 512) && ph >= P.ph_lo) { phase_moe_up(P, c, l); if (REPMASK & 512) { xcd_barrier(bar); phase_moe_up(P, c, l); } } PHASE_END();
        if ((PHMASK & 1024) && ph >= P.ph_lo) { phase_moe_down(P, c, l); if (REPMASK & 1024) { xcd_barrier(bar); phase_moe_down(P, c, l); } } PHASE_END();
    }
}


#ifdef DUMPDBG
__global__ void dump_kernel(float* out, const char* ws, int keep_out) {
    const size_t n = (size_t)T_LAT * D;
    for (size_t i = (size_t)blockIdx.x * blockDim.x + threadIdx.x; i < n; i += (size_t)gridDim.x * blockDim.x) {
        float v = keep_out ? out[i] : 0.f;
        const size_t offs[8] = {WS_HBUF, WS_ZBUF, WS_QBUF, WS_KBUF, WS_VBUF, WS_UBUF, WS_WCS, WS_WIN};
        const size_t lens[8] = {(size_t)T * 1024, (size_t)T * 1024, (size_t)BATCH * NH * SEQ * DQK, (size_t)BATCH * NH * NKEY * DQK, (size_t)BATCH * NH * NKEY * DV, (size_t)T * 1024, (size_t)4 * 4 * 128 * 256, (size_t)4 * 1024 * 1024};
#pragma unroll
        for (int b = 0; b < 8; ++b) {
            if (!((DUMPMASK >> b) & 1)) continue;
            const unsigned short u = ((const unsigned short*)(ws + offs[b]))[i % lens[b]];
            float f = __uint_as_float(((unsigned)u) << 16);
            if (!(fabsf(f) < 1e30f)) f = 777.f;
            v += f;
        }
        if (!(fabsf(v) < 1e30f)) v = 999.f;
        out[i] = v;
    }
}
#endif

#ifdef CHECKDBG
constexpr size_t WS_CHK = WS_END;
__device__ inline float blk_sum(float v, float* red) {
    for (int o = 32; o > 0; o >>= 1) v += __shfl_xor(v, o, 64);
    __syncthreads(); if ((threadIdx.x & 63) == 0) red[threadIdx.x >> 6] = v; __syncthreads();
    float t = 0; for (int i = 0; i < (int)blockDim.x / 64; ++i) t += red[i]; return t;
}
__device__ inline float blk_max(float v, float* red) {
    for (int o = 32; o > 0; o >>= 1) v = fmaxf(v, __shfl_xor(v, o, 64));
    __syncthreads(); if ((threadIdx.x & 63) == 0) red[threadIdx.x >> 6] = v; __syncthreads();
    float t = -1e30f; for (int i = 0; i < (int)blockDim.x / 64; ++i) t = fmaxf(t, red[i]); return t;
}
__global__ void chk_qkv(Params P) {
    __shared__ float red[8]; __shared__ float xin[256]; __shared__ float outv[128]; __shared__ float kr[32];
    const int s = blockIdx.x, tid = threadIdx.x;
    const int row = (s * 7919 + 13) % T; const int h = s & 7;
    const short* z = (const short*)P.out + (size_t)row * ZLD;
    const bool lat = row >= T_CTX; const int rr = lat ? row - T_CTX : row; const int b = lat ? (rr >> 14) : (rr >> 8); const int n = lat ? (rr & 16383) : (rr & 255);
    float* err = (float*)(P.ws + WS_CHK);
    const float2* ropetab = (const float2*)(P.ws + WS_ROPE);
    { const float cq = bf2f((unsigned short)z[tid]); const float ms = blk_sum(cq * cq, red) / 256.f; xin[tid] = cq * rsqrtf(ms + EPS) * P.in[9][tid]; __syncthreads();
      float u = 0; if (tid < 96) for (int k = 0; k < 256; ++k) u += xin[k] * P.in[10][(size_t)k * 768 + h * 96 + tid];
      const float ms2 = blk_sum(tid < 96 ? u * u : 0.f, red) / 96.f; if (tid < 96) outv[tid] = u * rsqrtf(ms2 + EPS) * P.in[13][tid]; __syncthreads();
      float val = 0; if (tid < 96) { val = outv[tid];
        if (lat && tid >= 64) { const int m = tid - 64; const int ax = m >> 4, i = m & 7, second = (m >> 3) & 1; const int pos = ax == 0 ? (n >> 6) : (n & 63); const float2 cs = ropetab[pos * 8 + i];
            const float x1 = outv[64 + ax * 16 + i], x2 = outv[64 + ax * 16 + 8 + i]; val = second ? (x2 * cs.x + x1 * cs.y) : (x1 * cs.x - x2 * cs.y); }
        val *= ATT_QSCALE; }
      const short* qd = lat ? (const short*)(P.ws + WS_QBUF) + ((size_t)(b * NH + h) * SEQ + n) * DQK : (const short*)(P.ws + WS_QCTX) + ((size_t)(b * NH + h) * NCTX + n) * DQK;
      const float got = tid < 96 ? bf2f((unsigned short)qd[tid]) : 0.f;
      const float d2 = blk_sum(tid < 96 ? (got - val) * (got - val) : 0.f, red), r2 = blk_sum(tid < 96 ? val * val : 0.f, red);
      if (tid == 0) { atomicAdd(&err[0], d2); atomicAdd(&err[1], r2); } }
    { __syncthreads(); const float ck = tid < 128 ? bf2f((unsigned short)z[256 + tid]) : 0.f; const float ms = blk_sum(ck * ck, red) / 128.f; if (tid < 128) xin[tid] = ck * rsqrtf(ms + EPS) * P.in[11][tid];
      if (tid < 32) kr[tid] = bf2f((unsigned short)z[384 + tid]); __syncthreads();
      float u = 0; if (tid < 128) for (int k = 0; k < 128; ++k) u += xin[k] * P.in[12][(size_t)k * 1024 + h * 128 + tid];
      float sq = 0; if (tid < 64) sq = u * u; else if (tid >= 128 && tid < 160) sq = kr[tid - 128] * kr[tid - 128];
      const float ms2 = blk_sum(sq, red) / 96.f; const float rs = rsqrtf(ms2 + EPS);
      if (tid < 64) outv[tid] = u * rs * P.in[14][tid]; if (tid >= 128 && tid < 160) outv[64 + tid - 128] = kr[tid - 128] * rs * P.in[14][64 + tid - 128]; __syncthreads();
      const int pos = lat ? NCTX + n : n;
      float val = 0; if (tid < 96) { val = outv[tid];
        if (lat && tid >= 64) { const int m = tid - 64; const int ax = m >> 4, i = m & 7, second = (m >> 3) & 1; const int pp = ax == 0 ? (n >> 6) : (n & 63); const float2 cs = ropetab[pp * 8 + i];
            const float x1 = outv[64 + ax * 16 + i], x2 = outv[64 + ax * 16 + 8 + i]; val = second ? (x2 * cs.x + x1 * cs.y) : (x1 * cs.x - x2 * cs.y); } }
      const short* kd = (const short*)(P.ws + WS_KBUF) + ((size_t)(b * NH + h) * NKEY + pos) * DQK;
      const float gotk = tid < 96 ? bf2f((unsigned short)kd[tid]) : 0.f;
      float d2 = blk_sum(tid < 96 ? (gotk - val) * (gotk - val) : 0.f, red), r2 = blk_sum(tid < 96 ? val * val : 0.f, red);
      if (tid == 0) { atomicAdd(&err[2], d2); atomicAdd(&err[3], r2); }
      const short* vd = (const short*)(P.ws + WS_VBUF) + ((size_t)(b * NH + h) * NKEY + pos) * DV;
      const bool isv = tid >= 64 && tid < 128; const float gotv = isv ? bf2f((unsigned short)vd[tid - 64]) : 0.f; const float vv = isv ? u : 0.f;
      d2 = blk_sum((gotv - vv) * (gotv - vv), red); r2 = blk_sum(vv * vv, red);
      if (tid == 0) { atomicAdd(&err[4], d2); atomicAdd(&err[5], r2); } }
}
__global__ void chk_attn(Params P) {
    extern __shared__ float pbuf[];
    __shared__ float red[8]; __shared__ float qv[96];
    const int s = blockIdx.x, tid = threadIdx.x; const int b = s & 1, h = (s >> 1) & 7; const bool ctxq = (s % 5) == 4; const int n = ctxq ? (s * 37) % NCTX : (s * 4099 + 77) % SEQ;
    const int bh = b * NH + h; const int nk = ctxq ? NCTX : NKEY;
    const short* q = ctxq ? (const short*)(P.ws + WS_QCTX) + ((size_t)bh * NCTX + n) * DQK : (const short*)(P.ws + WS_QBUF) + ((size_t)bh * SEQ + n) * DQK;
    const short* K = (const short*)(P.ws + WS_KBUF) + (size_t)bh * NKEY * DQK; const short* V = (const short*)(P.ws + WS_VBUF) + (size_t)bh * NKEY * DV;
    if (tid < 96) qv[tid] = bf2f((unsigned short)q[tid]); __syncthreads();
    float mx = -1e30f;
    for (int k = tid; k < nk; k += blockDim.x) { float a = 0; for (int d = 0; d < 96; ++d) a += qv[d] * bf2f((unsigned short)K[(size_t)k * DQK + d]); pbuf[k] = a; mx = fmaxf(mx, a); }
    mx = blk_max(mx, red);
    float sm = 0; for (int k = tid; k < nk; k += blockDim.x) { const float p = exp2f(pbuf[k] - mx); pbuf[k] = p; sm += p; }
    sm = blk_sum(sm, red);
    float o = 0; if (tid < 64) for (int k = 0; k < nk; ++k) o += pbuf[k] * bf2f((unsigned short)V[(size_t)k * DV + tid]);
    o /= sm;
    const short* mix = (const short*)(P.ws + WS_HBUF) + (size_t)(ctxq ? b * NCTX + n : T_CTX + b * SEQ + n) * 1024 + h * DV;
    const float got = tid < 64 ? bf2f((unsigned short)mix[tid]) : 0.f; const float ov = tid < 64 ? o : 0.f;
    const float d2 = blk_sum((got - ov) * (got - ov), red), r2 = blk_sum(ov * ov, red);
    float* err = (float*)(P.ws + WS_CHK);
    if (tid == 0) { atomicAdd(&err[6], d2); atomicAdd(&err[7], r2); }
}
__global__ void chk_fixup(float* out, const char* ws) {
    const float* err = (const float*)(ws + WS_CHK);
    float e = 0.f; bool zero = false;
    for (int k = 0; k < 4; ++k) if ((CHECKSEL >> k) & 1) { e = fmaxf(e, sqrtf(err[2 * k] / fmaxf(err[2 * k + 1], 1e-30f))); zero |= (err[2 * k + 1] == 0.f); }
    float f = 1.f; if (!(e < 0.006f)) f = 1.1f; if (!(e < 0.02f)) f = 1.3f; if (!(e < 0.1f)) f = 2.f; if (zero) f = 3.f;
    if (f == 1.f) return;
    const size_t n = (size_t)T_LAT * D;
    for (size_t i = (size_t)blockIdx.x * blockDim.x + threadIdx.x; i < n; i += (size_t)gridDim.x * blockDim.x) out[i] *= f;
}
#endif
#ifndef PHMASK
#define PHMASK 0xffff
#endif
#ifndef NPHASES
#define NPHASES 1000
#endif
extern "C" void kernel_launch(void* const* d_in, const int* in_sizes, int n_in, void* d_out, int out_size, void* d_ws, size_t ws_size, hipStream_t stream) {
    static int grid = 0;
    if (grid == 0) {
        if (n_in != 22 || out_size != T_LAT * D || ws_size < WS_END) { fprintf(stderr, "kernel_launch: shape/workspace mismatch (n_in %d out %d ws %zu need %zu)\n", n_in, out_size, ws_size, (size_t)WS_END); grid = -1; return; }
        int dev = 0, cus = 0, per_cu = 0;
        if (hipGetDevice(&dev) != hipSuccess || hipDeviceGetAttribute(&cus, hipDeviceAttributeMultiprocessorCount, dev) != hipSuccess) { grid = -1; return; }
        if (hipFuncSetAttribute((const void*)mega_fwd, hipFuncAttributeMaxDynamicSharedMemorySize, LDS_BYTES) != hipSuccess) { fprintf(stderr, "kernel_launch: hipFuncSetAttribute failed\n"); grid = -1; return; }
        if (hipOccupancyMaxActiveBlocksPerMultiprocessor(&per_cu, (const void*)mega_fwd, NTHR, LDS_BYTES) != hipSuccess || per_cu < 1) { fprintf(stderr, "kernel_launch: occupancy query says %d\n", per_cu); grid = -1; return; }
        (void)hipGetLastError();
#ifdef CHECKDBG
        (void)hipFuncSetAttribute((const void*)chk_attn, hipFuncAttributeMaxDynamicSharedMemorySize, NKEY * 4);
#endif
        grid = cus;
    }
    if (grid < 0) return;
    hipMemsetAsync((char*)d_ws + WS_CTL, 0, CTL_BYTES, stream);
    Params p{};
    for (int i = 0; i < 22; ++i) p.in[i] = (const float*)d_in[i];
    p.out = (float*)d_out; p.ws = (char*)d_ws; p.nphases = NPHASES; p.ph_lo = 0;
#ifdef CHECKDBG
    hipMemsetAsync((char*)d_ws + WS_CHK, 0, 64, stream);
    p.nphases = 5; hipLaunchKernelGGL(mega_fwd, dim3(grid), dim3(NTHR), LDS_BYTES, stream, p);
    hipLaunchKernelGGL(chk_qkv, dim3(512), dim3(256), 0, stream, p);
    hipMemsetAsync((char*)d_ws + WS_CTL, 0, CTL_BYTES, stream);
    p.nphases = 6; hipLaunchKernelGGL(mega_fwd, dim3(grid), dim3(NTHR), LDS_BYTES, stream, p);
    hipLaunchKernelGGL(chk_attn, dim3(160), dim3(256), NKEY * 4, stream, p);
    hipMemsetAsync((char*)d_ws + WS_CTL, 0, CTL_BYTES, stream);
    p.nphases = NPHASES;
#endif
#ifdef SPLIT_AT
    p.nphases = SPLIT_AT;
    hipLaunchKernelGGL(mega_fwd, dim3(grid), dim3(NTHR), LDS_BYTES, stream, p);
    hipMemsetAsync((char*)d_ws + WS_CTL, 0, XCD_BAR_WORDS * 4, stream);
    p.nphases = NPHASES; p.ph_lo = SPLIT_AT;
#endif
    hipLaunchKernelGGL(mega_fwd, dim3(grid), dim3(NTHR), LDS_BYTES, stream, p);
    const hipError_t le = hipPeekAtLastError();
    if (le != hipSuccess) fprintf(stderr, "kernel_launch: launch failed: %s\n", hipGetErrorName(le));
#ifdef CHECKDBG
    hipLaunchKernelGGL(chk_fixup, dim3(2048), dim3(256), 0, stream, (float*)d_out, (const char*)d_ws);
#endif
#ifdef DUMPDBG
    hipLaunchKernelGGL(dump_kernel, dim3(2048), dim3(256), 0, stream, (float*)d_out, (const char*)d_ws, (NPHASES >= 8) ? 1 : 0);
#endif
}
```
